# Optimizing an MI355X kernel written in HIP

```python
import jax, jax.numpy as jnp
from jax import lax
import numpy as np

D_MODEL = 1024
BATCH = 8
SEQ = 2048
DEPTH = 1

MIX_WIDTH = D_MODEL
POOL_WIDTH = MIX_WIDTH // 2
POOL_WINDOWS = (2, 4, 8, 16)
POOL_GROUP = POOL_WIDTH // 4
HEAD_DIM = 64
N_Q_HEADS = (MIX_WIDTH - POOL_WIDTH) // HEAD_DIM
N_KV_HEADS = 2
Q_PER_KV = N_Q_HEADS // N_KV_HEADS
IDX_HEADS = 8
IDX_DIM = 32
TOPK_MAX = 256
Q_BLOCK = 128
ROPE_THETA = 10000.0
D_FF = 2816
CONV_WIDTH = 3
EPS = 1e-6
NEG = -1e30

IN_SPLITS = (POOL_WIDTH, N_Q_HEADS * HEAD_DIM, N_KV_HEADS * HEAD_DIM, N_KV_HEADS * HEAD_DIM,
             IDX_HEADS * IDX_DIM, IDX_DIM, IDX_HEADS)
IN_WIDTH = POOL_WIDTH + N_Q_HEADS * HEAD_DIM + 2 * N_KV_HEADS * HEAD_DIM + IDX_HEADS * IDX_DIM + IDX_DIM + IDX_HEADS

kernel_name = "hybrid_pool_dsa_convffn"


def rms_norm(x, g):
    xf = x.astype(jnp.float32)
    y = xf * lax.rsqrt(jnp.mean(xf * xf, axis=-1, keepdims=True) + EPS)
    return (y * g.astype(jnp.float32)).astype(x.dtype)


def rope(x, pos):
    d = x.shape[-1]
    half = d // 2
    inv = jnp.exp(-jnp.log(jnp.float32(ROPE_THETA)) * jnp.arange(half, dtype=jnp.float32) / half)
    ang = pos.astype(jnp.float32)[:, None] * inv[None, :]
    cos = jnp.cos(ang)[:, None, :]
    sin = jnp.sin(ang)[:, None, :]
    xf = x.astype(jnp.float32)
    x1, x2 = xf[..., :half], xf[..., half:]
    out = jnp.concatenate([x1 * cos - x2 * sin, x2 * cos + x1 * sin], axis=-1)
    return out.astype(x.dtype)


def pool_mixer(v, pool_w, pool_scale):
    B, T, C = v.shape
    vf = v.astype(jnp.float32)
    csum = jnp.cumsum(vf, axis=1)
    t = jnp.arange(T)
    outs = []
    for g, w in enumerate(POOL_WINDOWS):
        sl = slice(g * POOL_GROUP, (g + 1) * POOL_GROUP)
        cg = csum[..., sl]
        lag = jnp.pad(cg, ((0, 0), (w, 0), (0, 0)))[:, :T]
        cnt = jnp.minimum(t + 1, w).astype(jnp.float32)[None, :, None]
        outs.append((cg - lag) / cnt - vf[..., sl])
    p = jnp.stack(outs, axis=2)
    y = jnp.einsum('btgc,gcd->btgd', p, pool_w.astype(jnp.float32)).reshape(B, T, C)
    return (y * pool_scale.astype(jnp.float32)).astype(v.dtype)


def dsa_mixer(q, k, v, qi, ki, wi):
    B, T = q.shape[0], q.shape[1]
    topk = min(TOPK_MAX, T // 4)
    nb = T // Q_BLOCK
    kpos = jnp.arange(T)
    b_idx = jnp.arange(B)[:, None, None]
    kif = ki.astype(jnp.float32)
    scale = HEAD_DIM ** -0.5

    def to_blocks(a):
        return a.reshape((a.shape[0], nb, Q_BLOCK) + a.shape[2:]).swapaxes(0, 1)

    def block(args):
        qb, qib, wib, t0 = args
        qpos = t0 + jnp.arange(Q_BLOCK)
        causal = kpos[None, :] <= qpos[:, None]
        rel = jax.nn.relu(jnp.einsum('bqhd,bsd->bqsh', qib.astype(jnp.float32), kif))
        score = jnp.einsum('bqsh,bqh->bqs', rel, wib.astype(jnp.float32))
        score = jnp.where(causal[None], score, NEG)
        _, idx = lax.top_k(score, topk)
        kg = k[b_idx, idx].astype(jnp.float32)
        vg = v[b_idx, idx].astype(jnp.float32)
        qg = qb.reshape(B, Q_BLOCK, N_KV_HEADS, Q_PER_KV, HEAD_DIM).astype(jnp.float32)
        logits = jnp.einsum('bqjgd,bqnjd->bqjgn', qg, kg) * scale
        valid = (idx <= qpos[None, :, None])[:, :, None, None, :]
        probs = jax.nn.softmax(jnp.where(valid, logits, NEG), axis=-1)
        o = jnp.einsum('bqjgn,bqnjd->bqjgd', probs, vg)
        return o.reshape(B, Q_BLOCK, N_Q_HEADS * HEAD_DIM).astype(q.dtype)

    outs = lax.map(block, (to_blocks(q), to_blocks(qi), to_blocks(wi), jnp.arange(nb) * Q_BLOCK))
    return outs.swapaxes(0, 1).reshape(B, T, N_Q_HEADS * HEAD_DIM)


def conv_ffn(h, w_up, conv_w, conv_b, w_down):
    u = h @ w_up
    T = u.shape[1]
    up = jnp.pad(u, ((0, 0), (CONV_WIDTH - 1, 0), (0, 0)))
    c = conv_b
    for j in range(CONV_WIDTH):
        c = c + up[:, j:j + T] * conv_w[j]
    gate, val = jnp.split(c, 2, axis=-1)
    return (jax.nn.silu(gate) * val) @ w_down


def setup_inputs(seed: int = 0) -> dict:
    key = jax.random.key(seed)
    ks = jax.random.split(key, 13)
    f32 = jnp.float32
    n = lambda k, s: jax.random.normal(k, s, dtype=f32)
    return {
        "x": n(ks[0], (BATCH, SEQ, D_MODEL)),
        "norm1_g": 1.0 + 0.02 * n(ks[1], (DEPTH, D_MODEL)),
        "w_in": n(ks[2], (DEPTH, D_MODEL, IN_WIDTH)) * D_MODEL ** -0.5,
        "q_norm_g": 1.0 + 0.02 * n(ks[3], (DEPTH, HEAD_DIM)),
        "k_norm_g": 1.0 + 0.02 * n(ks[4], (DEPTH, HEAD_DIM)),
        "pool_w": n(ks[5], (DEPTH, 4, POOL_GROUP, POOL_GROUP)) * POOL_GROUP ** -0.5,
        "pool_scale": 1.0 + 0.02 * n(ks[6], (DEPTH, POOL_WIDTH)),
        "w_out": n(ks[7], (DEPTH, MIX_WIDTH, D_MODEL)) * MIX_WIDTH ** -0.5,
        "norm2_g": 1.0 + 0.02 * n(ks[8], (DEPTH, D_MODEL)),
        "w_up": n(ks[9], (DEPTH, D_MODEL, 2 * D_FF)) * D_MODEL ** -0.5,
        "conv_w": n(ks[10], (DEPTH, CONV_WIDTH, 2 * D_FF)) * CONV_WIDTH ** -0.5,
        "conv_b": 0.02 * n(ks[11], (DEPTH, 2 * D_FF)),
        "w_down": n(ks[12], (DEPTH, D_FF, D_MODEL)) * D_FF ** -0.5,
    }


def reference(x, norm1_g, w_in, q_norm_g, k_norm_g, pool_w, pool_scale, w_out,
              norm2_g, w_up, conv_w, conv_b, w_down):
    B, T, _ = x.shape
    pos = jnp.arange(T)
    cuts = [int(c) for c in np.cumsum(IN_SPLITS)[:-1]]
    for l in range(DEPTH):
        h = rms_norm(x, norm1_g[l])
        proj = h @ w_in[l]
        v_pool, q, k, v, qi, ki, wi = jnp.split(proj, cuts, axis=-1)
        q = rope(rms_norm(q.reshape(B, T, N_Q_HEADS, HEAD_DIM), q_norm_g[l]), pos)
        k = rope(rms_norm(k.reshape(B, T, N_KV_HEADS, HEAD_DIM), k_norm_g[l]), pos)
        v = v.reshape(B, T, N_KV_HEADS, HEAD_DIM)
        qi = rope(qi.reshape(B, T, IDX_HEADS, IDX_DIM), pos)
        ki = rope(ki.reshape(B, T, 1, IDX_DIM), pos)[:, :, 0]
        wi = wi * (IDX_HEADS ** -0.5 * IDX_DIM ** -0.5)
        a_out = pool_mixer(v_pool, pool_w[l], pool_scale[l])
        b_out = dsa_mixer(q, k, v, qi, ki, wi)
        x = x + jnp.concatenate([a_out, b_out], axis=-1) @ w_out[l]
        x = x + conv_ffn(rms_norm(x, norm2_g[l]), w_up[l], conv_w[l], conv_b[l], w_down[l])
    return x
```

```cpp
#include <hip/hip_runtime.h>
#include <cstdint>
#include <cstdio>

typedef unsigned short bf16_t;
typedef short bf16x8 __attribute__((ext_vector_type(8)));
typedef float f32x4 __attribute__((ext_vector_type(4)));
typedef _Float16 f16_t;

constexpr int D_MODEL = 1024, BATCH = 8, SEQ = 2048, M = BATCH * SEQ;
constexpr int POOL_W = 512, NQH = 8, HD = 64, NKV = 2, IH = 8, ID = 32, TOPK = 256;
constexpr int IN_W = 1576, IN_WV = 1792;
constexpr int DFF = 2816, UP_W = 2 * DFF;
constexpr float EPS = 1e-6f;
constexpr float C2 = 0.125f * 1.4426950408889634f;

constexpr size_t MiB = 1u << 20;
constexpr size_t WS_ROPE = 1 * MiB;
constexpr size_t WS_WIN = 2 * MiB, WS_WOUT = 6 * MiB, WS_WUP = 8 * MiB, WS_WDN = 19 * MiB;
constexpr size_t WS_RSTD2 = 26 * MiB;
constexpr size_t WS_XN = 28 * MiB;
constexpr size_t WS_VP = 60 * MiB, WS_Q = 76 * MiB, WS_K = 92 * MiB, WS_V = 96 * MiB, WS_QI = 100 * MiB, WS_KI = 108 * MiB, WS_WI = 109 * MiB;
constexpr size_t WS_MASK = 110 * MiB, WS_MIX = 114 * MiB;
constexpr size_t WS_G = 60 * MiB;
constexpr size_t WS_CT = 148 * MiB;

__device__ __forceinline__ unsigned f2bf(float f) { unsigned u = __builtin_bit_cast(unsigned, f); return (u + 0x7fffu + ((u >> 16) & 1u)) >> 16; }
__device__ __forceinline__ float bf2f(bf16_t b) { return __builtin_bit_cast(float, (unsigned)b << 16); }
__device__ __forceinline__ float wave_sum(float v) {
#pragma unroll
    for (int o = 1; o < 64; o <<= 1) v += __shfl_xor(v, o);
    return v;
}
__device__ __forceinline__ float wave_max(float v) {
#pragma unroll
    for (int o = 1; o < 64; o <<= 1) v = fmaxf(v, __shfl_xor(v, o));
    return v;
}

__host__ __device__ __forceinline__ int win_actual(int v) {
    const int pn = v >> 8, w = v & 255, bj = w >> 7, wc = (w >> 5) & 3, j = w & 31;
    if (pn < 2) return v;
    if (pn < 5) return 512 + 64 * (4 * (pn - 2) + wc) + 32 * bj + j;
    const int hd = 2 * wc + (j >> 4), d = 16 * bj + (j & 15);
    if (pn == 5) return 1280 + 32 * hd + d;
    if (hd == 0) return 1536 + d;
    if (hd == 1 && d < 8) return 1568 + d;
    return -1;
}
__host__ __device__ __forceinline__ int win_virtual(int a) {
    if (a < 512) return a;
    if (a < 1280) { const int r = a - 512, head = r >> 6, d = r & 63; return 256 * (2 + (head >> 2)) + 128 * (d >> 5) + 32 * (head & 3) + (d & 31); }
    if (a < 1536) { const int r = a - 1280, hd = r >> 5, d = r & 31; return 256 * 5 + 128 * (d >> 4) + 32 * (hd >> 1) + 16 * (hd & 1) + (d & 15); }
    if (a < 1568) { const int d = a - 1536; return 1536 + 128 * (d >> 4) + (d & 15); }
    return 1536 + 16 + (a - 1568);
}
__host__ __device__ __forceinline__ int wup_actual(int v) { const int pn = v >> 8, w = v & 255; return (w >> 7) * DFF + 128 * pn + (w & 127); }

__global__ void __launch_bounds__(256) prep_wT(const float* __restrict__ W, int K, int N, bf16_t* __restrict__ Wt, int Nv, int mode, const float* __restrict__ kscale) {
    __shared__ float scr[4][64 * 33];
    const int wid = threadIdx.x >> 6, lane = threadIdx.x & 63;
    const int nblk = Nv / 32, nitems = (K / 64) * nblk;
    for (int item = blockIdx.x * 4 + wid; item < nitems; item += gridDim.x * 4) {
        const int kb = item / nblk, nb = item % nblk, k0 = 64 * kb, n0 = 32 * nb;
        const int v = n0 + (lane & 31);
        const int a = mode == 0 ? v : (mode == 1 ? win_actual(v) : wup_actual(v));
        float* s = scr[wid];
        for (int i = 0; i < 32; ++i) { const int kk = 2 * i + (lane >> 5);
            float val = 0.f; if (a >= 0) { val = W[(size_t)(k0 + kk) * N + a]; if (kscale) val *= kscale[k0 + kk]; }
            s[kk * 33 + (lane & 31)] = val; }
        __builtin_amdgcn_s_waitcnt(0xc07f); __builtin_amdgcn_wave_barrier();
        const int c = lane & 7;
        for (int j = 0; j < 4; ++j) { const int n = (lane >> 3) + 8 * j; const float* p = s + (8 * c) * 33 + n;
            uint4 o; o.x = f2bf(p[0]) | (f2bf(p[33]) << 16); o.y = f2bf(p[66]) | (f2bf(p[99]) << 16); o.z = f2bf(p[132]) | (f2bf(p[165]) << 16); o.w = f2bf(p[198]) | (f2bf(p[231]) << 16);
            *(uint4*)(Wt + (size_t)(n0 + n) * K + k0 + 8 * c) = o; }
        __builtin_amdgcn_s_waitcnt(0xc07f); __builtin_amdgcn_wave_barrier();
    }
}
__global__ void rope_table(float2* tab) {
    const int i = blockIdx.x * blockDim.x + threadIdx.x; if (i >= SEQ * 32) return;
    const int pos = i >> 5, k = i & 31;
    const float inv = expf(-logf(10000.0f) * (float)k / 32.0f);
    const float ang = (float)pos * inv;
    float s, c; sincosf(ang, &s, &c); tab[i] = make_float2(c, s);
}
__global__ void __launch_bounds__(256) rmsnorm_rows(const float* __restrict__ x, const float* __restrict__ g, bf16_t* __restrict__ out) {
    const int row = blockIdx.x * 4 + (threadIdx.x >> 6), lane = threadIdx.x & 63;
    const f32x4* xr = (const f32x4*)(x + (size_t)row * D_MODEL) + lane;
    f32x4 v[4]; float s = 0.f;
#pragma unroll
    for (int j = 0; j < 4; ++j) { v[j] = xr[64 * j]; s += v[j].x * v[j].x + v[j].y * v[j].y + v[j].z * v[j].z + v[j].w * v[j].w; }
    const float rstd = 1.0f / sqrtf(wave_sum(s) * (1.0f / D_MODEL) + EPS);
    unsigned long long* o8 = (unsigned long long*)(out + (size_t)row * D_MODEL) + lane;
#pragma unroll
    for (int j = 0; j < 4; ++j) { const f32x4 gg = ((const f32x4*)g)[lane + 64 * j];
        o8[64 * j] = (unsigned long long)(f2bf(v[j].x * rstd * gg.x) | (f2bf(v[j].y * rstd * gg.y) << 16)) | ((unsigned long long)(f2bf(v[j].z * rstd * gg.z) | (f2bf(v[j].w * rstd * gg.w) << 16)) << 32); }
}

__global__ void __launch_bounds__(256) gemm_naive(const bf16_t* __restrict__ A, int lda, const bf16_t* __restrict__ Bt, int ldb, float* __restrict__ C, int ldc, int K) {
    const int wid = threadIdx.x >> 6, lane = threadIdx.x & 63, fr = lane & 15, fq = lane >> 4;
    const int m0 = blockIdx.y * 128 + (wid >> 1) * 64, n0 = blockIdx.x * 128 + (wid & 1) * 64;
    f32x4 acc[4][4];
#pragma unroll
    for (int i = 0; i < 4; ++i)
#pragma unroll
        for (int j = 0; j < 4; ++j) acc[i][j] = (f32x4){0.f, 0.f, 0.f, 0.f};
    for (int k = 0; k < K; k += 32) {
        bf16x8 a[4], b[4];
#pragma unroll
        for (int i = 0; i < 4; ++i) a[i] = *(const bf16x8*)(A + (size_t)(m0 + 16 * i + fr) * lda + k + 8 * fq);
#pragma unroll
        for (int j = 0; j < 4; ++j) b[j] = *(const bf16x8*)(Bt + (size_t)(n0 + 16 * j + fr) * ldb + k + 8 * fq);
#pragma unroll
        for (int i = 0; i < 4; ++i)
#pragma unroll
            for (int j = 0; j < 4; ++j) acc[i][j] = __builtin_amdgcn_mfma_f32_16x16x32_bf16(a[i], b[j], acc[i][j], 0, 0, 0);
    }
#pragma unroll
    for (int i = 0; i < 4; ++i)
#pragma unroll
        for (int j = 0; j < 4; ++j)
#pragma unroll
            for (int r = 0; r < 4; ++r) C[(size_t)(m0 + 16 * i + 4 * fq + r) * ldc + n0 + 16 * j + fr] = acc[i][j][r];
}

__global__ void __launch_bounds__(256) proj_epilogue(const float* __restrict__ C, int row0, const float2* __restrict__ rope, const float* __restrict__ gq, const float* __restrict__ gk,
                                                     bf16_t* VP, bf16_t* Q, bf16_t* Kb, bf16_t* Vb, f16_t* QI, f16_t* KI, float* WI) {
    const int r = blockIdx.x, row = row0 + r, pos = row % SEQ, tid = threadIdx.x, wid = tid >> 6, lane = tid & 63;
    const float* c = C + (size_t)r * IN_WV;
    VP[(size_t)row * POOL_W + tid] = (bf16_t)f2bf(c[win_virtual(tid)]);
    VP[(size_t)row * POOL_W + 256 + tid] = (bf16_t)f2bf(c[win_virtual(256 + tid)]);
    const float2 cs = rope[pos * 32 + (lane & 31)];
    for (int hh = 0; hh < 2; ++hh) {
        const int h = 2 * wid + hh; const float val = c[win_virtual(512 + 64 * h + lane)];
        const float ss = wave_sum(val * val); const float n = val * (1.0f / sqrtf(ss * (1.0f / 64.0f) + EPS)) * gq[lane];
        const float p = __shfl_xor(n, 32); const float o = lane < 32 ? n * cs.x - p * cs.y : n * cs.x + p * cs.y;
        Q[(size_t)row * 512 + 64 * h + lane] = (bf16_t)f2bf(o * C2);
    }
    if (wid < 2) { const float val = c[win_virtual(1024 + 64 * wid + lane)];
        const float ss = wave_sum(val * val); const float n = val * (1.0f / sqrtf(ss * (1.0f / 64.0f) + EPS)) * gk[lane];
        const float p = __shfl_xor(n, 32); const float o = lane < 32 ? n * cs.x - p * cs.y : n * cs.x + p * cs.y;
        Kb[(size_t)row * 128 + 64 * wid + lane] = (bf16_t)f2bf(o);
    } else { Vb[(size_t)row * 128 + 64 * (wid - 2) + lane] = (bf16_t)f2bf(c[win_virtual(1152 + 64 * (wid - 2) + lane)]); }
    {
        const int d = tid & 31; const float val = c[win_virtual(1280 + tid)]; const float p = __shfl_xor(val, 16);
        const float2 cs2 = rope[pos * 32 + 2 * (d & 15)];
        const float o = d < 16 ? val * cs2.x - p * cs2.y : val * cs2.x + p * cs2.y;
        QI[(size_t)row * 256 + tid] = (f16_t)o;
    }
    if (tid < 32) { const int d = tid; const float val = c[win_virtual(1536 + d)]; const float p = __shfl_xor(val, 16);
        const float2 cs2 = rope[pos * 32 + 2 * (d & 15)];
        const float o = d < 16 ? val * cs2.x - p * cs2.y : val * cs2.x + p * cs2.y;
        KI[(size_t)row * 32 + d] = (f16_t)o; }
    if (tid >= 64 && tid < 72) WI[(size_t)row * 8 + (tid - 64)] = c[win_virtual(1568 + tid - 64)] * 0.0625f;
}

__global__ void __launch_bounds__(512) pool_naive(const bf16_t* __restrict__ VP, const float* __restrict__ pool_w, const float* __restrict__ pool_scale, bf16_t* __restrict__ MIX) {
    __shared__ float p[512];
    const int row = blockIdx.x, t = row % SEQ, tid = threadIdx.x, g = tid >> 7, c = tid & 127, w = 2 << g;
    const int cnt = (t + 1 < w) ? t + 1 : w;
    float s = 0.f;
    for (int k = 0; k < cnt; ++k) s += bf2f(VP[(size_t)(row - k) * POOL_W + tid]);
    p[tid] = s / (float)cnt - bf2f(VP[(size_t)row * POOL_W + tid]);
    __syncthreads();
    float y = 0.f; const float* pw = pool_w + (size_t)g * 128 * 128 + c;
    for (int k = 0; k < 128; ++k) y += p[g * 128 + k] * pw[(size_t)k * 128];
    MIX[(size_t)row * 1024 + tid] = (bf16_t)f2bf(y * pool_scale[tid]);
}

__device__ __forceinline__ unsigned score_key(float s) { if (s == 0.f) s = 0.f; const unsigned u = __builtin_bit_cast(unsigned, s); return (u & 0x80000000u) ? ~u : (u | 0x80000000u); }
__global__ void __launch_bounds__(256) indexer_naive(const f16_t* __restrict__ QI, const f16_t* __restrict__ KI, const float* __restrict__ WI, unsigned long long* __restrict__ MASK) {
    __shared__ float qs[4][256];
    __shared__ float sc[4][SEQ];
    const int wid = threadIdx.x >> 6, lane = threadIdx.x & 63;
    const int row = blockIdx.x * 4 + wid, b = row / SEQ, t = row % SEQ;
    for (int i = lane; i < 256; i += 64) qs[wid][i] = (float)QI[(size_t)row * 256 + i];
    float w[8];
#pragma unroll
    for (int h = 0; h < 8; ++h) w[h] = WI[(size_t)row * 8 + h];
    __builtin_amdgcn_s_waitcnt(0xc07f); __builtin_amdgcn_wave_barrier();
    const int nch = t / 64 + 1;
    for (int c = 0; c < nch; ++c) {
        const int s = 64 * c + lane;
        float k[32];
        const uint4* kp = (const uint4*)(KI + (size_t)(b * SEQ + s) * 32);
#pragma unroll
        for (int i = 0; i < 4; ++i) { const uint4 u = kp[i]; const unsigned uu[4] = {u.x, u.y, u.z, u.w};
#pragma unroll
            for (int e = 0; e < 4; ++e) { k[8 * i + 2 * e] = (float)__builtin_bit_cast(f16_t, (unsigned short)(uu[e] & 0xffffu)); k[8 * i + 2 * e + 1] = (float)__builtin_bit_cast(f16_t, (unsigned short)(uu[e] >> 16)); } }
        float score = 0.f;
#pragma unroll
        for (int h = 0; h < 8; ++h) { float d = 0.f;
            asm volatile("" ::: "memory");
#pragma unroll
            for (int i = 0; i < 32; ++i) d += qs[wid][32 * h + i] * k[i];
            score += w[h] * fmaxf(d, 0.f); }
        sc[wid][s] = score;
    }
    __builtin_amdgcn_s_waitcnt(0xc07f); __builtin_amdgcn_wave_barrier();
    unsigned key[32];
#pragma unroll
    for (int r = 0; r < 32; ++r) { const int s = 64 * r + lane; key[r] = (s <= t) ? score_key(sc[wid][s]) : 0u; }
    unsigned long long myword = 0ull;
    if (t < TOPK) {
#pragma unroll
        for (int r = 0; r < 32; ++r) { const unsigned long long bal = __ballot(64 * r + lane <= t); if (lane == r) myword = bal; }
    } else {
        unsigned prefix = 0u;
        for (int bit = 31; bit >= 0; --bit) {
            const unsigned cand = prefix | (1u << bit); int cnt = 0;
#pragma unroll
            for (int r = 0; r < 32; ++r) cnt += __popcll(__ballot(key[r] >= cand));
            if (cnt >= TOPK) prefix = cand;
        }
        const unsigned thr = prefix; int cgt = 0;
#pragma unroll
        for (int r = 0; r < 32; ++r) cgt += __popcll(__ballot(key[r] > thr));
        int need = TOPK - cgt;
#pragma unroll
        for (int r = 0; r < 32; ++r) {
            const bool tie = key[r] == thr; const unsigned long long tb = __ballot(tie);
            const int rank = __popcll(tb & ((1ull << lane) - 1ull));
            const bool sel = key[r] > thr || (tie && rank < need);
            need -= __popcll(tb); if (need < 0) need = 0;
            const unsigned long long bal = __ballot(sel); if (lane == r) myword = bal;
        }
    }
    if (lane < 32) MASK[(size_t)row * 32 + lane] = myword;
}

__global__ void __launch_bounds__(256) attn_naive(const bf16_t* __restrict__ Q, const bf16_t* __restrict__ Kb, const bf16_t* __restrict__ Vb, const unsigned long long* __restrict__ MASK, bf16_t* __restrict__ MIX) {
    __shared__ float qs[4][64];
    __shared__ float ps[4][64];
    const int wid = threadIdx.x >> 6, lane = threadIdx.x & 63;
    const int row = blockIdx.x >> 1, j = blockIdx.x & 1, h = 4 * j + wid, b = row / SEQ, t = row % SEQ;
    qs[wid][lane] = bf2f(Q[(size_t)row * 512 + 64 * h + lane]);
    __builtin_amdgcn_s_waitcnt(0xc07f); __builtin_amdgcn_wave_barrier();
    float m = -1e30f, l = 0.f, o = 0.f;
    const int nch = t / 64 + 1;
    for (int c = 0; c < nch; ++c) {
        const unsigned long long word = MASK[(size_t)row * 32 + c];
        if (word == 0ull) continue;
        const int s = 64 * c + lane; const bool sel = (word >> lane) & 1ull;
        float logit = -1e30f;
        if (sel) { const uint4* kp = (const uint4*)(Kb + (size_t)(b * SEQ + s) * 128 + 64 * j); float d = 0.f;
#pragma unroll
            for (int i = 0; i < 8; ++i) { const uint4 u = kp[i]; const unsigned uu[4] = {u.x, u.y, u.z, u.w};
#pragma unroll
                for (int e = 0; e < 4; ++e) { d += qs[wid][8 * i + 2 * e] * __builtin_bit_cast(float, uu[e] << 16); d += qs[wid][8 * i + 2 * e + 1] * __builtin_bit_cast(float, uu[e] & 0xffff0000u); } }
            logit = d; }
        const float mn = fmaxf(m, wave_max(logit)); const float alpha = exp2f(m - mn);
        const float p = sel ? exp2f(logit - mn) : 0.f;
        l = l * alpha + wave_sum(p); m = mn;
        ps[wid][lane] = p;
        __builtin_amdgcn_s_waitcnt(0xc07f); __builtin_amdgcn_wave_barrier();
        o *= alpha;
        const bf16_t* vp = Vb + (size_t)(b * SEQ + 64 * c) * 128 + 64 * j + lane;
        for (int k = 0; k < 64; ++k) { const float pk = ps[wid][k]; if (pk != 0.f) o += pk * bf2f(vp[(size_t)k * 128]); }
        __builtin_amdgcn_s_waitcnt(0xc07f); __builtin_amdgcn_wave_barrier();
    }
    MIX[(size_t)row * 1024 + 512 + 64 * h + lane] = (bf16_t)f2bf(o / l);
}

__global__ void __launch_bounds__(256) wout_epilogue(const float* __restrict__ C, int row0, const float* __restrict__ x, float* __restrict__ out, bf16_t* __restrict__ X1B, float* __restrict__ RSTD2) {
    const int r = blockIdx.x * 4 + (threadIdx.x >> 6), row = row0 + r, lane = threadIdx.x & 63;
    const f32x4* cr = (const f32x4*)(C + (size_t)r * D_MODEL) + lane; const f32x4* xr = (const f32x4*)(x + (size_t)row * D_MODEL) + lane;
    f32x4* orow = (f32x4*)(out + (size_t)row * D_MODEL) + lane; unsigned long long* o8 = (unsigned long long*)(X1B + (size_t)row * D_MODEL) + lane;
    float s = 0.f;
#pragma unroll
    for (int j = 0; j < 4; ++j) { const f32x4 v = xr[64 * j] + cr[64 * j]; orow[64 * j] = v; s += v.x * v.x + v.y * v.y + v.z * v.z + v.w * v.w;
        o8[64 * j] = (unsigned long long)(f2bf(v.x) | (f2bf(v.y) << 16)) | ((unsigned long long)(f2bf(v.z) | (f2bf(v.w) << 16)) << 32); }
    s = wave_sum(s);
    if (lane == 0) RSTD2[row] = 1.0f / sqrtf(s * (1.0f / D_MODEL) + EPS);
}
__global__ void __launch_bounds__(256) conv_gate(const float* __restrict__ U, int row0, const float* __restrict__ RSTD2, const float* __restrict__ conv_w, const float* __restrict__ conv_b, bf16_t* __restrict__ G) {
    const int t = blockIdx.y, n = blockIdx.x * 256 + threadIdx.x; if (n >= DFF) return;
    const int vg = 256 * (n >> 7) + (n & 127), vv = vg + 128;
    float cg = conv_b[n], cv = conv_b[DFF + n];
#pragma unroll
    for (int jj = 0; jj < 3; ++jj) { const int tt = t - 2 + jj; if (tt < 0) continue;
        const float rs = RSTD2[row0 + tt];
        cg += conv_w[jj * UP_W + n] * (U[(size_t)tt * UP_W + vg] * rs);
        cv += conv_w[jj * UP_W + DFF + n] * (U[(size_t)tt * UP_W + vv] * rs); }
    const float g = cg / (1.0f + expf(-cg)) * cv;
    G[(size_t)(row0 + t) * DFF + n] = (bf16_t)f2bf(g);
}
__global__ void __launch_bounds__(256) down_epilogue(const float* __restrict__ C, int row0, float* __restrict__ out) {
    const int r = blockIdx.x * 4 + (threadIdx.x >> 6), row = row0 + r, lane = threadIdx.x & 63;
    const f32x4* cr = (const f32x4*)(C + (size_t)r * D_MODEL) + lane; f32x4* orow = (f32x4*)(out + (size_t)row * D_MODEL) + lane;
#pragma unroll
    for (int j = 0; j < 4; ++j) orow[64 * j] = orow[64 * j] + cr[64 * j];
}

extern "C" void kernel_launch(void* const* d_in, const int* in_sizes, int n_in, void* d_out, int out_size, void* d_ws, size_t ws_size, hipStream_t stream) {
    const float* x = (const float*)d_in[0]; const float* norm1_g = (const float*)d_in[1]; const float* w_in = (const float*)d_in[2];
    const float* q_norm_g = (const float*)d_in[3]; const float* k_norm_g = (const float*)d_in[4]; const float* pool_w = (const float*)d_in[5];
    const float* pool_scale = (const float*)d_in[6]; const float* w_out = (const float*)d_in[7]; const float* norm2_g = (const float*)d_in[8];
    const float* w_up = (const float*)d_in[9]; const float* conv_w = (const float*)d_in[10]; const float* conv_b = (const float*)d_in[11]; const float* w_down = (const float*)d_in[12];
    float* out = (float*)d_out; unsigned char* ws = (unsigned char*)d_ws;
    float2* ROPE = (float2*)(ws + WS_ROPE);
    bf16_t *Win = (bf16_t*)(ws + WS_WIN), *Wout = (bf16_t*)(ws + WS_WOUT), *Wup = (bf16_t*)(ws + WS_WUP), *Wdn = (bf16_t*)(ws + WS_WDN);
    float* RSTD2 = (float*)(ws + WS_RSTD2);
    bf16_t *XN = (bf16_t*)(ws + WS_XN), *VP = (bf16_t*)(ws + WS_VP), *Q = (bf16_t*)(ws + WS_Q), *Kb = (bf16_t*)(ws + WS_K), *Vb = (bf16_t*)(ws + WS_V);
    f16_t *QI = (f16_t*)(ws + WS_QI), *KI = (f16_t*)(ws + WS_KI); float* WI = (float*)(ws + WS_WI);
    unsigned long long* MASK = (unsigned long long*)(ws + WS_MASK); bf16_t *MIX = (bf16_t*)(ws + WS_MIX), *G = (bf16_t*)(ws + WS_G);
    float* CT = (float*)(ws + WS_CT);

    prep_wT<<<1024, 256, 0, stream>>>(w_in, D_MODEL, IN_W, Win, IN_WV, 1, nullptr);
    prep_wT<<<1024, 256, 0, stream>>>(w_out, D_MODEL, D_MODEL, Wout, D_MODEL, 0, nullptr);
    prep_wT<<<1024, 256, 0, stream>>>(w_up, D_MODEL, UP_W, Wup, UP_W, 2, norm2_g);
    prep_wT<<<1024, 256, 0, stream>>>(w_down, DFF, D_MODEL, Wdn, D_MODEL, 0, nullptr);
    rope_table<<<SEQ * 32 / 256, 256, 0, stream>>>(ROPE);
    rmsnorm_rows<<<M / 4, 256, 0, stream>>>(x, norm1_g, XN);
    for (int b = 0; b < BATCH; ++b) {
        const int row0 = b * SEQ;
        gemm_naive<<<dim3(IN_WV / 128, SEQ / 128), 256, 0, stream>>>(XN + (size_t)row0 * D_MODEL, D_MODEL, Win, D_MODEL, CT, IN_WV, D_MODEL);
        proj_epilogue<<<SEQ, 256, 0, stream>>>(CT, row0, ROPE, q_norm_g, k_norm_g, VP, Q, Kb, Vb, QI, KI, WI);
    }
    pool_naive<<<M, 512, 0, stream>>>(VP, pool_w, pool_scale, MIX);
    indexer_naive<<<M / 4, 256, 0, stream>>>(QI, KI, WI, MASK);
    attn_naive<<<M * 2, 256, 0, stream>>>(Q, Kb, Vb, MASK, MIX);
    for (int b = 0; b < BATCH; ++b) {
        const int row0 = b * SEQ;
        gemm_naive<<<dim3(D_MODEL / 128, SEQ / 128), 256, 0, stream>>>(MIX + (size_t)row0 * 1024, 1024, Wout, 1024, CT, D_MODEL, 1024);
        wout_epilogue<<<SEQ / 4, 256, 0, stream>>>(CT, row0, x, out, XN, RSTD2);
    }
    for (int b = 0; b < BATCH; ++b) {
        const int row0 = b * SEQ;
        gemm_naive<<<dim3(UP_W / 128, SEQ / 128), 256, 0, stream>>>(XN + (size_t)row0 * D_MODEL, D_MODEL, Wup, D_MODEL, CT, UP_W, D_MODEL);
        conv_gate<<<dim3(DFF / 256, SEQ), 256, 0, stream>>>(CT, row0, RSTD2, conv_w, conv_b, G);
    }
    for (int b = 0; b < BATCH; ++b) {
        const int row0 = b * SEQ;
        gemm_naive<<<dim3(D_MODEL / 128, SEQ / 128), 256, 0, stream>>>(G + (size_t)row0 * DFF, DFF, Wdn, DFF, CT, D_MODEL, DFF);
        down_epilogue<<<SEQ / 4, 256, 0, stream>>>(CT, row0, out);
    }
}
```

```cpp
#include <hip/hip_runtime.h>
#include <cstdint>
#include <cstdio>

typedef unsigned short bf16_t;
typedef _Float16 f16_t;

constexpr int D_MODEL = 1024, BATCH = 8, SEQ = 2048, M = BATCH * SEQ;
constexpr int POOL_W = 512, NQH = 8, HD = 64, NKV = 2, IH = 8, ID = 32, TOPK = 256;
constexpr int IN_W = 1576, IN_WV = 1792;
constexpr int DFF = 2816, UP_W = 2 * DFF;
constexpr float EPS = 1e-6f;
constexpr float C2 = 0.125f * 1.4426950408889634f;

constexpr size_t MiB = 1u << 20;
constexpr size_t WS_CTL = 0, CTL_ZERO_BYTES = 32768;
constexpr size_t WS_ROPE = 1 * MiB;
constexpr size_t WS_ROPE16 = 1 * MiB + 512 * 1024;
constexpr size_t WS_WIN = 2 * MiB, WS_WOUT = 6 * MiB, WS_WUP = 8 * MiB, WS_WDN = 19 * MiB;
constexpr size_t WS_SS2 = 25 * MiB;
constexpr size_t WS_RSTD2 = 26 * MiB;
constexpr size_t WS_XN = 28 * MiB;
constexpr size_t WS_VP = 60 * MiB, WS_Q = 76 * MiB, WS_K = 92 * MiB, WS_V = 96 * MiB, WS_QI = 100 * MiB, WS_KI = 108 * MiB, WS_WI = 109 * MiB;
constexpr size_t WS_MASK = 110 * MiB, WS_MIX = 114 * MiB;
constexpr size_t WS_G = 60 * MiB;
constexpr size_t WS_X1L = 148 * MiB;
constexpr size_t WS_HF = 192 * MiB, WS_HL = 204 * MiB;
constexpr int CW_BAR = 4096;

#define GAS __attribute__((address_space(1)))
#define LAS __attribute__((address_space(3)))
typedef unsigned short bf16;
typedef unsigned v4u __attribute__((ext_vector_type(4)));
typedef float f32x4 __attribute__((ext_vector_type(4)));
typedef short bf16x8 __attribute__((ext_vector_type(8)));
typedef GAS unsigned gu32;
typedef GAS unsigned long long gu64;
#define RLX_AGENT __ATOMIC_RELAXED, __HIP_MEMORY_SCOPE_AGENT
#define LDS_WAIT() asm volatile("s_waitcnt lgkmcnt(0)" ::: "memory")
#define VM_WAIT() asm volatile("s_waitcnt vmcnt(0)" ::: "memory")
__device__ __forceinline__ unsigned long long rt() { return __builtin_amdgcn_s_memrealtime(); }
__device__ __forceinline__ unsigned f2bf(float f) { unsigned u = __builtin_bit_cast(unsigned, f); return (u + 0x7fffu + ((u >> 16) & 1u)) >> 16; }
__device__ __forceinline__ unsigned pk2(float lo, float hi) { return f2bf(lo) | (f2bf(hi) << 16); }

#define XB_TMO      128
#define XB_XCNT(j)  (256  + 64 * (j))
#define XB_XSUB(j)  (1280 + 64 * (j))
#define XB_XGEN(j)  (2304 + 64 * (j))
#define XB_TOP      3328
#define XB_TOPGEN   3392
#define XCD_BAR_WORDS 3456
#define XB_SPIN_CAP (1u << 18)

__device__ __forceinline__ unsigned xb_ld(unsigned* p)              { return __hip_atomic_load(p, __ATOMIC_RELAXED, __HIP_MEMORY_SCOPE_AGENT); }
__device__ __forceinline__ unsigned xb_add(unsigned* p, unsigned v) { return __hip_atomic_fetch_add(p, v, __ATOMIC_RELAXED, __HIP_MEMORY_SCOPE_AGENT); }
__device__ __forceinline__ unsigned xb_xcc_id() { return (unsigned)__builtin_amdgcn_s_getreg((3 << 11) | 20) & 0xFu; }
#define XB_SPIN(cond, bar) do { unsigned _sp = 0; while (cond) { __builtin_amdgcn_s_sleep(1); \
    if ((++_sp & 255u) == 0u) { if (xb_ld(&(bar)[XB_TMO])) break; if (_sp > XB_SPIN_CAP) { atomicAdd(&(bar)[XB_TMO], 1u); break; } } } } while (0)

struct XcdBarrier {
    unsigned* bar; unsigned x;
    volatile LAS unsigned* st;
    bool w0;
};

__device__ __forceinline__ XcdBarrier xcd_barrier_post(unsigned* bar, volatile LAS unsigned* st) {
    XcdBarrier b; b.bar = bar; b.x = xb_xcc_id(); b.st = st;
    if (threadIdx.x == 0) (void)xb_add(&bar[XB_XCNT(b.x)], 1u);
    return b;
}
__device__ __forceinline__ void xcd_barrier_complete(unsigned* bar, unsigned x, unsigned& nloc, unsigned& nx) {
    const unsigned G = gridDim.x * gridDim.y * gridDim.z;
    unsigned sum, cnt, mine, sp = 0u;
    for (;;) {
        sum = 0u; cnt = 0u; mine = 0u;
#pragma unroll
        for (unsigned j = 0; j < 16; ++j) { const unsigned c = xb_ld(&bar[XB_XCNT(j)]); sum += c; cnt += (c > 0u) ? 1u : 0u; mine = (j == x) ? c : mine; }
        if (sum == G) break;
        __builtin_amdgcn_s_sleep(1);
        if ((++sp & 255u) == 0u) { if (xb_ld(&bar[XB_TMO])) break; if (sp > XB_SPIN_CAP) { atomicAdd(&bar[XB_TMO], 1u); break; } }
    }
    nloc = mine > 0u ? mine : 1u; nx = cnt > 0u ? cnt : 1u;
}

__device__ __forceinline__ void xcd_barrier(const XcdBarrier& b) {
    asm volatile("s_waitcnt vmcnt(0)" ::: "memory");
    __syncthreads();
    if (b.w0 && __builtin_amdgcn_mbcnt_hi(~0u, __builtin_amdgcn_mbcnt_lo(~0u, 0u)) == 0u) {
        unsigned* bar = b.bar;
        __builtin_amdgcn_s_waitcnt(0);
        unsigned nloc = b.st[0], nx = b.st[1];
        if (nloc == 0u) { xcd_barrier_complete(bar, b.x, nloc, nx); b.st[0] = nloc; b.st[1] = nx; }
        const unsigned old = xb_add(&bar[XB_XSUB(b.x)], 1u);
        const unsigned gen = old / nloc;
        if (old + 1u == (gen + 1u) * nloc) {
            __builtin_amdgcn_fence(__ATOMIC_RELEASE, "agent");
            asm volatile("s_waitcnt vmcnt(0)" ::: "memory");
            const unsigned og = xb_add(&bar[XB_TOP], 1u);
            const unsigned tg = og / nx;
            if (og + 1u == (tg + 1u) * nx) xb_add(&bar[XB_TOPGEN], 1u);
            else XB_SPIN(xb_ld(&bar[XB_TOPGEN]) == tg, bar);
            __builtin_amdgcn_fence(__ATOMIC_ACQUIRE, "agent");
            xb_add(&bar[XB_XGEN(b.x)], 1u);
            asm volatile("s_waitcnt vmcnt(0)" ::: "memory");
        } else {
            XB_SPIN(xb_ld(&bar[XB_XGEN(b.x)]) == gen, bar);
            __builtin_amdgcn_fence(__ATOMIC_ACQUIRE, "agent");
            asm volatile("s_waitcnt vmcnt(0)" ::: "memory");
        }
    }
    __syncthreads();
}

__device__ __forceinline__ int mk_lane() { return (int)__builtin_amdgcn_mbcnt_hi(~0u, __builtin_amdgcn_mbcnt_lo(~0u, 0u)); }
__device__ __forceinline__ float bf2f(bf16_t b) { return __builtin_bit_cast(float, (unsigned)b << 16); }
__device__ __forceinline__ float wave_sum(float v) {
#pragma unroll
    for (int o = 1; o < 64; o <<= 1) v += __shfl_xor(v, o);
    return v;
}
__device__ __forceinline__ float wave_max(float v) {
#pragma unroll
    for (int o = 1; o < 64; o <<= 1) v = fmaxf(v, __shfl_xor(v, o));
    return v;
}

__host__ __device__ __forceinline__ int win_actual(int v) {
    const int pn = v >> 8, w = v & 255, bj = w >> 7, wc = (w >> 5) & 3, j = w & 31;
    if (pn < 2) return v;
    if (pn < 5) return 512 + 64 * (4 * (pn - 2) + wc) + 32 * bj + j;
    const int hd = 2 * wc + (j >> 4), d = 16 * bj + (j & 15);
    if (pn == 5) return 1280 + 32 * hd + d;
    if (hd == 0) return 1536 + d;
    if (hd == 1 && d < 8) return 1568 + d;
    return -1;
}
__host__ __device__ __forceinline__ int wup_actual(int v) { const int pn = v >> 8, w = v & 255; return (w >> 7) * DFF + 128 * pn + (w & 127); }

namespace pg8 {
#define PG8_LAS __attribute__((address_space(3)))
typedef unsigned short bf16_t;
typedef short bf16x8 __attribute__((ext_vector_type(8)));
typedef float f32x4 __attribute__((ext_vector_type(4)));
typedef unsigned u32x4 __attribute__((ext_vector_type(4)));
constexpr int BM = 256, BK = 64, HALF = 128, HTB = HALF * BK * 2  , STAGE_BYTES = 8 * HTB, NXCD = 8, WGM = 8;

__host__ __device__ __forceinline__ int lds_byte(int r, int c) { const int st = (r >> 4) * 2 + (c >> 5), rr = r & 15, cc = c & 31, ob = rr * 64 + cc * 2; return st * 1024 + (ob ^ (((ob >> 9) & 1) << 5)); }
__host__ __device__ __forceinline__ void stage_rc(int b, int& R, int& C) { const int st = b / 1024, sb = b % 1024, swz = sb ^ (((sb >> 9) & 1) << 5); R = (st >> 1) * 16 + swz / 64; C = (st & 1) * 32 + (swz % 64) / 2; }
__host__ __device__ __forceinline__ int perm32(int rho) { const int n = rho >> 4, i = rho & 15; return 8 * (i >> 2) + 4 * n + (i & 3); }

struct Unit { int pm, pn; };
struct Gemm { const bf16_t* A; const bf16_t* Bt; int M, N, K; };

struct StaticOrder {
    int nM, nN, nwg, G, c;
    __host__ __device__ void init(int M, int N, int G_, int c_) { nM = M / BM; nN = N / BM; nwg = nM * nN; G = G_; c = c_; }
    __host__ __device__ bool next(int i, Unit& u) const {
        const long L = (long)i * G + c; if (L >= nwg) return false;
        int wgid = (int)L; { const int q = nwg / NXCD, r = nwg % NXCD, xcd = wgid % NXCD, off = wgid / NXCD; wgid = (xcd < r ? xcd * (q + 1) : r * (q + 1) + (xcd - r) * q) + off; }
        const int nig = WGM * nN, gid = wgid / nig, fm = gid * WGM, gsz = (nM - fm) < WGM ? (nM - fm) : WGM;
        u.pm = fm + ((wgid % nig) % gsz); u.pn = (wgid % nig) / gsz; return true;
    }
    __device__ __forceinline__ void a_ready(const Unit&) const {}
    __device__ __forceinline__ void done(const Unit&) const {}
};

__device__ __forceinline__ unsigned cvt_pk_bf16(float lo, float hi) { unsigned r; asm volatile("v_cvt_pk_bf16_f32 %0, %1, %2" : "=v"(r) : "v"(lo), "v"(hi)); return r; }
__device__ __forceinline__ unsigned cvt_pk_f16(float lo, float hi) { return (unsigned)__builtin_bit_cast(unsigned short, (_Float16)lo) | ((unsigned)__builtin_bit_cast(unsigned short, (_Float16)hi) << 16); }
typedef float f32x2 __attribute__((ext_vector_type(2)));
typedef unsigned u32x2 __attribute__((ext_vector_type(2)));
__device__ __forceinline__ u32x4 pack8_bf16(const f32x4 a, const f32x4 b) { u32x4 w; w.x = cvt_pk_bf16(a[0], a[1]); w.y = cvt_pk_bf16(a[2], a[3]); w.z = cvt_pk_bf16(b[0], b[1]); w.w = cvt_pk_bf16(b[2], b[3]); return w; }
__device__ __forceinline__ u32x4 pack8_f16(const f32x4 a, const f32x4 b) { u32x4 w; w.x = cvt_pk_f16(a[0], a[1]); w.y = cvt_pk_f16(a[2], a[3]); w.z = cvt_pk_f16(b[0], b[1]); w.w = cvt_pk_f16(b[2], b[3]); return w; }

struct EpiProj {
    static constexpr bool PERM = true, AFTER_DRAIN = false, HAS_INIT = false;
    bf16_t *VP, *Q, *Kb, *Vb; _Float16 *QI, *KI; float* WI; const float* rope32; const float* rope16; const float *gq, *gk;
    __device__ __forceinline__ void operator()(const f32x4 (&acc)[2][2][4][2], const Unit& u, int wr, int wc, int fr, int fq) const {
        const int pn = u.pn, rowb = u.pm * BM + wr * 64 + fr;
        if (pn < 2) {
#pragma unroll
            for (int ai = 0; ai < 2; ++ai)
#pragma unroll
                for (int m = 0; m < 4; ++m) { bf16_t* rp = VP + (size_t)(rowb + ai * HALF + m * 16) * 512 + pn * 256 + wc * 32 + 8 * fq;
#pragma unroll
                    for (int bj = 0; bj < 2; ++bj) *(u32x4*)(rp + bj * HALF) = pack8_bf16(acc[ai][bj][m][0], acc[ai][bj][m][1]); }
        } else if (pn < 5) {
            if (pn == 4 && wc >= 2) {
#pragma unroll
                for (int ai = 0; ai < 2; ++ai)
#pragma unroll
                    for (int m = 0; m < 4; ++m) { bf16_t* rp = Vb + (size_t)(rowb + ai * HALF + m * 16) * 128 + 64 * (wc - 2) + 8 * fq;
#pragma unroll
                        for (int bj = 0; bj < 2; ++bj) *(u32x4*)(rp + bj * 32) = pack8_bf16(acc[ai][bj][m][0], acc[ai][bj][m][1]); }
            } else {
                const bool isk = (pn == 4); const float* g = isk ? gk : gq; const float osc = isk ? 1.0f : 0.18033688011112042f  ;
                f32x4 gv[2][2];
#pragma unroll
                for (int bj = 0; bj < 2; ++bj)
#pragma unroll
                    for (int n = 0; n < 2; ++n) gv[bj][n] = *(const f32x4*)(g + 32 * bj + 8 * fq + 4 * n);
                bf16_t* dst = isk ? (Kb + 64 * wc) : (Q + 64 * (4 * (pn - 2) + wc)); const int ld = isk ? 128 : 512;
#pragma unroll
                for (int ai = 0; ai < 2; ++ai)
#pragma unroll
                    for (int m = 0; m < 4; ++m) { const int row = rowb + ai * HALF + m * 16, pos = row & 2047;
                        float ss = 0.f;
#pragma unroll
                        for (int bj = 0; bj < 2; ++bj)
#pragma unroll
                            for (int n = 0; n < 2; ++n) { const f32x4 v = acc[ai][bj][m][n]; ss += (v[0] * v[0] + v[1] * v[1]) + (v[2] * v[2] + v[3] * v[3]); }
                        ss += __shfl_xor(ss, 16); ss += __shfl_xor(ss, 32);
                        const float rstd = 1.0f / sqrtf(ss * (1.0f / 64.0f) + 1e-6f);
                        const f32x4* rp = (const f32x4*)(rope32 + (size_t)(pos * 32 + 8 * fq) * 2);
                        f32x4 o1[2], o2[2];
#pragma unroll
                        for (int n = 0; n < 2; ++n) { const f32x4 cs0 = rp[2 * n], cs1 = rp[2 * n + 1];
                            const f32x4 x1 = acc[ai][0][m][n] * rstd * gv[0][n], x2 = acc[ai][1][m][n] * rstd * gv[1][n];
                            const f32x4 c = (f32x4){cs0[0], cs0[2], cs1[0], cs1[2]}, s = (f32x4){cs0[1], cs0[3], cs1[1], cs1[3]};
                            o1[n] = (x1 * c - x2 * s) * osc; o2[n] = (x2 * c + x1 * s) * osc; }
                        bf16_t* op = dst + (size_t)row * ld + 8 * fq;
                        *(u32x4*)(op) = pack8_bf16(o1[0], o1[1]); *(u32x4*)(op + 32) = pack8_bf16(o2[0], o2[1]); }
            }
        } else {
            const int hd = 2 * wc + (fq >> 1);
            if (pn == 6 && wc != 0) return;
            if (pn == 6 && hd == 1) {
                if (fq == 2) {
#pragma unroll
                    for (int ai = 0; ai < 2; ++ai)
#pragma unroll
                        for (int m = 0; m < 4; ++m) { float* wp = WI + (size_t)(rowb + ai * HALF + m * 16) * 8;
                            *(f32x4*)(wp) = acc[ai][0][m][0] * 0.0625f; *(f32x4*)(wp + 4) = acc[ai][0][m][1] * 0.0625f; }
                }
                return;
            }
            _Float16* dst = (pn == 5) ? (QI + 32 * hd) : KI; const int ld = (pn == 5) ? 256 : 32;
#pragma unroll
            for (int ai = 0; ai < 2; ++ai)
#pragma unroll
                for (int m = 0; m < 4; ++m) { const int row = rowb + ai * HALF + m * 16, pos = row & 2047;
                    const f32x4* rp = (const f32x4*)(rope16 + (size_t)(pos * 16 + 8 * (fq & 1)) * 2);
                    f32x4 o1[2], o2[2];
#pragma unroll
                    for (int n = 0; n < 2; ++n) { const f32x4 cs0 = rp[2 * n], cs1 = rp[2 * n + 1];
                        const f32x4 x1 = acc[ai][0][m][n], x2 = acc[ai][1][m][n];
                        const f32x4 c = (f32x4){cs0[0], cs0[2], cs1[0], cs1[2]}, s = (f32x4){cs0[1], cs0[3], cs1[1], cs1[3]};
                        o1[n] = x1 * c - x2 * s; o2[n] = x2 * c + x1 * s; }
                    _Float16* op = dst + (size_t)row * ld + 8 * (fq & 1);
                    *(u32x4*)(op) = pack8_f16(o1[0], o1[1]); *(u32x4*)(op + 16) = pack8_f16(o2[0], o2[1]); }
        }
    }
};

__device__ __forceinline__ f32x4 bf16lo_to_f32(const u32x2 w) { return (f32x4){__builtin_bit_cast(float, w.x << 16), __builtin_bit_cast(float, w.x & 0xffff0000u), __builtin_bit_cast(float, w.y << 16), __builtin_bit_cast(float, w.y & 0xffff0000u)}; }
struct EpiWout {
    static constexpr bool PERM = true, AFTER_DRAIN = false, HAS_INIT = true;
    const float* x; bf16_t* X1B; bf16_t* X1L; float* SS2;
    __device__ __forceinline__ void init(f32x4 (&acc)[2][2][4][2], const Unit& u, int wr, int wc, int fr, int fq) const {
        const int rowb = u.pm * BM + wr * 64 + fr, col0 = u.pn * BM + wc * 32 + 8 * fq;
#pragma unroll
        for (int ai = 0; ai < 2; ++ai)
#pragma unroll
            for (int m = 0; m < 4; ++m) { const size_t off = (size_t)(rowb + ai * HALF + m * 16) * 1024 + col0;
#pragma unroll
                for (int bj = 0; bj < 2; ++bj) { acc[ai][bj][m][0] = *(const f32x4*)(x + off + bj * HALF); acc[ai][bj][m][1] = *(const f32x4*)(x + off + bj * HALF + 4); } }
    }
    __device__ __forceinline__ void operator()(const f32x4 (&acc)[2][2][4][2], const Unit& u, int wr, int wc, int fr, int fq) const {
        const int rowb = u.pm * BM + wr * 64 + fr, col0 = u.pn * BM + wc * 32 + 8 * fq;
#pragma unroll
        for (int ai = 0; ai < 2; ++ai)
#pragma unroll
            for (int m = 0; m < 4; ++m) { const int row = rowb + ai * HALF + m * 16; const size_t off = (size_t)row * 1024 + col0; float ss = 0.f;
#pragma unroll
                for (int bj = 0; bj < 2; ++bj) { const f32x4 v0 = acc[ai][bj][m][0], v1 = acc[ai][bj][m][1];
                    ss += (v0[0] * v0[0] + v0[1] * v0[1]) + (v0[2] * v0[2] + v0[3] * v0[3]) + (v1[0] * v1[0] + v1[1] * v1[1]) + (v1[2] * v1[2] + v1[3] * v1[3]);
                    const u32x4 hi = pack8_bf16(v0, v1);
                    const f32x4 h0 = bf16lo_to_f32((u32x2){hi.x, hi.y}), h1 = bf16lo_to_f32((u32x2){hi.z, hi.w});
                    *(u32x4*)(X1B + off + bj * HALF) = hi; *(u32x4*)(X1L + off + bj * HALF) = pack8_bf16(v0 - h0, v1 - h1); }
                ss += __shfl_xor(ss, 16); ss += __shfl_xor(ss, 32);
                if (fq == 0) SS2[(size_t)row * 16 + 4 * u.pn + wc] = ss; }
    }
};
struct EpiDown {
    static constexpr bool PERM = true, AFTER_DRAIN = false, HAS_INIT = true;
    const bf16_t* X1B; const bf16_t* X1L; float* out;
    __device__ __forceinline__ void init(f32x4 (&acc)[2][2][4][2], const Unit& u, int wr, int wc, int fr, int fq) const {
        const int rowb = u.pm * BM + wr * 64 + fr, col0 = u.pn * BM + wc * 32 + 8 * fq;
#pragma unroll
        for (int ai = 0; ai < 2; ++ai) {
            u32x4 hv[4][2], lv[4][2];
#pragma unroll
            for (int m = 0; m < 4; ++m) { const size_t off = (size_t)(rowb + ai * HALF + m * 16) * 1024 + col0;
#pragma unroll
                for (int bj = 0; bj < 2; ++bj) { hv[m][bj] = *(const u32x4*)(X1B + off + bj * HALF); lv[m][bj] = *(const u32x4*)(X1L + off + bj * HALF); } }
#pragma unroll
            for (int m = 0; m < 4; ++m)
#pragma unroll
                for (int bj = 0; bj < 2; ++bj) {
                    acc[ai][bj][m][0] = bf16lo_to_f32((u32x2){hv[m][bj].x, hv[m][bj].y}) + bf16lo_to_f32((u32x2){lv[m][bj].x, lv[m][bj].y});
                    acc[ai][bj][m][1] = bf16lo_to_f32((u32x2){hv[m][bj].z, hv[m][bj].w}) + bf16lo_to_f32((u32x2){lv[m][bj].z, lv[m][bj].w}); }
        }
    }
    __device__ __forceinline__ void operator()(const f32x4 (&acc)[2][2][4][2], const Unit& u, int wr, int wc, int fr, int fq) const {
        const int rowb = u.pm * BM + wr * 64 + fr, col0 = u.pn * BM + wc * 32 + 8 * fq;
#pragma unroll
        for (int ai = 0; ai < 2; ++ai)
#pragma unroll
            for (int m = 0; m < 4; ++m) { float* p = out + (size_t)(rowb + ai * HALF + m * 16) * 1024 + col0;
#pragma unroll
                for (int bj = 0; bj < 2; ++bj) { *(f32x4*)(p + bj * HALF) = acc[ai][bj][m][0]; *(f32x4*)(p + bj * HALF + 4) = acc[ai][bj][m][1]; } }
    }
};
__device__ __forceinline__ float dpp_shr1(float v) { return __builtin_bit_cast(float, __builtin_amdgcn_update_dpp(0, __builtin_bit_cast(int, v), 0x111, 0xf, 0xf, false)); }
template <class T> __device__ __forceinline__ void stg_u32(void* base, unsigned boff, const T v) { *(T*)((char*)base + boff) = v; }
struct EpiUp {
    static constexpr bool PERM = true, AFTER_DRAIN = false, HAS_INIT = false;
    const PG8_LAS float* tab; const PG8_LAS float* wtab; bf16_t* G; bf16_t* HF; bf16_t* HL; mutable int par;
    __device__ __forceinline__ void operator()(const f32x4 (&acc)[2][2][4][2], const Unit& u, int wr, int wc, int fr_, int fq_) const {
        int fr = fr_, fq = fq_; asm volatile("" : "+v"(fr), "+v"(fq));
        const unsigned cb = 32 * wc + 8 * fq, ncol = 128 * u.pn + cb;
        const PG8_LAS float* tb = tab + par * 256 + wr * 64 + 4 * fr; const PG8_LAS float* wt = wtab + par * 1024 + cb; par ^= 1;
#pragma unroll
        for (int ai = 0; ai < 2; ++ai) {
            const unsigned rg = u.pm * BM + ai * HALF + wr * 64, g64 = rg >> 6;
            const f32x4 rs = *(const PG8_LAS f32x4*)(tb + ai * HALF);
            u32x2 gp[2][4];
#pragma unroll
            for (int n = 0; n < 2; ++n) {
                f32x4 cg[4];
#pragma unroll
                for (int bj = 0; bj < 2; ++bj) {
                    const PG8_LAS f32x4* wq = (const PG8_LAS f32x4*)(wt + 128 * bj + 4 * n);
                    const f32x4 w0 = wq[0], w1 = wq[64], w2 = wq[128], bb = wq[192];
                    f32x4 uu[4];
#pragma unroll
                    for (int m = 0; m < 4; ++m) uu[m] = acc[ai][bj][m][n] * rs[m];
                    const unsigned vcol = u.pn * 256u + bj * 128u + cb + 4u * n;
                    if (fr == 0) { stg_u32<u32x2>(HF, ((g64 * 2u + 0u) * 5632u + vcol) * 2u, (u32x2){cvt_pk_bf16(uu[0][0], uu[0][1]), cvt_pk_bf16(uu[0][2], uu[0][3])}); stg_u32<u32x2>(HF, ((g64 * 2u + 1u) * 5632u + vcol) * 2u, (u32x2){cvt_pk_bf16(uu[1][0], uu[1][1]), cvt_pk_bf16(uu[1][2], uu[1][3])}); }
                    if (fr == 15) { stg_u32<u32x2>(HL, ((g64 * 2u + 0u) * 5632u + vcol) * 2u, (u32x2){cvt_pk_bf16(uu[2][0], uu[2][1]), cvt_pk_bf16(uu[2][2], uu[2][3])}); stg_u32<u32x2>(HL, ((g64 * 2u + 1u) * 5632u + vcol) * 2u, (u32x2){cvt_pk_bf16(uu[3][0], uu[3][1]), cvt_pk_bf16(uu[3][2], uu[3][3])}); }
                    f32x4 d2, d3;
#pragma unroll
                    for (int i = 0; i < 4; ++i) { d2[i] = dpp_shr1(uu[2][i]); d3[i] = dpp_shr1(uu[3][i]); }
                    f32x4 c[4];
                    c[0] = bb + w0 * d2 + w1 * d3 + w2 * uu[0];
                    c[1] = bb + w0 * d3 + w1 * uu[0] + w2 * uu[1];
                    c[2] = bb + w0 * uu[0] + w1 * uu[1] + w2 * uu[2];
                    c[3] = bb + w0 * uu[1] + w1 * uu[2] + w2 * uu[3];
#pragma unroll
                    for (int m = 0; m < 4; ++m) {
                        if (bj == 0) cg[m] = c[m];
                        else { f32x4 gsl;
#pragma unroll
                            for (int i = 0; i < 4; ++i) { const float gt = cg[m][i]; gsl[i] = gt * __builtin_amdgcn_rcpf(1.0f + __builtin_amdgcn_exp2f(-gt)) * c[m][i]; }
                            gp[n][m] = (u32x2){cvt_pk_bf16(gsl[0], gsl[1]), cvt_pk_bf16(gsl[2], gsl[3])}; }
                    }
                }
            }
#pragma unroll
            for (int m = 0; m < 4; ++m)
                stg_u32<u32x4>(G, ((rg + 4u * fr + m) * 2816u + ncol) * 2u, (u32x4){gp[0][m].x, gp[0][m].y, gp[1][m].x, gp[1][m].y});
        }
    }
};
struct UpOrder : StaticOrder {
    const float* SS2; PG8_LAS float* tab; PG8_LAS float* wtab; const float* conv_w; const float* conv_b; int wv; mutable int par;
    __device__ __forceinline__ void a_ready(const Unit& u) const {
        const int t = wv * 64 + (int)__builtin_amdgcn_mbcnt_hi(~0u, __builtin_amdgcn_mbcnt_lo(~0u, 0u));
#pragma unroll
        for (int k = 0; k < 2; ++k) { const int idx = t + 512 * k, tap = idx >> 8, v = idx & 255, col = (v >> 7) * 2816 + 128 * u.pn + (v & 127);
            wtab[par * 1024 + idx] = (tap < 3 ? conv_w[tap * 5632 + col] : conv_b[col]) * ((v >> 7) ? 0.6931471805599453f : 1.4426950408889634f); }
        if (t < 256) { const f32x4* sp = (const f32x4*)(SS2 + (size_t)(u.pm * BM + t) * 16); const f32x4 a = sp[0], b = sp[1], c = sp[2], d = sp[3];
            const float s = (((a[0] + a[1]) + (a[2] + a[3])) + ((b[0] + b[1]) + (b[2] + b[3]))) + (((c[0] + c[1]) + (c[2] + c[3])) + ((d[0] + d[1]) + (d[2] + d[3])));
            tab[par * 256 + t] = __builtin_amdgcn_rsqf(s * (1.0f / 1024.0f) + 1e-6f); }
        par ^= 1;
    }
};

template <class Epi, class Sched, bool ALIGN_EPI = false, bool SP2 = false, bool ROWPERM = false>
__device__ __forceinline__ void gemm_phase(PG8_LAS unsigned char* lds, const Gemm g, const Sched& S, const Epi& E, const int wv  ) {
    int tid_ = wv * 64 + (int)__builtin_amdgcn_mbcnt_hi(~0u, __builtin_amdgcn_mbcnt_lo(~0u, 0u)); asm volatile("" : "+v"(tid_));
    const int tid = tid_, wid = __builtin_amdgcn_readfirstlane(tid >> 6), lane = tid & 63, wr = wid >> 2, wc = wid & 3, fr = lane & 15, fq = lane >> 4;
    const int K = g.K, nt = K / BK;
    unsigned voffA[2], voffB[2];
#pragma unroll
    for (int i = 0; i < 2; ++i) { int R, C; stage_rc(tid * 16 + i * 8192, R, C); const int Rb = Epi::PERM ? ((R & ~31) + perm32(R & 31)) : R;
        const int Ra = ROWPERM ? ((R & ~63) + 4 * (R & 15) + ((R >> 4) & 3)) : R;
        voffA[i] = (unsigned)(Ra * K + C) * 2u; voffB[i] = (unsigned)(Rb * K + C) * 2u; }
    const size_t kstep = (size_t)(BK * 2);
    const size_t hstep = (size_t)HALF * K * 2;
    const size_t tstep = 2 * hstep;
    const unsigned ldsw = (unsigned)wid * 1024u;
    const int aoff = lds_byte(wr * 64 + fr, fq * 8), boff = lds_byte(wc * 32 + fr, fq * 8);
#define PG8_SA(b, h) (((b) * 2 + (h)) * HTB)
#define PG8_SB(b, h) ((4 + (b) * 2 + (h)) * HTB)
#define PG8_STAGE(bufoff, gbase, voff) do { _Pragma("unroll") for (int _i = 0; _i < 2; ++_i) \
        __builtin_amdgcn_global_load_lds((const unsigned*)((const char*)(gbase) + (voff)[_i]), (PG8_LAS unsigned*)(lds + (bufoff) + ldsw + _i * 8192), 16, 0, 0); } while (0)
#define PG8_LDA(dst, b, h) do { _Pragma("unroll") for (int m = 0; m < 4; ++m) _Pragma("unroll") for (int k = 0; k < 2; ++k) dst[m][k] = *(const PG8_LAS bf16x8*)(lds + PG8_SA(b, h) + aoff + m * 2048 + k * 1024); } while (0)
#define PG8_LDB(dst, b, h) do { _Pragma("unroll") for (int n = 0; n < 2; ++n) _Pragma("unroll") for (int k = 0; k < 2; ++k) dst[n][k] = *(const PG8_LAS bf16x8*)(lds + PG8_SB(b, h) + boff + n * 2048 + k * 1024); } while (0)
#define PG8_MMA(ai, bj, At, Bt) do { __builtin_amdgcn_s_setprio(1); _Pragma("unroll") for (int m = 0; m < 4; ++m) _Pragma("unroll") for (int n = 0; n < 2; ++n) _Pragma("unroll") for (int k = 0; k < 2; ++k) \
        acc[ai][bj][m][n] = __builtin_amdgcn_mfma_f32_16x16x32_bf16(Bt[n][k], At[m][k], acc[ai][bj][m][n], 0, 0, 0); __builtin_amdgcn_s_setprio(0); } while (0)
#define PG8_WAIT_V(n) asm volatile("s_waitcnt vmcnt(" #n ")" ::: "memory")
#define PG8_WAIT_L(n) asm volatile("s_waitcnt lgkmcnt(" #n ")" ::: "memory")
#define PG8_BAR __builtin_amdgcn_s_barrier()
#define PG8_SCHED __builtin_amdgcn_sched_barrier(0)
    Unit cur, nxt; int ui = 0;
    if (!S.next(0, cur)) return;
    f32x4 acc[2][2][4][2];
    if constexpr (Epi::HAS_INIT) E.init(acc, cur, wr, wc, fr, fq);
    else {
#pragma unroll
    for (int a = 0; a < 2; ++a)
#pragma unroll
        for (int b = 0; b < 2; ++b)
#pragma unroll
            for (int m = 0; m < 4; ++m)
#pragma unroll
                for (int n = 0; n < 2; ++n) acc[a][b][m][n] = (f32x4){0.f, 0.f, 0.f, 0.f};
    }
    bf16x8 At[4][2], B0[2][2], B1[2][2];
    const char* cA = (const char*)g.A + (size_t)cur.pm * tstep; const char* cB = (const char*)g.Bt + (size_t)cur.pn * tstep;
    S.a_ready(cur);
    if constexpr (SP2) {
        PG8_STAGE(PG8_SB(0, 0), cB, voffB); PG8_STAGE(PG8_SB(0, 1), cB + hstep, voffB); PG8_STAGE(PG8_SA(0, 0), cA, voffA); PG8_STAGE(PG8_SA(0, 1), cA + hstep, voffA);
        if (wr == 1) PG8_BAR;
        PG8_WAIT_V(2); PG8_BAR;
        PG8_STAGE(PG8_SB(1, 0), cB + kstep, voffB); PG8_STAGE(PG8_SA(1, 0), cA + kstep, voffA); PG8_STAGE(PG8_SB(1, 1), cB + hstep + kstep, voffB);
        PG8_WAIT_V(6); PG8_BAR;
    } else {
        PG8_STAGE(PG8_SB(0, 0), cB, voffB); PG8_STAGE(PG8_SA(0, 0), cA, voffA); PG8_STAGE(PG8_SB(0, 1), cB + hstep, voffB); PG8_STAGE(PG8_SA(0, 1), cA + hstep, voffA);
        if (wr == 1) PG8_BAR;
        PG8_WAIT_V(4); PG8_BAR;
        PG8_STAGE(PG8_SB(1, 0), cB + kstep, voffB); PG8_STAGE(PG8_SA(1, 0), cA + kstep, voffA); PG8_STAGE(PG8_SB(1, 1), cB + hstep + kstep, voffB);
        PG8_WAIT_V(6); PG8_BAR;
    }
    for (;;) {
        const bool has_next = S.next(ui + 1, nxt);
        const char* nA = has_next ? (const char*)g.A + (size_t)nxt.pm * tstep : cA; const char* nB = has_next ? (const char*)g.Bt + (size_t)nxt.pn * tstep : cB;
        for (int t = 0; t < nt; t += 2) {
            const bool last = (t == nt - 2);
            const char* a1 = cA + (size_t)(t + 1) * kstep;
            const char* a2 = last ? nA : cA + (size_t)(t + 2) * kstep; const char* b2 = last ? nB : cB + (size_t)(t + 2) * kstep;
            const char* a3 = a2 + kstep; const char* b3 = b2 + kstep;
            if (last && has_next) S.a_ready(nxt);
            if constexpr (SP2) {
            PG8_LDB(B0, 0, 0); PG8_LDB(B1, 0, 1); PG8_SCHED; PG8_LDA(At, 0, 0); PG8_STAGE(PG8_SA(1, 1), a1 + hstep, voffA);
            PG8_WAIT_V(8); PG8_WAIT_L(0); PG8_BAR; PG8_MMA(0, 0, At, B0); PG8_MMA(0, 1, At, B1); PG8_BAR; PG8_SCHED;
            PG8_LDA(At, 0, 1); PG8_STAGE(PG8_SB(0, 0), b2, voffB); PG8_STAGE(PG8_SB(0, 1), b2 + hstep, voffB); PG8_STAGE(PG8_SA(0, 0), a2, voffA);
            PG8_WAIT_V(8); PG8_WAIT_L(0); PG8_BAR; PG8_MMA(1, 0, At, B0); PG8_MMA(1, 1, At, B1); PG8_BAR; PG8_SCHED;
            PG8_LDB(B0, 1, 0); PG8_LDB(B1, 1, 1); PG8_SCHED; PG8_LDA(At, 1, 0); PG8_STAGE(PG8_SA(0, 1), a2 + hstep, voffA);
            PG8_WAIT_V(8); PG8_WAIT_L(0); PG8_BAR; PG8_MMA(0, 0, At, B0); PG8_MMA(0, 1, At, B1); PG8_BAR; PG8_SCHED;
            PG8_LDA(At, 1, 1); PG8_STAGE(PG8_SB(1, 0), b3, voffB); PG8_STAGE(PG8_SB(1, 1), b3 + hstep, voffB); PG8_STAGE(PG8_SA(1, 0), a3, voffA);
            PG8_WAIT_V(8); PG8_WAIT_L(0); PG8_BAR; PG8_MMA(1, 0, At, B0); PG8_MMA(1, 1, At, B1); PG8_BAR; PG8_SCHED;
            } else {
            PG8_LDB(B0, 0, 0); PG8_SCHED; PG8_LDA(At, 0, 0); PG8_STAGE(PG8_SA(1, 1), a1 + hstep, voffA);
            PG8_WAIT_L(8); PG8_BAR; PG8_WAIT_L(0); PG8_MMA(0, 0, At, B0); PG8_BAR; PG8_SCHED;
            PG8_LDB(B1, 0, 1); PG8_STAGE(PG8_SB(0, 0), b2, voffB);
            PG8_BAR; PG8_WAIT_L(0); PG8_MMA(0, 1, At, B1); PG8_BAR;
            PG8_LDA(At, 0, 1); PG8_STAGE(PG8_SA(0, 0), a2, voffA);
            PG8_BAR; PG8_WAIT_L(0); PG8_MMA(1, 0, At, B0); PG8_BAR; PG8_SCHED;
            PG8_STAGE(PG8_SB(0, 1), b2 + hstep, voffB);
            PG8_WAIT_V(6); PG8_BAR; PG8_MMA(1, 1, At, B1); PG8_BAR;
            PG8_LDB(B0, 1, 0); PG8_SCHED; PG8_LDA(At, 1, 0); PG8_STAGE(PG8_SA(0, 1), a2 + hstep, voffA);
            PG8_WAIT_L(8); PG8_BAR; PG8_WAIT_L(0); PG8_MMA(0, 0, At, B0); PG8_BAR; PG8_SCHED;
            PG8_LDB(B1, 1, 1); PG8_STAGE(PG8_SB(1, 0), b3, voffB);
            PG8_BAR; PG8_WAIT_L(0); PG8_MMA(0, 1, At, B1); PG8_BAR;
            PG8_LDA(At, 1, 1); PG8_STAGE(PG8_SA(1, 0), a3, voffA);
            PG8_BAR; PG8_WAIT_L(0); PG8_MMA(1, 0, At, B0); PG8_BAR; PG8_SCHED;
            PG8_STAGE(PG8_SB(1, 1), b3 + hstep, voffB);
            PG8_WAIT_V(6); PG8_BAR; PG8_MMA(1, 1, At, B1); PG8_BAR;
            }
        }
        if constexpr (ALIGN_EPI) { if (wr == 0) PG8_BAR; }
        if constexpr (!Epi::AFTER_DRAIN) { E(acc, cur, wr, wc, fr, fq); S.done(cur); }
        if (!has_next) break;
        if constexpr (Epi::HAS_INIT) E.init(acc, nxt, wr, wc, fr, fq);
        else {
#pragma unroll
        for (int a = 0; a < 2; ++a)
#pragma unroll
            for (int b = 0; b < 2; ++b)
#pragma unroll
                for (int m = 0; m < 4; ++m)
#pragma unroll
                    for (int n = 0; n < 2; ++n) acc[a][b][m][n] = (f32x4){0.f, 0.f, 0.f, 0.f};
        }
        cur = nxt; cA = nA; cB = nB; ++ui;
        if constexpr (ALIGN_EPI) { if (wr == 1) PG8_BAR; }
    }
    PG8_WAIT_V(0);
    if constexpr (!ALIGN_EPI) { if (wr == 0) PG8_BAR; }
    PG8_BAR;
    if constexpr (Epi::AFTER_DRAIN) { E.fused(acc, cur, wr, wc, fr, fq, lds, wid, lane); S.done(cur); }
#undef PG8_SA
#undef PG8_SB
#undef PG8_STAGE
#undef PG8_LDA
#undef PG8_LDB
#undef PG8_MMA
#undef PG8_WAIT_V
#undef PG8_WAIT_L
#undef PG8_BAR
#undef PG8_SCHED
}
}

#include <hip/hip_bf16.h>
#include <cmath>
namespace attn_body {
using bf16=__hip_bfloat16;
using bf16x8=__attribute__((ext_vector_type(8)))short;
using s16x4=__attribute__((ext_vector_type(4)))short;
using f32x16=__attribute__((ext_vector_type(16)))float;
using u32x4=__attribute__((ext_vector_type(4)))unsigned;
constexpr int BATCH=8,NHEAD=8,SEQ=2048,D=64,QP=512,KP=128,OP=1024,OOFF=512;
constexpr int NW=8,QBLK=32,QB=QBLK*NW,KVBLK=64,NQB=SEQ/QB;
constexpr int ATTN_UNIT_ROWS=QB;
__device__ __forceinline__ int crow(int r,int hi){return (r&3)+8*(r>>2)+4*hi;}
#define SBAR() __builtin_amdgcn_sched_barrier(0)
__device__ __forceinline__ void cmask(f32x16&p0,f32x16&p1,int jb,int qrel,int hi){
  const float NEG=-INFINITY; int kb=64*jb+4*hi;
  #pragma unroll
  for(int r=0;r<16;++r){int kv=kb+(r&3)+8*(r>>2); if(kv>qrel)p0[r]=NEG; if(kv+32>qrel)p1[r]=NEG;}
}

constexpr int NSLOT=3, SLOTB=8192;
constexpr int LDS_K=0, LDS_V=NSLOT*SLOTB, LDS_WS=2*NSLOT*SLOTB, LDS_OST=LDS_WS+NW*64*4, LDS_BYTES=LDS_OST+NW*4096;
constexpr float C2=0.125f*1.4426950408889634f;
__device__ __forceinline__ void glds16(const void*gsrc,unsigned lds_dst){unsigned keep;
  asm volatile("s_mov_b32 %0, m0\n\ts_mov_b32 m0, %2\n\ts_nop 0\n\tglobal_load_lds_dwordx4 %1, off\n\ts_mov_b32 m0, %0":"=&s"(keep):"v"(gsrc),"s"(lds_dst):"memory");}
__device__ __forceinline__ float max3f(float a,float b,float c){float r;asm("v_max3_f32 %0, %1, %2, %3":"=v"(r):"v"(a),"v"(b),"v"(c));return r;}
__device__ __forceinline__ float max2f(float a,float b){float r;asm("v_max_f32_e32 %0, %1, %2":"=v"(r):"v"(a),"v"(b));return r;}
__device__ __forceinline__ float fadd_s(float a,float b){float r;asm("v_add_f32_e32 %0, %1, %2":"=v"(r):"v"(a),"v"(b));return r;}
__device__ __forceinline__ float fsub_s(float a,float b){float r;asm("v_sub_f32_e32 %0, %1, %2":"=v"(r):"v"(a),"v"(b));return r;}
typedef float f32x2_t __attribute__((ext_vector_type(2))); typedef __bf16 bf16x2_t __attribute__((ext_vector_type(2)));
__device__ __forceinline__ unsigned cvtpk_s(float lo,float hi){f32x2_t v={lo,hi};bf16x2_t b=__builtin_convertvector(v,bf16x2_t);return __builtin_bit_cast(unsigned,b);}
#define WAIT_BAR(N) asm volatile("s_waitcnt vmcnt(" #N ") lgkmcnt(0)\n\ts_barrier":::"memory")

__device__ __forceinline__ void qkt(f32x16&p0,f32x16&p1,const char*Kslot,const bf16x8*qr,const f32x16&negm,int r32,int hi){
  const char*kb=Kslot+hi*1024+r32*16;
  #pragma unroll
  for(int d0=0;d0<4;++d0){
    const bf16x8 b0=*reinterpret_cast<const bf16x8*>(kb+d0*2048);
    const bf16x8 b1=*reinterpret_cast<const bf16x8*>(kb+d0*2048+512);
    if(d0==0){p0=__builtin_amdgcn_mfma_f32_32x32x16_bf16(b0,qr[0],negm,0,0,0);p1=__builtin_amdgcn_mfma_f32_32x32x16_bf16(b1,qr[0],negm,0,0,0);}
    else{p0=__builtin_amdgcn_mfma_f32_32x32x16_bf16(b0,qr[d0],p0,0,0,0);p1=__builtin_amdgcn_mfma_f32_32x32x16_bf16(b1,qr[d0],p1,0,0,0);}}
}
typedef __attribute__((address_space(3))) const char* lds_cptr;
typedef short v4i16_t __attribute__((ext_vector_type(4)));
__device__ __forceinline__ void kload8(bf16x8*kf,lds_cptr kp){
  kf[0]=*(const __attribute__((address_space(3))) bf16x8*)(kp);      kf[1]=*(const __attribute__((address_space(3))) bf16x8*)(kp+512);
  kf[2]=*(const __attribute__((address_space(3))) bf16x8*)(kp+2048); kf[3]=*(const __attribute__((address_space(3))) bf16x8*)(kp+2560);
  kf[4]=*(const __attribute__((address_space(3))) bf16x8*)(kp+4096); kf[5]=*(const __attribute__((address_space(3))) bf16x8*)(kp+4608);
  kf[6]=*(const __attribute__((address_space(3))) bf16x8*)(kp+6144); kf[7]=*(const __attribute__((address_space(3))) bf16x8*)(kp+6656);
}
__device__ __forceinline__ void kload2(bf16x8*kf,lds_cptr kp,int j){ kf[2*j]=*(const __attribute__((address_space(3))) bf16x8*)(kp+j*2048); kf[2*j+1]=*(const __attribute__((address_space(3))) bf16x8*)(kp+j*2048+512); }
__device__ __forceinline__ s16x4 vtr(lds_cptr p){ return __builtin_bit_cast(s16x4,__builtin_amdgcn_ds_read_tr16_b64_v4i16((__attribute__((address_space(3))) v4i16_t*)p)); }
__device__ __forceinline__ float rowmax(const f32x16&p0,const f32x16&p1){
  float a=max3f(p0[0],p0[1],p1[0]),b=max3f(p0[2],p0[3],p1[1]);a=max3f(a,p1[2],p1[3]);
  #pragma unroll
  for(int r=4;r<16;r+=4){a=max3f(a,p0[r],p0[r+1]);b=max3f(b,p0[r+2],p0[r+3]);a=max3f(a,p1[r],p1[r+1]);b=max3f(b,p1[r+2],p1[r+3]);}
  const float m=max2f(a,b);
  auto rr=__builtin_amdgcn_permlane32_swap(__float_as_uint(m),__float_as_uint(m),false,false);
  return max2f(__uint_as_float(rr[0]),__uint_as_float(rr[1]));
}
__device__ __forceinline__ void pv(f32x16*o,int vb,bf16x8 pa0,bf16x8 pa1,bf16x8 pa2,bf16x8 pa3){
  #pragma unroll
  for(int d0=0;d0<2;++d0){s16x4 lo[4],hi[4];
    #pragma unroll
    for(int ks=0;ks<4;++ks){
      asm volatile("ds_read_b64_tr_b16 %0,%1 offset:%c2":"=&v"(lo[ks]):"v"(vb),"i"(d0*4096+ks*1024):"memory");
      asm volatile("ds_read_b64_tr_b16 %0,%1 offset:%c2":"=&v"(hi[ks]):"v"(vb),"i"(d0*4096+ks*1024+512):"memory");}
    asm volatile("s_waitcnt lgkmcnt(0)":::"memory");SBAR();
    #define PK(k) (bf16x8){lo[k][0],lo[k][1],lo[k][2],lo[k][3],hi[k][0],hi[k][1],hi[k][2],hi[k][3]}
    o[d0]=__builtin_amdgcn_mfma_f32_32x32x16_bf16(pa0,PK(0),o[d0],0,0,0);
    o[d0]=__builtin_amdgcn_mfma_f32_32x32x16_bf16(pa1,PK(1),o[d0],0,0,0);
    o[d0]=__builtin_amdgcn_mfma_f32_32x32x16_bf16(pa2,PK(2),o[d0],0,0,0);
    o[d0]=__builtin_amdgcn_mfma_f32_32x32x16_bf16(pa3,PK(3),o[d0],0,0,0);
    #undef PK
  }
}

#ifndef ATTN_STORE16
#define ATTN_STORE16(p,v) (*(u32x4*)(p)=(v))
#endif
template<int THRL> __device__ __forceinline__ void attn_unit(int b,int h,int qb,const bf16*Q,const bf16*__restrict__ K,const bf16*__restrict__ V,const unsigned long long*__restrict__ MASK,bf16*O,char*shm,const int wv){
  int tid_=wv*64+(int)__builtin_amdgcn_mbcnt_hi(~0u,__builtin_amdgcn_mbcnt_lo(~0u,0u)); asm volatile("":"+v"(tid_)); const int tid=tid_,lane=tid&63,r32=lane&31,hi=lane>>5; const int wid=__builtin_amdgcn_readfirstlane(tid>>6);
  const long rowbase=(long)b*SEQ; const int q0=qb*QB;
  const bf16*Qw=Q+(rowbase+q0+wid*QBLK)*QP+h*D;
  const bf16*Kh=K+rowbase*KP+(h>>2)*D,*Vh=V+rowbase*KP+(h>>2)*D;
  const unsigned lds0=(unsigned)(uintptr_t)shm;
  float*wsf=(float*)(shm+LDS_WS)+wid*64;
  const bf16*ksrc=Kh+(long)lane*KP+wid*8;
  const bf16*vsrc=Vh+(long)(16*(wid&3)+(lane>>2))*KP+(wid>>2)*32+(lane&3)*8;
  const unsigned kdst=lds0+LDS_K+wid*1024, vdst=lds0+LDS_V+wid*1024;
  #define DMA_K(t,slot) glds16(ksrc+(long)(t)*KVBLK*KP,(unsigned)__builtin_amdgcn_readfirstlane(kdst+(slot)))
  #define DMA_V(t,slot) glds16(vsrc+(long)(t)*KVBLK*KP,(unsigned)__builtin_amdgcn_readfirstlane(vdst+(slot)))
  const int vb0=(int)(lds0+LDS_V)+((lane>>4)&1)*32+(lane&3)*8+(4*hi+((lane&15)>>2))*64;
  const char*Kbase=shm+LDS_K; bf16x8 kf[8];
  const lds_cptr shm3=(lds_cptr)shm; const lds_cptr kp0=shm3+LDS_K+hi*1024+r32*16; const lds_cptr vp0=shm3+LDS_V+((lane>>4)&1)*32+(lane&3)*8+(4*hi+((lane&15)>>2))*64;
  const int NT=(q0+QB)/KVBLK;
  DMA_K(0,0);DMA_V(0,0);DMA_K(1,SLOTB);
  bf16x8 qr[4];
  #pragma unroll
  for(int d0=0;d0<4;++d0)qr[d0]=*reinterpret_cast<const bf16x8*>(&Qw[(long)r32*QP+d0*16+hi*8]);
  float l_reg=0.f;f32x16 o[2];o[0]=f32x16{};o[1]=f32x16{};const f32x16 negm=f32x16{};
  const int qrel=wid*QBLK+r32;
  const unsigned long long*mrow=MASK+(rowbase+q0+qrel)*(SEQ/64);
  unsigned long long mk=mrow[0];
  #define MKSH(WL,WH,t) unsigned WL=(unsigned)mk>>(4*hi), WH=(unsigned)(mk>>32)>>(4*hi); asm volatile("":"+v"(WL),"+v"(WH)); mk=mrow[(t)+1]
  #define CMASKW(P0,P1,WL,WH) do{ _Pragma("unroll") for(int r=0;r<16;++r){ const int ps_=(r&3)+8*(r>>2); const float a_=P0[r], b_=P1[r]; \
      const unsigned m0_=(unsigned)__builtin_amdgcn_sbfe((int)WL,ps_,1), m1_=(unsigned)__builtin_amdgcn_sbfe((int)WH,ps_,1); \
      const unsigned ua_=(__builtin_bit_cast(unsigned,a_)&m0_)|(0xff800000u&~m0_), ub_=(__builtin_bit_cast(unsigned,b_)&m1_)|(0xff800000u&~m1_); \
      P0[r]=__builtin_bit_cast(float,ua_); P1[r]=__builtin_bit_cast(float,ub_); } }while(0)
  #define START(P0,P1) do{ _Pragma("unroll") for(int r=0;r<16;++r)P0[r]=__builtin_amdgcn_exp2f(P0[r]); }while(0)
  #define RESC() do{}while(0)
  f32x16 pA0,pA1,pB0,pB1;
  int sl_prev=0,sl_cur=0,sl_next=SLOTB;
  #define ROT() do{sl_prev=sl_cur;sl_cur=sl_next;sl_next=(sl_next==(NSLOT-1)*SLOTB)?0:sl_next+SLOTB;}while(0)
  DMA_K(2,2*SLOTB);
  WAIT_BAR(3);
  qkt(pA0,pA1,Kbase,qr,negm,r32,hi);asm volatile("s_nop 15\n\ts_nop 7":"+v"(pA0),"+v"(pA1));{MKSH(wl0_,wh0_,0);CMASKW(pA0,pA1,wl0_,wh0_);}
  START(pA0,pA1);
  _Pragma("unroll") for(int r=0;r<16;++r)pA1[r]=__builtin_amdgcn_exp2f(pA1[r]);
  WAIT_BAR(0);
  DMA_K(3,0);DMA_V(1,SLOTB);
  ROT();
  kload8(kf,kp0+sl_cur);
  WAIT_BAR(2);
  s16x4 vlo[8],vhi[8]; u32x4 pw0,pw1,pw2,pw3;
  #define PKW(P,B) cvtpk_s(P[B],P[B+1])
  #define PAF(k) __builtin_bit_cast(bf16x8,pw##k)
  #define VFR(i) (bf16x8){vlo[i][0],vlo[i][1],vlo[i][2],vlo[i][3],vhi[i][0],vhi[i][1],vhi[i][2],vhi[i][3]}
  #define PIN(x) asm volatile("":"+v"(x))
  #define MX3(a,b,c) __builtin_fmaxf(__builtin_fmaxf((a),(b)),(c))
  #define GAPA(MF,A0,A1,A2,A3,W0,W1,PW) do{ MF; sacc+=A0; sacc+=A1; sacc+=A2; sacc+=A3; PIN(sacc); W0; W1; PIN(PW); SBAR(); }while(0)
  #define EX(v) __builtin_amdgcn_exp2f(v)
  #define GAPB(MF,X,B) do{ MF; X[B]=EX(X[B]); X[B+1]=EX(X[B+1]); X[B+2]=EX(X[B+2]); X[B+3]=EX(X[B+3]); PIN(X); SBAR(); }while(0)
  #define VRD(i) do{ vlo[i]=vtr(vp_+(((i)>>2)*4096+((i)&3)*1024)); vhi[i]=vtr(vp_+(((i)>>2)*4096+((i)&3)*1024+512)); }while(0)
  #define KRD(G,j) do{ if(G){ kload2(kf,kp0+sl_next,j); SBAR(); } }while(0)
  #define STEP(C0,C1,P0,P1,t,GK,GV,GL) do{ SBAR(); \
    const lds_cptr vp_=vp0+sl_prev; \
    VRD(0); SBAR(); float sacc=(P0[0]+P0[1]); \
    GAPA(C0=__builtin_amdgcn_mfma_f32_32x32x16_bf16(kf[0],qr[0],negm,0,0,0), P0[2],P0[3],P0[4],P0[5],     pw0[0]=PKW(P0,0), pw0[1]=PKW(P0,2), pw0); \
    VRD(4); SBAR(); GAPA(C1=__builtin_amdgcn_mfma_f32_32x32x16_bf16(kf[1],qr[0],negm,0,0,0), P0[6],P0[7],P0[8],P0[9],     pw0[2]=PKW(P0,4), pw0[3]=PKW(P0,6), pw0); \
    VRD(1); SBAR(); GAPA(C0=__builtin_amdgcn_mfma_f32_32x32x16_bf16(kf[2],qr[1],C0,0,0,0),   P0[10],P0[11],P0[12],P0[13], pw1[0]=PKW(P0,8), pw1[1]=PKW(P0,10), pw1); \
    VRD(5); SBAR(); GAPA(C1=__builtin_amdgcn_mfma_f32_32x32x16_bf16(kf[3],qr[1],C1,0,0,0),   P0[14],P0[15],P1[0],P1[1],   pw1[2]=PKW(P0,12),pw1[3]=PKW(P0,14), pw1); \
    VRD(2); SBAR(); GAPA(C0=__builtin_amdgcn_mfma_f32_32x32x16_bf16(kf[4],qr[2],C0,0,0,0),   P1[2],P1[3],P1[4],P1[5],     pw2[0]=PKW(P1,0), pw2[1]=PKW(P1,2), pw2); \
    VRD(6); SBAR(); GAPA(C1=__builtin_amdgcn_mfma_f32_32x32x16_bf16(kf[5],qr[2],C1,0,0,0),   P1[6],P1[7],P1[8],P1[9],     pw2[2]=PKW(P1,4), pw2[3]=PKW(P1,6), pw2); \
    VRD(3); SBAR(); GAPA(C0=__builtin_amdgcn_mfma_f32_32x32x16_bf16(kf[6],qr[3],C0,0,0,0),   P1[10],P1[11],P1[12],P1[13], pw3[0]=PKW(P1,8), pw3[1]=PKW(P1,10), pw3); \
    VRD(7); SBAR(); GAPA(C1=__builtin_amdgcn_mfma_f32_32x32x16_bf16(kf[7],qr[3],C1,0,0,0),   P1[14],P1[15],0.f,0.f,       pw3[2]=PKW(P1,12),pw3[3]=PKW(P1,14), pw3); \
    l_reg+=sacc; \
    MKSH(wl_,wh_,t); \
    if(GK){DMA_K((t)+3,sl_cur);} if(GV){DMA_V((t)+1,sl_next);} \
    CMASKW(C0,C1,wl_,wh_); \
    SBAR(); \
    GAPB(o[0]=__builtin_amdgcn_mfma_f32_32x32x16_bf16(PAF(0),VFR(0),o[0],0,0,0), C0,0); \
    GAPB(o[1]=__builtin_amdgcn_mfma_f32_32x32x16_bf16(PAF(0),VFR(4),o[1],0,0,0), C0,4); \
    KRD(GL,0); GAPB(o[0]=__builtin_amdgcn_mfma_f32_32x32x16_bf16(PAF(1),VFR(1),o[0],0,0,0), C0,8); \
    KRD(GL,1); GAPB(o[1]=__builtin_amdgcn_mfma_f32_32x32x16_bf16(PAF(1),VFR(5),o[1],0,0,0), C0,12); \
    KRD(GL,2); GAPB(o[0]=__builtin_amdgcn_mfma_f32_32x32x16_bf16(PAF(2),VFR(2),o[0],0,0,0), C1,0); \
    KRD(GL,3); GAPB(o[1]=__builtin_amdgcn_mfma_f32_32x32x16_bf16(PAF(2),VFR(6),o[1],0,0,0), C1,4); \
    GAPB(o[0]=__builtin_amdgcn_mfma_f32_32x32x16_bf16(PAF(3),VFR(3),o[0],0,0,0), C1,8); \
    GAPB(o[1]=__builtin_amdgcn_mfma_f32_32x32x16_bf16(PAF(3),VFR(7),o[1],0,0,0), C1,12); \
    }while(0)
  int t=1;
  for(;t+5<NT;t+=2){
    STEP(pB0,pB1,pA0,pA1,t,true,true,true);     WAIT_BAR(2); RESC(); ROT();
    STEP(pA0,pA1,pB0,pB1,t+1,true,true,true);   WAIT_BAR(2); RESC(); ROT();
  }
  #define ENDW(tt) do{ if((tt)+3<NT){WAIT_BAR(2);} else if((tt)+2<NT){WAIT_BAR(1);} else {WAIT_BAR(0);} }while(0)
  for(;t+1<NT;t+=2){
    STEP(pB0,pB1,pA0,pA1,t,(t+3<NT),(t+1<NT),(t+1<NT));       ENDW(t);   RESC(); ROT();
    STEP(pA0,pA1,pB0,pB1,t+1,(t+4<NT),(t+2<NT),(t+2<NT));     ENDW(t+1); RESC(); ROT();
  }
  STEP(pB0,pB1,pA0,pA1,NT-1,false,false,false); RESC();
  { float sacc=pB0[0]+pB0[1]; _Pragma("unroll") for(int r=2;r<16;++r)sacc+=pB0[r]; _Pragma("unroll") for(int r=0;r<16;++r)sacc+=pB1[r]; l_reg+=sacc;
    pw0=(u32x4){PKW(pB0,0),PKW(pB0,2),PKW(pB0,4),PKW(pB0,6)};pw1=(u32x4){PKW(pB0,8),PKW(pB0,10),PKW(pB0,12),PKW(pB0,14)};pw2=(u32x4){PKW(pB1,0),PKW(pB1,2),PKW(pB1,4),PKW(pB1,6)};pw3=(u32x4){PKW(pB1,8),PKW(pB1,10),PKW(pB1,12),PKW(pB1,14)};
    SBAR(); pv(o,vb0+sl_cur,PAF(0),PAF(1),PAF(2),PAF(3)); }
  #undef PKW
  #undef PAF
  #undef VFR
  #undef PIN
  #undef MX3
  #undef GAPA
  #undef GAPB
  #undef EX
  #undef VRD
  #undef KRD
  #undef STEP
  #undef ENDW
  {auto rr=__builtin_amdgcn_permlane32_swap(__float_as_uint(l_reg),__float_as_uint(l_reg),false,false);l_reg=__uint_as_float(rr[0])+__uint_as_float(rr[1]);}
  if(hi==0)wsf[32+r32]=l_reg;asm volatile("s_waitcnt lgkmcnt(0)":::"memory");
  float rli[16];
  #pragma unroll
  for(int r=0;r<16;++r)rli[r]=__builtin_amdgcn_rcpf(wsf[32+crow(r,hi)]);
  bf16*Ow=O+(rowbase+q0+wid*QBLK)*OP+OOFF+h*D;
  { bf16*stg=(bf16*)(shm+LDS_OST)+wid*2048;
    #pragma unroll
    for(int r=0;r<16;++r){const int orow=crow(r,hi);
      #pragma unroll
      for(int d0=0;d0<2;++d0)stg[orow*64+d0*32+r32]=__float2bfloat16(o[d0][r]*rli[r]);}
    asm volatile("s_waitcnt lgkmcnt(0)":::"memory");
    #pragma unroll
    for(int i=0;i<4;++i){const int row=i*8+(lane>>3),ch=lane&7; const u32x4 v=*(const u32x4*)(stg+row*64+ch*8); ATTN_STORE16(Ow+(long)row*OP+ch*8,v);} }
  asm volatile("s_waitcnt lgkmcnt(0)\n\ts_barrier":::"memory");
  #undef DMA_K
  #undef DMA_V
  #undef CMASKW
  #undef MKSH
  #undef START
  #undef RESC
  #undef ROT
}
constexpr int ATTN_LDS_BYTES=LDS_BYTES;
struct AttnTensors { const bf16* Q; const bf16* K; const bf16* V; const unsigned long long* MASK; bf16* O; };
struct AttnUnit { int bh; int qb; };
struct StaticOrder {
  int vcu,G;
  __device__ __forceinline__ explicit StaticOrder(int grid,int block):vcu((grid%8==0)?(block%8)*(grid/8)+block/8:block),G(grid){}
  __device__ __forceinline__ bool next(int i,AttnUnit&u)const{ const int it=vcu+(i>>1)*G; if(it>=BATCH*NHEAD*4)return false; const int s=it&3; u.bh=it>>2; u.qb=(i&1)?7-s:s; return true; }
  __device__ __forceinline__ void a_ready(const AttnUnit&)const{}
  __device__ __forceinline__ void done(const AttnUnit&)const{}
};
template<class Sched,int THRL=8> __device__ __forceinline__ void attn_phase(char*lds,const AttnTensors&T,const Sched&S,const int wv){
  AttnUnit u;
  for(int i=0;S.next(i,u);++i){ S.a_ready(u); attn_unit<THRL>(u.bh/NHEAD,u.bh%NHEAD,u.qb,T.Q,T.K,T.V,T.MASK,T.O,lds,wv); S.done(u); }
}
#undef SBAR
#undef WAIT_BAR
}

#ifndef REPS
#define REPS {1, 1, 1, 1, 1, 1, 1, 1}
#endif
constexpr int kReps[8] = REPS;
#ifndef SREPS
#define SREPS {1, 1, 1, 1, 1, 1, 1, 1}
#endif
constexpr int kSub[8] = SREPS;
typedef _Float16 f16x8 __attribute__((ext_vector_type(8)));
typedef float f32x16 __attribute__((ext_vector_type(16)));
__device__ __forceinline__ unsigned score_key(float s) { const unsigned u = __builtin_bit_cast(unsigned, s + 0.0f); return u ^ ((unsigned)((int)u >> 31) | 0x80000000u); }
__device__ __forceinline__ float key_score(unsigned k) { return __builtin_bit_cast(float, (k & 0x80000000u) ? (k & 0x7fffffffu) : ~k); }
__device__ __forceinline__ float wave_sum_f32(float v) {
    v += __builtin_bit_cast(float, __builtin_amdgcn_update_dpp(0, __builtin_bit_cast(int, v), 0xb1, 0xf, 0xf, false));
    v += __builtin_bit_cast(float, __builtin_amdgcn_update_dpp(0, __builtin_bit_cast(int, v), 0x4e, 0xf, 0xf, false));
    v += __builtin_bit_cast(float, __builtin_amdgcn_update_dpp(0, __builtin_bit_cast(int, v), 0x141, 0xf, 0xf, false));
    v += __builtin_bit_cast(float, __builtin_amdgcn_update_dpp(0, __builtin_bit_cast(int, v), 0x140, 0xf, 0xf, false));
    return __builtin_bit_cast(float, __builtin_amdgcn_readlane(__builtin_bit_cast(int, v), 0)) + __builtin_bit_cast(float, __builtin_amdgcn_readlane(__builtin_bit_cast(int, v), 16))
         + __builtin_bit_cast(float, __builtin_amdgcn_readlane(__builtin_bit_cast(int, v), 32)) + __builtin_bit_cast(float, __builtin_amdgcn_readlane(__builtin_bit_cast(int, v), 48));
}
__device__ __forceinline__ int wave_sum_i32(int v) {
    v += __builtin_amdgcn_update_dpp(0, v, 0xb1, 0xf, 0xf, false);
    v += __builtin_amdgcn_update_dpp(0, v, 0x4e, 0xf, 0xf, false);
    v += __builtin_amdgcn_update_dpp(0, v, 0x141, 0xf, 0xf, false);
    v += __builtin_amdgcn_update_dpp(0, v, 0x140, 0xf, 0xf, false);
    return __builtin_amdgcn_readlane(v, 0) + __builtin_amdgcn_readlane(v, 16) + __builtin_amdgcn_readlane(v, 32) + __builtin_amdgcn_readlane(v, 48);
}
__device__ __forceinline__ void count_ge8(unsigned& cnt, unsigned cand, unsigned k0, unsigned k1, unsigned k2, unsigned k3, unsigned k4, unsigned k5, unsigned k6, unsigned k7) {
    unsigned long long m0, m1, m2, m3;
    asm volatile(
        "v_cmp_ge_u32_e64 %1, %5, %13\n\tv_cmp_ge_u32_e64 %2, %6, %13\n\tv_cmp_ge_u32_e64 %3, %7, %13\n\tv_cmp_ge_u32_e64 %4, %8, %13\n\t"
        "v_addc_co_u32_e64 %0, vcc, 0, %0, %1\n\tv_cmp_ge_u32_e64 %1, %9, %13\n\t"
        "v_addc_co_u32_e64 %0, vcc, 0, %0, %2\n\tv_cmp_ge_u32_e64 %2, %10, %13\n\t"
        "v_addc_co_u32_e64 %0, vcc, 0, %0, %3\n\tv_cmp_ge_u32_e64 %3, %11, %13\n\t"
        "v_addc_co_u32_e64 %0, vcc, 0, %0, %4\n\tv_cmp_ge_u32_e64 %4, %12, %13\n\t"
        "v_addc_co_u32_e64 %0, vcc, 0, %0, %1\n\tv_addc_co_u32_e64 %0, vcc, 0, %0, %2\n\tv_addc_co_u32_e64 %0, vcc, 0, %0, %3\n\tv_addc_co_u32_e64 %0, vcc, 0, %0, %4"
        : "+v"(cnt), "=&s"(m0), "=&s"(m1), "=&s"(m2), "=&s"(m3)
        : "v"(k0), "v"(k1), "v"(k2), "v"(k3), "v"(k4), "v"(k5), "v"(k6), "v"(k7), "s"(cand) : "vcc");
}
#define IDX_REP8(X, o) X((o) + 0) X((o) + 1) X((o) + 2) X((o) + 3) X((o) + 4) X((o) + 5) X((o) + 6) X((o) + 7)
template <int NREG>
__device__ __forceinline__ void indexer_task_n(int b, int t0, const f16_t* __restrict__ QI, const f16_t* __restrict__ KI, const float* __restrict__ WI, unsigned long long* __restrict__ MASK, int lane) {
    const int r32 = lane & 31, hi = lane >> 5; const size_t rowb = (size_t)b * SEQ;
    const f16_t* qp = QI + (rowb + t0 + (r32 >> 3)) * 256 + 32 * (r32 & 7) + 8 * hi;
    const f16x8 a0 = *(const f16x8*)(qp), a1 = *(const f16x8*)(qp + 16);
    f32x4 wv[4];
#pragma unroll
    for (int q = 0; q < 4; ++q) wv[q] = *(const f32x4*)(WI + (rowb + t0 + q) * 8 + 4 * hi);
    const int nst = (t0 + 3) / 64 + 1;
    const f16_t* kp = KI + (rowb + r32) * 32 + 8 * hi;
    unsigned key[4][NREG];
    f16x8 bq[3][4];
#pragma unroll
    for (int i = 0; i < 4; ++i) bq[0][i] = *(const f16x8*)(kp + (i >> 1) * 1024 + (i & 1) * 16);
    if (1 < nst) {
#pragma unroll
        for (int i = 0; i < 4; ++i) bq[1][i] = *(const f16x8*)(kp + (size_t)2048 + (i >> 1) * 1024 + (i & 1) * 16); }
#pragma unroll
    for (int st = 0; st < NREG; ++st) {
        if (st < nst) {
            if (st + 2 < NREG && st + 2 < nst) {
#pragma unroll
                for (int i = 0; i < 4; ++i) bq[(st + 2) % 3][i] = *(const f16x8*)(kp + (size_t)(st + 2) * 2048 + (i >> 1) * 1024 + (i & 1) * 16);
            }
            const f32x16 z16 = (f32x16){0.f, 0.f, 0.f, 0.f, 0.f, 0.f, 0.f, 0.f, 0.f, 0.f, 0.f, 0.f, 0.f, 0.f, 0.f, 0.f};
            f32x16 c0 = __builtin_amdgcn_mfma_f32_32x32x16_f16(a0, bq[st % 3][0], z16, 0, 0, 0);
            c0 = __builtin_amdgcn_mfma_f32_32x32x16_f16(a1, bq[st % 3][1], c0, 0, 0, 0);
            f32x16 c1 = __builtin_amdgcn_mfma_f32_32x32x16_f16(a0, bq[st % 3][2], z16, 0, 0, 0);
            c1 = __builtin_amdgcn_mfma_f32_32x32x16_f16(a1, bq[st % 3][3], c1, 0, 0, 0);
#pragma unroll
            for (int q = 0; q < 4; ++q) {
                float pa = 0.f, pb = 0.f;
#pragma unroll
                for (int i = 0; i < 4; ++i) { pa += wv[q][i] * __builtin_amdgcn_fmed3f(c0[4 * q + i], 0.f, __builtin_inff()); pb += wv[q][i] * __builtin_amdgcn_fmed3f(c1[4 * q + i], 0.f, __builtin_inff()); }
                const auto rr = __builtin_amdgcn_permlane32_swap(__builtin_bit_cast(unsigned, pa), __builtin_bit_cast(unsigned, pb), false, false);
                const unsigned rr0 = rr[0], rr1 = rr[1];
                const float sc = __builtin_bit_cast(float, rr0) + __builtin_bit_cast(float, rr1);
                key[q][st] = (st + 1 < nst || 64 * st + lane <= t0 + q) ? score_key(sc) : 0u;
            }
        } else {
#pragma unroll
            for (int q = 0; q < 4; ++q) key[q][st] = 0u;
        }
    }
    const int t0u = __builtin_amdgcn_readfirstlane(t0), nstu = (t0u + 3) / 64 + 1;
    bool done[4], exact[4]; unsigned eq[4], gt[4], cgt[4];
#pragma unroll
    for (int q = 0; q < 4; ++q) { exact[q] = false; done[q] = (t0u + q < TOPK); eq[q] = 0xffffffffu; gt[q] = 0u; cgt[q] = 0u;
        if (!done[q]) {
#define IDX_TSTAGE(J, MK) _Pragma("unroll") for (int k = 0; k < 32; ++k) if ((k & J) == 0) { const unsigned t_ = ((key[q][k] >> J) ^ key[q][k + J]) & MK; key[q][k + J] ^= t_; key[q][k] ^= t_ << J; }
            IDX_TSTAGE(16, 0x0000ffffu) IDX_TSTAGE(8, 0x00ff00ffu) IDX_TSTAGE(4, 0x0f0f0f0fu) IDX_TSTAGE(2, 0x33333333u) IDX_TSTAGE(1, 0x55555555u)
#undef IDX_TSTAGE
        } }
#pragma unroll
    for (int b = 31; b >= 0; --b) {
        if (done[0] && done[1] && done[2] && done[3]) break;
        unsigned tb[4], c[4] = {0u, 0u, 0u, 0u};
#pragma unroll
        for (int q = 0; q < 4; ++q) { tb[q] = 0u; if (!done[q]) { tb[q] = eq[q] & key[q][b]; c[q] = (unsigned)__builtin_popcount(tb[q]) + cgt[q]; } }
        const int c01 = (done[0] && done[1]) ? 0 : wave_sum_i32((int)(c[0] | (c[1] << 16))), c23 = (done[2] && done[3]) ? 0 : wave_sum_i32((int)(c[2] | (c[3] << 16)));
        const int cs[4] = {c01 & 0xffff, c01 >> 16, c23 & 0xffff, c23 >> 16};
#pragma unroll
        for (int q = 0; q < 4; ++q) if (!done[q]) {
            if (cs[q] >= TOPK) { eq[q] = tb[q]; if (cs[q] == TOPK) { gt[q] |= tb[q]; done[q] = true; exact[q] = true; } }
            else { gt[q] |= tb[q]; cgt[q] = c[q]; eq[q] ^= tb[q]; } }
    }
#define IDX_PUTW(bal, st) do { const unsigned long long b_ = (bal); asm volatile("s_nop 1\n\tv_writelane_b32 %0, %2, %4\n\tv_writelane_b32 %1, %3, %4" : "+v"(wlo), "+v"(whi) : "s"((unsigned)b_), "s"((unsigned)(b_ >> 32)), "n"(st));     } while (0)
#pragma unroll
    for (int q = 0; q < 4; ++q) {
        const int t = t0 + q; unsigned wlo = 0u, whi = 0u;
        if (t < TOPK) {
#define IDX_X(st) IDX_PUTW(__ballot(64 * (st) + lane <= t), st);
            IDX_REP8(IDX_X, 0)
#undef IDX_X
        } else {
            const bool ex = exact[q]; const unsigned gsel = gt[q], ties = eq[q]; int need = 0;
            if (!ex) need = TOPK - wave_sum_i32((int)cgt[q]);
            const unsigned long long lt = (1ull << lane) - 1ull;
#define IDX_X(st) { bool sel_ = (gsel >> (st)) & 1u; \
                    if (!ex) { const bool tie_ = (ties >> (st)) & 1u; const unsigned long long tb_ = __ballot(tie_); sel_ = sel_ || (tie_ && __popcll(tb_ & lt) < need); need -= __popcll(tb_); if (need < 0) need = 0; } \
                    IDX_PUTW(__ballot(sel_), st); }
            IDX_REP8(IDX_X, 0)
            if (NREG > 8 && nst > 8) { IDX_REP8(IDX_X, 8) }
            if (NREG > 16 && nst > 16) { IDX_REP8(IDX_X, 16) }
            if (NREG > 24 && nst > 24) { IDX_REP8(IDX_X, 24) }
#undef IDX_X
        }
        if (lane < 32) MASK[(rowb + t) * 32 + lane] = (unsigned long long)wlo | ((unsigned long long)whi << 32);
    }
#undef IDX_PUTW
}
#undef IDX_REP8

constexpr int NWAVES = 8;
constexpr int RING_OFF = 0, RING_BYTES = 131072;
constexpr int LDSCTL_OFF = RING_BYTES, MISC_OFF = LDSCTL_OFF + 320;
constexpr int LDS_BYTES = 147456;
constexpr int TAB_OFF = MISC_OFF + 128;
constexpr int WTAB_OFF = TAB_OFF + 2048;
static_assert(WTAB_OFF + 8192 <= LDS_BYTES, "LDS map");
constexpr int N_PHASES = 8;

struct Args { const float* in[13]; float* out; unsigned char* ws; int ph_lo, ph_hi, li, pad; };

__device__ __forceinline__ void p0_transpose_item(const float* W, int K, int N, bf16_t* WT, int Nv, int mode, const float* kscale, LAS float* scr, int item, int lane) {
    const int nblk = Nv / 32, kb = item / nblk, nb = item % nblk, k0 = 64 * kb, n0 = 32 * nb;
    const int v = n0 + (lane & 31); const int a = mode == 0 ? v : (mode == 1 ? win_actual(v) : wup_actual(v));
    float vals[32];
    const float* wp = W + (size_t)(k0 + (lane >> 5)) * N + (a >= 0 ? a : 0);
#pragma unroll
    for (int i = 0; i < 32; ++i) vals[i] = wp[(size_t)(2 * i) * N];
#pragma unroll
    for (int i = 0; i < 32; ++i) { const int kk = 2 * i + (lane >> 5); float val = (a >= 0) ? vals[i] : 0.f;
        if (kscale) val *= kscale[k0 + kk];
        scr[kk * 33 + (lane & 31)] = val; }
    LDS_WAIT(); asm volatile("" ::: "memory");
    const int c = lane & 7;
#pragma unroll
    for (int j = 0; j < 4; ++j) { const int n = (lane >> 3) + 8 * j; const LAS float* s = scr + (8 * c) * 33 + n;
        v4u o; o.x = pk2(s[0 * 33], s[1 * 33]); o.y = pk2(s[2 * 33], s[3 * 33]); o.z = pk2(s[4 * 33], s[5 * 33]); o.w = pk2(s[6 * 33], s[7 * 33]);
        *(GAS v4u*)(WT + (size_t)(n0 + n) * K + k0 + 8 * c) = o; }
    LDS_WAIT(); asm volatile("" ::: "memory");
}

__global__ void __launch_bounds__(NWAVES * 64, 2) mk_fwd(Args args) {
    extern __shared__ __attribute__((aligned(16))) unsigned char lds[];
    LAS unsigned char* L = (LAS unsigned char*)lds;
    volatile LAS unsigned* MISC = (volatile LAS unsigned*)(L + MISC_OFF);
    const int wave = __builtin_amdgcn_readfirstlane((int)threadIdx.x >> 6);
#define MK_IDS const int lane = mk_lane(), tid = wave * 64 + lane; (void)tid
    const int G = gridDim.x; const int bx = blockIdx.x; const int vcu = (G % 8 == 0) ? (bx % 8) * (G / 8) + bx / 8 : bx;
    unsigned char* ws = args.ws;
    gu32* ctl = (gu32*)(ws + WS_CTL);
    const float* x = args.in[0]; const float* norm1_g = args.in[1]; const float* w_in = args.in[2]; const float* q_norm_g = args.in[3]; const float* k_norm_g = args.in[4];
    const float* w_out = args.in[7]; const float* norm2_g = args.in[8]; const float* w_up = args.in[9]; const float* conv_w = args.in[10]; const float* conv_b = args.in[11]; const float* w_down = args.in[12];
    float* out = args.out;
    float* ROPE = (float*)(ws + WS_ROPE); float* ROPE16 = (float*)(ws + WS_ROPE16);
    bf16_t *Win = (bf16_t*)(ws + WS_WIN), *Wout = (bf16_t*)(ws + WS_WOUT), *Wup = (bf16_t*)(ws + WS_WUP), *Wdn = (bf16_t*)(ws + WS_WDN);
    float* SS2 = (float*)(ws + WS_SS2);
    bf16_t *XN = (bf16_t*)(ws + WS_XN), *VP = (bf16_t*)(ws + WS_VP), *Q = (bf16_t*)(ws + WS_Q), *Kb = (bf16_t*)(ws + WS_K), *Vb = (bf16_t*)(ws + WS_V);
    f16_t *QI = (f16_t*)(ws + WS_QI), *KI = (f16_t*)(ws + WS_KI); float* WI = (float*)(ws + WS_WI);
    bf16_t *MIX = (bf16_t*)(ws + WS_MIX), *Gb = (bf16_t*)(ws + WS_G);
    bf16_t *HF = (bf16_t*)(ws + WS_HF), *HL = (bf16_t*)(ws + WS_HL); bf16_t* X1L = (bf16_t*)(ws + WS_X1L);
    unsigned long long* MASK = (unsigned long long*)(ws + WS_MASK); const float* pool_w = args.in[5]; const float* pool_scale = args.in[6];

    for (int u = (int)threadIdx.x; u < (LDS_BYTES - LDSCTL_OFF) / 4; u += NWAVES * 64) ((LAS unsigned*)(L + LDSCTL_OFF))[u] = 0u;
    __syncthreads();
    XcdBarrier bar = xcd_barrier_post((unsigned*)(ctl + CW_BAR) + args.li * XCD_BAR_WORDS, MISC + 8); bar.w0 = (wave == 0);
    const int lo = args.ph_lo, hi = args.ph_hi;
#define IN(k) (lo <= (k) && (k) < hi)
#define SEAM(k) do { if (IN(k) && IN((k) + 1)) xcd_barrier(bar); } while (0)
    const int gw = vcu * NWAVES + wave, NGW = G * NWAVES;

    if (IN(0)) for (int rep_ = 0; rep_ < kReps[0]; ++rep_) { if (rep_) xcd_barrier(bar);
        MK_IDS;
        LAS float* scr = (LAS float*)(L + RING_OFF + wave * 16384);
        constexpr int I_IN = (D_MODEL / 64) * (IN_WV / 32), I_OUT = (D_MODEL / 64) * (D_MODEL / 32), I_UP = (D_MODEL / 64) * (UP_W / 32), I_DN = (DFF / 64) * (D_MODEL / 32);
        for (int sr_ = 0; sr_ < kSub[0]; ++sr_)
        for (int it = gw; it < I_IN + I_OUT + I_UP + I_DN; it += NGW) {
            int r = it;
            if (r < I_IN) { p0_transpose_item(w_in, D_MODEL, IN_W, Win, IN_WV, 1, nullptr, scr, r, lane); continue; } r -= I_IN;
            if (r < I_OUT) { if (r >= 8 * (D_MODEL / 32)) p0_transpose_item(w_out, D_MODEL, D_MODEL, Wout, D_MODEL, 0, nullptr, scr, r, lane); continue; } r -= I_OUT;
            if (r < I_UP) { p0_transpose_item(w_up, D_MODEL, UP_W, Wup, UP_W, 2, norm2_g, scr, r, lane); continue; } r -= I_UP;
            p0_transpose_item(w_down, DFF, D_MODEL, Wdn, D_MODEL, 0, nullptr, scr, r, lane);
        }
        for (int sr_ = 0; sr_ < kSub[1]; ++sr_)
        for (int it = vcu * NWAVES * 64 + tid; it < 128 * D_MODEL; it += G * NWAVES * 64) {
            const int n = it & (D_MODEL - 1), c4 = it >> 10, g = c4 >> 5;
            const float* pw = pool_w + (size_t)(4 * c4) * 128;
            const float* wo = w_out + (size_t)(128 * g) * D_MODEL + n; const float* ps = pool_scale + 128 * g;
            float a4[4] = {0.f, 0.f, 0.f, 0.f};
#pragma unroll 32
            for (int d = 0; d < 128; ++d) { const float wv = wo[(size_t)d * D_MODEL] * ps[d];
#pragma unroll
                for (int e = 0; e < 4; ++e) a4[e] += pw[e * 128 + d] * wv; }
            *(unsigned long long*)(Wout + (size_t)n * D_MODEL + 4 * c4) = (unsigned long long)pk2(a4[0], a4[1]) | ((unsigned long long)pk2(a4[2], a4[3]) << 32);
        }
        for (int sr_ = 0; sr_ < kSub[2]; ++sr_)
        for (int i = vcu * NWAVES * 64 + tid; i < SEQ * 48; i += G * NWAVES * 64) {
            int pos, k; float inv; float* dst;
            if (i < SEQ * 32) { pos = i >> 5; k = i & 31; inv = expf(-logf(10000.0f) * (float)k / 32.0f); dst = ROPE + 2 * i; }
            else { const int i2 = i - SEQ * 32; pos = i2 >> 4; k = i2 & 15; inv = expf(-logf(10000.0f) * (float)k / 16.0f); dst = ROPE16 + 2 * i2; }
            float s, c; sincosf((float)pos * inv, &s, &c); dst[0] = c; dst[1] = s;
        }
        for (int sr_ = 0; sr_ < kSub[3]; ++sr_)
        for (int m4 = gw; m4 < M / 4; m4 += NGW) {
            f32x4 v[4][4]; float ssq[4];
#pragma unroll
            for (int r = 0; r < 4; ++r) { const GAS f32x4* xr = (const GAS f32x4*)(x + (size_t)(4 * m4 + r) * D_MODEL) + lane;
#pragma unroll
                for (int j = 0; j < 4; ++j) v[r][j] = xr[64 * j]; }
#pragma unroll
            for (int r = 0; r < 4; ++r) { float s = 0.f;
#pragma unroll
                for (int j = 0; j < 4; ++j) s += (v[r][j].x * v[r][j].x + v[r][j].y * v[r][j].y) + (v[r][j].z * v[r][j].z + v[r][j].w * v[r][j].w);
                ssq[r] = s; }
#pragma unroll
            for (int o = 1; o < 64; o <<= 1) {
#pragma unroll
                for (int r = 0; r < 4; ++r) ssq[r] += __shfl_xor(ssq[r], o); }
#pragma unroll
            for (int r = 0; r < 4; ++r) { const float rstd = 1.0f / sqrtf(ssq[r] * (1.0f / D_MODEL) + EPS);
                GAS unsigned long long* o8 = (GAS unsigned long long*)(XN + (size_t)(4 * m4 + r) * D_MODEL) + lane;
#pragma unroll
                for (int j = 0; j < 4; ++j) { const f32x4 gg = ((const f32x4*)norm1_g)[lane + 64 * j];
                    o8[64 * j] = (unsigned long long)pk2(v[r][j].x * rstd * gg.x, v[r][j].y * rstd * gg.y) | ((unsigned long long)pk2(v[r][j].z * rstd * gg.z, v[r][j].w * rstd * gg.w) << 32); } }
        }
    }
    SEAM(0);
    if (IN(1)) for (int rep_ = 0; rep_ < kReps[1]; ++rep_) { if (rep_) xcd_barrier(bar);
        pg8::Gemm g{XN, Win, M, IN_WV, D_MODEL}; pg8::StaticOrder S; S.init(M, IN_WV, G, bx);
        pg8::EpiProj E{VP, Q, Kb, Vb, QI, KI, WI, ROPE, ROPE16, q_norm_g, k_norm_g};
        pg8::gemm_phase<pg8::EpiProj, pg8::StaticOrder, true, true>(L + RING_OFF, g, S, E, wave);
    }
    SEAM(1);
    if (IN(2)) for (int rep_ = 0; rep_ < kReps[2]; ++rep_) { if (rep_) xcd_barrier(bar);
        MK_IDS;
        for (int sr_ = 0; sr_ < kSub[4]; ++sr_)
        for (int wi = gw; wi < M / 4; wi += NGW) {
            const int row = 4 * wi + (lane >> 4), t = row & (SEQ - 1);
            const bf16_t* vp = VP + (size_t)row * POOL_W + 8 * (lane & 15);
            v4u u2[2], u4[4], u8[8], u16[16];
#define POOL_LD(U, W, g) _Pragma("unroll") for (int k = 0; k < W; ++k) U[k] = *(const v4u*)(vp + 128 * (g) - (size_t)((k <= t) ? k : 0) * POOL_W);
            POOL_LD(u2, 2, 0) POOL_LD(u4, 4, 1) POOL_LD(u8, 8, 2) POOL_LD(u16, 16, 3)
#undef POOL_LD
#define POOL_OUT(U, W, g) do { float sum[8], v0[8]; \
                _Pragma("unroll") for (int e = 0; e < 8; ++e) sum[e] = 0.f; \
                _Pragma("unroll") for (int k = 0; k < W; ++k) { const float m_ = (k <= t) ? 1.f : 0.f; const unsigned uu[4] = {U[k].x, U[k].y, U[k].z, U[k].w}; \
                    _Pragma("unroll") for (int e = 0; e < 4; ++e) { const float lo = __builtin_bit_cast(float, uu[e] << 16), hh = __builtin_bit_cast(float, uu[e] & 0xffff0000u); sum[2 * e] += m_ * lo; sum[2 * e + 1] += m_ * hh; \
                        if (k == 0) { v0[2 * e] = lo; v0[2 * e + 1] = hh; } } } \
                const float rc = 1.0f / (float)((t + 1 < W) ? t + 1 : W); \
                v4u o; o.x = pk2(sum[0] * rc - v0[0], sum[1] * rc - v0[1]); o.y = pk2(sum[2] * rc - v0[2], sum[3] * rc - v0[3]); o.z = pk2(sum[4] * rc - v0[4], sum[5] * rc - v0[5]); o.w = pk2(sum[6] * rc - v0[6], sum[7] * rc - v0[7]); \
                *(v4u*)(MIX + (size_t)row * 1024 + 128 * (g) + 8 * (lane & 15)) = o; } while (0)
            POOL_OUT(u2, 2, 0); POOL_OUT(u4, 4, 1); POOL_OUT(u8, 8, 2); POOL_OUT(u16, 16, 3);
#undef POOL_OUT
        }
        for (int sr_ = 0; sr_ < kSub[5]; ++sr_)
        for (int id = gw; id < M / 4; id += NGW) {
            const int w = id & 2047, bb = w >> 8, tq = (id < 2048) ? (w & 255) : 511 - (w & 255);
            indexer_task_n<32>(bb, 4 * tq, QI, KI, WI, MASK, lane);
        }
    }
    SEAM(2);
    if (IN(3)) for (int rep_ = 0; rep_ < kReps[3]; ++rep_) { if (rep_) xcd_barrier(bar);
        const attn_body::AttnTensors AT{(const attn_body::bf16*)Q, (const attn_body::bf16*)Kb, (const attn_body::bf16*)Vb, MASK, (attn_body::bf16*)MIX};
        const attn_body::StaticOrder S((int)G, (int)bx);
        attn_body::attn_phase<attn_body::StaticOrder>((char*)lds + RING_OFF, AT, S, wave);
    }
    SEAM(3);
    if (IN(4)) for (int rep_ = 0; rep_ < kReps[4]; ++rep_) { if (rep_) xcd_barrier(bar);
        pg8::Gemm g{MIX, Wout, M, D_MODEL, D_MODEL}; pg8::StaticOrder S; S.init(M, D_MODEL, G, bx);
        pg8::EpiWout E{x, XN, X1L, SS2};
        pg8::gemm_phase<pg8::EpiWout, pg8::StaticOrder, true, true>(L + RING_OFF, g, S, E, wave);
    }
    SEAM(4);
    if (IN(5)) for (int rep_ = 0; rep_ < kReps[5]; ++rep_) { if (rep_) xcd_barrier(bar);
        pg8::Gemm g{XN, Wup, M, UP_W, D_MODEL}; pg8::UpOrder S; S.init(M, UP_W, G, bx); S.SS2 = SS2; S.tab = (LAS float*)(L + TAB_OFF); S.wtab = (LAS float*)(L + WTAB_OFF); S.conv_w = conv_w; S.conv_b = conv_b; S.wv = wave; S.par = 0;
        pg8::EpiUp E{(const LAS float*)(L + TAB_OFF), (const LAS float*)(L + WTAB_OFF), Gb, HF, HL, 0};
        pg8::gemm_phase<pg8::EpiUp, pg8::UpOrder, true, true, true>(L + RING_OFF, g, S, E, wave);
    }
    SEAM(5);
    if (IN(6)) for (int rep_ = 0; rep_ < kReps[6]; ++rep_) { if (rep_) xcd_barrier(bar);
        MK_IDS;
        for (int idx = vcu * NWAVES * 64 + tid; idx < 256 * 2 * (DFF / 4); idx += G * NWAVES * 64) {
            const int n4 = idx % (DFF / 4), gj = idx / (DFF / 4), j = gj & 1, g64 = gj >> 1, n = 4 * n4;
            const int vg = 256 * (n >> 7) + (n & 127);
            f32x4 cc[2];
#pragma unroll
            for (int bj = 0; bj < 2; ++bj) { const int v = vg + 128 * bj;
#define HLD(P, r) ({ const unsigned long long w_ = *(const unsigned long long*)((P) + (size_t)(r) * UP_W + v); (f32x4){__builtin_bit_cast(float, (unsigned)w_ << 16), __builtin_bit_cast(float, (unsigned)w_ & 0xffff0000u), __builtin_bit_cast(float, (unsigned)(w_ >> 32) << 16), __builtin_bit_cast(float, (unsigned)(w_ >> 32) & 0xffff0000u)}; })
                const f32x4 f0 = HLD(HF, g64 * 2 + 0), f1 = HLD(HF, g64 * 2 + 1);
                f32x4 l0 = (f32x4){0.f, 0.f, 0.f, 0.f}, l1 = l0;
                if (g64 & 31) { l0 = HLD(HL, (g64 - 1) * 2 + 0); l1 = HLD(HL, (g64 - 1) * 2 + 1); }
#undef HLD
                const f32x4 um2 = j ? l1 : l0, um1 = j ? f0 : l1, u0 = j ? f1 : f0;
                const float* wp = conv_w + bj * DFF + n;
                cc[bj] = *(const f32x4*)(conv_b + bj * DFF + n) + *(const f32x4*)(wp) * um2 + *(const f32x4*)(wp + UP_W) * um1 + *(const f32x4*)(wp + 2 * UP_W) * u0; }
            float gs[4];
#pragma unroll
            for (int i = 0; i < 4; ++i) { const float gt = cc[0][i]; gs[i] = gt / (1.0f + __expf(-gt)) * cc[1][i]; }
            unsigned long long w = (unsigned long long)pk2(gs[0], gs[1]) | ((unsigned long long)pk2(gs[2], gs[3]) << 32);
            *(unsigned long long*)(Gb + (size_t)(64 * g64 + j) * DFF + n) = w;
        }
    }
    SEAM(6);
    if (IN(7)) {
        pg8::Gemm g{Gb, Wdn, M, D_MODEL, DFF}; pg8::StaticOrder S; S.init(M, D_MODEL, G, bx);
        pg8::EpiDown E{XN, X1L, out};
        pg8::gemm_phase<pg8::EpiDown, pg8::StaticOrder, true, true>(L + RING_OFF, g, S, E, wave);
    }
#undef IN
#undef SEAM
}

static int mk_grid() {
    static int grid = 0;
    if (grid == 0) {
        int dev = 0, cus = 0, per_cu = 0;
        if (hipGetDevice(&dev) != hipSuccess || hipDeviceGetAttribute(&cus, hipDeviceAttributeMultiprocessorCount, dev) != hipSuccess) { fprintf(stderr, "kernel_launch: device query failed\n"); grid = -1; return grid; }
        if (hipFuncSetAttribute((const void*)mk_fwd, hipFuncAttributeMaxDynamicSharedMemorySize, LDS_BYTES) != hipSuccess) { fprintf(stderr, "kernel_launch: hipFuncSetAttribute failed\n"); grid = -1; return grid; }
        if (hipOccupancyMaxActiveBlocksPerMultiprocessor(&per_cu, (const void*)mk_fwd, NWAVES * 64, LDS_BYTES) != hipSuccess || per_cu < 1) { fprintf(stderr, "kernel_launch: occupancy query reports %d workgroups per CU\n", per_cu); (void)hipGetLastError(); }
        grid = cus;
    }
    return grid;
}
static void mk_launch(Args a, int lo, int hi, int li, hipStream_t stream) {
    const int grid = mk_grid(); if (grid <= 0) return;
    a.ph_lo = lo; a.ph_hi = hi; a.li = li;
    hipLaunchKernelGGL(mk_fwd, dim3(grid), dim3(NWAVES * 64), LDS_BYTES, stream, a);
}

extern "C" void kernel_launch(void* const* d_in, const int* in_sizes, int n_in, void* d_out, int out_size, void* d_ws, size_t ws_size, hipStream_t stream) {
    const float* pool_w = (const float*)d_in[5]; const float* pool_scale = (const float*)d_in[6];
    unsigned char* ws = (unsigned char*)d_ws;
    bf16_t *VP = (bf16_t*)(ws + WS_VP), *Q = (bf16_t*)(ws + WS_Q), *Kb = (bf16_t*)(ws + WS_K), *Vb = (bf16_t*)(ws + WS_V);
    f16_t *QI = (f16_t*)(ws + WS_QI), *KI = (f16_t*)(ws + WS_KI); float* WI = (float*)(ws + WS_WI);
    unsigned long long* MASK = (unsigned long long*)(ws + WS_MASK); bf16_t* MIX = (bf16_t*)(ws + WS_MIX);
    (void)hipMemsetAsync(ws + WS_CTL, 0, CTL_ZERO_BYTES, stream);
    Args a{};
    for (int i = 0; i < 13; ++i) a.in[i] = (const float*)d_in[i];
    a.out = (float*)d_out; a.ws = ws;
    mk_launch(a, 0, N_PHASES, 0, stream);
}
```

```cpp
#include <hip/hip_runtime.h>
#include <cstdint>
#include <cstdio>

typedef unsigned short bf16_t;
typedef _Float16 f16_t;

constexpr int D_MODEL = 1024, BATCH = 8, SEQ = 2048, M = BATCH * SEQ;
constexpr int POOL_W = 512, NQH = 8, HD = 64, NKV = 2, IH = 8, ID = 32, TOPK = 256;
constexpr int IN_W = 1576, IN_WV = 1792;
constexpr int DFF = 2816, UP_W = 2 * DFF;
constexpr float EPS = 1e-6f;
constexpr float C2 = 0.125f * 1.4426950408889634f;

constexpr size_t MiB = 1u << 20;
constexpr size_t WS_CTL = 0, CTL_ZERO_BYTES = 32768;
constexpr size_t WS_ROPE = 1 * MiB;
constexpr size_t WS_ROPE16 = 1 * MiB + 512 * 1024;
constexpr size_t WS_WIN = 2 * MiB, WS_WOUT = 6 * MiB, WS_WUP = 8 * MiB, WS_WDN = 19 * MiB;
constexpr size_t WS_SS2 = 25 * MiB;
constexpr size_t WS_RSTD2 = 26 * MiB;
constexpr size_t WS_XN = 28 * MiB;
constexpr size_t WS_VP = 60 * MiB, WS_Q = 76 * MiB, WS_K = 92 * MiB, WS_V = 96 * MiB, WS_QI = 100 * MiB, WS_KI = 108 * MiB, WS_WI = 109 * MiB;
constexpr size_t WS_MASK = 110 * MiB, WS_MIX = 114 * MiB;
constexpr size_t WS_G = 60 * MiB;
constexpr size_t WS_HF = 192 * MiB, WS_HL = 204 * MiB;
constexpr int CW_BAR = 4096;

#define GAS __attribute__((address_space(1)))
#define LAS __attribute__((address_space(3)))
typedef unsigned short bf16;
typedef unsigned v4u __attribute__((ext_vector_type(4)));
typedef float f32x4 __attribute__((ext_vector_type(4)));
typedef short bf16x8 __attribute__((ext_vector_type(8)));
typedef GAS unsigned gu32;
typedef GAS unsigned long long gu64;
#define RLX_AGENT __ATOMIC_RELAXED, __HIP_MEMORY_SCOPE_AGENT
#define LDS_WAIT() asm volatile("s_waitcnt lgkmcnt(0)" ::: "memory")
#define VM_WAIT() asm volatile("s_waitcnt vmcnt(0)" ::: "memory")
__device__ __forceinline__ unsigned long long rt() { return __builtin_amdgcn_s_memrealtime(); }
__device__ __forceinline__ unsigned f2bf(float f) { unsigned u = __builtin_bit_cast(unsigned, f); return (u + 0x7fffu + ((u >> 16) & 1u)) >> 16; }
__device__ __forceinline__ unsigned pk2(float lo, float hi) { return f2bf(lo) | (f2bf(hi) << 16); }

#define XB_TMO      128
#define XB_XCNT(j)  (256  + 64 * (j))
#define XB_XSUB(j)  (1280 + 64 * (j))
#define XB_XGEN(j)  (2304 + 64 * (j))
#define XB_TOP      3328
#define XB_TOPGEN   3392
#define XCD_BAR_WORDS 3456
#define XB_SPIN_CAP (1u << 18)

__device__ __forceinline__ unsigned xb_ld(unsigned* p)              { return __hip_atomic_load(p, __ATOMIC_RELAXED, __HIP_MEMORY_SCOPE_AGENT); }
__device__ __forceinline__ unsigned xb_add(unsigned* p, unsigned v) { return __hip_atomic_fetch_add(p, v, __ATOMIC_RELAXED, __HIP_MEMORY_SCOPE_AGENT); }
__device__ __forceinline__ unsigned xb_xcc_id() { return (unsigned)__builtin_amdgcn_s_getreg((3 << 11) | 20) & 0xFu; }
#define XB_SPIN(cond, bar) do { unsigned _sp = 0; while (cond) { __builtin_amdgcn_s_sleep(1); \
    if ((++_sp & 255u) == 0u) { if (xb_ld(&(bar)[XB_TMO])) break; if (_sp > XB_SPIN_CAP) { atomicAdd(&(bar)[XB_TMO], 1u); break; } } } } while (0)

struct XcdBarrier {
    unsigned* bar; unsigned x;
    volatile LAS unsigned* st;
    bool w0;
};

__device__ __forceinline__ XcdBarrier xcd_barrier_post(unsigned* bar, volatile LAS unsigned* st) {
    XcdBarrier b; b.bar = bar; b.x = xb_xcc_id(); b.st = st;
    if (threadIdx.x == 0) (void)xb_add(&bar[XB_XCNT(b.x)], 1u);
    return b;
}
__device__ __forceinline__ void xcd_barrier_complete(unsigned* bar, unsigned x, unsigned& nloc, unsigned& nx) {
    const unsigned G = gridDim.x * gridDim.y * gridDim.z;
    unsigned sum, cnt, mine, sp = 0u;
    for (;;) {
        sum = 0u; cnt = 0u; mine = 0u;
#pragma unroll
        for (unsigned j = 0; j < 16; ++j) { const unsigned c = xb_ld(&bar[XB_XCNT(j)]); sum += c; cnt += (c > 0u) ? 1u : 0u; mine = (j == x) ? c : mine; }
        if (sum == G) break;
        __builtin_amdgcn_s_sleep(1);
        if ((++sp & 255u) == 0u) { if (xb_ld(&bar[XB_TMO])) break; if (sp > XB_SPIN_CAP) { atomicAdd(&bar[XB_TMO], 1u); break; } }
    }
    nloc = mine > 0u ? mine : 1u; nx = cnt > 0u ? cnt : 1u;
}

__device__ __forceinline__ void xcd_barrier(const XcdBarrier& b) {
    asm volatile("s_waitcnt vmcnt(0)" ::: "memory");
    __syncthreads();
    if (b.w0 && __builtin_amdgcn_mbcnt_hi(~0u, __builtin_amdgcn_mbcnt_lo(~0u, 0u)) == 0u) {
        unsigned* bar = b.bar;
        __builtin_amdgcn_s_waitcnt(0);
        unsigned nloc = b.st[0], nx = b.st[1];
        if (nloc == 0u) { xcd_barrier_complete(bar, b.x, nloc, nx); b.st[0] = nloc; b.st[1] = nx; }
        const unsigned old = xb_add(&bar[XB_XSUB(b.x)], 1u);
        const unsigned gen = old / nloc;
        if (old + 1u == (gen + 1u) * nloc) {
            __builtin_amdgcn_fence(__ATOMIC_RELEASE, "agent");
            asm volatile("s_waitcnt vmcnt(0)" ::: "memory");
            const unsigned og = xb_add(&bar[XB_TOP], 1u);
            const unsigned tg = og / nx;
            if (og + 1u == (tg + 1u) * nx) xb_add(&bar[XB_TOPGEN], 1u);
            else XB_SPIN(xb_ld(&bar[XB_TOPGEN]) == tg, bar);
            __builtin_amdgcn_fence(__ATOMIC_ACQUIRE, "agent");
            xb_add(&bar[XB_XGEN(b.x)], 1u);
            asm volatile("s_waitcnt vmcnt(0)" ::: "memory");
        } else {
            XB_SPIN(xb_ld(&bar[XB_XGEN(b.x)]) == gen, bar);
            __builtin_amdgcn_fence(__ATOMIC_ACQUIRE, "agent");
            asm volatile("s_waitcnt vmcnt(0)" ::: "memory");
        }
    }
    __syncthreads();
}

__device__ __forceinline__ int mk_lane() { return (int)__builtin_amdgcn_mbcnt_hi(~0u, __builtin_amdgcn_mbcnt_lo(~0u, 0u)); }
__device__ __forceinline__ float bf2f(bf16_t b) { return __builtin_bit_cast(float, (unsigned)b << 16); }
__device__ __forceinline__ float wave_sum(float v) {
#pragma unroll
    for (int o = 1; o < 64; o <<= 1) v += __shfl_xor(v, o);
    return v;
}
__device__ __forceinline__ float wave_max(float v) {
#pragma unroll
    for (int o = 1; o < 64; o <<= 1) v = fmaxf(v, __shfl_xor(v, o));
    return v;
}

__host__ __device__ __forceinline__ int win_actual(int v) {
    const int pn = v >> 8, w = v & 255, bj = w >> 7, wc = (w >> 5) & 3, j = w & 31;
    if (pn < 2) return v;
    if (pn < 5) return 512 + 64 * (4 * (pn - 2) + wc) + 32 * bj + j;
    const int hd = 2 * wc + (j >> 4), d = 16 * bj + (j & 15);
    if (pn == 5) return 1280 + 32 * hd + d;
    if (hd == 0) return 1536 + d;
    if (hd == 1 && d < 8) return 1568 + d;
    return -1;
}
__host__ __device__ __forceinline__ int wup_actual(int v) { const int pn = v >> 8, w = v & 255; return (w >> 7) * DFF + 128 * pn + (w & 127); }

namespace pg8 {
#define PG8_LAS __attribute__((address_space(3)))
typedef unsigned short bf16_t;
typedef short bf16x8 __attribute__((ext_vector_type(8)));
typedef float f32x4 __attribute__((ext_vector_type(4)));
typedef unsigned u32x4 __attribute__((ext_vector_type(4)));
constexpr int BM = 256, BK = 64, HALF = 128, HTB = HALF * BK * 2  , STAGE_BYTES = 8 * HTB, NXCD = 8, WGM = 8;

__host__ __device__ __forceinline__ int lds_byte(int r, int c) { const int st = (r >> 4) * 2 + (c >> 5), rr = r & 15, cc = c & 31, ob = rr * 64 + cc * 2; return st * 1024 + (ob ^ (((ob >> 9) & 1) << 5)); }
__host__ __device__ __forceinline__ void stage_rc(int b, int& R, int& C) { const int st = b / 1024, sb = b % 1024, swz = sb ^ (((sb >> 9) & 1) << 5); R = (st >> 1) * 16 + swz / 64; C = (st & 1) * 32 + (swz % 64) / 2; }
__host__ __device__ __forceinline__ int perm32(int rho) { const int n = rho >> 4, i = rho & 15; return 8 * (i >> 2) + 4 * n + (i & 3); }

struct Unit { int pm, pn; };
struct Gemm { const bf16_t* A; const bf16_t* Bt; int M, N, K; };

struct StaticOrder {
    int nM, nN, nwg, G, c;
    __host__ __device__ void init(int M, int N, int G_, int c_) { nM = M / BM; nN = N / BM; nwg = nM * nN; G = G_; c = c_; }
    __host__ __device__ bool next(int i, Unit& u) const {
        const long L = (long)i * G + c; if (L >= nwg) return false;
        int wgid = (int)L; { const int q = nwg / NXCD, r = nwg % NXCD, xcd = wgid % NXCD, off = wgid / NXCD; wgid = (xcd < r ? xcd * (q + 1) : r * (q + 1) + (xcd - r) * q) + off; }
        const int nig = WGM * nN, gid = wgid / nig, fm = gid * WGM, gsz = (nM - fm) < WGM ? (nM - fm) : WGM;
        u.pm = fm + ((wgid % nig) % gsz); u.pn = (wgid % nig) / gsz; return true;
    }
    __device__ __forceinline__ void a_ready(const Unit&) const {}
    __device__ __forceinline__ void done(const Unit&) const {}
};

__device__ __forceinline__ unsigned cvt_pk_bf16(float lo, float hi) { unsigned r; asm volatile("v_cvt_pk_bf16_f32 %0, %1, %2" : "=v"(r) : "v"(lo), "v"(hi)); return r; }
__device__ __forceinline__ unsigned cvt_pk_f16(float lo, float hi) { return (unsigned)__builtin_bit_cast(unsigned short, (_Float16)lo) | ((unsigned)__builtin_bit_cast(unsigned short, (_Float16)hi) << 16); }
typedef float f32x2 __attribute__((ext_vector_type(2)));
typedef unsigned u32x2 __attribute__((ext_vector_type(2)));
__device__ __forceinline__ u32x4 pack8_bf16(const f32x4 a, const f32x4 b) { u32x4 w; w.x = cvt_pk_bf16(a[0], a[1]); w.y = cvt_pk_bf16(a[2], a[3]); w.z = cvt_pk_bf16(b[0], b[1]); w.w = cvt_pk_bf16(b[2], b[3]); return w; }
__device__ __forceinline__ u32x4 pack8_f16(const f32x4 a, const f32x4 b) { u32x4 w; w.x = cvt_pk_f16(a[0], a[1]); w.y = cvt_pk_f16(a[2], a[3]); w.z = cvt_pk_f16(b[0], b[1]); w.w = cvt_pk_f16(b[2], b[3]); return w; }

struct EpiProj {
    static constexpr bool PERM = true, AFTER_DRAIN = false, HAS_INIT = false;
    bf16_t *VP, *Q, *Kb, *Vb; _Float16 *QI, *KI; float* WI; const float* rope32; const float* rope16; const float *gq, *gk;
    __device__ __forceinline__ void operator()(const f32x4 (&acc)[2][2][4][2], const Unit& u, int wr, int wc, int fr, int fq) const {
        const int pn = u.pn, rowb = u.pm * BM + wr * 64 + fr;
        if (pn < 2) {
#pragma unroll
            for (int ai = 0; ai < 2; ++ai)
#pragma unroll
                for (int m = 0; m < 4; ++m) { bf16_t* rp = VP + (size_t)(rowb + ai * HALF + m * 16) * 512 + pn * 256 + wc * 32 + 8 * fq;
#pragma unroll
                    for (int bj = 0; bj < 2; ++bj) *(u32x4*)(rp + bj * HALF) = pack8_bf16(acc[ai][bj][m][0], acc[ai][bj][m][1]); }
        } else if (pn < 5) {
            if (pn == 4 && wc >= 2) {
#pragma unroll
                for (int ai = 0; ai < 2; ++ai)
#pragma unroll
                    for (int m = 0; m < 4; ++m) { bf16_t* rp = Vb + (size_t)(rowb + ai * HALF + m * 16) * 128 + 64 * (wc - 2) + 8 * fq;
#pragma unroll
                        for (int bj = 0; bj < 2; ++bj) *(u32x4*)(rp + bj * 32) = pack8_bf16(acc[ai][bj][m][0], acc[ai][bj][m][1]); }
            } else {
                const bool isk = (pn == 4); const float* g = isk ? gk : gq; const float osc = isk ? 1.0f : 0.18033688011112042f  ;
                f32x4 gv[2][2];
#pragma unroll
                for (int bj = 0; bj < 2; ++bj)
#pragma unroll
                    for (int n = 0; n < 2; ++n) gv[bj][n] = *(const f32x4*)(g + 32 * bj + 8 * fq + 4 * n);
                bf16_t* dst = isk ? (Kb + 64 * wc) : (Q + 64 * (4 * (pn - 2) + wc)); const int ld = isk ? 128 : 512;
#pragma unroll
                for (int ai = 0; ai < 2; ++ai)
#pragma unroll
                    for (int m = 0; m < 4; ++m) { const int row = rowb + ai * HALF + m * 16, pos = row & 2047;
                        float ss = 0.f;
#pragma unroll
                        for (int bj = 0; bj < 2; ++bj)
#pragma unroll
                            for (int n = 0; n < 2; ++n) { const f32x4 v = acc[ai][bj][m][n]; ss += (v[0] * v[0] + v[1] * v[1]) + (v[2] * v[2] + v[3] * v[3]); }
                        ss += __shfl_xor(ss, 16); ss += __shfl_xor(ss, 32);
                        const float rstd = 1.0f / sqrtf(ss * (1.0f / 64.0f) + 1e-6f);
                        const f32x4* rp = (const f32x4*)(rope32 + (size_t)(pos * 32 + 8 * fq) * 2);
                        f32x4 o1[2], o2[2];
#pragma unroll
                        for (int n = 0; n < 2; ++n) { const f32x4 cs0 = rp[2 * n], cs1 = rp[2 * n + 1];
                            const f32x4 x1 = acc[ai][0][m][n] * rstd * gv[0][n], x2 = acc[ai][1][m][n] * rstd * gv[1][n];
                            const f32x4 c = (f32x4){cs0[0], cs0[2], cs1[0], cs1[2]}, s = (f32x4){cs0[1], cs0[3], cs1[1], cs1[3]};
                            o1[n] = (x1 * c - x2 * s) * osc; o2[n] = (x2 * c + x1 * s) * osc; }
                        bf16_t* op = dst + (size_t)row * ld + 8 * fq;
                        *(u32x4*)(op) = pack8_bf16(o1[0], o1[1]); *(u32x4*)(op + 32) = pack8_bf16(o2[0], o2[1]); }
            }
        } else {
            const int hd = 2 * wc + (fq >> 1);
            if (pn == 6 && wc != 0) return;
            if (pn == 6 && hd == 1) {
                if (fq == 2) {
#pragma unroll
                    for (int ai = 0; ai < 2; ++ai)
#pragma unroll
                        for (int m = 0; m < 4; ++m) { float* wp = WI + (size_t)(rowb + ai * HALF + m * 16) * 8;
                            *(f32x4*)(wp) = acc[ai][0][m][0] * 0.0625f; *(f32x4*)(wp + 4) = acc[ai][0][m][1] * 0.0625f; }
                }
                return;
            }
            _Float16* dst = (pn == 5) ? (QI + 32 * hd) : KI; const int ld = (pn == 5) ? 256 : 32;
#pragma unroll
            for (int ai = 0; ai < 2; ++ai)
#pragma unroll
                for (int m = 0; m < 4; ++m) { const int row = rowb + ai * HALF + m * 16, pos = row & 2047;
                    const f32x4* rp = (const f32x4*)(rope16 + (size_t)(pos * 16 + 8 * (fq & 1)) * 2);
                    f32x4 o1[2], o2[2];
#pragma unroll
                    for (int n = 0; n < 2; ++n) { const f32x4 cs0 = rp[2 * n], cs1 = rp[2 * n + 1];
                        const f32x4 x1 = acc[ai][0][m][n], x2 = acc[ai][1][m][n];
                        const f32x4 c = (f32x4){cs0[0], cs0[2], cs1[0], cs1[2]}, s = (f32x4){cs0[1], cs0[3], cs1[1], cs1[3]};
                        o1[n] = x1 * c - x2 * s; o2[n] = x2 * c + x1 * s; }
                    _Float16* op = dst + (size_t)row * ld + 8 * (fq & 1);
                    *(u32x4*)(op) = pack8_f16(o1[0], o1[1]); *(u32x4*)(op + 16) = pack8_f16(o2[0], o2[1]); }
        }
    }
};

__device__ __forceinline__ f32x4 bf16lo_to_f32(const u32x2 w) { return (f32x4){__builtin_bit_cast(float, w.x << 16), __builtin_bit_cast(float, w.x & 0xffff0000u), __builtin_bit_cast(float, w.y << 16), __builtin_bit_cast(float, w.y & 0xffff0000u)}; }
struct EpiWout {
    static constexpr bool PERM = true, AFTER_DRAIN = false, HAS_INIT = true, NEXT_HOOK = false;
    const float* x; bf16_t* X1B; float* SS2;
    __device__ __forceinline__ void init(f32x4 (&acc)[2][2][4][2], const Unit& u, int wr, int wc, int fr, int fq) const {
        const int rowb = u.pm * BM + wr * 64 + fr, col0 = u.pn * BM + wc * 32 + 8 * fq;
#pragma unroll
        for (int ai = 0; ai < 2; ++ai)
#pragma unroll
            for (int m = 0; m < 4; ++m) { const size_t off = (size_t)(rowb + ai * HALF + m * 16) * 1024 + col0;
#pragma unroll
                for (int bj = 0; bj < 2; ++bj) { acc[ai][bj][m][0] = *(const f32x4*)(x + off + bj * HALF); acc[ai][bj][m][1] = *(const f32x4*)(x + off + bj * HALF + 4); } }
    }
    __device__ __forceinline__ void operator()(const f32x4 (&acc)[2][2][4][2], const Unit& u, int wr, int wc, int fr, int fq) const {
        const int rowb = u.pm * BM + wr * 64 + fr, col0 = u.pn * BM + wc * 32 + 8 * fq;
#pragma unroll
        for (int ai = 0; ai < 2; ++ai)
#pragma unroll
            for (int m = 0; m < 4; ++m) { const int row = rowb + ai * HALF + m * 16; const size_t off = (size_t)row * 1024 + col0; float ss = 0.f;
#pragma unroll
                for (int bj = 0; bj < 2; ++bj) { const f32x4 v0 = acc[ai][bj][m][0], v1 = acc[ai][bj][m][1];
                    ss += (v0[0] * v0[0] + v0[1] * v0[1]) + (v0[2] * v0[2] + v0[3] * v0[3]) + (v1[0] * v1[0] + v1[1] * v1[1]) + (v1[2] * v1[2] + v1[3] * v1[3]);
                    *(u32x4*)(X1B + off + bj * HALF) = pack8_bf16(v0, v1); }
                ss += __shfl_xor(ss, 16); ss += __shfl_xor(ss, 32);
                if (fq == 0) SS2[(size_t)row * 16 + 4 * u.pn + wc] = ss; }
    }
};
struct EpiDown {
    static constexpr bool PERM = true, AFTER_DRAIN = false, HAS_INIT = true, NEXT_HOOK = false;
    const bf16_t* X1B; float* out;
    __device__ __forceinline__ void init(f32x4 (&acc)[2][2][4][2], const Unit& u, int wr, int wc, int fr, int fq) const {
        const int rowb = u.pm * BM + wr * 64 + fr, col0 = u.pn * BM + wc * 32 + 8 * fq;
#pragma unroll
        for (int ai = 0; ai < 2; ++ai) {
            u32x4 hv[4][2];
#pragma unroll
            for (int m = 0; m < 4; ++m) { const size_t off = (size_t)(rowb + ai * HALF + m * 16) * 1024 + col0;
#pragma unroll
                for (int bj = 0; bj < 2; ++bj) hv[m][bj] = *(const u32x4*)(X1B + off + bj * HALF); }
#pragma unroll
            for (int m = 0; m < 4; ++m)
#pragma unroll
                for (int bj = 0; bj < 2; ++bj) { acc[ai][bj][m][0] = bf16lo_to_f32((u32x2){hv[m][bj].x, hv[m][bj].y}); acc[ai][bj][m][1] = bf16lo_to_f32((u32x2){hv[m][bj].z, hv[m][bj].w}); }
        }
    }
    __device__ __forceinline__ void operator()(const f32x4 (&acc)[2][2][4][2], const Unit& u, int wr, int wc, int fr, int fq) const {
        const int rowb = u.pm * BM + wr * 64 + fr, col0 = u.pn * BM + wc * 32 + 8 * fq;
#pragma unroll
        for (int ai = 0; ai < 2; ++ai)
#pragma unroll
            for (int m = 0; m < 4; ++m) { float* p = out + (size_t)(rowb + ai * HALF + m * 16) * 1024 + col0;
#pragma unroll
                for (int bj = 0; bj < 2; ++bj) { *(f32x4*)(p + bj * HALF) = acc[ai][bj][m][0]; *(f32x4*)(p + bj * HALF + 4) = acc[ai][bj][m][1]; } }
    }
};
__device__ __forceinline__ float dpp_shr1(float v) { return __builtin_bit_cast(float, __builtin_amdgcn_update_dpp(0, __builtin_bit_cast(int, v), 0x111, 0xf, 0xf, false)); }
template <class T> __device__ __forceinline__ void stg_u32(void* base, unsigned boff, const T v) { *(T*)((char*)base + boff) = v; }
struct EpiUp {
    static constexpr bool PERM = true, AFTER_DRAIN = false, HAS_INIT = false;
    const PG8_LAS float* tab; const PG8_LAS float* wtab; bf16_t* G; bf16_t* HF; bf16_t* HL; mutable int par;
    __device__ __forceinline__ void operator()(const f32x4 (&acc)[2][2][4][2], const Unit& u, int wr, int wc, int fr_, int fq_) const {
        int fr = fr_, fq = fq_; asm volatile("" : "+v"(fr), "+v"(fq));
        const unsigned cb = 32 * wc + 8 * fq, ncol = 128 * u.pn + cb;
        const PG8_LAS float* tb = tab + par * 256 + wr * 64 + 4 * fr; const PG8_LAS float* wt = wtab + par * 1024 + cb; par ^= 1;
#pragma unroll
        for (int ai = 0; ai < 2; ++ai) {
            const unsigned rg = u.pm * BM + ai * HALF + wr * 64, g64 = rg >> 6;
            const f32x4 rs = *(const PG8_LAS f32x4*)(tb + ai * HALF);
            u32x2 gp[2][4];
#pragma unroll
            for (int n = 0; n < 2; ++n) {
                f32x4 cg[4];
#pragma unroll
                for (int bj = 0; bj < 2; ++bj) {
                    const PG8_LAS f32x4* wq = (const PG8_LAS f32x4*)(wt + 128 * bj + 4 * n);
                    const f32x4 w0 = wq[0], w1 = wq[64], w2 = wq[128], bb = wq[192];
                    f32x4 uu[4];
#pragma unroll
                    for (int m = 0; m < 4; ++m) uu[m] = acc[ai][bj][m][n] * rs[m];
                    const unsigned vcol = u.pn * 256u + bj * 128u + cb + 4u * n;
                    if (fr == 0) { stg_u32<u32x2>(HF, ((g64 * 2u + 0u) * 5632u + vcol) * 2u, (u32x2){cvt_pk_bf16(uu[0][0], uu[0][1]), cvt_pk_bf16(uu[0][2], uu[0][3])}); stg_u32<u32x2>(HF, ((g64 * 2u + 1u) * 5632u + vcol) * 2u, (u32x2){cvt_pk_bf16(uu[1][0], uu[1][1]), cvt_pk_bf16(uu[1][2], uu[1][3])}); }
                    if (fr == 15) { stg_u32<u32x2>(HL, ((g64 * 2u + 0u) * 5632u + vcol) * 2u, (u32x2){cvt_pk_bf16(uu[2][0], uu[2][1]), cvt_pk_bf16(uu[2][2], uu[2][3])}); stg_u32<u32x2>(HL, ((g64 * 2u + 1u) * 5632u + vcol) * 2u, (u32x2){cvt_pk_bf16(uu[3][0], uu[3][1]), cvt_pk_bf16(uu[3][2], uu[3][3])}); }
                    f32x4 d2, d3;
#pragma unroll
                    for (int i = 0; i < 4; ++i) { d2[i] = dpp_shr1(uu[2][i]); d3[i] = dpp_shr1(uu[3][i]); }
                    f32x4 c[4];
                    c[0] = bb + w0 * d2 + w1 * d3 + w2 * uu[0];
                    c[1] = bb + w0 * d3 + w1 * uu[0] + w2 * uu[1];
                    c[2] = bb + w0 * uu[0] + w1 * uu[1] + w2 * uu[2];
                    c[3] = bb + w0 * uu[1] + w1 * uu[2] + w2 * uu[3];
#pragma unroll
                    for (int m = 0; m < 4; ++m) {
                        if (bj == 0) cg[m] = c[m];
                        else { f32x4 gsl;
#pragma unroll
                            for (int i = 0; i < 4; ++i) { const float gt = cg[m][i]; gsl[i] = gt * __builtin_amdgcn_rcpf(1.0f + __builtin_amdgcn_exp2f(-gt)) * c[m][i]; }
                            gp[n][m] = (u32x2){cvt_pk_bf16(gsl[0], gsl[1]), cvt_pk_bf16(gsl[2], gsl[3])}; }
                    }
                }
            }
#pragma unroll
            for (int m = 0; m < 4; ++m)
                stg_u32<u32x4>(G, ((rg + 4u * fr + m) * 2816u + ncol) * 2u, (u32x4){gp[0][m].x, gp[0][m].y, gp[1][m].x, gp[1][m].y});
        }
    }
};
struct UpOrder : StaticOrder {
    const float* SS2; PG8_LAS float* tab; PG8_LAS float* wtab; const float* conv_w; const float* conv_b; int wv; mutable int par;
    __device__ __forceinline__ void a_ready(const Unit& u) const {
        const int t = wv * 64 + (int)__builtin_amdgcn_mbcnt_hi(~0u, __builtin_amdgcn_mbcnt_lo(~0u, 0u));
#pragma unroll
        for (int k = 0; k < 2; ++k) { const int idx = t + 512 * k, tap = idx >> 8, v = idx & 255, col = (v >> 7) * 2816 + 128 * u.pn + (v & 127);
            wtab[par * 1024 + idx] = (tap < 3 ? conv_w[tap * 5632 + col] : conv_b[col]) * ((v >> 7) ? 0.6931471805599453f : 1.4426950408889634f); }
        if (t < 256) { const f32x4* sp = (const f32x4*)(SS2 + (size_t)(u.pm * BM + t) * 16); const f32x4 a = sp[0], b = sp[1], c = sp[2], d = sp[3];
            const float s = (((a[0] + a[1]) + (a[2] + a[3])) + ((b[0] + b[1]) + (b[2] + b[3]))) + (((c[0] + c[1]) + (c[2] + c[3])) + ((d[0] + d[1]) + (d[2] + d[3])));
            tab[par * 256 + t] = __builtin_amdgcn_rsqf(s * (1.0f / 1024.0f) + 1e-6f); }
        par ^= 1;
    }
};

template <class Epi, class Sched, bool ALIGN_EPI = false, bool SP2 = false, bool ROWPERM = false>
__device__ __forceinline__ void gemm_phase(PG8_LAS unsigned char* lds, const Gemm g, const Sched& S, const Epi& E, const int wv  ) {
    int tid_ = wv * 64 + (int)__builtin_amdgcn_mbcnt_hi(~0u, __builtin_amdgcn_mbcnt_lo(~0u, 0u)); asm volatile("" : "+v"(tid_));
    const int tid = tid_, wid = __builtin_amdgcn_readfirstlane(tid >> 6), lane = tid & 63, wr = wid >> 2, wc = wid & 3, fr = lane & 15, fq = lane >> 4;
    const int K = g.K, nt = K / BK;
    unsigned voffA[2], voffB[2];
#pragma unroll
    for (int i = 0; i < 2; ++i) { int R, C; stage_rc(tid * 16 + i * 8192, R, C); const int Rb = Epi::PERM ? ((R & ~31) + perm32(R & 31)) : R;
        const int Ra = ROWPERM ? ((R & ~63) + 4 * (R & 15) + ((R >> 4) & 3)) : R;
        voffA[i] = (unsigned)(Ra * K + C) * 2u; voffB[i] = (unsigned)(Rb * K + C) * 2u; }
    const size_t kstep = (size_t)(BK * 2);
    const size_t hstep = (size_t)HALF * K * 2;
    const size_t tstep = 2 * hstep;
    const unsigned ldsw = (unsigned)wid * 1024u;
    const int aoff = lds_byte(wr * 64 + fr, fq * 8), boff = lds_byte(wc * 32 + fr, fq * 8);
#define PG8_SA(b, h) (((b) * 2 + (h)) * HTB)
#define PG8_SB(b, h) ((4 + (b) * 2 + (h)) * HTB)
#define PG8_STAGE(bufoff, gbase, voff) do { _Pragma("unroll") for (int _i = 0; _i < 2; ++_i) \
        __builtin_amdgcn_global_load_lds((const unsigned*)((const char*)(gbase) + (voff)[_i]), (PG8_LAS unsigned*)(lds + (bufoff) + ldsw + _i * 8192), 16, 0, 0); } while (0)
#define PG8_LDA(dst, b, h) do { _Pragma("unroll") for (int m = 0; m < 4; ++m) _Pragma("unroll") for (int k = 0; k < 2; ++k) dst[m][k] = *(const PG8_LAS bf16x8*)(lds + PG8_SA(b, h) + aoff + m * 2048 + k * 1024); } while (0)
#define PG8_LDB(dst, b, h) do { _Pragma("unroll") for (int n = 0; n < 2; ++n) _Pragma("unroll") for (int k = 0; k < 2; ++k) dst[n][k] = *(const PG8_LAS bf16x8*)(lds + PG8_SB(b, h) + boff + n * 2048 + k * 1024); } while (0)
#define PG8_MMA(ai, bj, At, Bt) do { __builtin_amdgcn_s_setprio(1); _Pragma("unroll") for (int m = 0; m < 4; ++m) _Pragma("unroll") for (int n = 0; n < 2; ++n) _Pragma("unroll") for (int k = 0; k < 2; ++k) \
        acc[ai][bj][m][n] = __builtin_amdgcn_mfma_f32_16x16x32_bf16(Bt[n][k], At[m][k], acc[ai][bj][m][n], 0, 0, 0); __builtin_amdgcn_s_setprio(0); } while (0)
#define PG8_WAIT_V(n) asm volatile("s_waitcnt vmcnt(" #n ")" ::: "memory")
#define PG8_WAIT_L(n) asm volatile("s_waitcnt lgkmcnt(" #n ")" ::: "memory")
#define PG8_BAR __builtin_amdgcn_s_barrier()
#define PG8_SCHED __builtin_amdgcn_sched_barrier(0)
    Unit cur, nxt; int ui = 0;
    if (!S.next(0, cur)) return;
    f32x4 acc[2][2][4][2];
    if constexpr (Epi::HAS_INIT) E.init(acc, cur, wr, wc, fr, fq);
    else {
#pragma unroll
    for (int a = 0; a < 2; ++a)
#pragma unroll
        for (int b = 0; b < 2; ++b)
#pragma unroll
            for (int m = 0; m < 4; ++m)
#pragma unroll
                for (int n = 0; n < 2; ++n) acc[a][b][m][n] = (f32x4){0.f, 0.f, 0.f, 0.f};
    }
    bf16x8 At[4][2], B0[2][2], B1[2][2];
    const char* cA = (const char*)g.A + (size_t)cur.pm * tstep; const char* cB = (const char*)g.Bt + (size_t)cur.pn * tstep;
    S.a_ready(cur);
    if constexpr (SP2) {
        PG8_STAGE(PG8_SB(0, 0), cB, voffB); PG8_STAGE(PG8_SB(0, 1), cB + hstep, voffB); PG8_STAGE(PG8_SA(0, 0), cA, voffA); PG8_STAGE(PG8_SA(0, 1), cA + hstep, voffA);
        if (wr == 1) PG8_BAR;
        PG8_WAIT_V(2); PG8_BAR;
        PG8_STAGE(PG8_SB(1, 0), cB + kstep, voffB); PG8_STAGE(PG8_SA(1, 0), cA + kstep, voffA); PG8_STAGE(PG8_SB(1, 1), cB + hstep + kstep, voffB);
        PG8_WAIT_V(6); PG8_BAR;
    } else {
        PG8_STAGE(PG8_SB(0, 0), cB, voffB); PG8_STAGE(PG8_SA(0, 0), cA, voffA); PG8_STAGE(PG8_SB(0, 1), cB + hstep, voffB); PG8_STAGE(PG8_SA(0, 1), cA + hstep, voffA);
        if (wr == 1) PG8_BAR;
        PG8_WAIT_V(4); PG8_BAR;
        PG8_STAGE(PG8_SB(1, 0), cB + kstep, voffB); PG8_STAGE(PG8_SA(1, 0), cA + kstep, voffA); PG8_STAGE(PG8_SB(1, 1), cB + hstep + kstep, voffB);
        PG8_WAIT_V(6); PG8_BAR;
    }
    for (;;) {
        const bool has_next = S.next(ui + 1, nxt);
        const char* nA = has_next ? (const char*)g.A + (size_t)nxt.pm * tstep : cA; const char* nB = has_next ? (const char*)g.Bt + (size_t)nxt.pn * tstep : cB;
        for (int t = 0; t < nt; t += 2) {
            const bool last = (t == nt - 2);
            const char* a1 = cA + (size_t)(t + 1) * kstep;
            const char* a2 = last ? nA : cA + (size_t)(t + 2) * kstep; const char* b2 = last ? nB : cB + (size_t)(t + 2) * kstep;
            const char* a3 = a2 + kstep; const char* b3 = b2 + kstep;
            if (last && has_next) S.a_ready(nxt);
            if constexpr (SP2) {
            PG8_LDB(B0, 0, 0); PG8_LDB(B1, 0, 1); PG8_SCHED; PG8_LDA(At, 0, 0); PG8_STAGE(PG8_SA(1, 1), a1 + hstep, voffA);
            PG8_WAIT_V(8); PG8_WAIT_L(0); PG8_BAR; PG8_MMA(0, 0, At, B0); PG8_MMA(0, 1, At, B1); PG8_BAR; PG8_SCHED;
            PG8_LDA(At, 0, 1); PG8_STAGE(PG8_SB(0, 0), b2, voffB); PG8_STAGE(PG8_SB(0, 1), b2 + hstep, voffB); PG8_STAGE(PG8_SA(0, 0), a2, voffA);
            PG8_WAIT_V(8); PG8_WAIT_L(0); PG8_BAR; PG8_MMA(1, 0, At, B0); PG8_MMA(1, 1, At, B1); PG8_BAR; PG8_SCHED;
            PG8_LDB(B0, 1, 0); PG8_LDB(B1, 1, 1); PG8_SCHED; PG8_LDA(At, 1, 0); PG8_STAGE(PG8_SA(0, 1), a2 + hstep, voffA);
            PG8_WAIT_V(8); PG8_WAIT_L(0); PG8_BAR; PG8_MMA(0, 0, At, B0); PG8_MMA(0, 1, At, B1); PG8_BAR; PG8_SCHED;
            PG8_LDA(At, 1, 1); PG8_STAGE(PG8_SB(1, 0), b3, voffB); PG8_STAGE(PG8_SB(1, 1), b3 + hstep, voffB); PG8_STAGE(PG8_SA(1, 0), a3, voffA);
            PG8_WAIT_V(8); PG8_WAIT_L(0); PG8_BAR; PG8_MMA(1, 0, At, B0); PG8_MMA(1, 1, At, B1); PG8_BAR; PG8_SCHED;
            } else {
            PG8_LDB(B0, 0, 0); PG8_SCHED; PG8_LDA(At, 0, 0); PG8_STAGE(PG8_SA(1, 1), a1 + hstep, voffA);
            PG8_WAIT_L(8); PG8_BAR; PG8_WAIT_L(0); PG8_MMA(0, 0, At, B0); PG8_BAR; PG8_SCHED;
            PG8_LDB(B1, 0, 1); PG8_STAGE(PG8_SB(0, 0), b2, voffB);
            PG8_BAR; PG8_WAIT_L(0); PG8_MMA(0, 1, At, B1); PG8_BAR;
            PG8_LDA(At, 0, 1); PG8_STAGE(PG8_SA(0, 0), a2, voffA);
            PG8_BAR; PG8_WAIT_L(0); PG8_MMA(1, 0, At, B0); PG8_BAR; PG8_SCHED;
            PG8_STAGE(PG8_SB(0, 1), b2 + hstep, voffB);
            PG8_WAIT_V(6); PG8_BAR; PG8_MMA(1, 1, At, B1); PG8_BAR;
            PG8_LDB(B0, 1, 0); PG8_SCHED; PG8_LDA(At, 1, 0); PG8_STAGE(PG8_SA(0, 1), a2 + hstep, voffA);
            PG8_WAIT_L(8); PG8_BAR; PG8_WAIT_L(0); PG8_MMA(0, 0, At, B0); PG8_BAR; PG8_SCHED;
            PG8_LDB(B1, 1, 1); PG8_STAGE(PG8_SB(1, 0), b3, voffB);
            PG8_BAR; PG8_WAIT_L(0); PG8_MMA(0, 1, At, B1); PG8_BAR;
            PG8_LDA(At, 1, 1); PG8_STAGE(PG8_SA(1, 0), a3, voffA);
            PG8_BAR; PG8_WAIT_L(0); PG8_MMA(1, 0, At, B0); PG8_BAR; PG8_SCHED;
            PG8_STAGE(PG8_SB(1, 1), b3 + hstep, voffB);
            PG8_WAIT_V(6); PG8_BAR; PG8_MMA(1, 1, At, B1); PG8_BAR;
            }
        }
        if constexpr (ALIGN_EPI) { if (wr == 0) PG8_BAR; }
        if constexpr (!Epi::AFTER_DRAIN) { E(acc, cur, wr, wc, fr, fq); S.done(cur); }
        if (!has_next) break;
        if constexpr (Epi::HAS_INIT) E.init(acc, nxt, wr, wc, fr, fq);
        else {
#pragma unroll
        for (int a = 0; a < 2; ++a)
#pragma unroll
            for (int b = 0; b < 2; ++b)
#pragma unroll
                for (int m = 0; m < 4; ++m)
#pragma unroll
                    for (int n = 0; n < 2; ++n) acc[a][b][m][n] = (f32x4){0.f, 0.f, 0.f, 0.f};
        }
        cur = nxt; cA = nA; cB = nB; ++ui;
        if constexpr (ALIGN_EPI) { if (wr == 1) PG8_BAR; }
    }
    PG8_WAIT_V(0);
    if constexpr (!ALIGN_EPI) { if (wr == 0) PG8_BAR; }
    PG8_BAR;
    if constexpr (Epi::AFTER_DRAIN) { E.fused(acc, cur, wr, wc, fr, fq, lds, wid, lane); S.done(cur); }
#undef PG8_SA
#undef PG8_SB
#undef PG8_STAGE
#undef PG8_LDA
#undef PG8_LDB
#undef PG8_MMA
#undef PG8_WAIT_V
#undef PG8_WAIT_L
#undef PG8_BAR
#undef PG8_SCHED
}
}

#include <hip/hip_bf16.h>
#include <cmath>
namespace attn_body {
using bf16=__hip_bfloat16;
using bf16x8=__attribute__((ext_vector_type(8)))short;
using s16x4=__attribute__((ext_vector_type(4)))short;
using f32x16=__attribute__((ext_vector_type(16)))float;
using u32x4=__attribute__((ext_vector_type(4)))unsigned;
constexpr int BATCH=8,NHEAD=8,SEQ=2048,D=64,QP=512,KP=128,OP=1024,OOFF=512;
constexpr int NW=8,QBLK=32,QB=QBLK*NW,KVBLK=64,NQB=SEQ/QB;
constexpr int ATTN_UNIT_ROWS=QB;
__device__ __forceinline__ int crow(int r,int hi){return (r&3)+8*(r>>2)+4*hi;}
#define SBAR() __builtin_amdgcn_sched_barrier(0)
__device__ __forceinline__ void cmask(f32x16&p0,f32x16&p1,int jb,int qrel,int hi){
  const float NEG=-INFINITY; int kb=64*jb+4*hi;
  #pragma unroll
  for(int r=0;r<16;++r){int kv=kb+(r&3)+8*(r>>2); if(kv>qrel)p0[r]=NEG; if(kv+32>qrel)p1[r]=NEG;}
}

constexpr int NSLOT=3, SLOTB=8192;
constexpr int LDS_K=0, LDS_V=NSLOT*SLOTB, LDS_WS=2*NSLOT*SLOTB, LDS_OST=LDS_WS+NW*64*4, LDS_BYTES=LDS_OST+NW*4096;
constexpr float C2=0.125f*1.4426950408889634f;
__device__ __forceinline__ void glds16(const void*gsrc,unsigned lds_dst){unsigned keep;
  asm volatile("s_mov_b32 %0, m0\n\ts_mov_b32 m0, %2\n\ts_nop 0\n\tglobal_load_lds_dwordx4 %1, off\n\ts_mov_b32 m0, %0":"=&s"(keep):"v"(gsrc),"s"(lds_dst):"memory");}
__device__ __forceinline__ float max3f(float a,float b,float c){float r;asm("v_max3_f32 %0, %1, %2, %3":"=v"(r):"v"(a),"v"(b),"v"(c));return r;}
__device__ __forceinline__ float max2f(float a,float b){float r;asm("v_max_f32_e32 %0, %1, %2":"=v"(r):"v"(a),"v"(b));return r;}
__device__ __forceinline__ float fadd_s(float a,float b){float r;asm("v_add_f32_e32 %0, %1, %2":"=v"(r):"v"(a),"v"(b));return r;}
__device__ __forceinline__ float fsub_s(float a,float b){float r;asm("v_sub_f32_e32 %0, %1, %2":"=v"(r):"v"(a),"v"(b));return r;}
typedef float f32x2_t __attribute__((ext_vector_type(2))); typedef __bf16 bf16x2_t __attribute__((ext_vector_type(2)));
__device__ __forceinline__ unsigned cvtpk_s(float lo,float hi){f32x2_t v={lo,hi};bf16x2_t b=__builtin_convertvector(v,bf16x2_t);return __builtin_bit_cast(unsigned,b);}
#define WAIT_BAR(N) asm volatile("s_waitcnt vmcnt(" #N ") lgkmcnt(0)\n\ts_barrier":::"memory")

__device__ __forceinline__ void qkt(f32x16&p0,f32x16&p1,const char*Kslot,const bf16x8*qr,const f32x16&negm,int r32,int hi){
  const char*kb=Kslot+hi*1024+r32*16;
  #pragma unroll
  for(int d0=0;d0<4;++d0){
    const bf16x8 b0=*reinterpret_cast<const bf16x8*>(kb+d0*2048);
    const bf16x8 b1=*reinterpret_cast<const bf16x8*>(kb+d0*2048+512);
    if(d0==0){p0=__builtin_amdgcn_mfma_f32_32x32x16_bf16(b0,qr[0],negm,0,0,0);p1=__builtin_amdgcn_mfma_f32_32x32x16_bf16(b1,qr[0],negm,0,0,0);}
    else{p0=__builtin_amdgcn_mfma_f32_32x32x16_bf16(b0,qr[d0],p0,0,0,0);p1=__builtin_amdgcn_mfma_f32_32x32x16_bf16(b1,qr[d0],p1,0,0,0);}}
}
typedef __attribute__((address_space(3))) const char* lds_cptr;
typedef short v4i16_t __attribute__((ext_vector_type(4)));
__device__ __forceinline__ void kload8(bf16x8*kf,lds_cptr kp){
  kf[0]=*(const __attribute__((address_space(3))) bf16x8*)(kp);      kf[1]=*(const __attribute__((address_space(3))) bf16x8*)(kp+512);
  kf[2]=*(const __attribute__((address_space(3))) bf16x8*)(kp+2048); kf[3]=*(const __attribute__((address_space(3))) bf16x8*)(kp+2560);
  kf[4]=*(const __attribute__((address_space(3))) bf16x8*)(kp+4096); kf[5]=*(const __attribute__((address_space(3))) bf16x8*)(kp+4608);
  kf[6]=*(const __attribute__((address_space(3))) bf16x8*)(kp+6144); kf[7]=*(const __attribute__((address_space(3))) bf16x8*)(kp+6656);
}
__device__ __forceinline__ void kload2(bf16x8*kf,lds_cptr kp,int j){ kf[2*j]=*(const __attribute__((address_space(3))) bf16x8*)(kp+j*2048); kf[2*j+1]=*(const __attribute__((address_space(3))) bf16x8*)(kp+j*2048+512); }
__device__ __forceinline__ s16x4 vtr(lds_cptr p){ return __builtin_bit_cast(s16x4,__builtin_amdgcn_ds_read_tr16_b64_v4i16((__attribute__((address_space(3))) v4i16_t*)p)); }
__device__ __forceinline__ float rowmax(const f32x16&p0,const f32x16&p1){
  float a=max3f(p0[0],p0[1],p1[0]),b=max3f(p0[2],p0[3],p1[1]);a=max3f(a,p1[2],p1[3]);
  #pragma unroll
  for(int r=4;r<16;r+=4){a=max3f(a,p0[r],p0[r+1]);b=max3f(b,p0[r+2],p0[r+3]);a=max3f(a,p1[r],p1[r+1]);b=max3f(b,p1[r+2],p1[r+3]);}
  const float m=max2f(a,b);
  auto rr=__builtin_amdgcn_permlane32_swap(__float_as_uint(m),__float_as_uint(m),false,false);
  return max2f(__uint_as_float(rr[0]),__uint_as_float(rr[1]));
}
__device__ __forceinline__ void pv(f32x16*o,int vb,bf16x8 pa0,bf16x8 pa1,bf16x8 pa2,bf16x8 pa3){
  #pragma unroll
  for(int d0=0;d0<2;++d0){s16x4 lo[4],hi[4];
    #pragma unroll
    for(int ks=0;ks<4;++ks){
      asm volatile("ds_read_b64_tr_b16 %0,%1 offset:%c2":"=&v"(lo[ks]):"v"(vb),"i"(d0*4096+ks*1024):"memory");
      asm volatile("ds_read_b64_tr_b16 %0,%1 offset:%c2":"=&v"(hi[ks]):"v"(vb),"i"(d0*4096+ks*1024+512):"memory");}
    asm volatile("s_waitcnt lgkmcnt(0)":::"memory");SBAR();
    #define PK(k) (bf16x8){lo[k][0],lo[k][1],lo[k][2],lo[k][3],hi[k][0],hi[k][1],hi[k][2],hi[k][3]}
    o[d0]=__builtin_amdgcn_mfma_f32_32x32x16_bf16(pa0,PK(0),o[d0],0,0,0);
    o[d0]=__builtin_amdgcn_mfma_f32_32x32x16_bf16(pa1,PK(1),o[d0],0,0,0);
    o[d0]=__builtin_amdgcn_mfma_f32_32x32x16_bf16(pa2,PK(2),o[d0],0,0,0);
    o[d0]=__builtin_amdgcn_mfma_f32_32x32x16_bf16(pa3,PK(3),o[d0],0,0,0);
    #undef PK
  }
}

#ifndef ATTN_STORE16
#define ATTN_STORE16(p,v) (*(u32x4*)(p)=(v))
#endif
template<int THRL> __device__ __forceinline__ void attn_unit(int b,int h,int qb,const bf16*Q,const bf16*__restrict__ K,const bf16*__restrict__ V,const unsigned long long*__restrict__ MASK,bf16*O,char*shm,const int wv){
  int tid_=wv*64+(int)__builtin_amdgcn_mbcnt_hi(~0u,__builtin_amdgcn_mbcnt_lo(~0u,0u)); asm volatile("":"+v"(tid_)); const int tid=tid_,lane=tid&63,r32=lane&31,hi=lane>>5; const int wid=__builtin_amdgcn_readfirstlane(tid>>6);
  const long rowbase=(long)b*SEQ; const int q0=qb*QB;
  const bf16*Qw=Q+(rowbase+q0+wid*QBLK)*QP+h*D;
  const bf16*Kh=K+rowbase*KP+(h>>2)*D,*Vh=V+rowbase*KP+(h>>2)*D;
  const unsigned lds0=(unsigned)(uintptr_t)shm;
  float*wsf=(float*)(shm+LDS_WS)+wid*64;
  const bf16*ksrc=Kh+(long)lane*KP+wid*8;
  const bf16*vsrc=Vh+(long)(16*(wid&3)+(lane>>2))*KP+(wid>>2)*32+(lane&3)*8;
  const unsigned kdst=lds0+LDS_K+wid*1024, vdst=lds0+LDS_V+wid*1024;
  #define DMA_K(t,slot) glds16(ksrc+(long)(t)*KVBLK*KP,(unsigned)__builtin_amdgcn_readfirstlane(kdst+(slot)))
  #define DMA_V(t,slot) glds16(vsrc+(long)(t)*KVBLK*KP,(unsigned)__builtin_amdgcn_readfirstlane(vdst+(slot)))
  const int vb0=(int)(lds0+LDS_V)+((lane>>4)&1)*32+(lane&3)*8+(4*hi+((lane&15)>>2))*64;
  const char*Kbase=shm+LDS_K; bf16x8 kf[8];
  const lds_cptr shm3=(lds_cptr)shm; const lds_cptr kp0=shm3+LDS_K+hi*1024+r32*16; const lds_cptr vp0=shm3+LDS_V+((lane>>4)&1)*32+(lane&3)*8+(4*hi+((lane&15)>>2))*64;
  const int NT=(q0+QB)/KVBLK;
  DMA_K(0,0);DMA_V(0,0);DMA_K(1,SLOTB);
  bf16x8 qr[4];
  #pragma unroll
  for(int d0=0;d0<4;++d0)qr[d0]=*reinterpret_cast<const bf16x8*>(&Qw[(long)r32*QP+d0*16+hi*8]);
  float l_reg=0.f;f32x16 o[2];o[0]=f32x16{};o[1]=f32x16{};const f32x16 negm=f32x16{};
  const int qrel=wid*QBLK+r32;
  const unsigned long long*mrow=MASK+(rowbase+q0+qrel)*(SEQ/64);
  unsigned long long mk=mrow[0];
  #define MKSH(WL,WH,t) unsigned WL=(unsigned)mk>>(4*hi), WH=(unsigned)(mk>>32)>>(4*hi); asm volatile("":"+v"(WL),"+v"(WH)); mk=mrow[(t)+1]
  #define CMASKW(P0,P1,WL,WH) do{ _Pragma("unroll") for(int r=0;r<16;++r){ const int ps_=(r&3)+8*(r>>2); const float a_=P0[r], b_=P1[r]; \
      const unsigned m0_=(unsigned)__builtin_amdgcn_sbfe((int)WL,ps_,1), m1_=(unsigned)__builtin_amdgcn_sbfe((int)WH,ps_,1); \
      const unsigned ua_=(__builtin_bit_cast(unsigned,a_)&m0_)|(0xff800000u&~m0_), ub_=(__builtin_bit_cast(unsigned,b_)&m1_)|(0xff800000u&~m1_); \
      P0[r]=__builtin_bit_cast(float,ua_); P1[r]=__builtin_bit_cast(float,ub_); } }while(0)
  #define START(P0,P1) do{ _Pragma("unroll") for(int r=0;r<16;++r)P0[r]=__builtin_amdgcn_exp2f(P0[r]); }while(0)
  #define RESC() do{}while(0)
  f32x16 pA0,pA1,pB0,pB1;
  int sl_prev=0,sl_cur=0,sl_next=SLOTB;
  #define ROT() do{sl_prev=sl_cur;sl_cur=sl_next;sl_next=(sl_next==(NSLOT-1)*SLOTB)?0:sl_next+SLOTB;}while(0)
  DMA_K(2,2*SLOTB);
  WAIT_BAR(3);
  qkt(pA0,pA1,Kbase,qr,negm,r32,hi);asm volatile("s_nop 15\n\ts_nop 7":"+v"(pA0),"+v"(pA1));{MKSH(wl0_,wh0_,0);CMASKW(pA0,pA1,wl0_,wh0_);}
  START(pA0,pA1);
  _Pragma("unroll") for(int r=0;r<16;++r)pA1[r]=__builtin_amdgcn_exp2f(pA1[r]);
  WAIT_BAR(0);
  DMA_K(3,0);DMA_V(1,SLOTB);
  ROT();
  kload8(kf,kp0+sl_cur);
  WAIT_BAR(2);
  s16x4 vlo[8],vhi[8]; u32x4 pw0,pw1,pw2,pw3;
  #define PKW(P,B) cvtpk_s(P[B],P[B+1])
  #define PAF(k) __builtin_bit_cast(bf16x8,pw##k)
  #define VFR(i) (bf16x8){vlo[i][0],vlo[i][1],vlo[i][2],vlo[i][3],vhi[i][0],vhi[i][1],vhi[i][2],vhi[i][3]}
  #define PIN(x) asm volatile("":"+v"(x))
  #define MX3(a,b,c) __builtin_fmaxf(__builtin_fmaxf((a),(b)),(c))
  #define GAPA(MF,A0,A1,A2,A3,W0,W1,PW) do{ MF; sacc+=A0; sacc+=A1; sacc+=A2; sacc+=A3; PIN(sacc); W0; W1; PIN(PW); SBAR(); }while(0)
  #define EX(v) __builtin_amdgcn_exp2f(v)
  #define GAPB(MF,X,B) do{ MF; X[B]=EX(X[B]); X[B+1]=EX(X[B+1]); X[B+2]=EX(X[B+2]); X[B+3]=EX(X[B+3]); PIN(X); SBAR(); }while(0)
  #define VRD(i) do{ vlo[i]=vtr(vp_+(((i)>>2)*4096+((i)&3)*1024)); vhi[i]=vtr(vp_+(((i)>>2)*4096+((i)&3)*1024+512)); }while(0)
  #define KRD(G,j) do{ if(G){ kload2(kf,kp0+sl_next,j); SBAR(); } }while(0)
  #define STEP(C0,C1,P0,P1,t,GK,GV,GL) do{ SBAR(); \
    const lds_cptr vp_=vp0+sl_prev; \
    VRD(0); SBAR(); float sacc=(P0[0]+P0[1]); \
    GAPA(C0=__builtin_amdgcn_mfma_f32_32x32x16_bf16(kf[0],qr[0],negm,0,0,0), P0[2],P0[3],P0[4],P0[5],     pw0[0]=PKW(P0,0), pw0[1]=PKW(P0,2), pw0); \
    VRD(4); SBAR(); GAPA(C1=__builtin_amdgcn_mfma_f32_32x32x16_bf16(kf[1],qr[0],negm,0,0,0), P0[6],P0[7],P0[8],P0[9],     pw0[2]=PKW(P0,4), pw0[3]=PKW(P0,6), pw0); \
    VRD(1); SBAR(); GAPA(C0=__builtin_amdgcn_mfma_f32_32x32x16_bf16(kf[2],qr[1],C0,0,0,0),   P0[10],P0[11],P0[12],P0[13], pw1[0]=PKW(P0,8), pw1[1]=PKW(P0,10), pw1); \
    VRD(5); SBAR(); GAPA(C1=__builtin_amdgcn_mfma_f32_32x32x16_bf16(kf[3],qr[1],C1,0,0,0),   P0[14],P0[15],P1[0],P1[1],   pw1[2]=PKW(P0,12),pw1[3]=PKW(P0,14), pw1); \
    VRD(2); SBAR(); GAPA(C0=__builtin_amdgcn_mfma_f32_32x32x16_bf16(kf[4],qr[2],C0,0,0,0),   P1[2],P1[3],P1[4],P1[5],     pw2[0]=PKW(P1,0), pw2[1]=PKW(P1,2), pw2); \
    VRD(6); SBAR(); GAPA(C1=__builtin_amdgcn_mfma_f32_32x32x16_bf16(kf[5],qr[2],C1,0,0,0),   P1[6],P1[7],P1[8],P1[9],     pw2[2]=PKW(P1,4), pw2[3]=PKW(P1,6), pw2); \
    VRD(3); SBAR(); GAPA(C0=__builtin_amdgcn_mfma_f32_32x32x16_bf16(kf[6],qr[3],C0,0,0,0),   P1[10],P1[11],P1[12],P1[13], pw3[0]=PKW(P1,8), pw3[1]=PKW(P1,10), pw3); \
    VRD(7); SBAR(); GAPA(C1=__builtin_amdgcn_mfma_f32_32x32x16_bf16(kf[7],qr[3],C1,0,0,0),   P1[14],P1[15],0.f,0.f,       pw3[2]=PKW(P1,12),pw3[3]=PKW(P1,14), pw3); \
    l_reg+=sacc; \
    MKSH(wl_,wh_,t); \
    if(GK){DMA_K((t)+3,sl_cur);} if(GV){DMA_V((t)+1,sl_next);} \
    CMASKW(C0,C1,wl_,wh_); \
    SBAR(); \
    GAPB(o[0]=__builtin_amdgcn_mfma_f32_32x32x16_bf16(PAF(0),VFR(0),o[0],0,0,0), C0,0); \
    GAPB(o[1]=__builtin_amdgcn_mfma_f32_32x32x16_bf16(PAF(0),VFR(4),o[1],0,0,0), C0,4); \
    KRD(GL,0); GAPB(o[0]=__builtin_amdgcn_mfma_f32_32x32x16_bf16(PAF(1),VFR(1),o[0],0,0,0), C0,8); \
    KRD(GL,1); GAPB(o[1]=__builtin_amdgcn_mfma_f32_32x32x16_bf16(PAF(1),VFR(5),o[1],0,0,0), C0,12); \
    KRD(GL,2); GAPB(o[0]=__builtin_amdgcn_mfma_f32_32x32x16_bf16(PAF(2),VFR(2),o[0],0,0,0), C1,0); \
    KRD(GL,3); GAPB(o[1]=__builtin_amdgcn_mfma_f32_32x32x16_bf16(PAF(2),VFR(6),o[1],0,0,0), C1,4); \
    GAPB(o[0]=__builtin_amdgcn_mfma_f32_32x32x16_bf16(PAF(3),VFR(3),o[0],0,0,0), C1,8); \
    GAPB(o[1]=__builtin_amdgcn_mfma_f32_32x32x16_bf16(PAF(3),VFR(7),o[1],0,0,0), C1,12); \
    }while(0)
  int t=1;
  for(;t+5<NT;t+=2){
    STEP(pB0,pB1,pA0,pA1,t,true,true,true);     WAIT_BAR(2); RESC(); ROT();
    STEP(pA0,pA1,pB0,pB1,t+1,true,true,true);   WAIT_BAR(2); RESC(); ROT();
  }
  #define ENDW(tt) do{ if((tt)+3<NT){WAIT_BAR(2);} else if((tt)+2<NT){WAIT_BAR(1);} else {WAIT_BAR(0);} }while(0)
  for(;t+1<NT;t+=2){
    STEP(pB0,pB1,pA0,pA1,t,(t+3<NT),(t+1<NT),(t+1<NT));       ENDW(t);   RESC(); ROT();
    STEP(pA0,pA1,pB0,pB1,t+1,(t+4<NT),(t+2<NT),(t+2<NT));     ENDW(t+1); RESC(); ROT();
  }
  STEP(pB0,pB1,pA0,pA1,NT-1,false,false,false); RESC();
  { float sacc=pB0[0]+pB0[1]; _Pragma("unroll") for(int r=2;r<16;++r)sacc+=pB0[r]; _Pragma("unroll") for(int r=0;r<16;++r)sacc+=pB1[r]; l_reg+=sacc;
    pw0=(u32x4){PKW(pB0,0),PKW(pB0,2),PKW(pB0,4),PKW(pB0,6)};pw1=(u32x4){PKW(pB0,8),PKW(pB0,10),PKW(pB0,12),PKW(pB0,14)};pw2=(u32x4){PKW(pB1,0),PKW(pB1,2),PKW(pB1,4),PKW(pB1,6)};pw3=(u32x4){PKW(pB1,8),PKW(pB1,10),PKW(pB1,12),PKW(pB1,14)};
    SBAR(); pv(o,vb0+sl_cur,PAF(0),PAF(1),PAF(2),PAF(3)); }
  #undef PKW
  #undef PAF
  #undef VFR
  #undef PIN
  #undef MX3
  #undef GAPA
  #undef GAPB
  #undef EX
  #undef VRD
  #undef KRD
  #undef STEP
  #undef ENDW
  {auto rr=__builtin_amdgcn_permlane32_swap(__float_as_uint(l_reg),__float_as_uint(l_reg),false,false);l_reg=__uint_as_float(rr[0])+__uint_as_float(rr[1]);}
  if(hi==0)wsf[32+r32]=l_reg;asm volatile("s_waitcnt lgkmcnt(0)":::"memory");
  float rli[16];
  #pragma unroll
  for(int r=0;r<16;++r)rli[r]=__builtin_amdgcn_rcpf(wsf[32+crow(r,hi)]);
  bf16*Ow=O+(rowbase+q0+wid*QBLK)*OP+OOFF+h*D;
  { bf16*stg=(bf16*)(shm+LDS_OST)+wid*2048;
    #pragma unroll
    for(int r=0;r<16;++r){const int orow=crow(r,hi);
      #pragma unroll
      for(int d0=0;d0<2;++d0)stg[orow*64+d0*32+r32]=__float2bfloat16(o[d0][r]*rli[r]);}
    asm volatile("s_waitcnt lgkmcnt(0)":::"memory");
    #pragma unroll
    for(int i=0;i<4;++i){const int row=i*8+(lane>>3),ch=lane&7; const u32x4 v=*(const u32x4*)(stg+row*64+ch*8); ATTN_STORE16(Ow+(long)row*OP+ch*8,v);} }
  asm volatile("s_waitcnt lgkmcnt(0)\n\ts_barrier":::"memory");
  #undef DMA_K
  #undef DMA_V
  #undef CMASKW
  #undef MKSH
  #undef START
  #undef RESC
  #undef ROT
}
constexpr int ATTN_LDS_BYTES=LDS_BYTES;
struct AttnTensors { const bf16* Q; const bf16* K; const bf16* V; const unsigned long long* MASK; bf16* O; };
struct AttnUnit { int bh; int qb; };
struct StaticOrder {
  int vcu,G;
  __device__ __forceinline__ explicit StaticOrder(int grid,int block):vcu((grid%8==0)?(block%8)*(grid/8)+block/8:block),G(grid){}
  __device__ __forceinline__ bool next(int i,AttnUnit&u)const{ const int it=vcu+(i>>1)*G; if(it>=BATCH*NHEAD*4)return false; const int s=it&3; u.bh=it>>2; u.qb=(i&1)?7-s:s; return true; }
  __device__ __forceinline__ void a_ready(const AttnUnit&)const{}
  __device__ __forceinline__ void done(const AttnUnit&)const{}
};
template<class Sched,int THRL=8> __device__ __forceinline__ void attn_phase(char*lds,const AttnTensors&T,const Sched&S,const int wv){
  AttnUnit u;
  for(int i=0;S.next(i,u);++i){ S.a_ready(u); attn_unit<THRL>(u.bh/NHEAD,u.bh%NHEAD,u.qb,T.Q,T.K,T.V,T.MASK,T.O,lds,wv); S.done(u); }
}
#undef SBAR
#undef WAIT_BAR
}

#ifndef REPS
#define REPS {1, 1, 1, 1, 1, 1, 1, 1}
#endif
constexpr int kReps[8] = REPS;
#ifndef SREPS
#define SREPS {1, 1, 1, 1, 1, 1, 1, 1}
#endif
constexpr int kSub[8] = SREPS;
typedef _Float16 f16x8 __attribute__((ext_vector_type(8)));
typedef float f32x16 __attribute__((ext_vector_type(16)));
__device__ __forceinline__ unsigned score_key(float s) { const unsigned u = __builtin_bit_cast(unsigned, s + 0.0f); return u ^ ((unsigned)((int)u >> 31) | 0x80000000u); }
__device__ __forceinline__ float key_score(unsigned k) { return __builtin_bit_cast(float, (k & 0x80000000u) ? (k & 0x7fffffffu) : ~k); }
__device__ __forceinline__ float wave_sum_f32(float v) {
    v += __builtin_bit_cast(float, __builtin_amdgcn_update_dpp(0, __builtin_bit_cast(int, v), 0xb1, 0xf, 0xf, false));
    v += __builtin_bit_cast(float, __builtin_amdgcn_update_dpp(0, __builtin_bit_cast(int, v), 0x4e, 0xf, 0xf, false));
    v += __builtin_bit_cast(float, __builtin_amdgcn_update_dpp(0, __builtin_bit_cast(int, v), 0x141, 0xf, 0xf, false));
    v += __builtin_bit_cast(float, __builtin_amdgcn_update_dpp(0, __builtin_bit_cast(int, v), 0x140, 0xf, 0xf, false));
    return __builtin_bit_cast(float, __builtin_amdgcn_readlane(__builtin_bit_cast(int, v), 0)) + __builtin_bit_cast(float, __builtin_amdgcn_readlane(__builtin_bit_cast(int, v), 16))
         + __builtin_bit_cast(float, __builtin_amdgcn_readlane(__builtin_bit_cast(int, v), 32)) + __builtin_bit_cast(float, __builtin_amdgcn_readlane(__builtin_bit_cast(int, v), 48));
}
__device__ __forceinline__ int wave_sum_i32(int v) {
    v += __builtin_amdgcn_update_dpp(0, v, 0xb1, 0xf, 0xf, false);
    v += __builtin_amdgcn_update_dpp(0, v, 0x4e, 0xf, 0xf, false);
    v += __builtin_amdgcn_update_dpp(0, v, 0x141, 0xf, 0xf, false);
    v += __builtin_amdgcn_update_dpp(0, v, 0x140, 0xf, 0xf, false);
    return __builtin_amdgcn_readlane(v, 0) + __builtin_amdgcn_readlane(v, 16) + __builtin_amdgcn_readlane(v, 32) + __builtin_amdgcn_readlane(v, 48);
}
__device__ __forceinline__ void count_ge8(unsigned& cnt, unsigned cand, unsigned k0, unsigned k1, unsigned k2, unsigned k3, unsigned k4, unsigned k5, unsigned k6, unsigned k7) {
    unsigned long long m0, m1, m2, m3;
    asm volatile(
        "v_cmp_ge_u32_e64 %1, %5, %13\n\tv_cmp_ge_u32_e64 %2, %6, %13\n\tv_cmp_ge_u32_e64 %3, %7, %13\n\tv_cmp_ge_u32_e64 %4, %8, %13\n\t"
        "v_addc_co_u32_e64 %0, vcc, 0, %0, %1\n\tv_cmp_ge_u32_e64 %1, %9, %13\n\t"
        "v_addc_co_u32_e64 %0, vcc, 0, %0, %2\n\tv_cmp_ge_u32_e64 %2, %10, %13\n\t"
        "v_addc_co_u32_e64 %0, vcc, 0, %0, %3\n\tv_cmp_ge_u32_e64 %3, %11, %13\n\t"
        "v_addc_co_u32_e64 %0, vcc, 0, %0, %4\n\tv_cmp_ge_u32_e64 %4, %12, %13\n\t"
        "v_addc_co_u32_e64 %0, vcc, 0, %0, %1\n\tv_addc_co_u32_e64 %0, vcc, 0, %0, %2\n\tv_addc_co_u32_e64 %0, vcc, 0, %0, %3\n\tv_addc_co_u32_e64 %0, vcc, 0, %0, %4"
        : "+v"(cnt), "=&s"(m0), "=&s"(m1), "=&s"(m2), "=&s"(m3)
        : "v"(k0), "v"(k1), "v"(k2), "v"(k3), "v"(k4), "v"(k5), "v"(k6), "v"(k7), "s"(cand) : "vcc");
}
#define IDX_REP8(X, o) X((o) + 0) X((o) + 1) X((o) + 2) X((o) + 3) X((o) + 4) X((o) + 5) X((o) + 6) X((o) + 7)
template <int NREG>
__device__ __forceinline__ void indexer_task_n(int b, int t0, const f16_t* __restrict__ QI, const f16_t* __restrict__ KI, const float* __restrict__ WI, unsigned long long* __restrict__ MASK, int lane) {
    const int r32 = lane & 31, hi = lane >> 5; const size_t rowb = (size_t)b * SEQ;
    const f16_t* qp = QI + (rowb + t0 + (r32 >> 3)) * 256 + 32 * (r32 & 7) + 8 * hi;
    const f16x8 a0 = *(const f16x8*)(qp), a1 = *(const f16x8*)(qp + 16);
    f32x4 wv[4];
#pragma unroll
    for (int q = 0; q < 4; ++q) wv[q] = *(const f32x4*)(WI + (rowb + t0 + q) * 8 + 4 * hi);
    const int nst = (t0 + 3) / 64 + 1;
    const f16_t* kp = KI + (rowb + r32) * 32 + 8 * hi;
    unsigned key[4][NREG];
    f16x8 bq[3][4];
#pragma unroll
    for (int i = 0; i < 4; ++i) bq[0][i] = *(const f16x8*)(kp + (i >> 1) * 1024 + (i & 1) * 16);
    if (1 < nst) {
#pragma unroll
        for (int i = 0; i < 4; ++i) bq[1][i] = *(const f16x8*)(kp + (size_t)2048 + (i >> 1) * 1024 + (i & 1) * 16); }
#pragma unroll
    for (int st = 0; st < NREG; ++st) {
        if (st < nst) {
            if (st + 2 < NREG && st + 2 < nst) {
#pragma unroll
                for (int i = 0; i < 4; ++i) bq[(st + 2) % 3][i] = *(const f16x8*)(kp + (size_t)(st + 2) * 2048 + (i >> 1) * 1024 + (i & 1) * 16);
            }
            const f32x16 z16 = (f32x16){0.f, 0.f, 0.f, 0.f, 0.f, 0.f, 0.f, 0.f, 0.f, 0.f, 0.f, 0.f, 0.f, 0.f, 0.f, 0.f};
            f32x16 c0 = __builtin_amdgcn_mfma_f32_32x32x16_f16(a0, bq[st % 3][0], z16, 0, 0, 0);
            c0 = __builtin_amdgcn_mfma_f32_32x32x16_f16(a1, bq[st % 3][1], c0, 0, 0, 0);
            f32x16 c1 = __builtin_amdgcn_mfma_f32_32x32x16_f16(a0, bq[st % 3][2], z16, 0, 0, 0);
            c1 = __builtin_amdgcn_mfma_f32_32x32x16_f16(a1, bq[st % 3][3], c1, 0, 0, 0);
#pragma unroll
            for (int q = 0; q < 4; ++q) {
                float pa = 0.f, pb = 0.f;
#pragma unroll
                for (int i = 0; i < 4; ++i) { pa += wv[q][i] * __builtin_amdgcn_fmed3f(c0[4 * q + i], 0.f, __builtin_inff()); pb += wv[q][i] * __builtin_amdgcn_fmed3f(c1[4 * q + i], 0.f, __builtin_inff()); }
                const auto rr = __builtin_amdgcn_permlane32_swap(__builtin_bit_cast(unsigned, pa), __builtin_bit_cast(unsigned, pb), false, false);
                const unsigned rr0 = rr[0], rr1 = rr[1];
                const float sc = __builtin_bit_cast(float, rr0) + __builtin_bit_cast(float, rr1);
                key[q][st] = (st + 1 < nst || 64 * st + lane <= t0 + q) ? score_key(sc) : 0u;
            }
        } else {
#pragma unroll
            for (int q = 0; q < 4; ++q) key[q][st] = 0u;
        }
    }
    const int t0u = __builtin_amdgcn_readfirstlane(t0), nstu = (t0u + 3) / 64 + 1;
    bool done[4], exact[4]; unsigned eq[4], gt[4], cgt[4];
#pragma unroll
    for (int q = 0; q < 4; ++q) { exact[q] = false; done[q] = (t0u + q < TOPK); eq[q] = 0xffffffffu; gt[q] = 0u; cgt[q] = 0u;
        if (!done[q]) {
#define IDX_TSTAGE(J, MK) _Pragma("unroll") for (int k = 0; k < 32; ++k) if ((k & J) == 0) { const unsigned t_ = ((key[q][k] >> J) ^ key[q][k + J]) & MK; key[q][k + J] ^= t_; key[q][k] ^= t_ << J; }
            IDX_TSTAGE(16, 0x0000ffffu) IDX_TSTAGE(8, 0x00ff00ffu) IDX_TSTAGE(4, 0x0f0f0f0fu) IDX_TSTAGE(2, 0x33333333u) IDX_TSTAGE(1, 0x55555555u)
#undef IDX_TSTAGE
        } }
#pragma unroll
    for (int b = 31; b >= 0; --b) {
        if (done[0] && done[1] && done[2] && done[3]) break;
        unsigned tb[4], c[4] = {0u, 0u, 0u, 0u};
#pragma unroll
        for (int q = 0; q < 4; ++q) { tb[q] = 0u; if (!done[q]) { tb[q] = eq[q] & key[q][b]; c[q] = (unsigned)__builtin_popcount(tb[q]) + cgt[q]; } }
        const int c01 = (done[0] && done[1]) ? 0 : wave_sum_i32((int)(c[0] | (c[1] << 16))), c23 = (done[2] && done[3]) ? 0 : wave_sum_i32((int)(c[2] | (c[3] << 16)));
        const int cs[4] = {c01 & 0xffff, c01 >> 16, c23 & 0xffff, c23 >> 16};
#pragma unroll
        for (int q = 0; q < 4; ++q) if (!done[q]) {
            if (cs[q] >= TOPK) { eq[q] = tb[q]; if (cs[q] == TOPK) { gt[q] |= tb[q]; done[q] = true; exact[q] = true; } }
            else { gt[q] |= tb[q]; cgt[q] = c[q]; eq[q] ^= tb[q]; } }
    }
#define IDX_PUTW(bal, st) do { const unsigned long long b_ = (bal); asm volatile("s_nop 1\n\tv_writelane_b32 %0, %2, %4\n\tv_writelane_b32 %1, %3, %4" : "+v"(wlo), "+v"(whi) : "s"((unsigned)b_), "s"((unsigned)(b_ >> 32)), "n"(st));     } while (0)
#pragma unroll
    for (int q = 0; q < 4; ++q) {
        const int t = t0 + q; unsigned wlo = 0u, whi = 0u;
        if (t < TOPK) {
#define IDX_X(st) IDX_PUTW(__ballot(64 * (st) + lane <= t), st);
            IDX_REP8(IDX_X, 0)
#undef IDX_X
        } else {
            const bool ex = exact[q]; const unsigned gsel = gt[q], ties = eq[q]; int need = 0;
            if (!ex) need = TOPK - wave_sum_i32((int)cgt[q]);
            const unsigned long long lt = (1ull << lane) - 1ull;
#define IDX_X(st) { bool sel_ = (gsel >> (st)) & 1u; \
                    if (!ex) { const bool tie_ = (ties >> (st)) & 1u; const unsigned long long tb_ = __ballot(tie_); sel_ = sel_ || (tie_ && __popcll(tb_ & lt) < need); need -= __popcll(tb_); if (need < 0) need = 0; } \
                    IDX_PUTW(__ballot(sel_), st); }
            IDX_REP8(IDX_X, 0)
            if (NREG > 8 && nst > 8) { IDX_REP8(IDX_X, 8) }
            if (NREG > 16 && nst > 16) { IDX_REP8(IDX_X, 16) }
            if (NREG > 24 && nst > 24) { IDX_REP8(IDX_X, 24) }
#undef IDX_X
        }
        if (lane < 32) MASK[(rowb + t) * 32 + lane] = (unsigned long long)wlo | ((unsigned long long)whi << 32);
    }
#undef IDX_PUTW
}
#undef IDX_REP8

constexpr int NWAVES = 8;
constexpr int RING_OFF = 0, RING_BYTES = 131072;
constexpr int LDSCTL_OFF = RING_BYTES, MISC_OFF = LDSCTL_OFF + 320;
constexpr int LDS_BYTES = 147456;
constexpr int TAB_OFF = MISC_OFF + 128;
constexpr int WTAB_OFF = TAB_OFF + 2048;
static_assert(WTAB_OFF + 8192 <= LDS_BYTES, "LDS map");
constexpr int N_PHASES = 8;

struct Args { const float* in[13]; float* out; unsigned char* ws; int ph_lo, ph_hi, li, pad; };

__device__ __forceinline__ void p0_transpose_item(const float* W, int K, int N, bf16_t* WT, int Nv, int mode, const float* kscale, LAS float* scr, int item, int lane) {
    const int nblk = Nv / 32, kb = item / nblk, nb = item % nblk, k0 = 64 * kb, n0 = 32 * nb;
    const int v = n0 + (lane & 31); const int a = mode == 0 ? v : (mode == 1 ? win_actual(v) : wup_actual(v));
    float vals[32];
    const float* wp = W + (size_t)(k0 + (lane >> 5)) * N + (a >= 0 ? a : 0);
#pragma unroll
    for (int i = 0; i < 32; ++i) vals[i] = wp[(size_t)(2 * i) * N];
#pragma unroll
    for (int i = 0; i < 32; ++i) { const int kk = 2 * i + (lane >> 5); float val = (a >= 0) ? vals[i] : 0.f;
        if (kscale) val *= kscale[k0 + kk];
        scr[kk * 33 + (lane & 31)] = val; }
    LDS_WAIT(); asm volatile("" ::: "memory");
    const int c = lane & 7;
#pragma unroll
    for (int j = 0; j < 4; ++j) { const int n = (lane >> 3) + 8 * j; const LAS float* s = scr + (8 * c) * 33 + n;
        v4u o; o.x = pk2(s[0 * 33], s[1 * 33]); o.y = pk2(s[2 * 33], s[3 * 33]); o.z = pk2(s[4 * 33], s[5 * 33]); o.w = pk2(s[6 * 33], s[7 * 33]);
        *(GAS v4u*)(WT + (size_t)(n0 + n) * K + k0 + 8 * c) = o; }
    LDS_WAIT(); asm volatile("" ::: "memory");
}

__global__ void __launch_bounds__(NWAVES * 64, 2) mk_fwd(Args args) {
    extern __shared__ __attribute__((aligned(16))) unsigned char lds[];
    LAS unsigned char* L = (LAS unsigned char*)lds;
    volatile LAS unsigned* MISC = (volatile LAS unsigned*)(L + MISC_OFF);
    const int wave = __builtin_amdgcn_readfirstlane((int)threadIdx.x >> 6);
#define MK_IDS const int lane = mk_lane(), tid = wave * 64 + lane; (void)tid
    const int G = gridDim.x; const int bx = blockIdx.x; const int vcu = (G % 8 == 0) ? (bx % 8) * (G / 8) + bx / 8 : bx;
    unsigned char* ws = args.ws;
    gu32* ctl = (gu32*)(ws + WS_CTL);
    const float* x = args.in[0]; const float* norm1_g = args.in[1]; const float* w_in = args.in[2]; const float* q_norm_g = args.in[3]; const float* k_norm_g = args.in[4];
    const float* w_out = args.in[7]; const float* norm2_g = args.in[8]; const float* w_up = args.in[9]; const float* conv_w = args.in[10]; const float* conv_b = args.in[11]; const float* w_down = args.in[12];
    float* out = args.out;
    float* ROPE = (float*)(ws + WS_ROPE); float* ROPE16 = (float*)(ws + WS_ROPE16);
    bf16_t *Win = (bf16_t*)(ws + WS_WIN), *Wout = (bf16_t*)(ws + WS_WOUT), *Wup = (bf16_t*)(ws + WS_WUP), *Wdn = (bf16_t*)(ws + WS_WDN);
    float* SS2 = (float*)(ws + WS_SS2);
    bf16_t *XN = (bf16_t*)(ws + WS_XN), *VP = (bf16_t*)(ws + WS_VP), *Q = (bf16_t*)(ws + WS_Q), *Kb = (bf16_t*)(ws + WS_K), *Vb = (bf16_t*)(ws + WS_V);
    f16_t *QI = (f16_t*)(ws + WS_QI), *KI = (f16_t*)(ws + WS_KI); float* WI = (float*)(ws + WS_WI);
    bf16_t *MIX = (bf16_t*)(ws + WS_MIX), *Gb = (bf16_t*)(ws + WS_G);
    bf16_t *HF = (bf16_t*)(ws + WS_HF), *HL = (bf16_t*)(ws + WS_HL);
    unsigned long long* MASK = (unsigned long long*)(ws + WS_MASK); const float* pool_w = args.in[5]; const float* pool_scale = args.in[6];

    for (int u = (int)threadIdx.x; u < (LDS_BYTES - LDSCTL_OFF) / 4; u += NWAVES * 64) ((LAS unsigned*)(L + LDSCTL_OFF))[u] = 0u;
    __syncthreads();
    XcdBarrier bar = xcd_barrier_post((unsigned*)(ctl + CW_BAR) + args.li * XCD_BAR_WORDS, MISC + 8); bar.w0 = (wave == 0);
    const int lo = args.ph_lo, hi = args.ph_hi;
#define IN(k) (lo <= (k) && (k) < hi)
#define SEAM(k) do { if (IN(k) && IN((k) + 1)) xcd_barrier(bar); } while (0)
    const int gw = vcu * NWAVES + wave, NGW = G * NWAVES;

    if (IN(0)) for (int rep_ = 0; rep_ < kReps[0]; ++rep_) { if (rep_) xcd_barrier(bar);
        MK_IDS;
        LAS float* scr = (LAS float*)(L + RING_OFF + wave * 16384);
        constexpr int I_IN = (D_MODEL / 64) * (IN_WV / 32), I_OUT = (D_MODEL / 64) * (D_MODEL / 32), I_UP = (D_MODEL / 64) * (UP_W / 32), I_DN = (DFF / 64) * (D_MODEL / 32);
        for (int sr_ = 0; sr_ < kSub[0]; ++sr_)
        for (int it = gw; it < I_IN + I_OUT + I_UP + I_DN; it += NGW) {
            int r = it;
            if (r < I_IN) { p0_transpose_item(w_in, D_MODEL, IN_W, Win, IN_WV, 1, nullptr, scr, r, lane); continue; } r -= I_IN;
            if (r < I_OUT) { if (r >= 8 * (D_MODEL / 32)) p0_transpose_item(w_out, D_MODEL, D_MODEL, Wout, D_MODEL, 0, nullptr, scr, r, lane); continue; } r -= I_OUT;
            if (r < I_UP) { p0_transpose_item(w_up, D_MODEL, UP_W, Wup, UP_W, 2, norm2_g, scr, r, lane); continue; } r -= I_UP;
            p0_transpose_item(w_down, DFF, D_MODEL, Wdn, D_MODEL, 0, nullptr, scr, r, lane);
        }
        for (int sr_ = 0; sr_ < kSub[1]; ++sr_)
        for (int it = vcu * NWAVES * 64 + tid; it < 128 * D_MODEL; it += G * NWAVES * 64) {
            const int n = it & (D_MODEL - 1), c4 = it >> 10, g = c4 >> 5;
            const float* pw = pool_w + (size_t)(4 * c4) * 128;
            const float* wo = w_out + (size_t)(128 * g) * D_MODEL + n; const float* ps = pool_scale + 128 * g;
            float a4[4] = {0.f, 0.f, 0.f, 0.f};
#pragma unroll 32
            for (int d = 0; d < 128; ++d) { const float wv = wo[(size_t)d * D_MODEL] * ps[d];
#pragma unroll
                for (int e = 0; e < 4; ++e) a4[e] += pw[e * 128 + d] * wv; }
            *(unsigned long long*)(Wout + (size_t)n * D_MODEL + 4 * c4) = (unsigned long long)pk2(a4[0], a4[1]) | ((unsigned long long)pk2(a4[2], a4[3]) << 32);
        }
        for (int sr_ = 0; sr_ < kSub[2]; ++sr_)
        for (int i = vcu * NWAVES * 64 + tid; i < SEQ * 48; i += G * NWAVES * 64) {
            int pos, k; float inv; float* dst;
            if (i < SEQ * 32) { pos = i >> 5; k = i & 31; inv = expf(-logf(10000.0f) * (float)k / 32.0f); dst = ROPE + 2 * i; }
            else { const int i2 = i - SEQ * 32; pos = i2 >> 4; k = i2 & 15; inv = expf(-logf(10000.0f) * (float)k / 16.0f); dst = ROPE16 + 2 * i2; }
            float s, c; sincosf((float)pos * inv, &s, &c); dst[0] = c; dst[1] = s;
        }
        for (int sr_ = 0; sr_ < kSub[3]; ++sr_)
        for (int m4 = gw; m4 < M / 4; m4 += NGW) {
            f32x4 v[4][4]; float ssq[4];
#pragma unroll
            for (int r = 0; r < 4; ++r) { const GAS f32x4* xr = (const GAS f32x4*)(x + (size_t)(4 * m4 + r) * D_MODEL) + lane;
#pragma unroll
                for (int j = 0; j < 4; ++j) v[r][j] = xr[64 * j]; }
#pragma unroll
            for (int r = 0; r < 4; ++r) { float s = 0.f;
#pragma unroll
                for (int j = 0; j < 4; ++j) s += (v[r][j].x * v[r][j].x + v[r][j].y * v[r][j].y) + (v[r][j].z * v[r][j].z + v[r][j].w * v[r][j].w);
                ssq[r] = s; }
#pragma unroll
            for (int o = 1; o < 64; o <<= 1) {
#pragma unroll
                for (int r = 0; r < 4; ++r) ssq[r] += __shfl_xor(ssq[r], o); }
#pragma unroll
            for (int r = 0; r < 4; ++r) { const float rstd = 1.0f / sqrtf(ssq[r] * (1.0f / D_MODEL) + EPS);
                GAS unsigned long long* o8 = (GAS unsigned long long*)(XN + (size_t)(4 * m4 + r) * D_MODEL) + lane;
#pragma unroll
                for (int j = 0; j < 4; ++j) { const f32x4 gg = ((const f32x4*)norm1_g)[lane + 64 * j];
                    o8[64 * j] = (unsigned long long)pk2(v[r][j].x * rstd * gg.x, v[r][j].y * rstd * gg.y) | ((unsigned long long)pk2(v[r][j].z * rstd * gg.z, v[r][j].w * rstd * gg.w) << 32); } }
        }
    }
    SEAM(0);
    if (IN(1)) for (int rep_ = 0; rep_ < kReps[1]; ++rep_) { if (rep_) xcd_barrier(bar);
        pg8::Gemm g{XN, Win, M, IN_WV, D_MODEL}; pg8::StaticOrder S; S.init(M, IN_WV, G, bx);
        pg8::EpiProj E{VP, Q, Kb, Vb, QI, KI, WI, ROPE, ROPE16, q_norm_g, k_norm_g};
        pg8::gemm_phase<pg8::EpiProj, pg8::StaticOrder, true, true>(L + RING_OFF, g, S, E, wave);
    }
    SEAM(1);
    if (IN(2)) for (int rep_ = 0; rep_ < kReps[2]; ++rep_) { if (rep_) xcd_barrier(bar);
        MK_IDS;
        for (int sr_ = 0; sr_ < kSub[4]; ++sr_)
        for (int wi = gw; wi < M / 4; wi += NGW) {
            const int row = 4 * wi + (lane >> 4), t = row & (SEQ - 1);
            const bf16_t* vp = VP + (size_t)row * POOL_W + 8 * (lane & 15);
            v4u u2[2], u4[4], u8[8], u16[16];
#define POOL_LD(U, W, g) _Pragma("unroll") for (int k = 0; k < W; ++k) U[k] = *(const v4u*)(vp + 128 * (g) - (size_t)((k <= t) ? k : 0) * POOL_W);
            POOL_LD(u2, 2, 0) POOL_LD(u4, 4, 1) POOL_LD(u8, 8, 2) POOL_LD(u16, 16, 3)
#undef POOL_LD
#define POOL_OUT(U, W, g) do { float sum[8], v0[8]; \
                _Pragma("unroll") for (int e = 0; e < 8; ++e) sum[e] = 0.f; \
                _Pragma("unroll") for (int k = 0; k < W; ++k) { const float m_ = (k <= t) ? 1.f : 0.f; const unsigned uu[4] = {U[k].x, U[k].y, U[k].z, U[k].w}; \
                    _Pragma("unroll") for (int e = 0; e < 4; ++e) { const float lo = __builtin_bit_cast(float, uu[e] << 16), hh = __builtin_bit_cast(float, uu[e] & 0xffff0000u); sum[2 * e] += m_ * lo; sum[2 * e + 1] += m_ * hh; \
                        if (k == 0) { v0[2 * e] = lo; v0[2 * e + 1] = hh; } } } \
                const float rc = 1.0f / (float)((t + 1 < W) ? t + 1 : W); \
                v4u o; o.x = pk2(sum[0] * rc - v0[0], sum[1] * rc - v0[1]); o.y = pk2(sum[2] * rc - v0[2], sum[3] * rc - v0[3]); o.z = pk2(sum[4] * rc - v0[4], sum[5] * rc - v0[5]); o.w = pk2(sum[6] * rc - v0[6], sum[7] * rc - v0[7]); \
                *(v4u*)(MIX + (size_t)row * 1024 + 128 * (g) + 8 * (lane & 15)) = o; } while (0)
            POOL_OUT(u2, 2, 0); POOL_OUT(u4, 4, 1); POOL_OUT(u8, 8, 2); POOL_OUT(u16, 16, 3);
#undef POOL_OUT
        }
        for (int sr_ = 0; sr_ < kSub[5]; ++sr_)
        for (int id = gw; id < M / 4; id += NGW) {
            const int w = id & 2047, bb = w >> 8, tq = (id < 2048) ? (w & 255) : 511 - (w & 255);
            indexer_task_n<32>(bb, 4 * tq, QI, KI, WI, MASK, lane);
        }
    }
    SEAM(2);
    if (IN(3)) for (int rep_ = 0; rep_ < kReps[3]; ++rep_) { if (rep_) xcd_barrier(bar);
        const attn_body::AttnTensors AT{(const attn_body::bf16*)Q, (const attn_body::bf16*)Kb, (const attn_body::bf16*)Vb, MASK, (attn_body::bf16*)MIX};
        const attn_body::StaticOrder S((int)G, (int)bx);
        attn_body::attn_phase<attn_body::StaticOrder>((char*)lds + RING_OFF, AT, S, wave);
    }
    SEAM(3);
    if (IN(4)) for (int rep_ = 0; rep_ < kReps[4]; ++rep_) { if (rep_) xcd_barrier(bar);
        pg8::Gemm g{MIX, Wout, M, D_MODEL, D_MODEL}; pg8::StaticOrder S; S.init(M, D_MODEL, G, bx);
        pg8::EpiWout E{x, XN, SS2};
        pg8::gemm_phase<pg8::EpiWout, pg8::StaticOrder, true, true>(L + RING_OFF, g, S, E, wave);
    }
    SEAM(4);
    if (IN(5)) for (int rep_ = 0; rep_ < kReps[5]; ++rep_) { if (rep_) xcd_barrier(bar);
        pg8::Gemm g{XN, Wup, M, UP_W, D_MODEL}; pg8::UpOrder S; S.init(M, UP_W, G, bx); S.SS2 = SS2; S.tab = (LAS float*)(L + TAB_OFF); S.wtab = (LAS float*)(L + WTAB_OFF); S.conv_w = conv_w; S.conv_b = conv_b; S.wv = wave; S.par = 0;
        pg8::EpiUp E{(const LAS float*)(L + TAB_OFF), (const LAS float*)(L + WTAB_OFF), Gb, HF, HL, 0};
        pg8::gemm_phase<pg8::EpiUp, pg8::UpOrder, true, true, true>(L + RING_OFF, g, S, E, wave);
    }
    SEAM(5);
    if (IN(6)) for (int rep_ = 0; rep_ < kReps[6]; ++rep_) { if (rep_) xcd_barrier(bar);
        MK_IDS;
        for (int idx = vcu * NWAVES * 64 + tid; idx < 256 * 2 * (DFF / 4); idx += G * NWAVES * 64) {
            const int n4 = idx % (DFF / 4), gj = idx / (DFF / 4), j = gj & 1, g64 = gj >> 1, n = 4 * n4;
            const int vg = 256 * (n >> 7) + (n & 127);
            f32x4 cc[2];
#pragma unroll
            for (int bj = 0; bj < 2; ++bj) { const int v = vg + 128 * bj;
#define HLD(P, r) ({ const unsigned long long w_ = *(const unsigned long long*)((P) + (size_t)(r) * UP_W + v); (f32x4){__builtin_bit_cast(float, (unsigned)w_ << 16), __builtin_bit_cast(float, (unsigned)w_ & 0xffff0000u), __builtin_bit_cast(float, (unsigned)(w_ >> 32) << 16), __builtin_bit_cast(float, (unsigned)(w_ >> 32) & 0xffff0000u)}; })
                const f32x4 f0 = HLD(HF, g64 * 2 + 0), f1 = HLD(HF, g64 * 2 + 1);
                f32x4 l0 = (f32x4){0.f, 0.f, 0.f, 0.f}, l1 = l0;
                if (g64 & 31) { l0 = HLD(HL, (g64 - 1) * 2 + 0); l1 = HLD(HL, (g64 - 1) * 2 + 1); }
#undef HLD
                const f32x4 um2 = j ? l1 : l0, um1 = j ? f0 : l1, u0 = j ? f1 : f0;
                const float* wp = conv_w + bj * DFF + n;
                cc[bj] = *(const f32x4*)(conv_b + bj * DFF + n) + *(const f32x4*)(wp) * um2 + *(const f32x4*)(wp + UP_W) * um1 + *(const f32x4*)(wp + 2 * UP_W) * u0; }
            float gs[4];
#pragma unroll
            for (int i = 0; i < 4; ++i) { const float gt = cc[0][i]; gs[i] = gt / (1.0f + __expf(-gt)) * cc[1][i]; }
            unsigned long long w = (unsigned long long)pk2(gs[0], gs[1]) | ((unsigned long long)pk2(gs[2], gs[3]) << 32);
            *(unsigned long long*)(Gb + (size_t)(64 * g64 + j) * DFF + n) = w;
        }
    }
    SEAM(6);
    if (IN(7)) {
        pg8::Gemm g{Gb, Wdn, M, D_MODEL, DFF}; pg8::StaticOrder S; S.init(M, D_MODEL, G, bx);
        pg8::EpiDown E{XN, out};
        pg8::gemm_phase<pg8::EpiDown, pg8::StaticOrder, true, true>(L + RING_OFF, g, S, E, wave);
    }
#undef IN
#undef SEAM
}

static int mk_grid() {
    static int grid = 0;
    if (grid == 0) {
        int dev = 0, cus = 0, per_cu = 0;
        if (hipGetDevice(&dev) != hipSuccess || hipDeviceGetAttribute(&cus, hipDeviceAttributeMultiprocessorCount, dev) != hipSuccess) { fprintf(stderr, "kernel_launch: device query failed\n"); grid = -1; return grid; }
        if (hipFuncSetAttribute((const void*)mk_fwd, hipFuncAttributeMaxDynamicSharedMemorySize, LDS_BYTES) != hipSuccess) { fprintf(stderr, "kernel_launch: hipFuncSetAttribute failed\n"); grid = -1; return grid; }
        if (hipOccupancyMaxActiveBlocksPerMultiprocessor(&per_cu, (const void*)mk_fwd, NWAVES * 64, LDS_BYTES) != hipSuccess || per_cu < 1) { fprintf(stderr, "kernel_launch: occupancy query reports %d workgroups per CU\n", per_cu); (void)hipGetLastError(); }
        grid = cus;
    }
    return grid;
}
static void mk_launch(Args a, int lo, int hi, int li, hipStream_t stream) {
    const int grid = mk_grid(); if (grid <= 0) return;
    a.ph_lo = lo; a.ph_hi = hi; a.li = li;
    hipLaunchKernelGGL(mk_fwd, dim3(grid), dim3(NWAVES * 64), LDS_BYTES, stream, a);
}

extern "C" void kernel_launch(void* const* d_in, const int* in_sizes, int n_in, void* d_out, int out_size, void* d_ws, size_t ws_size, hipStream_t stream) {
    const float* pool_w = (const float*)d_in[5]; const float* pool_scale = (const float*)d_in[6];
    unsigned char* ws = (unsigned char*)d_ws;
    bf16_t *VP = (bf16_t*)(ws + WS_VP), *Q = (bf16_t*)(ws + WS_Q), *Kb = (bf16_t*)(ws + WS_K), *Vb = (bf16_t*)(ws + WS_V);
    f16_t *QI = (f16_t*)(ws + WS_QI), *KI = (f16_t*)(ws + WS_KI); float* WI = (float*)(ws + WS_WI);
    unsigned long long* MASK = (unsigned long long*)(ws + WS_MASK); bf16_t* MIX = (bf16_t*)(ws + WS_MIX);
    (void)hipMemsetAsync(ws + WS_CTL, 0, CTL_ZERO_BYTES, stream);
    Args a{};
    for (int i = 0; i < 13; ++i) a.in[i] = (const float*)d_in[i];
    a.out = (float*)d_out; a.ws = ws;
    mk_launch(a, 0, N_PHASES, 0, stream);
}
```

```cpp
#include <hip/hip_runtime.h>
#include <cstdint>
#include <cstdio>

typedef unsigned short bf16_t;
typedef _Float16 f16_t;

constexpr int D_MODEL = 1024, BATCH = 8, SEQ = 2048, M = BATCH * SEQ;
constexpr int POOL_W = 512, NQH = 8, HD = 64, NKV = 2, IH = 8, ID = 32, TOPK = 256;
constexpr int IN_W = 1576, IN_WV = 1792;
constexpr int DFF = 2816, UP_W = 2 * DFF;
constexpr float EPS = 1e-6f;
constexpr float C2 = 0.125f * 1.4426950408889634f;

constexpr size_t MiB = 1u << 20;
constexpr size_t WS_CTL = 0, CTL_ZERO_BYTES = 32768;
constexpr size_t WS_ROPE = 1 * MiB;
constexpr size_t WS_ROPE16 = 1 * MiB + 512 * 1024;
constexpr size_t WS_WIN = 2 * MiB, WS_WOUT = 6 * MiB, WS_WUP = 8 * MiB, WS_WDN = 19 * MiB;
constexpr size_t WS_SS2 = 25 * MiB;
constexpr size_t WS_RSTD2 = 26 * MiB;
constexpr size_t WS_XN = 28 * MiB;
constexpr size_t WS_VP = 60 * MiB, WS_Q = 76 * MiB, WS_K = 92 * MiB, WS_V = 96 * MiB, WS_QI = 100 * MiB, WS_KI = 108 * MiB, WS_WI = 109 * MiB;
constexpr size_t WS_MASK = 110 * MiB, WS_MIX = 114 * MiB;
constexpr size_t WS_G = 60 * MiB;
constexpr size_t WS_HF = 192 * MiB, WS_HL = 204 * MiB;
constexpr int CW_BAR = 4096;

#define GAS __attribute__((address_space(1)))
#define LAS __attribute__((address_space(3)))
typedef unsigned short bf16;
typedef unsigned v4u __attribute__((ext_vector_type(4)));
typedef float f32x4 __attribute__((ext_vector_type(4)));
typedef short bf16x8 __attribute__((ext_vector_type(8)));
typedef GAS unsigned gu32;
typedef GAS unsigned long long gu64;
#define RLX_AGENT __ATOMIC_RELAXED, __HIP_MEMORY_SCOPE_AGENT
#define LDS_WAIT() asm volatile("s_waitcnt lgkmcnt(0)" ::: "memory")
#define VM_WAIT() asm volatile("s_waitcnt vmcnt(0)" ::: "memory")
__device__ __forceinline__ unsigned long long rt() { return __builtin_amdgcn_s_memrealtime(); }
__device__ __forceinline__ unsigned f2bf(float f) { unsigned u = __builtin_bit_cast(unsigned, f); return (u + 0x7fffu + ((u >> 16) & 1u)) >> 16; }
__device__ __forceinline__ unsigned pk2(float lo, float hi) { return f2bf(lo) | (f2bf(hi) << 16); }

#define XB_TMO      128
#define XB_XCNT(j)  (256  + 64 * (j))
#define XB_XSUB(j)  (1280 + 64 * (j))
#define XB_XGEN(j)  (2304 + 64 * (j))
#define XB_TOP      3328
#define XB_TOPGEN   3392
#define XCD_BAR_WORDS 3456
#define XB_SPIN_CAP (1u << 18)

__device__ __forceinline__ unsigned xb_ld(unsigned* p)              { return __hip_atomic_load(p, __ATOMIC_RELAXED, __HIP_MEMORY_SCOPE_AGENT); }
__device__ __forceinline__ unsigned xb_add(unsigned* p, unsigned v) { return __hip_atomic_fetch_add(p, v, __ATOMIC_RELAXED, __HIP_MEMORY_SCOPE_AGENT); }
__device__ __forceinline__ unsigned xb_xcc_id() { return (unsigned)__builtin_amdgcn_s_getreg((3 << 11) | 20) & 0xFu; }
#define XB_SPIN(cond, bar) do { unsigned _sp = 0; while (cond) { __builtin_amdgcn_s_sleep(1); \
    if ((++_sp & 255u) == 0u) { if (xb_ld(&(bar)[XB_TMO])) break; if (_sp > XB_SPIN_CAP) { atomicAdd(&(bar)[XB_TMO], 1u); break; } } } } while (0)

struct XcdBarrier {
    unsigned* bar; unsigned x;
    volatile LAS unsigned* st;
    bool w0;
};

__device__ __forceinline__ XcdBarrier xcd_barrier_post(unsigned* bar, volatile LAS unsigned* st) {
    XcdBarrier b; b.bar = bar; b.x = xb_xcc_id(); b.st = st;
    if (threadIdx.x == 0) (void)xb_add(&bar[XB_XCNT(b.x)], 1u);
    return b;
}
__device__ __forceinline__ void xcd_barrier_complete(unsigned* bar, unsigned x, unsigned& nloc, unsigned& nx) {
    const unsigned G = gridDim.x * gridDim.y * gridDim.z;
    unsigned sum, cnt, mine, sp = 0u;
    for (;;) {
        sum = 0u; cnt = 0u; mine = 0u;
#pragma unroll
        for (unsigned j = 0; j < 16; ++j) { const unsigned c = xb_ld(&bar[XB_XCNT(j)]); sum += c; cnt += (c > 0u) ? 1u : 0u; mine = (j == x) ? c : mine; }
        if (sum == G) break;
        __builtin_amdgcn_s_sleep(1);
        if ((++sp & 255u) == 0u) { if (xb_ld(&bar[XB_TMO])) break; if (sp > XB_SPIN_CAP) { atomicAdd(&bar[XB_TMO], 1u); break; } }
    }
    nloc = mine > 0u ? mine : 1u; nx = cnt > 0u ? cnt : 1u;
}

__device__ __forceinline__ void xcd_barrier(const XcdBarrier& b) {
    asm volatile("s_waitcnt vmcnt(0)" ::: "memory");
    __syncthreads();
    if (b.w0 && __builtin_amdgcn_mbcnt_hi(~0u, __builtin_amdgcn_mbcnt_lo(~0u, 0u)) == 0u) {
        unsigned* bar = b.bar;
        __builtin_amdgcn_s_waitcnt(0);
        unsigned nloc = b.st[0], nx = b.st[1];
        if (nloc == 0u) { xcd_barrier_complete(bar, b.x, nloc, nx); b.st[0] = nloc; b.st[1] = nx; }
        const unsigned old = xb_add(&bar[XB_XSUB(b.x)], 1u);
        const unsigned gen = old / nloc;
        if (old + 1u == (gen + 1u) * nloc) {
            __builtin_amdgcn_fence(__ATOMIC_RELEASE, "agent");
            asm volatile("s_waitcnt vmcnt(0)" ::: "memory");
            const unsigned og = xb_add(&bar[XB_TOP], 1u);
            const unsigned tg = og / nx;
            if (og + 1u == (tg + 1u) * nx) xb_add(&bar[XB_TOPGEN], 1u);
            else XB_SPIN(xb_ld(&bar[XB_TOPGEN]) == tg, bar);
            __builtin_amdgcn_fence(__ATOMIC_ACQUIRE, "agent");
            xb_add(&bar[XB_XGEN(b.x)], 1u);
            asm volatile("s_waitcnt vmcnt(0)" ::: "memory");
        } else {
            XB_SPIN(xb_ld(&bar[XB_XGEN(b.x)]) == gen, bar);
            __builtin_amdgcn_fence(__ATOMIC_ACQUIRE, "agent");
            asm volatile("s_waitcnt vmcnt(0)" ::: "memory");
        }
    }
    __syncthreads();
}

__device__ __forceinline__ int mk_lane() { return (int)__builtin_amdgcn_mbcnt_hi(~0u, __builtin_amdgcn_mbcnt_lo(~0u, 0u)); }
__device__ __forceinline__ float bf2f(bf16_t b) { return __builtin_bit_cast(float, (unsigned)b << 16); }
__device__ __forceinline__ float wave_sum(float v) {
#pragma unroll
    for (int o = 1; o < 64; o <<= 1) v += __shfl_xor(v, o);
    return v;
}
__device__ __forceinline__ float wave_max(float v) {
#pragma unroll
    for (int o = 1; o < 64; o <<= 1) v = fmaxf(v, __shfl_xor(v, o));
    return v;
}

__host__ __device__ __forceinline__ int win_actual(int v) {
    const int pn = v >> 8, w = v & 255, bj = w >> 7, wc = (w >> 5) & 3, j = w & 31;
    if (pn < 2) return v;
    if (pn < 5) return 512 + 64 * (4 * (pn - 2) + wc) + 32 * bj + j;
    const int hd = 2 * wc + (j >> 4), d = 16 * bj + (j & 15);
    if (pn == 5) return 1280 + 32 * hd + d;
    if (hd == 0) return 1536 + d;
    if (hd == 1 && d < 8) return 1568 + d;
    return -1;
}
__host__ __device__ __forceinline__ int wup_actual(int v) { const int pn = v >> 8, w = v & 255; return (w >> 7) * DFF + 128 * pn + (w & 127); }

namespace pg8 {
#define PG8_LAS __attribute__((address_space(3)))
typedef unsigned short bf16_t;
typedef short bf16x8 __attribute__((ext_vector_type(8)));
typedef float f32x4 __attribute__((ext_vector_type(4)));
typedef unsigned u32x4 __attribute__((ext_vector_type(4)));
constexpr int BM = 256, BK = 64, HALF = 128, HTB = HALF * BK * 2  , STAGE_BYTES = 8 * HTB, NXCD = 8, WGM = 8;

__host__ __device__ __forceinline__ int lds_byte(int r, int c) { const int st = (r >> 4) * 2 + (c >> 5), rr = r & 15, cc = c & 31, ob = rr * 64 + cc * 2; return st * 1024 + (ob ^ (((ob >> 9) & 1) << 5)); }
__host__ __device__ __forceinline__ void stage_rc(int b, int& R, int& C) { const int st = b / 1024, sb = b % 1024, swz = sb ^ (((sb >> 9) & 1) << 5); R = (st >> 1) * 16 + swz / 64; C = (st & 1) * 32 + (swz % 64) / 2; }
__host__ __device__ __forceinline__ int perm32(int rho) { const int n = rho >> 4, i = rho & 15; return 8 * (i >> 2) + 4 * n + (i & 3); }

struct Unit { int pm, pn; };
struct Gemm { const bf16_t* A; const bf16_t* Bt; int M, N, K; };

struct StaticOrder {
    int nM, nN, nwg, G, c;
    __host__ __device__ void init(int M, int N, int G_, int c_) { nM = M / BM; nN = N / BM; nwg = nM * nN; G = G_; c = c_; }
    __host__ __device__ bool next(int i, Unit& u) const {
        const long L = (long)i * G + c; if (L >= nwg) return false;
        int wgid = (int)L; { const int q = nwg / NXCD, r = nwg % NXCD, xcd = wgid % NXCD, off = wgid / NXCD; wgid = (xcd < r ? xcd * (q + 1) : r * (q + 1) + (xcd - r) * q) + off; }
        const int nig = WGM * nN, gid = wgid / nig, fm = gid * WGM, gsz = (nM - fm) < WGM ? (nM - fm) : WGM;
        u.pm = fm + ((wgid % nig) % gsz); u.pn = (wgid % nig) / gsz; return true;
    }
    __device__ __forceinline__ void a_ready(const Unit&) const {}
    __device__ __forceinline__ void done(const Unit&) const {}
};

__device__ __forceinline__ unsigned cvt_pk_bf16(float lo, float hi) { unsigned r; asm volatile("v_cvt_pk_bf16_f32 %0, %1, %2" : "=v"(r) : "v"(lo), "v"(hi)); return r; }
__device__ __forceinline__ unsigned cvt_pk_f16(float lo, float hi) { return (unsigned)__builtin_bit_cast(unsigned short, (_Float16)lo) | ((unsigned)__builtin_bit_cast(unsigned short, (_Float16)hi) << 16); }
typedef float f32x2 __attribute__((ext_vector_type(2)));
typedef unsigned u32x2 __attribute__((ext_vector_type(2)));
__device__ __forceinline__ u32x4 pack8_bf16(const f32x4 a, const f32x4 b) { u32x4 w; w.x = cvt_pk_bf16(a[0], a[1]); w.y = cvt_pk_bf16(a[2], a[3]); w.z = cvt_pk_bf16(b[0], b[1]); w.w = cvt_pk_bf16(b[2], b[3]); return w; }
__device__ __forceinline__ u32x4 pack8_f16(const f32x4 a, const f32x4 b) { u32x4 w; w.x = cvt_pk_f16(a[0], a[1]); w.y = cvt_pk_f16(a[2], a[3]); w.z = cvt_pk_f16(b[0], b[1]); w.w = cvt_pk_f16(b[2], b[3]); return w; }

struct EpiProj {
    static constexpr bool PERM = true, AFTER_DRAIN = false, HAS_INIT = false;
    bf16_t *VP, *Q, *Kb, *Vb; _Float16 *QI, *KI; float* WI; const float* rope32; const float* rope16; const float *gq, *gk;
    __device__ __forceinline__ void operator()(const f32x4 (&acc)[2][2][4][2], const Unit& u, int wr, int wc, int fr, int fq) const {
        const int pn = u.pn, rowb = u.pm * BM + wr * 64 + fr;
        if (pn < 2) {
#pragma unroll
            for (int ai = 0; ai < 2; ++ai)
#pragma unroll
                for (int m = 0; m < 4; ++m) { bf16_t* rp = VP + (size_t)(rowb + ai * HALF + m * 16) * 512 + pn * 256 + wc * 32 + 8 * fq;
#pragma unroll
                    for (int bj = 0; bj < 2; ++bj) *(u32x4*)(rp + bj * HALF) = pack8_bf16(acc[ai][bj][m][0], acc[ai][bj][m][1]); }
        } else if (pn < 5) {
            if (pn == 4 && wc >= 2) {
#pragma unroll
                for (int ai = 0; ai < 2; ++ai)
#pragma unroll
                    for (int m = 0; m < 4; ++m) { bf16_t* rp = Vb + (size_t)(rowb + ai * HALF + m * 16) * 128 + 64 * (wc - 2) + 8 * fq;
#pragma unroll
                        for (int bj = 0; bj < 2; ++bj) *(u32x4*)(rp + bj * 32) = pack8_bf16(acc[ai][bj][m][0], acc[ai][bj][m][1]); }
            } else {
                const bool isk = (pn == 4); const float* g = isk ? gk : gq; const float osc = isk ? 1.0f : 0.18033688011112042f  ;
                f32x4 gv[2][2];
#pragma unroll
                for (int bj = 0; bj < 2; ++bj)
#pragma unroll
                    for (int n = 0; n < 2; ++n) gv[bj][n] = *(const f32x4*)(g + 32 * bj + 8 * fq + 4 * n);
                bf16_t* dst = isk ? (Kb + 64 * wc) : (Q + 64 * (4 * (pn - 2) + wc)); const int ld = isk ? 128 : 512;
#pragma unroll
                for (int ai = 0; ai < 2; ++ai)
#pragma unroll
                    for (int m = 0; m < 4; ++m) { const int row = rowb + ai * HALF + m * 16, pos = row & 2047;
                        float ss = 0.f;
#pragma unroll
                        for (int bj = 0; bj < 2; ++bj)
#pragma unroll
                            for (int n = 0; n < 2; ++n) { const f32x4 v = acc[ai][bj][m][n]; ss += (v[0] * v[0] + v[1] * v[1]) + (v[2] * v[2] + v[3] * v[3]); }
                        ss += __shfl_xor(ss, 16); ss += __shfl_xor(ss, 32);
                        const float rstd = 1.0f / sqrtf(ss * (1.0f / 64.0f) + 1e-6f);
                        const f32x4* rp = (const f32x4*)(rope32 + (size_t)(pos * 32 + 8 * fq) * 2);
                        f32x4 o1[2], o2[2];
#pragma unroll
                        for (int n = 0; n < 2; ++n) { const f32x4 cs0 = rp[2 * n], cs1 = rp[2 * n + 1];
                            const f32x4 x1 = acc[ai][0][m][n] * rstd * gv[0][n], x2 = acc[ai][1][m][n] * rstd * gv[1][n];
                            const f32x4 c = (f32x4){cs0[0], cs0[2], cs1[0], cs1[2]}, s = (f32x4){cs0[1], cs0[3], cs1[1], cs1[3]};
                            o1[n] = (x1 * c - x2 * s) * osc; o2[n] = (x2 * c + x1 * s) * osc; }
                        bf16_t* op = dst + (size_t)row * ld + 8 * fq;
                        *(u32x4*)(op) = pack8_bf16(o1[0], o1[1]); *(u32x4*)(op + 32) = pack8_bf16(o2[0], o2[1]); }
            }
        } else {
            const int hd = 2 * wc + (fq >> 1);
            if (pn == 6 && wc != 0) return;
            if (pn == 6 && hd == 1) {
                if (fq == 2) {
#pragma unroll
                    for (int ai = 0; ai < 2; ++ai)
#pragma unroll
                        for (int m = 0; m < 4; ++m) { float* wp = WI + (size_t)(rowb + ai * HALF + m * 16) * 8;
                            *(f32x4*)(wp) = acc[ai][0][m][0] * 0.0625f; *(f32x4*)(wp + 4) = acc[ai][0][m][1] * 0.0625f; }
                }
                return;
            }
            _Float16* dst = (pn == 5) ? (QI + 32 * hd) : KI; const int ld = (pn == 5) ? 256 : 32;
#pragma unroll
            for (int ai = 0; ai < 2; ++ai)
#pragma unroll
                for (int m = 0; m < 4; ++m) { const int row = rowb + ai * HALF + m * 16, pos = row & 2047;
                    const f32x4* rp = (const f32x4*)(rope16 + (size_t)(pos * 16 + 8 * (fq & 1)) * 2);
                    f32x4 o1[2], o2[2];
#pragma unroll
                    for (int n = 0; n < 2; ++n) { const f32x4 cs0 = rp[2 * n], cs1 = rp[2 * n + 1];
                        const f32x4 x1 = acc[ai][0][m][n], x2 = acc[ai][1][m][n];
                        const f32x4 c = (f32x4){cs0[0], cs0[2], cs1[0], cs1[2]}, s = (f32x4){cs0[1], cs0[3], cs1[1], cs1[3]};
                        o1[n] = x1 * c - x2 * s; o2[n] = x2 * c + x1 * s; }
                    _Float16* op = dst + (size_t)row * ld + 8 * (fq & 1);
                    *(u32x4*)(op) = pack8_f16(o1[0], o1[1]); *(u32x4*)(op + 16) = pack8_f16(o2[0], o2[1]); }
        }
    }
};

__device__ __forceinline__ f32x4 bf16lo_to_f32(const u32x2 w) { return (f32x4){__builtin_bit_cast(float, w.x << 16), __builtin_bit_cast(float, w.x & 0xffff0000u), __builtin_bit_cast(float, w.y << 16), __builtin_bit_cast(float, w.y & 0xffff0000u)}; }
struct EpiWout {
    static constexpr bool PERM = true, AFTER_DRAIN = false, HAS_INIT = true, NEXT_HOOK = false;
    const float* x; bf16_t* X1B; float* SS2;
    __device__ __forceinline__ void init(f32x4 (&acc)[2][2][4][2], const Unit& u, int wr, int wc, int fr, int fq) const {
        const int rowb = u.pm * BM + wr * 64 + fr, col0 = u.pn * BM + wc * 32 + 8 * fq;
#pragma unroll
        for (int ai = 0; ai < 2; ++ai)
#pragma unroll
            for (int m = 0; m < 4; ++m) { const size_t off = (size_t)(rowb + ai * HALF + m * 16) * 1024 + col0;
#pragma unroll
                for (int bj = 0; bj < 2; ++bj) { acc[ai][bj][m][0] = *(const f32x4*)(x + off + bj * HALF); acc[ai][bj][m][1] = *(const f32x4*)(x + off + bj * HALF + 4); } }
    }
    __device__ __forceinline__ void operator()(const f32x4 (&acc)[2][2][4][2], const Unit& u, int wr, int wc, int fr, int fq) const {
        const int rowb = u.pm * BM + wr * 64 + fr, col0 = u.pn * BM + wc * 32 + 8 * fq;
#pragma unroll
        for (int ai = 0; ai < 2; ++ai)
#pragma unroll
            for (int m = 0; m < 4; ++m) { const int row = rowb + ai * HALF + m * 16; const size_t off = (size_t)row * 1024 + col0; float ss = 0.f;
#pragma unroll
                for (int bj = 0; bj < 2; ++bj) { const f32x4 v0 = acc[ai][bj][m][0], v1 = acc[ai][bj][m][1];
                    ss += (v0[0] * v0[0] + v0[1] * v0[1]) + (v0[2] * v0[2] + v0[3] * v0[3]) + (v1[0] * v1[0] + v1[1] * v1[1]) + (v1[2] * v1[2] + v1[3] * v1[3]);
                    *(u32x4*)(X1B + off + bj * HALF) = pack8_bf16(v0, v1); }
                ss += __shfl_xor(ss, 16); ss += __shfl_xor(ss, 32);
                if (fq == 0) SS2[(size_t)row * 16 + 4 * u.pn + wc] = ss; }
    }
};
struct EpiDown {
    static constexpr bool PERM = true, AFTER_DRAIN = false, HAS_INIT = true, NEXT_HOOK = false;
    const bf16_t* X1B; float* out;
    __device__ __forceinline__ void init(f32x4 (&acc)[2][2][4][2], const Unit& u, int wr, int wc, int fr, int fq) const {
        const int rowb = u.pm * BM + wr * 64 + fr, col0 = u.pn * BM + wc * 32 + 8 * fq;
#pragma unroll
        for (int ai = 0; ai < 2; ++ai) {
            u32x4 hv[4][2];
#pragma unroll
            for (int m = 0; m < 4; ++m) { const size_t off = (size_t)(rowb + ai * HALF + m * 16) * 1024 + col0;
#pragma unroll
                for (int bj = 0; bj < 2; ++bj) hv[m][bj] = *(const u32x4*)(X1B + off + bj * HALF); }
#pragma unroll
            for (int m = 0; m < 4; ++m)
#pragma unroll
                for (int bj = 0; bj < 2; ++bj) { acc[ai][bj][m][0] = bf16lo_to_f32((u32x2){hv[m][bj].x, hv[m][bj].y}); acc[ai][bj][m][1] = bf16lo_to_f32((u32x2){hv[m][bj].z, hv[m][bj].w}); }
        }
    }
    __device__ __forceinline__ void operator()(const f32x4 (&acc)[2][2][4][2], const Unit& u, int wr, int wc, int fr, int fq) const {
        const int rowb = u.pm * BM + wr * 64 + fr, col0 = u.pn * BM + wc * 32 + 8 * fq;
#pragma unroll
        for (int ai = 0; ai < 2; ++ai)
#pragma unroll
            for (int m = 0; m < 4; ++m) { float* p = out + (size_t)(rowb + ai * HALF + m * 16) * 1024 + col0;
#pragma unroll
                for (int bj = 0; bj < 2; ++bj) { *(f32x4*)(p + bj * HALF) = acc[ai][bj][m][0]; *(f32x4*)(p + bj * HALF + 4) = acc[ai][bj][m][1]; } }
    }
};
__device__ __forceinline__ float dpp_shr1(float v) { return __builtin_bit_cast(float, __builtin_amdgcn_update_dpp(0, __builtin_bit_cast(int, v), 0x111, 0xf, 0xf, false)); }
template <class T> __device__ __forceinline__ void stg_u32(void* base, unsigned boff, const T v) { *(T*)((char*)base + boff) = v; }
struct EpiUp {
    static constexpr bool PERM = true, AFTER_DRAIN = false, HAS_INIT = false;
    const PG8_LAS float* tab; const PG8_LAS float* wtab; bf16_t* G; bf16_t* HF; bf16_t* HL; mutable int par;
    __device__ __forceinline__ void operator()(const f32x4 (&acc)[2][2][4][2], const Unit& u, int wr, int wc, int fr_, int fq_) const {
        int fr = fr_, fq = fq_; asm volatile("" : "+v"(fr), "+v"(fq));
        const unsigned cb = 32 * wc + 8 * fq, ncol = 128 * u.pn + cb;
        const PG8_LAS float* tb = tab + par * 256 + wr * 64 + 4 * fr; const PG8_LAS float* wt = wtab + par * 1024 + cb; par ^= 1;
#pragma unroll
        for (int ai = 0; ai < 2; ++ai) {
            const unsigned rg = u.pm * BM + ai * HALF + wr * 64, g64 = rg >> 6;
            const f32x4 rs = *(const PG8_LAS f32x4*)(tb + ai * HALF);
            u32x2 gp[2][4];
#pragma unroll
            for (int n = 0; n < 2; ++n) {
                f32x4 cg[4];
#pragma unroll
                for (int bj = 0; bj < 2; ++bj) {
                    const PG8_LAS f32x4* wq = (const PG8_LAS f32x4*)(wt + 128 * bj + 4 * n);
                    const f32x4 w0 = wq[0], w1 = wq[64], w2 = wq[128], bb = wq[192];
                    f32x4 uu[4];
#pragma unroll
                    for (int m = 0; m < 4; ++m) uu[m] = acc[ai][bj][m][n] * rs[m];
                    const unsigned vcol = u.pn * 256u + bj * 128u + cb + 4u * n;
                    if (fr == 0) { stg_u32<u32x2>(HF, ((g64 * 2u + 0u) * 5632u + vcol) * 2u, (u32x2){cvt_pk_bf16(uu[0][0], uu[0][1]), cvt_pk_bf16(uu[0][2], uu[0][3])}); stg_u32<u32x2>(HF, ((g64 * 2u + 1u) * 5632u + vcol) * 2u, (u32x2){cvt_pk_bf16(uu[1][0], uu[1][1]), cvt_pk_bf16(uu[1][2], uu[1][3])}); }
                    if (fr == 15) { stg_u32<u32x2>(HL, ((g64 * 2u + 0u) * 5632u + vcol) * 2u, (u32x2){cvt_pk_bf16(uu[2][0], uu[2][1]), cvt_pk_bf16(uu[2][2], uu[2][3])}); stg_u32<u32x2>(HL, ((g64 * 2u + 1u) * 5632u + vcol) * 2u, (u32x2){cvt_pk_bf16(uu[3][0], uu[3][1]), cvt_pk_bf16(uu[3][2], uu[3][3])}); }
                    f32x4 d2, d3;
#pragma unroll
                    for (int i = 0; i < 4; ++i) { d2[i] = dpp_shr1(uu[2][i]); d3[i] = dpp_shr1(uu[3][i]); }
                    f32x4 c[4];
                    c[0] = bb + w0 * d2 + w1 * d3 + w2 * uu[0];
                    c[1] = bb + w0 * d3 + w1 * uu[0] + w2 * uu[1];
                    c[2] = bb + w0 * uu[0] + w1 * uu[1] + w2 * uu[2];
                    c[3] = bb + w0 * uu[1] + w1 * uu[2] + w2 * uu[3];
#pragma unroll
                    for (int m = 0; m < 4; ++m) {
                        if (bj == 0) cg[m] = c[m];
                        else { f32x4 gsl;
#pragma unroll
                            for (int i = 0; i < 4; ++i) gsl[i] = __builtin_amdgcn_exp2f(-cg[m][i]);
                            gsl = gsl + 1.0f;
#pragma unroll
                            for (int i = 0; i < 4; ++i) gsl[i] = __builtin_amdgcn_rcpf(gsl[i]);
                            gsl = (cg[m] * gsl) * c[m];
                            gp[n][m] = (u32x2){cvt_pk_bf16(gsl[0], gsl[1]), cvt_pk_bf16(gsl[2], gsl[3])}; }
                    }
                }
            }
#pragma unroll
            for (int m = 0; m < 4; ++m)
                stg_u32<u32x4>(G, ((rg + 4u * fr + m) * 2816u + ncol) * 2u, (u32x4){gp[0][m].x, gp[0][m].y, gp[1][m].x, gp[1][m].y});
        }
    }
};
struct UpOrder : StaticOrder {
    const float* SS2; PG8_LAS float* tab; PG8_LAS float* wtab; const float* conv_w; const float* conv_b; int wv; mutable int par;
    __device__ __forceinline__ void a_ready(const Unit& u) const {
        const int t = wv * 64 + (int)__builtin_amdgcn_mbcnt_hi(~0u, __builtin_amdgcn_mbcnt_lo(~0u, 0u));
#pragma unroll
        for (int k = 0; k < 2; ++k) { const int idx = t + 512 * k, tap = idx >> 8, v = idx & 255, col = (v >> 7) * 2816 + 128 * u.pn + (v & 127);
            wtab[par * 1024 + idx] = (tap < 3 ? conv_w[tap * 5632 + col] : conv_b[col]) * ((v >> 7) ? 0.6931471805599453f : 1.4426950408889634f); }
        if (t < 256) { const f32x4* sp = (const f32x4*)(SS2 + (size_t)(u.pm * BM + t) * 16); const f32x4 a = sp[0], b = sp[1], c = sp[2], d = sp[3];
            const float s = (((a[0] + a[1]) + (a[2] + a[3])) + ((b[0] + b[1]) + (b[2] + b[3]))) + (((c[0] + c[1]) + (c[2] + c[3])) + ((d[0] + d[1]) + (d[2] + d[3])));
            tab[par * 256 + t] = __builtin_amdgcn_rsqf(s * (1.0f / 1024.0f) + 1e-6f); }
        par ^= 1;
    }
};

template <class Epi, class Sched, bool ALIGN_EPI = false, bool SP2 = false, bool ROWPERM = false>
__device__ __forceinline__ void gemm_phase(PG8_LAS unsigned char* lds, const Gemm g, const Sched& S, const Epi& E, const int wv  ) {
    int tid_ = wv * 64 + (int)__builtin_amdgcn_mbcnt_hi(~0u, __builtin_amdgcn_mbcnt_lo(~0u, 0u)); asm volatile("" : "+v"(tid_));
    const int tid = tid_, wid = __builtin_amdgcn_readfirstlane(tid >> 6), lane = tid & 63, wr = wid >> 2, wc = wid & 3, fr = lane & 15, fq = lane >> 4;
    const int K = g.K, nt = K / BK;
    unsigned voffA[2], voffB[2];
#pragma unroll
    for (int i = 0; i < 2; ++i) { int R, C; stage_rc(tid * 16 + i * 8192, R, C); const int Rb = Epi::PERM ? ((R & ~31) + perm32(R & 31)) : R;
        const int Ra = ROWPERM ? ((R & ~63) + 4 * (R & 15) + ((R >> 4) & 3)) : R;
        voffA[i] = (unsigned)(Ra * K + C) * 2u; voffB[i] = (unsigned)(Rb * K + C) * 2u; }
    const size_t kstep = (size_t)(BK * 2);
    const size_t hstep = (size_t)HALF * K * 2;
    const size_t tstep = 2 * hstep;
    const unsigned ldsw = (unsigned)wid * 1024u;
    const int aoff = lds_byte(wr * 64 + fr, fq * 8), boff = lds_byte(wc * 32 + fr, fq * 8);
#define PG8_SA(b, h) (((b) * 2 + (h)) * HTB)
#define PG8_SB(b, h) ((4 + (b) * 2 + (h)) * HTB)
#define PG8_STAGE(bufoff, gbase, voff) do { _Pragma("unroll") for (int _i = 0; _i < 2; ++_i) \
        __builtin_amdgcn_global_load_lds((const unsigned*)((const char*)(gbase) + (voff)[_i]), (PG8_LAS unsigned*)(lds + (bufoff) + ldsw + _i * 8192), 16, 0, 0); } while (0)
#define PG8_LDA(dst, b, h) do { _Pragma("unroll") for (int m = 0; m < 4; ++m) _Pragma("unroll") for (int k = 0; k < 2; ++k) dst[m][k] = *(const PG8_LAS bf16x8*)(lds + PG8_SA(b, h) + aoff + m * 2048 + k * 1024); } while (0)
#define PG8_LDB(dst, b, h) do { _Pragma("unroll") for (int n = 0; n < 2; ++n) _Pragma("unroll") for (int k = 0; k < 2; ++k) dst[n][k] = *(const PG8_LAS bf16x8*)(lds + PG8_SB(b, h) + boff + n * 2048 + k * 1024); } while (0)
#define PG8_MMA(ai, bj, At, Bt) do { __builtin_amdgcn_s_setprio(1); _Pragma("unroll") for (int m = 0; m < 4; ++m) _Pragma("unroll") for (int n = 0; n < 2; ++n) _Pragma("unroll") for (int k = 0; k < 2; ++k) \
        acc[ai][bj][m][n] = __builtin_amdgcn_mfma_f32_16x16x32_bf16(Bt[n][k], At[m][k], acc[ai][bj][m][n], 0, 0, 0); __builtin_amdgcn_s_setprio(0); } while (0)
#define PG8_WAIT_V(n) asm volatile("s_waitcnt vmcnt(" #n ")" ::: "memory")
#define PG8_WAIT_L(n) asm volatile("s_waitcnt lgkmcnt(" #n ")" ::: "memory")
#define PG8_BAR __builtin_amdgcn_s_barrier()
#define PG8_SCHED __builtin_amdgcn_sched_barrier(0)
    Unit cur, nxt; int ui = 0;
    if (!S.next(0, cur)) return;
    f32x4 acc[2][2][4][2];
    if constexpr (Epi::HAS_INIT) E.init(acc, cur, wr, wc, fr, fq);
    else {
#pragma unroll
    for (int a = 0; a < 2; ++a)
#pragma unroll
        for (int b = 0; b < 2; ++b)
#pragma unroll
            for (int m = 0; m < 4; ++m)
#pragma unroll
                for (int n = 0; n < 2; ++n) acc[a][b][m][n] = (f32x4){0.f, 0.f, 0.f, 0.f};
    }
    bf16x8 At[4][2], B0[2][2], B1[2][2];
    const char* cA = (const char*)g.A + (size_t)cur.pm * tstep; const char* cB = (const char*)g.Bt + (size_t)cur.pn * tstep;
    S.a_ready(cur);
    if constexpr (SP2) {
        PG8_STAGE(PG8_SB(0, 0), cB, voffB); PG8_STAGE(PG8_SB(0, 1), cB + hstep, voffB); PG8_STAGE(PG8_SA(0, 0), cA, voffA); PG8_STAGE(PG8_SA(0, 1), cA + hstep, voffA);
        if (wr == 1) PG8_BAR;
        PG8_WAIT_V(2); PG8_BAR;
        PG8_STAGE(PG8_SB(1, 0), cB + kstep, voffB); PG8_STAGE(PG8_SA(1, 0), cA + kstep, voffA); PG8_STAGE(PG8_SB(1, 1), cB + hstep + kstep, voffB);
        PG8_WAIT_V(6); PG8_BAR;
    } else {
        PG8_STAGE(PG8_SB(0, 0), cB, voffB); PG8_STAGE(PG8_SA(0, 0), cA, voffA); PG8_STAGE(PG8_SB(0, 1), cB + hstep, voffB); PG8_STAGE(PG8_SA(0, 1), cA + hstep, voffA);
        if (wr == 1) PG8_BAR;
        PG8_WAIT_V(4); PG8_BAR;
        PG8_STAGE(PG8_SB(1, 0), cB + kstep, voffB); PG8_STAGE(PG8_SA(1, 0), cA + kstep, voffA); PG8_STAGE(PG8_SB(1, 1), cB + hstep + kstep, voffB);
        PG8_WAIT_V(6); PG8_BAR;
    }
    for (;;) {
        const bool has_next = S.next(ui + 1, nxt);
        const char* nA = has_next ? (const char*)g.A + (size_t)nxt.pm * tstep : cA; const char* nB = has_next ? (const char*)g.Bt + (size_t)nxt.pn * tstep : cB;
        for (int t = 0; t < nt; t += 2) {
            const bool last = (t == nt - 2);
            const char* a1 = cA + (size_t)(t + 1) * kstep;
            const char* a2 = last ? nA : cA + (size_t)(t + 2) * kstep; const char* b2 = last ? nB : cB + (size_t)(t + 2) * kstep;
            const char* a3 = a2 + kstep; const char* b3 = b2 + kstep;
            if (last && has_next) S.a_ready(nxt);
            if constexpr (SP2) {
            PG8_LDB(B0, 0, 0); PG8_LDB(B1, 0, 1); PG8_SCHED; PG8_LDA(At, 0, 0); PG8_STAGE(PG8_SA(1, 1), a1 + hstep, voffA);
            PG8_WAIT_V(8); PG8_WAIT_L(0); PG8_BAR; PG8_MMA(0, 0, At, B0); PG8_MMA(0, 1, At, B1); PG8_BAR; PG8_SCHED;
            PG8_LDA(At, 0, 1); PG8_STAGE(PG8_SB(0, 0), b2, voffB); PG8_STAGE(PG8_SB(0, 1), b2 + hstep, voffB); PG8_STAGE(PG8_SA(0, 0), a2, voffA);
            PG8_WAIT_V(8); PG8_WAIT_L(0); PG8_BAR; PG8_MMA(1, 0, At, B0); PG8_MMA(1, 1, At, B1); PG8_BAR; PG8_SCHED;
            PG8_LDB(B0, 1, 0); PG8_LDB(B1, 1, 1); PG8_SCHED; PG8_LDA(At, 1, 0); PG8_STAGE(PG8_SA(0, 1), a2 + hstep, voffA);
            PG8_WAIT_V(8); PG8_WAIT_L(0); PG8_BAR; PG8_MMA(0, 0, At, B0); PG8_MMA(0, 1, At, B1); PG8_BAR; PG8_SCHED;
            PG8_LDA(At, 1, 1); PG8_STAGE(PG8_SB(1, 0), b3, voffB); PG8_STAGE(PG8_SB(1, 1), b3 + hstep, voffB); PG8_STAGE(PG8_SA(1, 0), a3, voffA);
            PG8_WAIT_V(8); PG8_WAIT_L(0); PG8_BAR; PG8_MMA(1, 0, At, B0); PG8_MMA(1, 1, At, B1); PG8_BAR; PG8_SCHED;
            } else {
            PG8_LDB(B0, 0, 0); PG8_SCHED; PG8_LDA(At, 0, 0); PG8_STAGE(PG8_SA(1, 1), a1 + hstep, voffA);
            PG8_WAIT_L(8); PG8_BAR; PG8_WAIT_L(0); PG8_MMA(0, 0, At, B0); PG8_BAR; PG8_SCHED;
            PG8_LDB(B1, 0, 1); PG8_STAGE(PG8_SB(0, 0), b2, voffB);
            PG8_BAR; PG8_WAIT_L(0); PG8_MMA(0, 1, At, B1); PG8_BAR;
            PG8_LDA(At, 0, 1); PG8_STAGE(PG8_SA(0, 0), a2, voffA);
            PG8_BAR; PG8_WAIT_L(0); PG8_MMA(1, 0, At, B0); PG8_BAR; PG8_SCHED;
            PG8_STAGE(PG8_SB(0, 1), b2 + hstep, voffB);
            PG8_WAIT_V(6); PG8_BAR; PG8_MMA(1, 1, At, B1); PG8_BAR;
            PG8_LDB(B0, 1, 0); PG8_SCHED; PG8_LDA(At, 1, 0); PG8_STAGE(PG8_SA(0, 1), a2 + hstep, voffA);
            PG8_WAIT_L(8); PG8_BAR; PG8_WAIT_L(0); PG8_MMA(0, 0, At, B0); PG8_BAR; PG8_SCHED;
            PG8_LDB(B1, 1, 1); PG8_STAGE(PG8_SB(1, 0), b3, voffB);
            PG8_BAR; PG8_WAIT_L(0); PG8_MMA(0, 1, At, B1); PG8_BAR;
            PG8_LDA(At, 1, 1); PG8_STAGE(PG8_SA(1, 0), a3, voffA);
            PG8_BAR; PG8_WAIT_L(0); PG8_MMA(1, 0, At, B0); PG8_BAR; PG8_SCHED;
            PG8_STAGE(PG8_SB(1, 1), b3 + hstep, voffB);
            PG8_WAIT_V(6); PG8_BAR; PG8_MMA(1, 1, At, B1); PG8_BAR;
            }
        }
        if constexpr (ALIGN_EPI) { if (wr == 0) PG8_BAR; }
        if constexpr (!Epi::AFTER_DRAIN) { E(acc, cur, wr, wc, fr, fq); S.done(cur); }
        if (!has_next) break;
        if constexpr (Epi::HAS_INIT) E.init(acc, nxt, wr, wc, fr, fq);
        else {
#pragma unroll
        for (int a = 0; a < 2; ++a)
#pragma unroll
            for (int b = 0; b < 2; ++b)
#pragma unroll
                for (int m = 0; m < 4; ++m)
#pragma unroll
                    for (int n = 0; n < 2; ++n) acc[a][b][m][n] = (f32x4){0.f, 0.f, 0.f, 0.f};
        }
        cur = nxt; cA = nA; cB = nB; ++ui;
        if constexpr (ALIGN_EPI) { if (wr == 1) PG8_BAR; }
    }
    PG8_WAIT_V(0);
    if constexpr (!ALIGN_EPI) { if (wr == 0) PG8_BAR; }
    PG8_BAR;
    if constexpr (Epi::AFTER_DRAIN) { E.fused(acc, cur, wr, wc, fr, fq, lds, wid, lane); S.done(cur); }
#undef PG8_SA
#undef PG8_SB
#undef PG8_STAGE
#undef PG8_LDA
#undef PG8_LDB
#undef PG8_MMA
#undef PG8_WAIT_V
#undef PG8_WAIT_L
#undef PG8_BAR
#undef PG8_SCHED
}
}

#include <hip/hip_bf16.h>
#include <cmath>
namespace attn_body {
using bf16=__hip_bfloat16;
using bf16x8=__attribute__((ext_vector_type(8)))short;
using s16x4=__attribute__((ext_vector_type(4)))short;
using f32x16=__attribute__((ext_vector_type(16)))float;
using u32x4=__attribute__((ext_vector_type(4)))unsigned;
constexpr int BATCH=8,NHEAD=8,SEQ=2048,D=64,QP=512,KP=128,OP=1024,OOFF=512;
constexpr int NW=8,QBLK=32,QB=QBLK*NW,KVBLK=64,NQB=SEQ/QB;
constexpr int ATTN_UNIT_ROWS=QB;
__device__ __forceinline__ int crow(int r,int hi){return (r&3)+8*(r>>2)+4*hi;}
#define SBAR() __builtin_amdgcn_sched_barrier(0)
__device__ __forceinline__ void cmask(f32x16&p0,f32x16&p1,int jb,int qrel,int hi){
  const float NEG=-INFINITY; int kb=64*jb+4*hi;
  #pragma unroll
  for(int r=0;r<16;++r){int kv=kb+(r&3)+8*(r>>2); if(kv>qrel)p0[r]=NEG; if(kv+32>qrel)p1[r]=NEG;}
}

constexpr int NSLOT=3, SLOTB=8192;
constexpr int LDS_K=0, LDS_V=NSLOT*SLOTB, LDS_WS=2*NSLOT*SLOTB, LDS_OST=LDS_WS+NW*64*4, LDS_BYTES=LDS_OST+NW*4096;
constexpr float C2=0.125f*1.4426950408889634f;
__device__ __forceinline__ void glds16(const void*gsrc,unsigned lds_dst){unsigned keep;
  asm volatile("s_mov_b32 %0, m0\n\ts_mov_b32 m0, %2\n\ts_nop 0\n\tglobal_load_lds_dwordx4 %1, off\n\ts_mov_b32 m0, %0":"=&s"(keep):"v"(gsrc),"s"(lds_dst):"memory");}
__device__ __forceinline__ float max3f(float a,float b,float c){float r;asm("v_max3_f32 %0, %1, %2, %3":"=v"(r):"v"(a),"v"(b),"v"(c));return r;}
__device__ __forceinline__ float max2f(float a,float b){float r;asm("v_max_f32_e32 %0, %1, %2":"=v"(r):"v"(a),"v"(b));return r;}
__device__ __forceinline__ float fadd_s(float a,float b){float r;asm("v_add_f32_e32 %0, %1, %2":"=v"(r):"v"(a),"v"(b));return r;}
__device__ __forceinline__ float fsub_s(float a,float b){float r;asm("v_sub_f32_e32 %0, %1, %2":"=v"(r):"v"(a),"v"(b));return r;}
typedef float f32x2_t __attribute__((ext_vector_type(2))); typedef __bf16 bf16x2_t __attribute__((ext_vector_type(2)));
__device__ __forceinline__ unsigned cvtpk_s(float lo,float hi){f32x2_t v={lo,hi};bf16x2_t b=__builtin_convertvector(v,bf16x2_t);return __builtin_bit_cast(unsigned,b);}
#define WAIT_BAR(N) asm volatile("s_waitcnt vmcnt(" #N ") lgkmcnt(0)\n\ts_barrier":::"memory")

__device__ __forceinline__ void qkt(f32x16&p0,f32x16&p1,const char*Kslot,const bf16x8*qr,const f32x16&negm,int r32,int hi){
  const char*kb=Kslot+hi*1024+r32*16;
  #pragma unroll
  for(int d0=0;d0<4;++d0){
    const bf16x8 b0=*reinterpret_cast<const bf16x8*>(kb+d0*2048);
    const bf16x8 b1=*reinterpret_cast<const bf16x8*>(kb+d0*2048+512);
    if(d0==0){p0=__builtin_amdgcn_mfma_f32_32x32x16_bf16(b0,qr[0],negm,0,0,0);p1=__builtin_amdgcn_mfma_f32_32x32x16_bf16(b1,qr[0],negm,0,0,0);}
    else{p0=__builtin_amdgcn_mfma_f32_32x32x16_bf16(b0,qr[d0],p0,0,0,0);p1=__builtin_amdgcn_mfma_f32_32x32x16_bf16(b1,qr[d0],p1,0,0,0);}}
}
typedef __attribute__((address_space(3))) const char* lds_cptr;
typedef short v4i16_t __attribute__((ext_vector_type(4)));
__device__ __forceinline__ void kload8(bf16x8*kf,lds_cptr kp){
  kf[0]=*(const __attribute__((address_space(3))) bf16x8*)(kp);      kf[1]=*(const __attribute__((address_space(3))) bf16x8*)(kp+512);
  kf[2]=*(const __attribute__((address_space(3))) bf16x8*)(kp+2048); kf[3]=*(const __attribute__((address_space(3))) bf16x8*)(kp+2560);
  kf[4]=*(const __attribute__((address_space(3))) bf16x8*)(kp+4096); kf[5]=*(const __attribute__((address_space(3))) bf16x8*)(kp+4608);
  kf[6]=*(const __attribute__((address_space(3))) bf16x8*)(kp+6144); kf[7]=*(const __attribute__((address_space(3))) bf16x8*)(kp+6656);
}
__device__ __forceinline__ void kload2(bf16x8*kf,lds_cptr kp,int j){ kf[2*j]=*(const __attribute__((address_space(3))) bf16x8*)(kp+j*2048); kf[2*j+1]=*(const __attribute__((address_space(3))) bf16x8*)(kp+j*2048+512); }
__device__ __forceinline__ s16x4 vtr(lds_cptr p){ return __builtin_bit_cast(s16x4,__builtin_amdgcn_ds_read_tr16_b64_v4i16((__attribute__((address_space(3))) v4i16_t*)p)); }
__device__ __forceinline__ float rowmax(const f32x16&p0,const f32x16&p1){
  float a=max3f(p0[0],p0[1],p1[0]),b=max3f(p0[2],p0[3],p1[1]);a=max3f(a,p1[2],p1[3]);
  #pragma unroll
  for(int r=4;r<16;r+=4){a=max3f(a,p0[r],p0[r+1]);b=max3f(b,p0[r+2],p0[r+3]);a=max3f(a,p1[r],p1[r+1]);b=max3f(b,p1[r+2],p1[r+3]);}
  const float m=max2f(a,b);
  auto rr=__builtin_amdgcn_permlane32_swap(__float_as_uint(m),__float_as_uint(m),false,false);
  return max2f(__uint_as_float(rr[0]),__uint_as_float(rr[1]));
}
__device__ __forceinline__ void pv(f32x16*o,int vb,bf16x8 pa0,bf16x8 pa1,bf16x8 pa2,bf16x8 pa3){
  #pragma unroll
  for(int d0=0;d0<2;++d0){s16x4 lo[4],hi[4];
    #pragma unroll
    for(int ks=0;ks<4;++ks){
      asm volatile("ds_read_b64_tr_b16 %0,%1 offset:%c2":"=&v"(lo[ks]):"v"(vb),"i"(d0*4096+ks*1024):"memory");
      asm volatile("ds_read_b64_tr_b16 %0,%1 offset:%c2":"=&v"(hi[ks]):"v"(vb),"i"(d0*4096+ks*1024+512):"memory");}
    asm volatile("s_waitcnt lgkmcnt(0)":::"memory");SBAR();
    #define PK(k) (bf16x8){lo[k][0],lo[k][1],lo[k][2],lo[k][3],hi[k][0],hi[k][1],hi[k][2],hi[k][3]}
    o[d0]=__builtin_amdgcn_mfma_f32_32x32x16_bf16(pa0,PK(0),o[d0],0,0,0);
    o[d0]=__builtin_amdgcn_mfma_f32_32x32x16_bf16(pa1,PK(1),o[d0],0,0,0);
    o[d0]=__builtin_amdgcn_mfma_f32_32x32x16_bf16(pa2,PK(2),o[d0],0,0,0);
    o[d0]=__builtin_amdgcn_mfma_f32_32x32x16_bf16(pa3,PK(3),o[d0],0,0,0);
    #undef PK
  }
}

#ifndef ATTN_STORE16
#define ATTN_STORE16(p,v) (*(u32x4*)(p)=(v))
#endif
template<int THRL> __device__ __forceinline__ void attn_unit(int b,int h,int qb,const bf16*Q,const bf16*__restrict__ K,const bf16*__restrict__ V,const unsigned long long*__restrict__ MASK,bf16*O,char*shm,const int wv){
  int tid_=wv*64+(int)__builtin_amdgcn_mbcnt_hi(~0u,__builtin_amdgcn_mbcnt_lo(~0u,0u)); asm volatile("":"+v"(tid_)); const int tid=tid_,lane=tid&63,r32=lane&31,hi=lane>>5; const int wid=__builtin_amdgcn_readfirstlane(tid>>6);
  const long rowbase=(long)b*SEQ; const int q0=qb*QB;
  const bf16*Qw=Q+(rowbase+q0+wid*QBLK)*QP+h*D;
  const bf16*Kh=K+rowbase*KP+(h>>2)*D,*Vh=V+rowbase*KP+(h>>2)*D;
  const unsigned lds0=(unsigned)(uintptr_t)shm;
  float*wsf=(float*)(shm+LDS_WS)+wid*64;
  const bf16*ksrc=Kh+(long)lane*KP+wid*8;
  const bf16*vsrc=Vh+(long)(16*(wid&3)+(lane>>2))*KP+(wid>>2)*32+(lane&3)*8;
  const unsigned kdst=lds0+LDS_K+wid*1024, vdst=lds0+LDS_V+wid*1024;
  #define DMA_K(t,slot) glds16(ksrc+(long)(t)*KVBLK*KP,(unsigned)__builtin_amdgcn_readfirstlane(kdst+(slot)))
  #define DMA_V(t,slot) glds16(vsrc+(long)(t)*KVBLK*KP,(unsigned)__builtin_amdgcn_readfirstlane(vdst+(slot)))
  const int vb0=(int)(lds0+LDS_V)+((lane>>4)&1)*32+(lane&3)*8+(4*hi+((lane&15)>>2))*64;
  const char*Kbase=shm+LDS_K; bf16x8 kf[8];
  const lds_cptr shm3=(lds_cptr)shm; const lds_cptr kp0=shm3+LDS_K+hi*1024+r32*16; const lds_cptr vp0=shm3+LDS_V+((lane>>4)&1)*32+(lane&3)*8+(4*hi+((lane&15)>>2))*64;
  const int NT=(q0+QB)/KVBLK;
  DMA_K(0,0);DMA_V(0,0);DMA_K(1,SLOTB);
  bf16x8 qr[4];
  #pragma unroll
  for(int d0=0;d0<4;++d0)qr[d0]=*reinterpret_cast<const bf16x8*>(&Qw[(long)r32*QP+d0*16+hi*8]);
  float l_reg=0.f;f32x16 o[2];o[0]=f32x16{};o[1]=f32x16{};const f32x16 negm=f32x16{};
  const int qrel=wid*QBLK+r32;
  const unsigned long long*mrow=MASK+(rowbase+q0+qrel)*(SEQ/64);
  unsigned long long mk=mrow[0];
  #define MKSH(WL,WH,t) unsigned WL=(unsigned)mk>>(4*hi), WH=(unsigned)(mk>>32)>>(4*hi); asm volatile("":"+v"(WL),"+v"(WH)); mk=mrow[(t)+1]
  #define CMASKW(P0,P1,WL,WH) do{ _Pragma("unroll") for(int r=0;r<16;++r){ const int ps_=(r&3)+8*(r>>2); const float a_=P0[r], b_=P1[r]; \
      const unsigned m0_=(unsigned)__builtin_amdgcn_sbfe((int)WL,ps_,1), m1_=(unsigned)__builtin_amdgcn_sbfe((int)WH,ps_,1); \
      const unsigned ua_=(__builtin_bit_cast(unsigned,a_)&m0_)|(0xff800000u&~m0_), ub_=(__builtin_bit_cast(unsigned,b_)&m1_)|(0xff800000u&~m1_); \
      P0[r]=__builtin_bit_cast(float,ua_); P1[r]=__builtin_bit_cast(float,ub_); } }while(0)
  #define START(P0,P1) do{ _Pragma("unroll") for(int r=0;r<16;++r)P0[r]=__builtin_amdgcn_exp2f(P0[r]); }while(0)
  #define RESC() do{}while(0)
  f32x16 pA0,pA1,pB0,pB1;
  int sl_prev=0,sl_cur=0,sl_next=SLOTB;
  #define ROT() do{sl_prev=sl_cur;sl_cur=sl_next;sl_next=(sl_next==(NSLOT-1)*SLOTB)?0:sl_next+SLOTB;}while(0)
  DMA_K(2,2*SLOTB);
  WAIT_BAR(3);
  qkt(pA0,pA1,Kbase,qr,negm,r32,hi);asm volatile("s_nop 15\n\ts_nop 7":"+v"(pA0),"+v"(pA1));{MKSH(wl0_,wh0_,0);CMASKW(pA0,pA1,wl0_,wh0_);}
  START(pA0,pA1);
  _Pragma("unroll") for(int r=0;r<16;++r)pA1[r]=__builtin_amdgcn_exp2f(pA1[r]);
  WAIT_BAR(0);
  DMA_K(3,0);DMA_V(1,SLOTB);
  ROT();
  kload8(kf,kp0+sl_cur);
  WAIT_BAR(2);
  s16x4 vlo[8],vhi[8]; u32x4 pw0,pw1,pw2,pw3;
  #define PKW(P,B) cvtpk_s(P[B],P[B+1])
  #define PAF(k) __builtin_bit_cast(bf16x8,pw##k)
  #define VFR(i) (bf16x8){vlo[i][0],vlo[i][1],vlo[i][2],vlo[i][3],vhi[i][0],vhi[i][1],vhi[i][2],vhi[i][3]}
  #define PIN(x) asm volatile("":"+v"(x))
  #define MX3(a,b,c) __builtin_fmaxf(__builtin_fmaxf((a),(b)),(c))
  #define GAPA(MF,A0,A1,A2,A3,W0,W1,PW) do{ MF; sacc+=A0; sacc+=A1; sacc+=A2; sacc+=A3; PIN(sacc); W0; W1; PIN(PW); SBAR(); }while(0)
  #define EX(v) __builtin_amdgcn_exp2f(v)
  #define GAPB(MF,X,B) do{ MF; X[B]=EX(X[B]); X[B+1]=EX(X[B+1]); X[B+2]=EX(X[B+2]); X[B+3]=EX(X[B+3]); PIN(X); SBAR(); }while(0)
  #define VRD(i) do{ vlo[i]=vtr(vp_+(((i)>>2)*4096+((i)&3)*1024)); vhi[i]=vtr(vp_+(((i)>>2)*4096+((i)&3)*1024+512)); }while(0)
  #define KRD(G,j) do{ if(G){ kload2(kf,kp0+sl_next,j); SBAR(); } }while(0)
  #define STEP(C0,C1,P0,P1,t,GK,GV,GL) do{ SBAR(); \
    const lds_cptr vp_=vp0+sl_prev; \
    VRD(0); SBAR(); float sacc=(P0[0]+P0[1]); \
    GAPA(C0=__builtin_amdgcn_mfma_f32_32x32x16_bf16(kf[0],qr[0],negm,0,0,0), P0[2],P0[3],P0[4],P0[5],     pw0[0]=PKW(P0,0), pw0[1]=PKW(P0,2), pw0); \
    VRD(4); SBAR(); GAPA(C1=__builtin_amdgcn_mfma_f32_32x32x16_bf16(kf[1],qr[0],negm,0,0,0), P0[6],P0[7],P0[8],P0[9],     pw0[2]=PKW(P0,4), pw0[3]=PKW(P0,6), pw0); \
    VRD(1); SBAR(); GAPA(C0=__builtin_amdgcn_mfma_f32_32x32x16_bf16(kf[2],qr[1],C0,0,0,0),   P0[10],P0[11],P0[12],P0[13], pw1[0]=PKW(P0,8), pw1[1]=PKW(P0,10), pw1); \
    VRD(5); SBAR(); GAPA(C1=__builtin_amdgcn_mfma_f32_32x32x16_bf16(kf[3],qr[1],C1,0,0,0),   P0[14],P0[15],P1[0],P1[1],   pw1[2]=PKW(P0,12),pw1[3]=PKW(P0,14), pw1); \
    VRD(2); SBAR(); GAPA(C0=__builtin_amdgcn_mfma_f32_32x32x16_bf16(kf[4],qr[2],C0,0,0,0),   P1[2],P1[3],P1[4],P1[5],     pw2[0]=PKW(P1,0), pw2[1]=PKW(P1,2), pw2); \
    VRD(6); SBAR(); GAPA(C1=__builtin_amdgcn_mfma_f32_32x32x16_bf16(kf[5],qr[2],C1,0,0,0),   P1[6],P1[7],P1[8],P1[9],     pw2[2]=PKW(P1,4), pw2[3]=PKW(P1,6), pw2); \
    VRD(3); SBAR(); GAPA(C0=__builtin_amdgcn_mfma_f32_32x32x16_bf16(kf[6],qr[3],C0,0,0,0),   P1[10],P1[11],P1[12],P1[13], pw3[0]=PKW(P1,8), pw3[1]=PKW(P1,10), pw3); \
    VRD(7); SBAR(); GAPA(C1=__builtin_amdgcn_mfma_f32_32x32x16_bf16(kf[7],qr[3],C1,0,0,0),   P1[14],P1[15],0.f,0.f,       pw3[2]=PKW(P1,12),pw3[3]=PKW(P1,14), pw3); \
    l_reg+=sacc; \
    MKSH(wl_,wh_,t); \
    if(GK){DMA_K((t)+3,sl_cur);} if(GV){DMA_V((t)+1,sl_next);} \
    CMASKW(C0,C1,wl_,wh_); \
    SBAR(); \
    GAPB(o[0]=__builtin_amdgcn_mfma_f32_32x32x16_bf16(PAF(0),VFR(0),o[0],0,0,0), C0,0); \
    GAPB(o[1]=__builtin_amdgcn_mfma_f32_32x32x16_bf16(PAF(0),VFR(4),o[1],0,0,0), C0,4); \
    KRD(GL,0); GAPB(o[0]=__builtin_amdgcn_mfma_f32_32x32x16_bf16(PAF(1),VFR(1),o[0],0,0,0), C0,8); \
    KRD(GL,1); GAPB(o[1]=__builtin_amdgcn_mfma_f32_32x32x16_bf16(PAF(1),VFR(5),o[1],0,0,0), C0,12); \
    KRD(GL,2); GAPB(o[0]=__builtin_amdgcn_mfma_f32_32x32x16_bf16(PAF(2),VFR(2),o[0],0,0,0), C1,0); \
    KRD(GL,3); GAPB(o[1]=__builtin_amdgcn_mfma_f32_32x32x16_bf16(PAF(2),VFR(6),o[1],0,0,0), C1,4); \
    GAPB(o[0]=__builtin_amdgcn_mfma_f32_32x32x16_bf16(PAF(3),VFR(3),o[0],0,0,0), C1,8); \
    GAPB(o[1]=__builtin_amdgcn_mfma_f32_32x32x16_bf16(PAF(3),VFR(7),o[1],0,0,0), C1,12); \
    }while(0)
  int t=1;
  for(;t+5<NT;t+=2){
    STEP(pB0,pB1,pA0,pA1,t,true,true,true);     WAIT_BAR(2); RESC(); ROT();
    STEP(pA0,pA1,pB0,pB1,t+1,true,true,true);   WAIT_BAR(2); RESC(); ROT();
  }
  #define ENDW(tt) do{ if((tt)+3<NT){WAIT_BAR(2);} else if((tt)+2<NT){WAIT_BAR(1);} else {WAIT_BAR(0);} }while(0)
  for(;t+1<NT;t+=2){
    STEP(pB0,pB1,pA0,pA1,t,(t+3<NT),(t+1<NT),(t+1<NT));       ENDW(t);   RESC(); ROT();
    STEP(pA0,pA1,pB0,pB1,t+1,(t+4<NT),(t+2<NT),(t+2<NT));     ENDW(t+1); RESC(); ROT();
  }
  STEP(pB0,pB1,pA0,pA1,NT-1,false,false,false); RESC();
  { float sacc=pB0[0]+pB0[1]; _Pragma("unroll") for(int r=2;r<16;++r)sacc+=pB0[r]; _Pragma("unroll") for(int r=0;r<16;++r)sacc+=pB1[r]; l_reg+=sacc;
    pw0=(u32x4){PKW(pB0,0),PKW(pB0,2),PKW(pB0,4),PKW(pB0,6)};pw1=(u32x4){PKW(pB0,8),PKW(pB0,10),PKW(pB0,12),PKW(pB0,14)};pw2=(u32x4){PKW(pB1,0),PKW(pB1,2),PKW(pB1,4),PKW(pB1,6)};pw3=(u32x4){PKW(pB1,8),PKW(pB1,10),PKW(pB1,12),PKW(pB1,14)};
    SBAR(); pv(o,vb0+sl_cur,PAF(0),PAF(1),PAF(2),PAF(3)); }
  #undef PKW
  #undef PAF
  #undef VFR
  #undef PIN
  #undef MX3
  #undef GAPA
  #undef GAPB
  #undef EX
  #undef VRD
  #undef KRD
  #undef STEP
  #undef ENDW
  {auto rr=__builtin_amdgcn_permlane32_swap(__float_as_uint(l_reg),__float_as_uint(l_reg),false,false);l_reg=__uint_as_float(rr[0])+__uint_as_float(rr[1]);}
  if(hi==0)wsf[32+r32]=l_reg;asm volatile("s_waitcnt lgkmcnt(0)":::"memory");
  float rli[16];
  #pragma unroll
  for(int r=0;r<16;++r)rli[r]=__builtin_amdgcn_rcpf(wsf[32+crow(r,hi)]);
  bf16*Ow=O+(rowbase+q0+wid*QBLK)*OP+OOFF+h*D;
  { bf16*stg=(bf16*)(shm+LDS_OST)+wid*2048;
    #pragma unroll
    for(int r=0;r<16;++r){const int orow=crow(r,hi);
      #pragma unroll
      for(int d0=0;d0<2;++d0)stg[orow*64+d0*32+r32]=__float2bfloat16(o[d0][r]*rli[r]);}
    asm volatile("s_waitcnt lgkmcnt(0)":::"memory");
    #pragma unroll
    for(int i=0;i<4;++i){const int row=i*8+(lane>>3),ch=lane&7; const u32x4 v=*(const u32x4*)(stg+row*64+ch*8); ATTN_STORE16(Ow+(long)row*OP+ch*8,v);} }
  asm volatile("s_waitcnt lgkmcnt(0)\n\ts_barrier":::"memory");
  #undef DMA_K
  #undef DMA_V
  #undef CMASKW
  #undef MKSH
  #undef START
  #undef RESC
  #undef ROT
}
constexpr int ATTN_LDS_BYTES=LDS_BYTES;
struct AttnTensors { const bf16* Q; const bf16* K; const bf16* V; const unsigned long long* MASK; bf16* O; };
struct AttnUnit { int bh; int qb; };
struct StaticOrder {
  int vcu,G;
  __device__ __forceinline__ explicit StaticOrder(int grid,int block):vcu((grid%8==0)?(block%8)*(grid/8)+block/8:block),G(grid){}
  __device__ __forceinline__ bool next(int i,AttnUnit&u)const{ const int it=vcu+(i>>1)*G; if(it>=BATCH*NHEAD*4)return false; const int s=it&3; u.bh=it>>2; u.qb=(i&1)?7-s:s; return true; }
  __device__ __forceinline__ void a_ready(const AttnUnit&)const{}
  __device__ __forceinline__ void done(const AttnUnit&)const{}
};
template<class Sched,int THRL=8> __device__ __forceinline__ void attn_phase(char*lds,const AttnTensors&T,const Sched&S,const int wv){
  AttnUnit u;
  for(int i=0;S.next(i,u);++i){ S.a_ready(u); attn_unit<THRL>(u.bh/NHEAD,u.bh%NHEAD,u.qb,T.Q,T.K,T.V,T.MASK,T.O,lds,wv); S.done(u); }
}
#undef SBAR
#undef WAIT_BAR
}

#ifndef REPS
#define REPS {1, 1, 1, 1, 1, 1, 1, 1}
#endif
constexpr int kReps[8] = REPS;
#ifndef SREPS
#define SREPS {1, 1, 1, 1, 1, 1, 1, 1}
#endif
constexpr int kSub[8] = SREPS;
typedef _Float16 f16x8 __attribute__((ext_vector_type(8)));
typedef float f32x16 __attribute__((ext_vector_type(16)));
__device__ __forceinline__ unsigned score_key(float s) { const unsigned u = __builtin_bit_cast(unsigned, s + 0.0f); return u ^ ((unsigned)((int)u >> 31) | 0x80000000u); }
__device__ __forceinline__ float key_score(unsigned k) { return __builtin_bit_cast(float, (k & 0x80000000u) ? (k & 0x7fffffffu) : ~k); }
__device__ __forceinline__ float wave_sum_f32(float v) {
    v += __builtin_bit_cast(float, __builtin_amdgcn_update_dpp(0, __builtin_bit_cast(int, v), 0xb1, 0xf, 0xf, false));
    v += __builtin_bit_cast(float, __builtin_amdgcn_update_dpp(0, __builtin_bit_cast(int, v), 0x4e, 0xf, 0xf, false));
    v += __builtin_bit_cast(float, __builtin_amdgcn_update_dpp(0, __builtin_bit_cast(int, v), 0x141, 0xf, 0xf, false));
    v += __builtin_bit_cast(float, __builtin_amdgcn_update_dpp(0, __builtin_bit_cast(int, v), 0x140, 0xf, 0xf, false));
    return __builtin_bit_cast(float, __builtin_amdgcn_readlane(__builtin_bit_cast(int, v), 0)) + __builtin_bit_cast(float, __builtin_amdgcn_readlane(__builtin_bit_cast(int, v), 16))
         + __builtin_bit_cast(float, __builtin_amdgcn_readlane(__builtin_bit_cast(int, v), 32)) + __builtin_bit_cast(float, __builtin_amdgcn_readlane(__builtin_bit_cast(int, v), 48));
}
__device__ __forceinline__ int wave_sum_i32(int v) {
    v += __builtin_amdgcn_update_dpp(0, v, 0xb1, 0xf, 0xf, false);
    v += __builtin_amdgcn_update_dpp(0, v, 0x4e, 0xf, 0xf, false);
    v += __builtin_amdgcn_update_dpp(0, v, 0x141, 0xf, 0xf, false);
    v += __builtin_amdgcn_update_dpp(0, v, 0x140, 0xf, 0xf, false);
    return __builtin_amdgcn_readlane(v, 0) + __builtin_amdgcn_readlane(v, 16) + __builtin_amdgcn_readlane(v, 32) + __builtin_amdgcn_readlane(v, 48);
}
__device__ __forceinline__ void count_ge8(unsigned& cnt, unsigned cand, unsigned k0, unsigned k1, unsigned k2, unsigned k3, unsigned k4, unsigned k5, unsigned k6, unsigned k7) {
    unsigned long long m0, m1, m2, m3;
    asm volatile(
        "v_cmp_ge_u32_e64 %1, %5, %13\n\tv_cmp_ge_u32_e64 %2, %6, %13\n\tv_cmp_ge_u32_e64 %3, %7, %13\n\tv_cmp_ge_u32_e64 %4, %8, %13\n\t"
        "v_addc_co_u32_e64 %0, vcc, 0, %0, %1\n\tv_cmp_ge_u32_e64 %1, %9, %13\n\t"
        "v_addc_co_u32_e64 %0, vcc, 0, %0, %2\n\tv_cmp_ge_u32_e64 %2, %10, %13\n\t"
        "v_addc_co_u32_e64 %0, vcc, 0, %0, %3\n\tv_cmp_ge_u32_e64 %3, %11, %13\n\t"
        "v_addc_co_u32_e64 %0, vcc, 0, %0, %4\n\tv_cmp_ge_u32_e64 %4, %12, %13\n\t"
        "v_addc_co_u32_e64 %0, vcc, 0, %0, %1\n\tv_addc_co_u32_e64 %0, vcc, 0, %0, %2\n\tv_addc_co_u32_e64 %0, vcc, 0, %0, %3\n\tv_addc_co_u32_e64 %0, vcc, 0, %0, %4"
        : "+v"(cnt), "=&s"(m0), "=&s"(m1), "=&s"(m2), "=&s"(m3)
        : "v"(k0), "v"(k1), "v"(k2), "v"(k3), "v"(k4), "v"(k5), "v"(k6), "v"(k7), "s"(cand) : "vcc");
}
#define IDX_REP8(X, o) X((o) + 0) X((o) + 1) X((o) + 2) X((o) + 3) X((o) + 4) X((o) + 5) X((o) + 6) X((o) + 7)
template <int NREG>
__device__ __forceinline__ void indexer_task_n(int b, int t0, const f16_t* __restrict__ QI, const f16_t* __restrict__ KI, const float* __restrict__ WI, unsigned long long* __restrict__ MASK, int lane) {
    const int r32 = lane & 31, hi = lane >> 5; const size_t rowb = (size_t)b * SEQ;
    const f16_t* qp = QI + (rowb + t0 + (r32 >> 3)) * 256 + 32 * (r32 & 7) + 8 * hi;
    const f16x8 a0 = *(const f16x8*)(qp), a1 = *(const f16x8*)(qp + 16);
    f32x4 wv[4];
#pragma unroll
    for (int q = 0; q < 4; ++q) wv[q] = *(const f32x4*)(WI + (rowb + t0 + q) * 8 + 4 * hi);
    const int nst = (t0 + 3) / 64 + 1;
    const f16_t* kp = KI + (rowb + r32) * 32 + 8 * hi;
    unsigned key[4][NREG];
    f16x8 bq[3][4];
#pragma unroll
    for (int i = 0; i < 4; ++i) bq[0][i] = *(const f16x8*)(kp + (i >> 1) * 1024 + (i & 1) * 16);
    if (1 < nst) {
#pragma unroll
        for (int i = 0; i < 4; ++i) bq[1][i] = *(const f16x8*)(kp + (size_t)2048 + (i >> 1) * 1024 + (i & 1) * 16); }
#pragma unroll
    for (int st = 0; st < NREG; ++st) {
        if (st < nst) {
            if (st + 2 < NREG && st + 2 < nst) {
#pragma unroll
                for (int i = 0; i < 4; ++i) bq[(st + 2) % 3][i] = *(const f16x8*)(kp + (size_t)(st + 2) * 2048 + (i >> 1) * 1024 + (i & 1) * 16);
            }
            const f32x16 z16 = (f32x16){0.f, 0.f, 0.f, 0.f, 0.f, 0.f, 0.f, 0.f, 0.f, 0.f, 0.f, 0.f, 0.f, 0.f, 0.f, 0.f};
            f32x16 c0 = __builtin_amdgcn_mfma_f32_32x32x16_f16(a0, bq[st % 3][0], z16, 0, 0, 0);
            c0 = __builtin_amdgcn_mfma_f32_32x32x16_f16(a1, bq[st % 3][1], c0, 0, 0, 0);
            f32x16 c1 = __builtin_amdgcn_mfma_f32_32x32x16_f16(a0, bq[st % 3][2], z16, 0, 0, 0);
            c1 = __builtin_amdgcn_mfma_f32_32x32x16_f16(a1, bq[st % 3][3], c1, 0, 0, 0);
#pragma unroll
            for (int q = 0; q < 4; ++q) {
                float pa = 0.f, pb = 0.f;
#pragma unroll
                for (int i = 0; i < 4; ++i) { pa += wv[q][i] * __builtin_amdgcn_fmed3f(c0[4 * q + i], 0.f, __builtin_inff()); pb += wv[q][i] * __builtin_amdgcn_fmed3f(c1[4 * q + i], 0.f, __builtin_inff()); }
                const auto rr = __builtin_amdgcn_permlane32_swap(__builtin_bit_cast(unsigned, pa), __builtin_bit_cast(unsigned, pb), false, false);
                const unsigned rr0 = rr[0], rr1 = rr[1];
                const float sc = __builtin_bit_cast(float, rr0) + __builtin_bit_cast(float, rr1);
                key[q][st] = __builtin_bit_cast(unsigned, sc + 0.0f);
            }
        } else {
#pragma unroll
            for (int q = 0; q < 4; ++q) key[q][st] = 0u;
        }
    }
    const int t0u = __builtin_amdgcn_readfirstlane(t0), nstu = (t0u + 3) / 64 + 1;
    bool done[4], exact[4]; unsigned eq[4], gt[4], cgt[4];
#pragma unroll
    for (int q = 0; q < 4; ++q) { exact[q] = false; done[q] = (t0u + q < TOPK); gt[q] = 0u; cgt[q] = 0u;
        { const int nv_ = (lane <= t0u + q) ? ((t0u + q - lane) >> 6) + 1 : 0; eq[q] = nv_ >= 32 ? 0xffffffffu : ((1u << nv_) - 1u); }
        if (!done[q]) {
#define IDX_PSTAGE(J, SA, SB) _Pragma("unroll") for (int k = 0; k < 32; ++k) if ((k & J) == 0) { const unsigned a_ = key[q][k], b_ = key[q][k + J]; key[q][k] = __builtin_amdgcn_perm(b_, a_, SA); key[q][k + J] = __builtin_amdgcn_perm(b_, a_, SB); if ((k & 3) == 3) __builtin_amdgcn_sched_barrier(0); }
#define IDX_TSTAGE(J, MK) _Pragma("unroll") for (int k = 0; k < 32; ++k) if ((k & J) == 0) { const unsigned a_ = key[q][k], b_ = key[q][k + J]; \
                key[q][k] = (a_ & ~(MK << J)) | ((b_ << J) & (MK << J)); key[q][k + J] = (b_ & ~MK) | ((a_ >> J) & MK); if ((k & 3) == 3) __builtin_amdgcn_sched_barrier(0); }
            IDX_PSTAGE(16, 0x05040100u, 0x07060302u) IDX_PSTAGE(8, 0x06020400u, 0x07030501u) IDX_TSTAGE(4, 0x0f0f0f0fu) IDX_TSTAGE(2, 0x33333333u) IDX_TSTAGE(1, 0x55555555u)
#undef IDX_TSTAGE
#undef IDX_PSTAGE
        } }
#pragma unroll
    for (int b = 31; b >= 0; --b) {
        if (done[0] && done[1] && done[2] && done[3]) break;
        unsigned tb[4], c[4] = {0u, 0u, 0u, 0u};
#pragma unroll
        for (int q = 0; q < 4; ++q) { tb[q] = 0u; if (!done[q]) { unsigned sg_ = key[q][31]; asm volatile("" : "+v"(sg_));
            tb[q] = eq[q] & (b == 31 ? ~sg_ : (key[q][b] ^ sg_)); c[q] = (unsigned)__builtin_popcount(tb[q]) + cgt[q]; } }
        const int c01 = (done[0] && done[1]) ? 0 : wave_sum_i32((int)(c[0] | (c[1] << 16))), c23 = (done[2] && done[3]) ? 0 : wave_sum_i32((int)(c[2] | (c[3] << 16)));
        const int cs[4] = {c01 & 0xffff, c01 >> 16, c23 & 0xffff, c23 >> 16};
#pragma unroll
        for (int q = 0; q < 4; ++q) if (!done[q]) {
            if (cs[q] >= TOPK) { eq[q] = tb[q]; if (cs[q] == TOPK) { gt[q] |= tb[q]; done[q] = true; exact[q] = true; } }
            else { gt[q] |= tb[q]; cgt[q] = c[q]; eq[q] ^= tb[q]; } }
    }
#define IDX_PUTW(bal, st) do { const unsigned long long b_ = (bal); asm volatile("s_nop 1\n\tv_writelane_b32 %0, %2, %4\n\tv_writelane_b32 %1, %3, %4" : "+v"(wlo), "+v"(whi) : "s"((unsigned)b_), "s"((unsigned)(b_ >> 32)), "n"(st));     } while (0)
#pragma unroll
    for (int q = 0; q < 4; ++q) {
        const int t = t0 + q; unsigned wlo = 0u, whi = 0u;
        if (t < TOPK) {
#define IDX_X(st) IDX_PUTW(__ballot(64 * (st) + lane <= t), st);
            IDX_REP8(IDX_X, 0)
#undef IDX_X
        } else {
            const bool ex = exact[q]; const unsigned gsel = gt[q], ties = eq[q]; int need = 0;
            if (!ex) need = TOPK - wave_sum_i32((int)cgt[q]);
            const unsigned long long lt = (1ull << lane) - 1ull;
#define IDX_X(st) { bool sel_ = (gsel >> (st)) & 1u; \
                    if (!ex) { const bool tie_ = (ties >> (st)) & 1u; const unsigned long long tb_ = __ballot(tie_); sel_ = sel_ || (tie_ && __popcll(tb_ & lt) < need); need -= __popcll(tb_); if (need < 0) need = 0; } \
                    IDX_PUTW(__ballot(sel_), st); }
            IDX_REP8(IDX_X, 0)
            if (NREG > 8 && nst > 8) { IDX_REP8(IDX_X, 8) }
            if (NREG > 16 && nst > 16) { IDX_REP8(IDX_X, 16) }
            if (NREG > 24 && nst > 24) { IDX_REP8(IDX_X, 24) }
#undef IDX_X
        }
        if (lane < 32) MASK[(rowb + t) * 32 + lane] = (unsigned long long)wlo | ((unsigned long long)whi << 32);
    }
#undef IDX_PUTW
}
#undef IDX_REP8

constexpr int NWAVES = 8;
constexpr int RING_OFF = 0, RING_BYTES = 131072;
constexpr int LDSCTL_OFF = RING_BYTES, MISC_OFF = LDSCTL_OFF + 320;
constexpr int LDS_BYTES = 147456;
constexpr int TAB_OFF = MISC_OFF + 128;
constexpr int WTAB_OFF = TAB_OFF + 2048;
static_assert(WTAB_OFF + 8192 <= LDS_BYTES, "LDS map");
constexpr int N_PHASES = 8;

struct Args { const float* in[13]; float* out; unsigned char* ws; int ph_lo, ph_hi, li, pad; };

__device__ __forceinline__ void p0_transpose_item(const float* W, int K, int N, bf16_t* WT, int Nv, int mode, const float* kscale, LAS float* scr, int item, int lane) {
    const int nblk = Nv / 32, kb = item / nblk, nb = item % nblk, k0 = 64 * kb, n0 = 32 * nb;
    const int v = n0 + (lane & 31); const int a = mode == 0 ? v : (mode == 1 ? win_actual(v) : wup_actual(v));
    float vals[32];
    const float* wp = W + (size_t)(k0 + (lane >> 5)) * N + (a >= 0 ? a : 0);
#pragma unroll
    for (int i = 0; i < 32; ++i) vals[i] = wp[(size_t)(2 * i) * N];
#pragma unroll
    for (int i = 0; i < 32; ++i) { const int kk = 2 * i + (lane >> 5); float val = (a >= 0) ? vals[i] : 0.f;
        if (kscale) val *= kscale[k0 + kk];
        scr[kk * 33 + (lane & 31)] = val; }
    LDS_WAIT(); asm volatile("" ::: "memory");
    const int c = lane & 7;
#pragma unroll
    for (int j = 0; j < 4; ++j) { const int n = (lane >> 3) + 8 * j; const LAS float* s = scr + (8 * c) * 33 + n;
        v4u o; o.x = pk2(s[0 * 33], s[1 * 33]); o.y = pk2(s[2 * 33], s[3 * 33]); o.z = pk2(s[4 * 33], s[5 * 33]); o.w = pk2(s[6 * 33], s[7 * 33]);
        *(GAS v4u*)(WT + (size_t)(n0 + n) * K + k0 + 8 * c) = o; }
    LDS_WAIT(); asm volatile("" ::: "memory");
}

__global__ void __launch_bounds__(NWAVES * 64, 2) mk_fwd(Args args) {
    extern __shared__ __attribute__((aligned(16))) unsigned char lds[];
    LAS unsigned char* L = (LAS unsigned char*)lds;
    volatile LAS unsigned* MISC = (volatile LAS unsigned*)(L + MISC_OFF);
    const int wave = __builtin_amdgcn_readfirstlane((int)threadIdx.x >> 6);
#define MK_IDS const int lane = mk_lane(), tid = wave * 64 + lane; (void)tid
    const int G = gridDim.x; const int bx = blockIdx.x; const int vcu = (G % 8 == 0) ? (bx % 8) * (G / 8) + bx / 8 : bx;
    unsigned char* ws = args.ws;
    gu32* ctl = (gu32*)(ws + WS_CTL);
    const float* x = args.in[0]; const float* norm1_g = args.in[1]; const float* w_in = args.in[2]; const float* q_norm_g = args.in[3]; const float* k_norm_g = args.in[4];
    const float* w_out = args.in[7]; const float* norm2_g = args.in[8]; const float* w_up = args.in[9]; const float* conv_w = args.in[10]; const float* conv_b = args.in[11]; const float* w_down = args.in[12];
    float* out = args.out;
    float* ROPE = (float*)(ws + WS_ROPE); float* ROPE16 = (float*)(ws + WS_ROPE16);
    bf16_t *Win = (bf16_t*)(ws + WS_WIN), *Wout = (bf16_t*)(ws + WS_WOUT), *Wup = (bf16_t*)(ws + WS_WUP), *Wdn = (bf16_t*)(ws + WS_WDN);
    float* SS2 = (float*)(ws + WS_SS2);
    bf16_t *XN = (bf16_t*)(ws + WS_XN), *VP = (bf16_t*)(ws + WS_VP), *Q = (bf16_t*)(ws + WS_Q), *Kb = (bf16_t*)(ws + WS_K), *Vb = (bf16_t*)(ws + WS_V);
    f16_t *QI = (f16_t*)(ws + WS_QI), *KI = (f16_t*)(ws + WS_KI); float* WI = (float*)(ws + WS_WI);
    bf16_t *MIX = (bf16_t*)(ws + WS_MIX), *Gb = (bf16_t*)(ws + WS_G);
    bf16_t *HF = (bf16_t*)(ws + WS_HF), *HL = (bf16_t*)(ws + WS_HL);
    unsigned long long* MASK = (unsigned long long*)(ws + WS_MASK); const float* pool_w = args.in[5]; const float* pool_scale = args.in[6];

    for (int u = (int)threadIdx.x; u < (LDS_BYTES - LDSCTL_OFF) / 4; u += NWAVES * 64) ((LAS unsigned*)(L + LDSCTL_OFF))[u] = 0u;
    __syncthreads();
    XcdBarrier bar = xcd_barrier_post((unsigned*)(ctl + CW_BAR) + args.li * XCD_BAR_WORDS, MISC + 8); bar.w0 = (wave == 0);
    const int lo = args.ph_lo, hi = args.ph_hi;
#define IN(k) (lo <= (k) && (k) < hi)
#define SEAM(k) do { if (IN(k) && IN((k) + 1)) xcd_barrier(bar); } while (0)
    const int gw = vcu * NWAVES + wave, NGW = G * NWAVES;

    if (IN(0)) for (int rep_ = 0; rep_ < kReps[0]; ++rep_) { if (rep_) xcd_barrier(bar);
        MK_IDS;
        LAS float* scr = (LAS float*)(L + RING_OFF + wave * 16384);
        constexpr int I_IN = (D_MODEL / 64) * (IN_WV / 32), I_OUT = (D_MODEL / 64) * (D_MODEL / 32), I_UP = (D_MODEL / 64) * (UP_W / 32), I_DN = (DFF / 64) * (D_MODEL / 32);
        for (int sr_ = 0; sr_ < kSub[0]; ++sr_)
        for (int it = gw; it < I_IN + I_OUT + I_UP + I_DN; it += NGW) {
            int r = it;
            if (r < I_IN) { p0_transpose_item(w_in, D_MODEL, IN_W, Win, IN_WV, 1, nullptr, scr, r, lane); continue; } r -= I_IN;
            if (r < I_OUT) { if (r >= 8 * (D_MODEL / 32)) p0_transpose_item(w_out, D_MODEL, D_MODEL, Wout, D_MODEL, 0, nullptr, scr, r, lane); continue; } r -= I_OUT;
            if (r < I_UP) { p0_transpose_item(w_up, D_MODEL, UP_W, Wup, UP_W, 2, norm2_g, scr, r, lane); continue; } r -= I_UP;
            p0_transpose_item(w_down, DFF, D_MODEL, Wdn, D_MODEL, 0, nullptr, scr, r, lane);
        }
        for (int sr_ = 0; sr_ < kSub[1]; ++sr_)
        for (int it = vcu * NWAVES * 64 + tid; it < 128 * D_MODEL; it += G * NWAVES * 64) {
            const int n = it & (D_MODEL - 1), c4 = it >> 10, g = c4 >> 5;
            const float* pw = pool_w + (size_t)(4 * c4) * 128;
            const float* wo = w_out + (size_t)(128 * g) * D_MODEL + n; const float* ps = pool_scale + 128 * g;
            float a4[4] = {0.f, 0.f, 0.f, 0.f};
#pragma unroll 32
            for (int d = 0; d < 128; ++d) { const float wv = wo[(size_t)d * D_MODEL] * ps[d];
#pragma unroll
                for (int e = 0; e < 4; ++e) a4[e] += pw[e * 128 + d] * wv; }
            *(unsigned long long*)(Wout + (size_t)n * D_MODEL + 4 * c4) = (unsigned long long)pk2(a4[0], a4[1]) | ((unsigned long long)pk2(a4[2], a4[3]) << 32);
        }
        for (int sr_ = 0; sr_ < kSub[2]; ++sr_)
        for (int i = vcu * NWAVES * 64 + tid; i < SEQ * 48; i += G * NWAVES * 64) {
            int pos, k; float inv; float* dst;
            if (i < SEQ * 32) { pos = i >> 5; k = i & 31; inv = expf(-logf(10000.0f) * (float)k / 32.0f); dst = ROPE + 2 * i; }
            else { const int i2 = i - SEQ * 32; pos = i2 >> 4; k = i2 & 15; inv = expf(-logf(10000.0f) * (float)k / 16.0f); dst = ROPE16 + 2 * i2; }
            float s, c; sincosf((float)pos * inv, &s, &c); dst[0] = c; dst[1] = s;
        }
        for (int sr_ = 0; sr_ < kSub[3]; ++sr_)
        for (int m4 = gw; m4 < M / 4; m4 += NGW) {
            f32x4 v[4][4]; float ssq[4];
#pragma unroll
            for (int r = 0; r < 4; ++r) { const GAS f32x4* xr = (const GAS f32x4*)(x + (size_t)(4 * m4 + r) * D_MODEL) + lane;
#pragma unroll
                for (int j = 0; j < 4; ++j) v[r][j] = xr[64 * j]; }
#pragma unroll
            for (int r = 0; r < 4; ++r) { float s = 0.f;
#pragma unroll
                for (int j = 0; j < 4; ++j) s += (v[r][j].x * v[r][j].x + v[r][j].y * v[r][j].y) + (v[r][j].z * v[r][j].z + v[r][j].w * v[r][j].w);
                ssq[r] = s; }
#pragma unroll
            for (int o = 1; o < 64; o <<= 1) {
#pragma unroll
                for (int r = 0; r < 4; ++r) ssq[r] += __shfl_xor(ssq[r], o); }
#pragma unroll
            for (int r = 0; r < 4; ++r) { const float rstd = 1.0f / sqrtf(ssq[r] * (1.0f / D_MODEL) + EPS);
                GAS unsigned long long* o8 = (GAS unsigned long long*)(XN + (size_t)(4 * m4 + r) * D_MODEL) + lane;
#pragma unroll
                for (int j = 0; j < 4; ++j) { const f32x4 gg = ((const f32x4*)norm1_g)[lane + 64 * j];
                    o8[64 * j] = (unsigned long long)pk2(v[r][j].x * rstd * gg.x, v[r][j].y * rstd * gg.y) | ((unsigned long long)pk2(v[r][j].z * rstd * gg.z, v[r][j].w * rstd * gg.w) << 32); } }
        }
    }
    SEAM(0);
    if (IN(1)) for (int rep_ = 0; rep_ < kReps[1]; ++rep_) { if (rep_) xcd_barrier(bar);
        pg8::Gemm g{XN, Win, M, IN_WV, D_MODEL}; pg8::StaticOrder S; S.init(M, IN_WV, G, bx);
        pg8::EpiProj E{VP, Q, Kb, Vb, QI, KI, WI, ROPE, ROPE16, q_norm_g, k_norm_g};
        pg8::gemm_phase<pg8::EpiProj, pg8::StaticOrder, true, true>(L + RING_OFF, g, S, E, wave);
    }
    SEAM(1);
    if (IN(2)) for (int rep_ = 0; rep_ < kReps[2]; ++rep_) { if (rep_) xcd_barrier(bar);
        MK_IDS;
        for (int sr_ = 0; sr_ < kSub[4]; ++sr_)
        for (int wi = gw; wi < M / 4; wi += NGW) {
            const int row = 4 * wi + (lane >> 4), t = row & (SEQ - 1);
            const bf16_t* vp = VP + (size_t)row * POOL_W + 8 * (lane & 15);
            v4u u2[2], u4[4], u8[8], u16[16];
#define POOL_LD(U, W, g) _Pragma("unroll") for (int k = 0; k < W; ++k) U[k] = *(const v4u*)(vp + 128 * (g) - (size_t)((k <= t) ? k : 0) * POOL_W);
            POOL_LD(u2, 2, 0) POOL_LD(u4, 4, 1) POOL_LD(u8, 8, 2) POOL_LD(u16, 16, 3)
#undef POOL_LD
#define POOL_OUT(U, W, g) do { float sum[8], v0[8]; \
                _Pragma("unroll") for (int e = 0; e < 8; ++e) sum[e] = 0.f; \
                _Pragma("unroll") for (int k = 0; k < W; ++k) { const float m_ = (k <= t) ? 1.f : 0.f; const unsigned uu[4] = {U[k].x, U[k].y, U[k].z, U[k].w}; \
                    _Pragma("unroll") for (int e = 0; e < 4; ++e) { const float lo = __builtin_bit_cast(float, uu[e] << 16), hh = __builtin_bit_cast(float, uu[e] & 0xffff0000u); sum[2 * e] += m_ * lo; sum[2 * e + 1] += m_ * hh; \
                        if (k == 0) { v0[2 * e] = lo; v0[2 * e + 1] = hh; } } } \
                const float rc = 1.0f / (float)((t + 1 < W) ? t + 1 : W); \
                v4u o; o.x = pk2(sum[0] * rc - v0[0], sum[1] * rc - v0[1]); o.y = pk2(sum[2] * rc - v0[2], sum[3] * rc - v0[3]); o.z = pk2(sum[4] * rc - v0[4], sum[5] * rc - v0[5]); o.w = pk2(sum[6] * rc - v0[6], sum[7] * rc - v0[7]); \
                *(v4u*)(MIX + (size_t)row * 1024 + 128 * (g) + 8 * (lane & 15)) = o; } while (0)
            POOL_OUT(u2, 2, 0); POOL_OUT(u4, 4, 1); POOL_OUT(u8, 8, 2); POOL_OUT(u16, 16, 3);
#undef POOL_OUT
        }
        for (int sr_ = 0; sr_ < kSub[5]; ++sr_)
        for (int id = gw; id < M / 4; id += NGW) {
            const int w = id & 2047, bb = w >> 8, tq = (id < 2048) ? (w & 255) : 511 - (w & 255);
            indexer_task_n<32>(bb, 4 * tq, QI, KI, WI, MASK, lane);
        }
    }
    SEAM(2);
    if (IN(3)) for (int rep_ = 0; rep_ < kReps[3]; ++rep_) { if (rep_) xcd_barrier(bar);
        const attn_body::AttnTensors AT{(const attn_body::bf16*)Q, (const attn_body::bf16*)Kb, (const attn_body::bf16*)Vb, MASK, (attn_body::bf16*)MIX};
        const attn_body::StaticOrder S((int)G, (int)bx);
        attn_body::attn_phase<attn_body::StaticOrder>((char*)lds + RING_OFF, AT, S, wave);
    }
    SEAM(3);
    if (IN(4)) for (int rep_ = 0; rep_ < kReps[4]; ++rep_) { if (rep_) xcd_barrier(bar);
        pg8::Gemm g{MIX, Wout, M, D_MODEL, D_MODEL}; pg8::StaticOrder S; S.init(M, D_MODEL, G, bx);
        pg8::EpiWout E{x, XN, SS2};
        pg8::gemm_phase<pg8::EpiWout, pg8::StaticOrder, true, true>(L + RING_OFF, g, S, E, wave);
    }
    SEAM(4);
    if (IN(5)) for (int rep_ = 0; rep_ < kReps[5]; ++rep_) { if (rep_) xcd_barrier(bar);
        pg8::Gemm g{XN, Wup, M, UP_W, D_MODEL}; pg8::UpOrder S; S.init(M, UP_W, G, bx); S.SS2 = SS2; S.tab = (LAS float*)(L + TAB_OFF); S.wtab = (LAS float*)(L + WTAB_OFF); S.conv_w = conv_w; S.conv_b = conv_b; S.wv = wave; S.par = 0;
        pg8::EpiUp E{(const LAS float*)(L + TAB_OFF), (const LAS float*)(L + WTAB_OFF), Gb, HF, HL, 0};
        pg8::gemm_phase<pg8::EpiUp, pg8::UpOrder, true, true, true>(L + RING_OFF, g, S, E, wave);
    }
    SEAM(5);
    if (IN(6)) for (int rep_ = 0; rep_ < kReps[6]; ++rep_) { if (rep_) xcd_barrier(bar);
        MK_IDS;
        for (int idx = vcu * NWAVES * 64 + tid; idx < 256 * 2 * (DFF / 4); idx += G * NWAVES * 64) {
            const int n4 = idx % (DFF / 4), gj = idx / (DFF / 4), j = gj & 1, g64 = gj >> 1, n = 4 * n4;
            const int vg = 256 * (n >> 7) + (n & 127);
            f32x4 cc[2];
#pragma unroll
            for (int bj = 0; bj < 2; ++bj) { const int v = vg + 128 * bj;
#define HLD(P, r) ({ const unsigned long long w_ = *(const unsigned long long*)((P) + (size_t)(r) * UP_W + v); (f32x4){__builtin_bit_cast(float, (unsigned)w_ << 16), __builtin_bit_cast(float, (unsigned)w_ & 0xffff0000u), __builtin_bit_cast(float, (unsigned)(w_ >> 32) << 16), __builtin_bit_cast(float, (unsigned)(w_ >> 32) & 0xffff0000u)}; })
                const f32x4 f0 = HLD(HF, g64 * 2 + 0), f1 = HLD(HF, g64 * 2 + 1);
                f32x4 l0 = (f32x4){0.f, 0.f, 0.f, 0.f}, l1 = l0;
                if (g64 & 31) { l0 = HLD(HL, (g64 - 1) * 2 + 0); l1 = HLD(HL, (g64 - 1) * 2 + 1); }
#undef HLD
                const f32x4 um2 = j ? l1 : l0, um1 = j ? f0 : l1, u0 = j ? f1 : f0;
                const float* wp = conv_w + bj * DFF + n;
                cc[bj] = *(const f32x4*)(conv_b + bj * DFF + n) + *(const f32x4*)(wp) * um2 + *(const f32x4*)(wp + UP_W) * um1 + *(const f32x4*)(wp + 2 * UP_W) * u0; }
            float gs[4];
#pragma unroll
            for (int i = 0; i < 4; ++i) { const float gt = cc[0][i]; gs[i] = gt / (1.0f + __expf(-gt)) * cc[1][i]; }
            unsigned long long w = (unsigned long long)pk2(gs[0], gs[1]) | ((unsigned long long)pk2(gs[2], gs[3]) << 32);
            *(unsigned long long*)(Gb + (size_t)(64 * g64 + j) * DFF + n) = w;
        }
    }
    SEAM(6);
    if (IN(7)) {
        pg8::Gemm g{Gb, Wdn, M, D_MODEL, DFF}; pg8::StaticOrder S; S.init(M, D_MODEL, G, bx);
        pg8::EpiDown E{XN, out};
        pg8::gemm_phase<pg8::EpiDown, pg8::StaticOrder, true, true>(L + RING_OFF, g, S, E, wave);
    }
#undef IN
#undef SEAM
}

static int mk_grid() {
    static int grid = 0;
    if (grid == 0) {
        int dev = 0, cus = 0, per_cu = 0;
        if (hipGetDevice(&dev) != hipSuccess || hipDeviceGetAttribute(&cus, hipDeviceAttributeMultiprocessorCount, dev) != hipSuccess) { fprintf(stderr, "kernel_launch: device query failed\n"); grid = -1; return grid; }
        if (hipFuncSetAttribute((const void*)mk_fwd, hipFuncAttributeMaxDynamicSharedMemorySize, LDS_BYTES) != hipSuccess) { fprintf(stderr, "kernel_launch: hipFuncSetAttribute failed\n"); grid = -1; return grid; }
        if (hipOccupancyMaxActiveBlocksPerMultiprocessor(&per_cu, (const void*)mk_fwd, NWAVES * 64, LDS_BYTES) != hipSuccess || per_cu < 1) { fprintf(stderr, "kernel_launch: occupancy query reports %d workgroups per CU\n", per_cu); (void)hipGetLastError(); }
        grid = cus;
    }
    return grid;
}
static void mk_launch(Args a, int lo, int hi, int li, hipStream_t stream) {
    const int grid = mk_grid(); if (grid <= 0) return;
    a.ph_lo = lo; a.ph_hi = hi; a.li = li;
    hipLaunchKernelGGL(mk_fwd, dim3(grid), dim3(NWAVES * 64), LDS_BYTES, stream, a);
}

extern "C" void kernel_launch(void* const* d_in, const int* in_sizes, int n_in, void* d_out, int out_size, void* d_ws, size_t ws_size, hipStream_t stream) {
    const float* pool_w = (const float*)d_in[5]; const float* pool_scale = (const float*)d_in[6];
    unsigned char* ws = (unsigned char*)d_ws;
    bf16_t *VP = (bf16_t*)(ws + WS_VP), *Q = (bf16_t*)(ws + WS_Q), *Kb = (bf16_t*)(ws + WS_K), *Vb = (bf16_t*)(ws + WS_V);
    f16_t *QI = (f16_t*)(ws + WS_QI), *KI = (f16_t*)(ws + WS_KI); float* WI = (float*)(ws + WS_WI);
    unsigned long long* MASK = (unsigned long long*)(ws + WS_MASK); bf16_t* MIX = (bf16_t*)(ws + WS_MIX);
    (void)hipMemsetAsync(ws + WS_CTL, 0, CTL_ZERO_BYTES, stream);
    Args a{};
    for (int i = 0; i < 13; ++i) a.in[i] = (const float*)d_in[i];
    a.out = (float*)d_out; a.ws = ws;
    mk_launch(a, 0, N_PHASES, 0, stream);
}
```

```cpp
#include <hip/hip_runtime.h>
#include <cstdint>
#include <cstdio>

typedef unsigned short bf16_t;
typedef _Float16 f16_t;

constexpr int D_MODEL = 1024, BATCH = 8, SEQ = 2048, M = BATCH * SEQ;
constexpr int POOL_W = 512, NQH = 8, HD = 64, NKV = 2, IH = 8, ID = 32, TOPK = 256;
constexpr int IN_W = 1576, IN_WV = 1792;
constexpr int DFF = 2816, UP_W = 2 * DFF;
constexpr float EPS = 1e-6f;
constexpr float C2 = 0.125f * 1.4426950408889634f;

constexpr size_t MiB = 1u << 20;
constexpr size_t WS_CTL = 0, CTL_ZERO_BYTES = 32768;
constexpr size_t WS_ROPE = 1 * MiB;
constexpr size_t WS_ROPE16 = 1 * MiB + 512 * 1024;
constexpr size_t WS_WIN = 2 * MiB, WS_WOUT = 6 * MiB, WS_WUP = 8 * MiB, WS_WDN = 19 * MiB;
constexpr size_t WS_SS2 = 25 * MiB;
constexpr size_t WS_RSTD2 = 26 * MiB;
constexpr size_t WS_XN = 28 * MiB;
constexpr size_t WS_VP = 60 * MiB, WS_Q = 76 * MiB, WS_K = 92 * MiB, WS_V = 96 * MiB, WS_QI = 100 * MiB, WS_KI = 108 * MiB, WS_WI = 109 * MiB;
constexpr size_t WS_MASK = 110 * MiB, WS_MIX = 114 * MiB;
constexpr size_t WS_G = 60 * MiB;
constexpr size_t WS_HF = 192 * MiB, WS_HL = 204 * MiB;
constexpr int CW_BAR = 4096;

#define GAS __attribute__((address_space(1)))
#define LAS __attribute__((address_space(3)))
typedef unsigned short bf16;
typedef unsigned v4u __attribute__((ext_vector_type(4)));
typedef float f32x4 __attribute__((ext_vector_type(4)));
typedef short bf16x8 __attribute__((ext_vector_type(8)));
typedef GAS unsigned gu32;
typedef GAS unsigned long long gu64;
#define RLX_AGENT __ATOMIC_RELAXED, __HIP_MEMORY_SCOPE_AGENT
#define LDS_WAIT() asm volatile("s_waitcnt lgkmcnt(0)" ::: "memory")
#define VM_WAIT() asm volatile("s_waitcnt vmcnt(0)" ::: "memory")
__device__ __forceinline__ unsigned long long rt() { return __builtin_amdgcn_s_memrealtime(); }
__device__ __forceinline__ unsigned f2bf(float f) { unsigned u = __builtin_bit_cast(unsigned, f); return (u + 0x7fffu + ((u >> 16) & 1u)) >> 16; }
__device__ __forceinline__ unsigned pk2(float lo, float hi) { return f2bf(lo) | (f2bf(hi) << 16); }

#define XB_TMO      128
#define XB_XCNT(j)  (256  + 64 * (j))
#define XB_XSUB(j)  (1280 + 64 * (j))
#define XB_XGEN(j)  (2304 + 64 * (j))
#define XB_TOP      3328
#define XB_TOPGEN   3392
#define XCD_BAR_WORDS 3456
#define XB_SPIN_CAP (1u << 18)

__device__ __forceinline__ unsigned xb_ld(unsigned* p)              { return __hip_atomic_load(p, __ATOMIC_RELAXED, __HIP_MEMORY_SCOPE_AGENT); }
__device__ __forceinline__ unsigned xb_add(unsigned* p, unsigned v) { return __hip_atomic_fetch_add(p, v, __ATOMIC_RELAXED, __HIP_MEMORY_SCOPE_AGENT); }
__device__ __forceinline__ unsigned xb_xcc_id() { return (unsigned)__builtin_amdgcn_s_getreg((3 << 11) | 20) & 0xFu; }
#define XB_SPIN(cond, bar) do { unsigned _sp = 0; while (cond) { __builtin_amdgcn_s_sleep(1); \
    if ((++_sp & 255u) == 0u) { if (xb_ld(&(bar)[XB_TMO])) break; if (_sp > XB_SPIN_CAP) { atomicAdd(&(bar)[XB_TMO], 1u); break; } } } } while (0)

struct XcdBarrier {
    unsigned* bar; unsigned x;
    volatile LAS unsigned* st;
    bool w0;
};

__device__ __forceinline__ XcdBarrier xcd_barrier_post(unsigned* bar, volatile LAS unsigned* st) {
    XcdBarrier b; b.bar = bar; b.x = xb_xcc_id(); b.st = st;
    if (threadIdx.x == 0) (void)xb_add(&bar[XB_XCNT(b.x)], 1u);
    return b;
}
__device__ __forceinline__ void xcd_barrier_complete(unsigned* bar, unsigned x, unsigned& nloc, unsigned& nx) {
    const unsigned G = gridDim.x * gridDim.y * gridDim.z;
    unsigned sum, cnt, mine, sp = 0u;
    for (;;) {
        sum = 0u; cnt = 0u; mine = 0u;
#pragma unroll
        for (unsigned j = 0; j < 16; ++j) { const unsigned c = xb_ld(&bar[XB_XCNT(j)]); sum += c; cnt += (c > 0u) ? 1u : 0u; mine = (j == x) ? c : mine; }
        if (sum == G) break;
        __builtin_amdgcn_s_sleep(1);
        if ((++sp & 255u) == 0u) { if (xb_ld(&bar[XB_TMO])) break; if (sp > XB_SPIN_CAP) { atomicAdd(&bar[XB_TMO], 1u); break; } }
    }
    nloc = mine > 0u ? mine : 1u; nx = cnt > 0u ? cnt : 1u;
}

__device__ __forceinline__ void xcd_barrier(const XcdBarrier& b) {
    asm volatile("s_waitcnt vmcnt(0)" ::: "memory");
    __syncthreads();
    if (b.w0 && __builtin_amdgcn_mbcnt_hi(~0u, __builtin_amdgcn_mbcnt_lo(~0u, 0u)) == 0u) {
        unsigned* bar = b.bar;
        __builtin_amdgcn_s_waitcnt(0);
        unsigned nloc = b.st[0], nx = b.st[1];
        if (nloc == 0u) { xcd_barrier_complete(bar, b.x, nloc, nx); b.st[0] = nloc; b.st[1] = nx; }
        const unsigned old = xb_add(&bar[XB_XSUB(b.x)], 1u);
        const unsigned gen = old / nloc;
        if (old + 1u == (gen + 1u) * nloc) {
            __builtin_amdgcn_fence(__ATOMIC_RELEASE, "agent");
            asm volatile("s_waitcnt vmcnt(0)" ::: "memory");
            const unsigned og = xb_add(&bar[XB_TOP], 1u);
            const unsigned tg = og / nx;
            if (og + 1u == (tg + 1u) * nx) xb_add(&bar[XB_TOPGEN], 1u);
            else XB_SPIN(xb_ld(&bar[XB_TOPGEN]) == tg, bar);
            __builtin_amdgcn_fence(__ATOMIC_ACQUIRE, "agent");
            xb_add(&bar[XB_XGEN(b.x)], 1u);
            asm volatile("s_waitcnt vmcnt(0)" ::: "memory");
        } else {
            XB_SPIN(xb_ld(&bar[XB_XGEN(b.x)]) == gen, bar);
            __builtin_amdgcn_fence(__ATOMIC_ACQUIRE, "agent");
            asm volatile("s_waitcnt vmcnt(0)" ::: "memory");
        }
    }
    __syncthreads();
}

__device__ __forceinline__ int mk_lane() { return (int)__builtin_amdgcn_mbcnt_hi(~0u, __builtin_amdgcn_mbcnt_lo(~0u, 0u)); }
__device__ __forceinline__ float bf2f(bf16_t b) { return __builtin_bit_cast(float, (unsigned)b << 16); }
__device__ __forceinline__ float wave_sum(float v) {
#pragma unroll
    for (int o = 1; o < 64; o <<= 1) v += __shfl_xor(v, o);
    return v;
}
__device__ __forceinline__ float wave_max(float v) {
#pragma unroll
    for (int o = 1; o < 64; o <<= 1) v = fmaxf(v, __shfl_xor(v, o));
    return v;
}

__host__ __device__ __forceinline__ int win_actual(int v) {
    const int pn = v >> 8, w = v & 255, bj = w >> 7, wc = (w >> 5) & 3, j = w & 31;
    if (pn < 2) return v;
    if (pn < 5) return 512 + 64 * (4 * (pn - 2) + wc) + 32 * bj + j;
    const int hd = 2 * wc + (j >> 4), d = 16 * bj + (j & 15);
    if (pn == 5) return 1280 + 32 * hd + d;
    if (hd == 0) return 1536 + d;
    if (hd == 1 && d < 8) return 1568 + d;
    return -1;
}
__host__ __device__ __forceinline__ int wup_actual(int v) { const int pn = v >> 8, w = v & 255; return (w >> 7) * DFF + 128 * pn + (w & 127); }

namespace pg8 {
#define PG8_LAS __attribute__((address_space(3)))
typedef unsigned short bf16_t;
typedef short bf16x8 __attribute__((ext_vector_type(8)));
typedef float f32x4 __attribute__((ext_vector_type(4)));
typedef unsigned u32x4 __attribute__((ext_vector_type(4)));
constexpr int BM = 256, BK = 64, HALF = 128, HTB = HALF * BK * 2  , STAGE_BYTES = 8 * HTB, NXCD = 8, WGM = 8;

__host__ __device__ __forceinline__ int lds_byte(int r, int c) { const int st = (r >> 4) * 2 + (c >> 5), rr = r & 15, cc = c & 31, ob = rr * 64 + cc * 2; return st * 1024 + (ob ^ (((ob >> 9) & 1) << 5)); }
__host__ __device__ __forceinline__ void stage_rc(int b, int& R, int& C) { const int st = b / 1024, sb = b % 1024, swz = sb ^ (((sb >> 9) & 1) << 5); R = (st >> 1) * 16 + swz / 64; C = (st & 1) * 32 + (swz % 64) / 2; }
__host__ __device__ __forceinline__ int perm32(int rho) { const int n = rho >> 4, i = rho & 15; return 8 * (i >> 2) + 4 * n + (i & 3); }

struct Unit { int pm, pn; };
struct Gemm { const bf16_t* A; const bf16_t* Bt; int M, N, K; };

struct StaticOrder {
    int nM, nN, nwg, G, c;
    __host__ __device__ void init(int M, int N, int G_, int c_) { nM = M / BM; nN = N / BM; nwg = nM * nN; G = G_; c = c_; }
    __host__ __device__ bool next(int i, Unit& u) const {
        const long L = (long)i * G + c; if (L >= nwg) return false;
        int wgid = (int)L; { const int q = nwg / NXCD, r = nwg % NXCD, xcd = wgid % NXCD, off = wgid / NXCD; wgid = (xcd < r ? xcd * (q + 1) : r * (q + 1) + (xcd - r) * q) + off; }
        const int nig = WGM * nN, gid = wgid / nig, fm = gid * WGM, gsz = (nM - fm) < WGM ? (nM - fm) : WGM;
        u.pm = fm + ((wgid % nig) % gsz); u.pn = (wgid % nig) / gsz; return true;
    }
    __device__ __forceinline__ void a_ready(const Unit&) const {}
    __device__ __forceinline__ void done(const Unit&) const {}
};

__device__ __forceinline__ unsigned cvt_pk_bf16(float lo, float hi) { unsigned r; asm volatile("v_cvt_pk_bf16_f32 %0, %1, %2" : "=v"(r) : "v"(lo), "v"(hi)); return r; }
__device__ __forceinline__ unsigned cvt_pk_f16(float lo, float hi) { return (unsigned)__builtin_bit_cast(unsigned short, (_Float16)lo) | ((unsigned)__builtin_bit_cast(unsigned short, (_Float16)hi) << 16); }
typedef float f32x2 __attribute__((ext_vector_type(2)));
typedef unsigned u32x2 __attribute__((ext_vector_type(2)));
__device__ __forceinline__ u32x4 pack8_bf16(const f32x4 a, const f32x4 b) { u32x4 w; w.x = cvt_pk_bf16(a[0], a[1]); w.y = cvt_pk_bf16(a[2], a[3]); w.z = cvt_pk_bf16(b[0], b[1]); w.w = cvt_pk_bf16(b[2], b[3]); return w; }
__device__ __forceinline__ u32x4 pack8_f16(const f32x4 a, const f32x4 b) { u32x4 w; w.x = cvt_pk_f16(a[0], a[1]); w.y = cvt_pk_f16(a[2], a[3]); w.z = cvt_pk_f16(b[0], b[1]); w.w = cvt_pk_f16(b[2], b[3]); return w; }

struct EpiProj {
    static constexpr bool PERM = true, AFTER_DRAIN = false, HAS_INIT = false;
    bf16_t *VP, *Q, *Kb, *Vb; _Float16 *QI, *KI; float* WI; const float* rope32; const float* rope16; const float *gq, *gk;
    __device__ __forceinline__ void operator()(const f32x4 (&acc)[2][2][4][2], const Unit& u, int wr, int wc, int fr, int fq) const {
        const int pn = u.pn, rowb = u.pm * BM + wr * 64 + fr;
        if (pn < 2) {
#pragma unroll
            for (int ai = 0; ai < 2; ++ai)
#pragma unroll
                for (int m = 0; m < 4; ++m) { bf16_t* rp = VP + (size_t)(rowb + ai * HALF + m * 16) * 512 + pn * 256 + wc * 32 + 8 * fq;
#pragma unroll
                    for (int bj = 0; bj < 2; ++bj) *(u32x4*)(rp + bj * HALF) = pack8_bf16(acc[ai][bj][m][0], acc[ai][bj][m][1]); }
        } else if (pn < 5) {
            if (pn == 4 && wc >= 2) {
#pragma unroll
                for (int ai = 0; ai < 2; ++ai)
#pragma unroll
                    for (int m = 0; m < 4; ++m) { bf16_t* rp = Vb + (size_t)(rowb + ai * HALF + m * 16) * 128 + 64 * (wc - 2) + 8 * fq;
#pragma unroll
                        for (int bj = 0; bj < 2; ++bj) *(u32x4*)(rp + bj * 32) = pack8_bf16(acc[ai][bj][m][0], acc[ai][bj][m][1]); }
            } else {
                const bool isk = (pn == 4); const float* g = isk ? gk : gq; const float osc = isk ? 1.0f : 0.18033688011112042f  ;
                f32x4 gv[2][2];
#pragma unroll
                for (int bj = 0; bj < 2; ++bj)
#pragma unroll
                    for (int n = 0; n < 2; ++n) gv[bj][n] = *(const f32x4*)(g + 32 * bj + 8 * fq + 4 * n);
                bf16_t* dst = isk ? (Kb + 64 * wc) : (Q + 64 * (4 * (pn - 2) + wc)); const int ld = isk ? 128 : 512;
#pragma unroll
                for (int ai = 0; ai < 2; ++ai)
#pragma unroll
                    for (int m = 0; m < 4; ++m) { const int row = rowb + ai * HALF + m * 16, pos = row & 2047;
                        float ss = 0.f;
#pragma unroll
                        for (int bj = 0; bj < 2; ++bj)
#pragma unroll
                            for (int n = 0; n < 2; ++n) { const f32x4 v = acc[ai][bj][m][n]; ss += (v[0] * v[0] + v[1] * v[1]) + (v[2] * v[2] + v[3] * v[3]); }
                        ss += __shfl_xor(ss, 16); ss += __shfl_xor(ss, 32);
                        const float rstd = 1.0f / sqrtf(ss * (1.0f / 64.0f) + 1e-6f);
                        const f32x4* rp = (const f32x4*)(rope32 + (size_t)(pos * 32 + 8 * fq) * 2);
                        f32x4 o1[2], o2[2];
#pragma unroll
                        for (int n = 0; n < 2; ++n) { const f32x4 cs0 = rp[2 * n], cs1 = rp[2 * n + 1];
                            const f32x4 x1 = acc[ai][0][m][n] * rstd * gv[0][n], x2 = acc[ai][1][m][n] * rstd * gv[1][n];
                            const f32x4 c = (f32x4){cs0[0], cs0[2], cs1[0], cs1[2]}, s = (f32x4){cs0[1], cs0[3], cs1[1], cs1[3]};
                            o1[n] = (x1 * c - x2 * s) * osc; o2[n] = (x2 * c + x1 * s) * osc; }
                        bf16_t* op = dst + (size_t)row * ld + 8 * fq;
                        *(u32x4*)(op) = pack8_bf16(o1[0], o1[1]); *(u32x4*)(op + 32) = pack8_bf16(o2[0], o2[1]); }
            }
        } else {
            const int hd = 2 * wc + (fq >> 1);
            if (pn == 6 && wc != 0) return;
            if (pn == 6 && hd == 1) {
                if (fq == 2) {
#pragma unroll
                    for (int ai = 0; ai < 2; ++ai)
#pragma unroll
                        for (int m = 0; m < 4; ++m) { float* wp = WI + (size_t)(rowb + ai * HALF + m * 16) * 8;
                            *(f32x4*)(wp) = acc[ai][0][m][0] * 0.0625f; *(f32x4*)(wp + 4) = acc[ai][0][m][1] * 0.0625f; }
                }
                return;
            }
            _Float16* dst = (pn == 5) ? (QI + 32 * hd) : KI; const int ld = (pn == 5) ? 256 : 32;
#pragma unroll
            for (int ai = 0; ai < 2; ++ai)
#pragma unroll
                for (int m = 0; m < 4; ++m) { const int row = rowb + ai * HALF + m * 16, pos = row & 2047;
                    const f32x4* rp = (const f32x4*)(rope16 + (size_t)(pos * 16 + 8 * (fq & 1)) * 2);
                    f32x4 o1[2], o2[2];
#pragma unroll
                    for (int n = 0; n < 2; ++n) { const f32x4 cs0 = rp[2 * n], cs1 = rp[2 * n + 1];
                        const f32x4 x1 = acc[ai][0][m][n], x2 = acc[ai][1][m][n];
                        const f32x4 c = (f32x4){cs0[0], cs0[2], cs1[0], cs1[2]}, s = (f32x4){cs0[1], cs0[3], cs1[1], cs1[3]};
                        o1[n] = x1 * c - x2 * s; o2[n] = x2 * c + x1 * s; }
                    _Float16* op = dst + (size_t)row * ld + 8 * (fq & 1);
                    *(u32x4*)(op) = pack8_f16(o1[0], o1[1]); *(u32x4*)(op + 16) = pack8_f16(o2[0], o2[1]); }
        }
    }
};

__device__ __forceinline__ f32x4 bf16lo_to_f32(const u32x2 w) { return (f32x4){__builtin_bit_cast(float, w.x << 16), __builtin_bit_cast(float, w.x & 0xffff0000u), __builtin_bit_cast(float, w.y << 16), __builtin_bit_cast(float, w.y & 0xffff0000u)}; }
struct EpiWout {
    static constexpr bool PERM = true, AFTER_DRAIN = false, HAS_INIT = true, NEXT_HOOK = false;
    const float* x; bf16_t* X1B; float* SS2;
    __device__ __forceinline__ void init(f32x4 (&acc)[2][2][4][2], const Unit& u, int wr, int wc, int fr, int fq) const {
        const int rowb = u.pm * BM + wr * 64 + fr, col0 = u.pn * BM + wc * 32 + 8 * fq;
#pragma unroll
        for (int ai = 0; ai < 2; ++ai)
#pragma unroll
            for (int m = 0; m < 4; ++m) { const size_t off = (size_t)(rowb + ai * HALF + m * 16) * 1024 + col0;
#pragma unroll
                for (int bj = 0; bj < 2; ++bj) { acc[ai][bj][m][0] = *(const f32x4*)(x + off + bj * HALF); acc[ai][bj][m][1] = *(const f32x4*)(x + off + bj * HALF + 4); } }
    }
    __device__ __forceinline__ void operator()(const f32x4 (&acc)[2][2][4][2], const Unit& u, int wr, int wc, int fr, int fq) const {
        const int rowb = u.pm * BM + wr * 64 + fr, col0 = u.pn * BM + wc * 32 + 8 * fq;
#pragma unroll
        for (int ai = 0; ai < 2; ++ai)
#pragma unroll
            for (int m = 0; m < 4; ++m) { const int row = rowb + ai * HALF + m * 16; const size_t off = (size_t)row * 1024 + col0; float ss = 0.f;
#pragma unroll
                for (int bj = 0; bj < 2; ++bj) { const f32x4 v0 = acc[ai][bj][m][0], v1 = acc[ai][bj][m][1];
                    ss += (v0[0] * v0[0] + v0[1] * v0[1]) + (v0[2] * v0[2] + v0[3] * v0[3]) + (v1[0] * v1[0] + v1[1] * v1[1]) + (v1[2] * v1[2] + v1[3] * v1[3]);
                    *(u32x4*)(X1B + off + bj * HALF) = pack8_bf16(v0, v1); }
                ss += __shfl_xor(ss, 16); ss += __shfl_xor(ss, 32);
                if (fq == 0) SS2[(size_t)row * 16 + 4 * u.pn + wc] = ss; }
    }
};
struct EpiDown {
    static constexpr bool PERM = true, AFTER_DRAIN = false, HAS_INIT = true, NEXT_HOOK = false;
    const bf16_t* X1B; float* out;
    __device__ __forceinline__ void init(f32x4 (&acc)[2][2][4][2], const Unit& u, int wr, int wc, int fr, int fq) const {
        const int rowb = u.pm * BM + wr * 64 + fr, col0 = u.pn * BM + wc * 32 + 8 * fq;
#pragma unroll
        for (int ai = 0; ai < 2; ++ai) {
            u32x4 hv[4][2];
#pragma unroll
            for (int m = 0; m < 4; ++m) { const size_t off = (size_t)(rowb + ai * HALF + m * 16) * 1024 + col0;
#pragma unroll
                for (int bj = 0; bj < 2; ++bj) hv[m][bj] = *(const u32x4*)(X1B + off + bj * HALF); }
#pragma unroll
            for (int m = 0; m < 4; ++m)
#pragma unroll
                for (int bj = 0; bj < 2; ++bj) { acc[ai][bj][m][0] = bf16lo_to_f32((u32x2){hv[m][bj].x, hv[m][bj].y}); acc[ai][bj][m][1] = bf16lo_to_f32((u32x2){hv[m][bj].z, hv[m][bj].w}); }
        }
    }
    __device__ __forceinline__ void operator()(const f32x4 (&acc)[2][2][4][2], const Unit& u, int wr, int wc, int fr, int fq) const {
        const int rowb = u.pm * BM + wr * 64 + fr, col0 = u.pn * BM + wc * 32 + 8 * fq;
#pragma unroll
        for (int ai = 0; ai < 2; ++ai)
#pragma unroll
            for (int m = 0; m < 4; ++m) { float* p = out + (size_t)(rowb + ai * HALF + m * 16) * 1024 + col0;
#pragma unroll
                for (int bj = 0; bj < 2; ++bj) { *(f32x4*)(p + bj * HALF) = acc[ai][bj][m][0]; *(f32x4*)(p + bj * HALF + 4) = acc[ai][bj][m][1]; } }
    }
};
__device__ __forceinline__ float dpp_shr1(float v) { return __builtin_bit_cast(float, __builtin_amdgcn_update_dpp(0, __builtin_bit_cast(int, v), 0x111, 0xf, 0xf, false)); }
template <class T> __device__ __forceinline__ void stg_u32(void* base, unsigned boff, const T v) { *(T*)((char*)base + boff) = v; }
struct EpiUp {
    static constexpr bool PERM = true, AFTER_DRAIN = false, HAS_INIT = false;
    const PG8_LAS float* tab; const PG8_LAS float* wtab; bf16_t* G; bf16_t* HF; bf16_t* HL; mutable int par;
    __device__ __forceinline__ void operator()(const f32x4 (&acc)[2][2][4][2], const Unit& u, int wr, int wc, int fr_, int fq_) const {
        int fr = fr_, fq = fq_; asm volatile("" : "+v"(fr), "+v"(fq));
        const unsigned cb = 32 * wc + 8 * fq, ncol = 128 * u.pn + cb;
        const PG8_LAS float* tb = tab + par * 256 + wr * 64 + 4 * fr; const PG8_LAS float* wt = wtab + par * 1024 + cb; par ^= 1;
#pragma unroll
        for (int ai = 0; ai < 2; ++ai) {
            const unsigned rg = u.pm * BM + ai * HALF + wr * 64, g64 = rg >> 6;
            const f32x4 rs = *(const PG8_LAS f32x4*)(tb + ai * HALF);
            u32x2 gp[2][4];
#pragma unroll
            for (int n = 0; n < 2; ++n) {
                f32x4 cg[4];
#pragma unroll
                for (int bj = 0; bj < 2; ++bj) {
                    const PG8_LAS f32x4* wq = (const PG8_LAS f32x4*)(wt + 128 * bj + 4 * n);
                    const f32x4 w0 = wq[0], w1 = wq[64], w2 = wq[128], bb = wq[192];
                    f32x4 uu[4];
#pragma unroll
                    for (int m = 0; m < 4; ++m) uu[m] = acc[ai][bj][m][n] * rs[m];
                    const unsigned vcol = u.pn * 256u + bj * 128u + cb + 4u * n;
                    if (fr == 0) { stg_u32<u32x2>(HF, ((g64 * 2u + 0u) * 5632u + vcol) * 2u, (u32x2){cvt_pk_bf16(uu[0][0], uu[0][1]), cvt_pk_bf16(uu[0][2], uu[0][3])}); stg_u32<u32x2>(HF, ((g64 * 2u + 1u) * 5632u + vcol) * 2u, (u32x2){cvt_pk_bf16(uu[1][0], uu[1][1]), cvt_pk_bf16(uu[1][2], uu[1][3])}); }
                    if (fr == 15) { stg_u32<u32x2>(HL, ((g64 * 2u + 0u) * 5632u + vcol) * 2u, (u32x2){cvt_pk_bf16(uu[2][0], uu[2][1]), cvt_pk_bf16(uu[2][2], uu[2][3])}); stg_u32<u32x2>(HL, ((g64 * 2u + 1u) * 5632u + vcol) * 2u, (u32x2){cvt_pk_bf16(uu[3][0], uu[3][1]), cvt_pk_bf16(uu[3][2], uu[3][3])}); }
                    f32x4 d2, d3;
#pragma unroll
                    for (int i = 0; i < 4; ++i) { d2[i] = dpp_shr1(uu[2][i]); d3[i] = dpp_shr1(uu[3][i]); }
                    f32x4 c[4];
                    c[0] = bb + w0 * d2 + w1 * d3 + w2 * uu[0];
                    c[1] = bb + w0 * d3 + w1 * uu[0] + w2 * uu[1];
                    c[2] = bb + w0 * uu[0] + w1 * uu[1] + w2 * uu[2];
                    c[3] = bb + w0 * uu[1] + w1 * uu[2] + w2 * uu[3];
#pragma unroll
                    for (int m = 0; m < 4; ++m) {
                        if (bj == 0) cg[m] = c[m];
                        else { f32x4 gsl;
#pragma unroll
                            for (int i = 0; i < 4; ++i) gsl[i] = __builtin_amdgcn_exp2f(-cg[m][i]);
                            gsl = gsl + 1.0f;
#pragma unroll
                            for (int i = 0; i < 4; ++i) gsl[i] = __builtin_amdgcn_rcpf(gsl[i]);
                            gsl = (cg[m] * gsl) * c[m];
                            gp[n][m] = (u32x2){cvt_pk_bf16(gsl[0], gsl[1]), cvt_pk_bf16(gsl[2], gsl[3])}; }
                    }
                }
            }
#pragma unroll
            for (int m = 0; m < 4; ++m)
                stg_u32<u32x4>(G, ((rg + 4u * fr + m) * 2816u + ncol) * 2u, (u32x4){gp[0][m].x, gp[0][m].y, gp[1][m].x, gp[1][m].y});
        }
    }
};
struct UpOrder : StaticOrder {
    const float* SS2; PG8_LAS float* tab; PG8_LAS float* wtab; const float* conv_w; const float* conv_b; int wv; mutable int par;
    __device__ __forceinline__ void a_ready(const Unit& u) const {
        const int t = wv * 64 + (int)__builtin_amdgcn_mbcnt_hi(~0u, __builtin_amdgcn_mbcnt_lo(~0u, 0u));
#pragma unroll
        for (int k = 0; k < 2; ++k) { const int idx = t + 512 * k, tap = idx >> 8, v = idx & 255, col = (v >> 7) * 2816 + 128 * u.pn + (v & 127);
            wtab[par * 1024 + idx] = (tap < 3 ? conv_w[tap * 5632 + col] : conv_b[col]) * ((v >> 7) ? 0.6931471805599453f : 1.4426950408889634f); }
        if (t < 256) { const f32x4* sp = (const f32x4*)(SS2 + (size_t)(u.pm * BM + t) * 16); const f32x4 a = sp[0], b = sp[1], c = sp[2], d = sp[3];
            const float s = (((a[0] + a[1]) + (a[2] + a[3])) + ((b[0] + b[1]) + (b[2] + b[3]))) + (((c[0] + c[1]) + (c[2] + c[3])) + ((d[0] + d[1]) + (d[2] + d[3])));
            tab[par * 256 + t] = __builtin_amdgcn_rsqf(s * (1.0f / 1024.0f) + 1e-6f); }
        par ^= 1;
    }
};

template <class Epi, class Sched, bool ALIGN_EPI = false, bool SP2 = false, bool ROWPERM = false>
__device__ __forceinline__ void gemm_phase(PG8_LAS unsigned char* lds, const Gemm g, const Sched& S, const Epi& E, const int wv  ) {
    int tid_ = wv * 64 + (int)__builtin_amdgcn_mbcnt_hi(~0u, __builtin_amdgcn_mbcnt_lo(~0u, 0u)); asm volatile("" : "+v"(tid_));
    const int tid = tid_, wid = __builtin_amdgcn_readfirstlane(tid >> 6), lane = tid & 63, wr = wid >> 2, wc = wid & 3, fr = lane & 15, fq = lane >> 4;
    const int K = g.K, nt = K / BK;
    unsigned voffA[2], voffB[2];
#pragma unroll
    for (int i = 0; i < 2; ++i) { int R, C; stage_rc(tid * 16 + i * 8192, R, C); const int Rb = Epi::PERM ? ((R & ~31) + perm32(R & 31)) : R;
        const int Ra = ROWPERM ? ((R & ~63) + 4 * (R & 15) + ((R >> 4) & 3)) : R;
        voffA[i] = (unsigned)(Ra * K + C) * 2u; voffB[i] = (unsigned)(Rb * K + C) * 2u; }
    const size_t kstep = (size_t)(BK * 2);
    const size_t hstep = (size_t)HALF * K * 2;
    const size_t tstep = 2 * hstep;
    const unsigned ldsw = (unsigned)wid * 1024u;
    const int aoff = lds_byte(wr * 64 + fr, fq * 8), boff = lds_byte(wc * 32 + fr, fq * 8);
#define PG8_SA(b, h) (((b) * 2 + (h)) * HTB)
#define PG8_SB(b, h) ((4 + (b) * 2 + (h)) * HTB)
#define PG8_STAGE(bufoff, gbase, voff) do { _Pragma("unroll") for (int _i = 0; _i < 2; ++_i) \
        __builtin_amdgcn_global_load_lds((const unsigned*)((const char*)(gbase) + (voff)[_i]), (PG8_LAS unsigned*)(lds + (bufoff) + ldsw + _i * 8192), 16, 0, 0); } while (0)
#define PG8_LDA(dst, b, h) do { _Pragma("unroll") for (int m = 0; m < 4; ++m) _Pragma("unroll") for (int k = 0; k < 2; ++k) dst[m][k] = *(const PG8_LAS bf16x8*)(lds + PG8_SA(b, h) + aoff + m * 2048 + k * 1024); } while (0)
#define PG8_LDB(dst, b, h) do { _Pragma("unroll") for (int n = 0; n < 2; ++n) _Pragma("unroll") for (int k = 0; k < 2; ++k) dst[n][k] = *(const PG8_LAS bf16x8*)(lds + PG8_SB(b, h) + boff + n * 2048 + k * 1024); } while (0)
#define PG8_MMA(ai, bj, At, Bt) do { __builtin_amdgcn_s_setprio(1); _Pragma("unroll") for (int m = 0; m < 4; ++m) _Pragma("unroll") for (int n = 0; n < 2; ++n) _Pragma("unroll") for (int k = 0; k < 2; ++k) \
        acc[ai][bj][m][n] = __builtin_amdgcn_mfma_f32_16x16x32_bf16(Bt[n][k], At[m][k], acc[ai][bj][m][n], 0, 0, 0); __builtin_amdgcn_s_setprio(0); } while (0)
#define PG8_WAIT_V(n) asm volatile("s_waitcnt vmcnt(" #n ")" ::: "memory")
#define PG8_WAIT_L(n) asm volatile("s_waitcnt lgkmcnt(" #n ")" ::: "memory")
#define PG8_BAR __builtin_amdgcn_s_barrier()
#define PG8_SCHED __builtin_amdgcn_sched_barrier(0)
    Unit cur, nxt; int ui = 0;
    if (!S.next(0, cur)) return;
    f32x4 acc[2][2][4][2];
    if constexpr (Epi::HAS_INIT) E.init(acc, cur, wr, wc, fr, fq);
    else {
#pragma unroll
    for (int a = 0; a < 2; ++a)
#pragma unroll
        for (int b = 0; b < 2; ++b)
#pragma unroll
            for (int m = 0; m < 4; ++m)
#pragma unroll
                for (int n = 0; n < 2; ++n) acc[a][b][m][n] = (f32x4){0.f, 0.f, 0.f, 0.f};
    }
    bf16x8 At[4][2], B0[2][2], B1[2][2];
    const char* cA = (const char*)g.A + (size_t)cur.pm * tstep; const char* cB = (const char*)g.Bt + (size_t)cur.pn * tstep;
    S.a_ready(cur);
    if constexpr (SP2) {
        PG8_STAGE(PG8_SB(0, 0), cB, voffB); PG8_STAGE(PG8_SB(0, 1), cB + hstep, voffB); PG8_STAGE(PG8_SA(0, 0), cA, voffA); PG8_STAGE(PG8_SA(0, 1), cA + hstep, voffA);
        if (wr == 1) PG8_BAR;
        PG8_WAIT_V(2); PG8_BAR;
        PG8_STAGE(PG8_SB(1, 0), cB + kstep, voffB); PG8_STAGE(PG8_SA(1, 0), cA + kstep, voffA); PG8_STAGE(PG8_SB(1, 1), cB + hstep + kstep, voffB);
        PG8_WAIT_V(6); PG8_BAR;
    } else {
        PG8_STAGE(PG8_SB(0, 0), cB, voffB); PG8_STAGE(PG8_SA(0, 0), cA, voffA); PG8_STAGE(PG8_SB(0, 1), cB + hstep, voffB); PG8_STAGE(PG8_SA(0, 1), cA + hstep, voffA);
        if (wr == 1) PG8_BAR;
        PG8_WAIT_V(4); PG8_BAR;
        PG8_STAGE(PG8_SB(1, 0), cB + kstep, voffB); PG8_STAGE(PG8_SA(1, 0), cA + kstep, voffA); PG8_STAGE(PG8_SB(1, 1), cB + hstep + kstep, voffB);
        PG8_WAIT_V(6); PG8_BAR;
    }
    for (;;) {
        const bool has_next = S.next(ui + 1, nxt);
        const char* nA = has_next ? (const char*)g.A + (size_t)nxt.pm * tstep : cA; const char* nB = has_next ? (const char*)g.Bt + (size_t)nxt.pn * tstep : cB;
        for (int t = 0; t < nt; t += 2) {
            const bool last = (t == nt - 2);
            const char* a1 = cA + (size_t)(t + 1) * kstep;
            const char* a2 = last ? nA : cA + (size_t)(t + 2) * kstep; const char* b2 = last ? nB : cB + (size_t)(t + 2) * kstep;
            const char* a3 = a2 + kstep; const char* b3 = b2 + kstep;
            if (last && has_next) S.a_ready(nxt);
            if constexpr (SP2) {
            PG8_LDB(B0, 0, 0); PG8_LDB(B1, 0, 1); PG8_SCHED; PG8_LDA(At, 0, 0); PG8_STAGE(PG8_SA(1, 1), a1 + hstep, voffA);
            PG8_WAIT_V(8); PG8_WAIT_L(0); PG8_BAR; PG8_MMA(0, 0, At, B0); PG8_MMA(0, 1, At, B1); PG8_BAR; PG8_SCHED;
            PG8_LDA(At, 0, 1); PG8_STAGE(PG8_SB(0, 0), b2, voffB); PG8_STAGE(PG8_SB(0, 1), b2 + hstep, voffB); PG8_STAGE(PG8_SA(0, 0), a2, voffA);
            PG8_WAIT_V(8); PG8_WAIT_L(0); PG8_BAR; PG8_MMA(1, 0, At, B0); PG8_MMA(1, 1, At, B1); PG8_BAR; PG8_SCHED;
            PG8_LDB(B0, 1, 0); PG8_LDB(B1, 1, 1); PG8_SCHED; PG8_LDA(At, 1, 0); PG8_STAGE(PG8_SA(0, 1), a2 + hstep, voffA);
            PG8_WAIT_V(8); PG8_WAIT_L(0); PG8_BAR; PG8_MMA(0, 0, At, B0); PG8_MMA(0, 1, At, B1); PG8_BAR; PG8_SCHED;
            PG8_LDA(At, 1, 1); PG8_STAGE(PG8_SB(1, 0), b3, voffB); PG8_STAGE(PG8_SB(1, 1), b3 + hstep, voffB); PG8_STAGE(PG8_SA(1, 0), a3, voffA);
            PG8_WAIT_V(8); PG8_WAIT_L(0); PG8_BAR; PG8_MMA(1, 0, At, B0); PG8_MMA(1, 1, At, B1); PG8_BAR; PG8_SCHED;
            } else {
            PG8_LDB(B0, 0, 0); PG8_SCHED; PG8_LDA(At, 0, 0); PG8_STAGE(PG8_SA(1, 1), a1 + hstep, voffA);
            PG8_WAIT_L(8); PG8_BAR; PG8_WAIT_L(0); PG8_MMA(0, 0, At, B0); PG8_BAR; PG8_SCHED;
            PG8_LDB(B1, 0, 1); PG8_STAGE(PG8_SB(0, 0), b2, voffB);
            PG8_BAR; PG8_WAIT_L(0); PG8_MMA(0, 1, At, B1); PG8_BAR;
            PG8_LDA(At, 0, 1); PG8_STAGE(PG8_SA(0, 0), a2, voffA);
            PG8_BAR; PG8_WAIT_L(0); PG8_MMA(1, 0, At, B0); PG8_BAR; PG8_SCHED;
            PG8_STAGE(PG8_SB(0, 1), b2 + hstep, voffB);
            PG8_WAIT_V(6); PG8_BAR; PG8_MMA(1, 1, At, B1); PG8_BAR;
            PG8_LDB(B0, 1, 0); PG8_SCHED; PG8_LDA(At, 1, 0); PG8_STAGE(PG8_SA(0, 1), a2 + hstep, voffA);
            PG8_WAIT_L(8); PG8_BAR; PG8_WAIT_L(0); PG8_MMA(0, 0, At, B0); PG8_BAR; PG8_SCHED;
            PG8_LDB(B1, 1, 1); PG8_STAGE(PG8_SB(1, 0), b3, voffB);
            PG8_BAR; PG8_WAIT_L(0); PG8_MMA(0, 1, At, B1); PG8_BAR;
            PG8_LDA(At, 1, 1); PG8_STAGE(PG8_SA(1, 0), a3, voffA);
            PG8_BAR; PG8_WAIT_L(0); PG8_MMA(1, 0, At, B0); PG8_BAR; PG8_SCHED;
            PG8_STAGE(PG8_SB(1, 1), b3 + hstep, voffB);
            PG8_WAIT_V(6); PG8_BAR; PG8_MMA(1, 1, At, B1); PG8_BAR;
            }
        }
        if constexpr (ALIGN_EPI) { if (wr == 0) PG8_BAR; }
        if constexpr (!Epi::AFTER_DRAIN) { E(acc, cur, wr, wc, fr, fq); S.done(cur); }
        if (!has_next) break;
        if constexpr (Epi::HAS_INIT) E.init(acc, nxt, wr, wc, fr, fq);
        else {
#pragma unroll
        for (int a = 0; a < 2; ++a)
#pragma unroll
            for (int b = 0; b < 2; ++b)
#pragma unroll
                for (int m = 0; m < 4; ++m)
#pragma unroll
                    for (int n = 0; n < 2; ++n) acc[a][b][m][n] = (f32x4){0.f, 0.f, 0.f, 0.f};
        }
        cur = nxt; cA = nA; cB = nB; ++ui;
        if constexpr (ALIGN_EPI) { if (wr == 1) PG8_BAR; }
    }
    PG8_WAIT_V(0);
    if constexpr (!ALIGN_EPI) { if (wr == 0) PG8_BAR; }
    PG8_BAR;
    if constexpr (Epi::AFTER_DRAIN) { E.fused(acc, cur, wr, wc, fr, fq, lds, wid, lane); S.done(cur); }
#undef PG8_SA
#undef PG8_SB
#undef PG8_STAGE
#undef PG8_LDA
#undef PG8_LDB
#undef PG8_MMA
#undef PG8_WAIT_V
#undef PG8_WAIT_L
#undef PG8_BAR
#undef PG8_SCHED
}
}

#include <hip/hip_bf16.h>
#include <cmath>
namespace attn_body {
using bf16=__hip_bfloat16;
using bf16x8=__attribute__((ext_vector_type(8)))short;
using s16x4=__attribute__((ext_vector_type(4)))short;
using f32x16=__attribute__((ext_vector_type(16)))float;
using u32x4=__attribute__((ext_vector_type(4)))unsigned;
constexpr int BATCH=8,NHEAD=8,SEQ=2048,D=64,QP=512,KP=128,OP=1024,OOFF=512;
constexpr int NW=8,QBLK=32,QB=QBLK*NW,KVBLK=64,NQB=SEQ/QB;
constexpr int ATTN_UNIT_ROWS=QB;
__device__ __forceinline__ int crow(int r,int hi){return (r&3)+8*(r>>2)+4*hi;}
#define SBAR() __builtin_amdgcn_sched_barrier(0)
__device__ __forceinline__ void cmask(f32x16&p0,f32x16&p1,int jb,int qrel,int hi){
  const float NEG=-INFINITY; int kb=64*jb+4*hi;
  #pragma unroll
  for(int r=0;r<16;++r){int kv=kb+(r&3)+8*(r>>2); if(kv>qrel)p0[r]=NEG; if(kv+32>qrel)p1[r]=NEG;}
}

constexpr int NSLOT=3, SLOTB=8192;
constexpr int LDS_K=0, LDS_V=NSLOT*SLOTB, LDS_WS=2*NSLOT*SLOTB, LDS_OST=LDS_WS+NW*64*4, LDS_BYTES=LDS_OST+NW*4096;
constexpr float C2=0.125f*1.4426950408889634f;
__device__ __forceinline__ void glds16(const void*gsrc,unsigned lds_dst){unsigned keep;
  asm volatile("s_mov_b32 %0, m0\n\ts_mov_b32 m0, %2\n\ts_nop 0\n\tglobal_load_lds_dwordx4 %1, off\n\ts_mov_b32 m0, %0":"=&s"(keep):"v"(gsrc),"s"(lds_dst):"memory");}
__device__ __forceinline__ float max3f(float a,float b,float c){float r;asm("v_max3_f32 %0, %1, %2, %3":"=v"(r):"v"(a),"v"(b),"v"(c));return r;}
__device__ __forceinline__ float max2f(float a,float b){float r;asm("v_max_f32_e32 %0, %1, %2":"=v"(r):"v"(a),"v"(b));return r;}
__device__ __forceinline__ float fadd_s(float a,float b){float r;asm("v_add_f32_e32 %0, %1, %2":"=v"(r):"v"(a),"v"(b));return r;}
__device__ __forceinline__ float fsub_s(float a,float b){float r;asm("v_sub_f32_e32 %0, %1, %2":"=v"(r):"v"(a),"v"(b));return r;}
typedef float f32x2_t __attribute__((ext_vector_type(2))); typedef __bf16 bf16x2_t __attribute__((ext_vector_type(2)));
__device__ __forceinline__ unsigned cvtpk_s(float lo,float hi){f32x2_t v={lo,hi};bf16x2_t b=__builtin_convertvector(v,bf16x2_t);return __builtin_bit_cast(unsigned,b);}
#define WAIT_BAR(N) asm volatile("s_waitcnt vmcnt(" #N ") lgkmcnt(0)\n\ts_barrier":::"memory")

__device__ __forceinline__ void qkt(f32x16&p0,f32x16&p1,const char*Kslot,const bf16x8*qr,const f32x16&negm,int r32,int hi){
  const char*kb=Kslot+hi*1024+r32*16;
  #pragma unroll
  for(int d0=0;d0<4;++d0){
    const bf16x8 b0=*reinterpret_cast<const bf16x8*>(kb+d0*2048);
    const bf16x8 b1=*reinterpret_cast<const bf16x8*>(kb+d0*2048+512);
    if(d0==0){p0=__builtin_amdgcn_mfma_f32_32x32x16_bf16(b0,qr[0],negm,0,0,0);p1=__builtin_amdgcn_mfma_f32_32x32x16_bf16(b1,qr[0],negm,0,0,0);}
    else{p0=__builtin_amdgcn_mfma_f32_32x32x16_bf16(b0,qr[d0],p0,0,0,0);p1=__builtin_amdgcn_mfma_f32_32x32x16_bf16(b1,qr[d0],p1,0,0,0);}}
}
typedef __attribute__((address_space(3))) const char* lds_cptr;
typedef short v4i16_t __attribute__((ext_vector_type(4)));
__device__ __forceinline__ void kload8(bf16x8*kf,lds_cptr kp){
  kf[0]=*(const __attribute__((address_space(3))) bf16x8*)(kp);      kf[1]=*(const __attribute__((address_space(3))) bf16x8*)(kp+512);
  kf[2]=*(const __attribute__((address_space(3))) bf16x8*)(kp+2048); kf[3]=*(const __attribute__((address_space(3))) bf16x8*)(kp+2560);
  kf[4]=*(const __attribute__((address_space(3))) bf16x8*)(kp+4096); kf[5]=*(const __attribute__((address_space(3))) bf16x8*)(kp+4608);
  kf[6]=*(const __attribute__((address_space(3))) bf16x8*)(kp+6144); kf[7]=*(const __attribute__((address_space(3))) bf16x8*)(kp+6656);
}
__device__ __forceinline__ void kload2(bf16x8*kf,lds_cptr kp,int j){ kf[2*j]=*(const __attribute__((address_space(3))) bf16x8*)(kp+j*2048); kf[2*j+1]=*(const __attribute__((address_space(3))) bf16x8*)(kp+j*2048+512); }
__device__ __forceinline__ s16x4 vtr(lds_cptr p){ return __builtin_bit_cast(s16x4,__builtin_amdgcn_ds_read_tr16_b64_v4i16((__attribute__((address_space(3))) v4i16_t*)p)); }
__device__ __forceinline__ float rowmax(const f32x16&p0,const f32x16&p1){
  float a=max3f(p0[0],p0[1],p1[0]),b=max3f(p0[2],p0[3],p1[1]);a=max3f(a,p1[2],p1[3]);
  #pragma unroll
  for(int r=4;r<16;r+=4){a=max3f(a,p0[r],p0[r+1]);b=max3f(b,p0[r+2],p0[r+3]);a=max3f(a,p1[r],p1[r+1]);b=max3f(b,p1[r+2],p1[r+3]);}
  const float m=max2f(a,b);
  auto rr=__builtin_amdgcn_permlane32_swap(__float_as_uint(m),__float_as_uint(m),false,false);
  return max2f(__uint_as_float(rr[0]),__uint_as_float(rr[1]));
}
__device__ __forceinline__ void pv(f32x16*o,int vb,bf16x8 pa0,bf16x8 pa1,bf16x8 pa2,bf16x8 pa3){
  #pragma unroll
  for(int d0=0;d0<2;++d0){s16x4 lo[4],hi[4];
    #pragma unroll
    for(int ks=0;ks<4;++ks){
      asm volatile("ds_read_b64_tr_b16 %0,%1 offset:%c2":"=&v"(lo[ks]):"v"(vb),"i"(d0*4096+ks*1024):"memory");
      asm volatile("ds_read_b64_tr_b16 %0,%1 offset:%c2":"=&v"(hi[ks]):"v"(vb),"i"(d0*4096+ks*1024+512):"memory");}
    asm volatile("s_waitcnt lgkmcnt(0)":::"memory");SBAR();
    #define PK(k) (bf16x8){lo[k][0],lo[k][1],lo[k][2],lo[k][3],hi[k][0],hi[k][1],hi[k][2],hi[k][3]}
    o[d0]=__builtin_amdgcn_mfma_f32_32x32x16_bf16(pa0,PK(0),o[d0],0,0,0);
    o[d0]=__builtin_amdgcn_mfma_f32_32x32x16_bf16(pa1,PK(1),o[d0],0,0,0);
    o[d0]=__builtin_amdgcn_mfma_f32_32x32x16_bf16(pa2,PK(2),o[d0],0,0,0);
    o[d0]=__builtin_amdgcn_mfma_f32_32x32x16_bf16(pa3,PK(3),o[d0],0,0,0);
    #undef PK
  }
}

#ifndef ATTN_STORE16
#define ATTN_STORE16(p,v) (*(u32x4*)(p)=(v))
#endif
template<int THRL> __device__ __forceinline__ void attn_unit(int b,int h,int qb,const bf16*Q,const bf16*__restrict__ K,const bf16*__restrict__ V,const unsigned long long*__restrict__ MASK,bf16*O,char*shm,const int wv){
  int tid_=wv*64+(int)__builtin_amdgcn_mbcnt_hi(~0u,__builtin_amdgcn_mbcnt_lo(~0u,0u)); asm volatile("":"+v"(tid_)); const int tid=tid_,lane=tid&63,r32=lane&31,hi=lane>>5; const int wid=__builtin_amdgcn_readfirstlane(tid>>6);
  const long rowbase=(long)b*SEQ; const int q0=qb*QB;
  const bf16*Qw=Q+(rowbase+q0+wid*QBLK)*QP+h*D;
  const bf16*Kh=K+rowbase*KP+(h>>2)*D,*Vh=V+rowbase*KP+(h>>2)*D;
  const unsigned lds0=(unsigned)(uintptr_t)shm;
  float*wsf=(float*)(shm+LDS_WS)+wid*64;
  const bf16*ksrc=Kh+(long)lane*KP+wid*8;
  const bf16*vsrc=Vh+(long)(16*(wid&3)+(lane>>2))*KP+(wid>>2)*32+(lane&3)*8;
  const unsigned kdst=lds0+LDS_K+wid*1024, vdst=lds0+LDS_V+wid*1024;
  #define DMA_K(t,slot) glds16(ksrc+(long)(t)*KVBLK*KP,(unsigned)__builtin_amdgcn_readfirstlane(kdst+(slot)))
  #define DMA_V(t,slot) glds16(vsrc+(long)(t)*KVBLK*KP,(unsigned)__builtin_amdgcn_readfirstlane(vdst+(slot)))
  const int vb0=(int)(lds0+LDS_V)+((lane>>4)&1)*32+(lane&3)*8+(4*hi+((lane&15)>>2))*64;
  const char*Kbase=shm+LDS_K; bf16x8 kf[8];
  const lds_cptr shm3=(lds_cptr)shm; const lds_cptr kp0=shm3+LDS_K+hi*1024+r32*16; const lds_cptr vp0=shm3+LDS_V+((lane>>4)&1)*32+(lane&3)*8+(4*hi+((lane&15)>>2))*64;
  const int NT=(q0+QB)/KVBLK;
  DMA_K(0,0);DMA_V(0,0);DMA_K(1,SLOTB);
  bf16x8 qr[4];
  #pragma unroll
  for(int d0=0;d0<4;++d0)qr[d0]=*reinterpret_cast<const bf16x8*>(&Qw[(long)r32*QP+d0*16+hi*8]);
  float l_reg=0.f;f32x16 o[2];o[0]=f32x16{};o[1]=f32x16{};const f32x16 negm=f32x16{};
  const int qrel=wid*QBLK+r32;
  const unsigned long long*mrow=MASK+(rowbase+q0+qrel)*(SEQ/64);
  unsigned long long mk=mrow[0];
  #define MKSH(WL,WH,t) unsigned WL=(unsigned)mk>>(4*hi), WH=(unsigned)(mk>>32)>>(4*hi); asm volatile("":"+v"(WL),"+v"(WH)); mk=mrow[(t)+1]
  #define CMASKW(P0,P1,WL,WH) do{ _Pragma("unroll") for(int r=0;r<16;++r){ const int ps_=(r&3)+8*(r>>2); const float a_=P0[r], b_=P1[r]; \
      const unsigned m0_=(unsigned)__builtin_amdgcn_sbfe((int)WL,ps_,1), m1_=(unsigned)__builtin_amdgcn_sbfe((int)WH,ps_,1); \
      const unsigned ua_=(__builtin_bit_cast(unsigned,a_)&m0_)|(0xff800000u&~m0_), ub_=(__builtin_bit_cast(unsigned,b_)&m1_)|(0xff800000u&~m1_); \
      P0[r]=__builtin_bit_cast(float,ua_); P1[r]=__builtin_bit_cast(float,ub_); } }while(0)
  #define START(P0,P1) do{ _Pragma("unroll") for(int r=0;r<16;++r)P0[r]=__builtin_amdgcn_exp2f(P0[r]); }while(0)
  #define RESC() do{}while(0)
  f32x16 pA0,pA1,pB0,pB1;
  int sl_prev=0,sl_cur=0,sl_next=SLOTB;
  #define ROT() do{sl_prev=sl_cur;sl_cur=sl_next;sl_next=(sl_next==(NSLOT-1)*SLOTB)?0:sl_next+SLOTB;}while(0)
  DMA_K(2,2*SLOTB);
  WAIT_BAR(3);
  qkt(pA0,pA1,Kbase,qr,negm,r32,hi);asm volatile("s_nop 15\n\ts_nop 7":"+v"(pA0),"+v"(pA1));{MKSH(wl0_,wh0_,0);CMASKW(pA0,pA1,wl0_,wh0_);}
  START(pA0,pA1);
  _Pragma("unroll") for(int r=0;r<16;++r)pA1[r]=__builtin_amdgcn_exp2f(pA1[r]);
  WAIT_BAR(0);
  DMA_K(3,0);DMA_V(1,SLOTB);
  ROT();
  kload8(kf,kp0+sl_cur);
  WAIT_BAR(2);
  s16x4 vlo[8],vhi[8]; u32x4 pw0,pw1,pw2,pw3;
  #define PKW(P,B) cvtpk_s(P[B],P[B+1])
  #define PAF(k) __builtin_bit_cast(bf16x8,pw##k)
  #define VFR(i) (bf16x8){vlo[i][0],vlo[i][1],vlo[i][2],vlo[i][3],vhi[i][0],vhi[i][1],vhi[i][2],vhi[i][3]}
  #define PIN(x) asm volatile("":"+v"(x))
  #define MX3(a,b,c) __builtin_fmaxf(__builtin_fmaxf((a),(b)),(c))
  #define GAPA(MF,A0,A1,A2,A3,W0,W1,PW) do{ MF; sacc+=A0; sacc+=A1; sacc+=A2; sacc+=A3; PIN(sacc); W0; W1; PIN(PW); SBAR(); }while(0)
  #define EX(v) __builtin_amdgcn_exp2f(v)
  #define GAPB(MF,X,B) do{ MF; X[B]=EX(X[B]); X[B+1]=EX(X[B+1]); X[B+2]=EX(X[B+2]); X[B+3]=EX(X[B+3]); PIN(X); SBAR(); }while(0)
  #define VRD(i) do{ vlo[i]=vtr(vp_+(((i)>>2)*4096+((i)&3)*1024)); vhi[i]=vtr(vp_+(((i)>>2)*4096+((i)&3)*1024+512)); }while(0)
  #define KRD(G,j) do{ if(G){ kload2(kf,kp0+sl_next,j); SBAR(); } }while(0)
  #define STEP(C0,C1,P0,P1,t,GK,GV,GL) do{ SBAR(); \
    const lds_cptr vp_=vp0+sl_prev; \
    VRD(0); SBAR(); float sacc=(P0[0]+P0[1]); \
    GAPA(C0=__builtin_amdgcn_mfma_f32_32x32x16_bf16(kf[0],qr[0],negm,0,0,0), P0[2],P0[3],P0[4],P0[5],     pw0[0]=PKW(P0,0), pw0[1]=PKW(P0,2), pw0); \
    VRD(4); SBAR(); GAPA(C1=__builtin_amdgcn_mfma_f32_32x32x16_bf16(kf[1],qr[0],negm,0,0,0), P0[6],P0[7],P0[8],P0[9],     pw0[2]=PKW(P0,4), pw0[3]=PKW(P0,6), pw0); \
    VRD(1); SBAR(); GAPA(C0=__builtin_amdgcn_mfma_f32_32x32x16_bf16(kf[2],qr[1],C0,0,0,0),   P0[10],P0[11],P0[12],P0[13], pw1[0]=PKW(P0,8), pw1[1]=PKW(P0,10), pw1); \
    VRD(5); SBAR(); GAPA(C1=__builtin_amdgcn_mfma_f32_32x32x16_bf16(kf[3],qr[1],C1,0,0,0),   P0[14],P0[15],P1[0],P1[1],   pw1[2]=PKW(P0,12),pw1[3]=PKW(P0,14), pw1); \
    VRD(2); SBAR(); GAPA(C0=__builtin_amdgcn_mfma_f32_32x32x16_bf16(kf[4],qr[2],C0,0,0,0),   P1[2],P1[3],P1[4],P1[5],     pw2[0]=PKW(P1,0), pw2[1]=PKW(P1,2), pw2); \
    VRD(6); SBAR(); GAPA(C1=__builtin_amdgcn_mfma_f32_32x32x16_bf16(kf[5],qr[2],C1,0,0,0),   P1[6],P1[7],P1[8],P1[9],     pw2[2]=PKW(P1,4), pw2[3]=PKW(P1,6), pw2); \
    VRD(3); SBAR(); GAPA(C0=__builtin_amdgcn_mfma_f32_32x32x16_bf16(kf[6],qr[3],C0,0,0,0),   P1[10],P1[11],P1[12],P1[13], pw3[0]=PKW(P1,8), pw3[1]=PKW(P1,10), pw3); \
    VRD(7); SBAR(); GAPA(C1=__builtin_amdgcn_mfma_f32_32x32x16_bf16(kf[7],qr[3],C1,0,0,0),   P1[14],P1[15],0.f,0.f,       pw3[2]=PKW(P1,12),pw3[3]=PKW(P1,14), pw3); \
    l_reg+=sacc; \
    MKSH(wl_,wh_,t); \
    if(GK){DMA_K((t)+3,sl_cur);} if(GV){DMA_V((t)+1,sl_next);} \
    CMASKW(C0,C1,wl_,wh_); \
    SBAR(); \
    GAPB(o[0]=__builtin_amdgcn_mfma_f32_32x32x16_bf16(PAF(0),VFR(0),o[0],0,0,0), C0,0); \
    GAPB(o[1]=__builtin_amdgcn_mfma_f32_32x32x16_bf16(PAF(0),VFR(4),o[1],0,0,0), C0,4); \
    KRD(GL,0); GAPB(o[0]=__builtin_amdgcn_mfma_f32_32x32x16_bf16(PAF(1),VFR(1),o[0],0,0,0), C0,8); \
    KRD(GL,1); GAPB(o[1]=__builtin_amdgcn_mfma_f32_32x32x16_bf16(PAF(1),VFR(5),o[1],0,0,0), C0,12); \
    KRD(GL,2); GAPB(o[0]=__builtin_amdgcn_mfma_f32_32x32x16_bf16(PAF(2),VFR(2),o[0],0,0,0), C1,0); \
    KRD(GL,3); GAPB(o[1]=__builtin_amdgcn_mfma_f32_32x32x16_bf16(PAF(2),VFR(6),o[1],0,0,0), C1,4); \
    GAPB(o[0]=__builtin_amdgcn_mfma_f32_32x32x16_bf16(PAF(3),VFR(3),o[0],0,0,0), C1,8); \
    GAPB(o[1]=__builtin_amdgcn_mfma_f32_32x32x16_bf16(PAF(3),VFR(7),o[1],0,0,0), C1,12); \
    }while(0)
  int t=1;
  for(;t+5<NT;t+=2){
    STEP(pB0,pB1,pA0,pA1,t,true,true,true);     WAIT_BAR(2); RESC(); ROT();
    STEP(pA0,pA1,pB0,pB1,t+1,true,true,true);   WAIT_BAR(2); RESC(); ROT();
  }
  #define ENDW(tt) do{ if((tt)+3<NT){WAIT_BAR(2);} else if((tt)+2<NT){WAIT_BAR(1);} else {WAIT_BAR(0);} }while(0)
  for(;t+1<NT;t+=2){
    STEP(pB0,pB1,pA0,pA1,t,(t+3<NT),(t+1<NT),(t+1<NT));       ENDW(t);   RESC(); ROT();
    STEP(pA0,pA1,pB0,pB1,t+1,(t+4<NT),(t+2<NT),(t+2<NT));     ENDW(t+1); RESC(); ROT();
  }
  STEP(pB0,pB1,pA0,pA1,NT-1,false,false,false); RESC();
  { float sacc=pB0[0]+pB0[1]; _Pragma("unroll") for(int r=2;r<16;++r)sacc+=pB0[r]; _Pragma("unroll") for(int r=0;r<16;++r)sacc+=pB1[r]; l_reg+=sacc;
    pw0=(u32x4){PKW(pB0,0),PKW(pB0,2),PKW(pB0,4),PKW(pB0,6)};pw1=(u32x4){PKW(pB0,8),PKW(pB0,10),PKW(pB0,12),PKW(pB0,14)};pw2=(u32x4){PKW(pB1,0),PKW(pB1,2),PKW(pB1,4),PKW(pB1,6)};pw3=(u32x4){PKW(pB1,8),PKW(pB1,10),PKW(pB1,12),PKW(pB1,14)};
    SBAR(); pv(o,vb0+sl_cur,PAF(0),PAF(1),PAF(2),PAF(3)); }
  #undef PKW
  #undef PAF
  #undef VFR
  #undef PIN
  #undef MX3
  #undef GAPA
  #undef GAPB
  #undef EX
  #undef VRD
  #undef KRD
  #undef STEP
  #undef ENDW
  {auto rr=__builtin_amdgcn_permlane32_swap(__float_as_uint(l_reg),__float_as_uint(l_reg),false,false);l_reg=__uint_as_float(rr[0])+__uint_as_float(rr[1]);}
  if(hi==0)wsf[32+r32]=l_reg;asm volatile("s_waitcnt lgkmcnt(0)":::"memory");
  float rli[16];
  #pragma unroll
  for(int r=0;r<16;++r)rli[r]=__builtin_amdgcn_rcpf(wsf[32+crow(r,hi)]);
  bf16*Ow=O+(rowbase+q0+wid*QBLK)*OP+OOFF+h*D;
  { bf16*stg=(bf16*)(shm+LDS_OST)+wid*2048;
    #pragma unroll
    for(int r=0;r<16;++r){const int orow=crow(r,hi);
      #pragma unroll
      for(int d0=0;d0<2;++d0)stg[orow*64+d0*32+r32]=__float2bfloat16(o[d0][r]*rli[r]);}
    asm volatile("s_waitcnt lgkmcnt(0)":::"memory");
    #pragma unroll
    for(int i=0;i<4;++i){const int row=i*8+(lane>>3),ch=lane&7; const u32x4 v=*(const u32x4*)(stg+row*64+ch*8); ATTN_STORE16(Ow+(long)row*OP+ch*8,v);} }
  asm volatile("s_waitcnt lgkmcnt(0)\n\ts_barrier":::"memory");
  #undef DMA_K
  #undef DMA_V
  #undef CMASKW
  #undef MKSH
  #undef START
  #undef RESC
  #undef ROT
}
constexpr int ATTN_LDS_BYTES=LDS_BYTES;
struct AttnTensors { const bf16* Q; const bf16* K; const bf16* V; const unsigned long long* MASK; bf16* O; };
struct AttnUnit { int bh; int qb; };
struct StaticOrder {
  int vcu,G;
  __device__ __forceinline__ explicit StaticOrder(int grid,int block):vcu((grid%8==0)?(block%8)*(grid/8)+block/8:block),G(grid){}
  __device__ __forceinline__ bool next(int i,AttnUnit&u)const{ const int it=vcu+(i>>1)*G; if(it>=BATCH*NHEAD*4)return false; const int s=it&3; u.bh=it>>2; u.qb=(i&1)?7-s:s; return true; }
  __device__ __forceinline__ void a_ready(const AttnUnit&)const{}
  __device__ __forceinline__ void done(const AttnUnit&)const{}
};
template<class Sched,int THRL=8> __device__ __forceinline__ void attn_phase(char*lds,const AttnTensors&T,const Sched&S,const int wv){
  AttnUnit u;
  for(int i=0;S.next(i,u);++i){ S.a_ready(u); attn_unit<THRL>(u.bh/NHEAD,u.bh%NHEAD,u.qb,T.Q,T.K,T.V,T.MASK,T.O,lds,wv); S.done(u); }
}
#undef SBAR
#undef WAIT_BAR
}

#ifndef REPS
#define REPS {1, 1, 1, 1, 1, 1, 1, 1}
#endif
constexpr int kReps[8] = REPS;
#ifndef SREPS
#define SREPS {1, 1, 1, 1, 1, 1, 1, 1}
#endif
constexpr int kSub[8] = SREPS;
typedef _Float16 f16x8 __attribute__((ext_vector_type(8)));
typedef float f32x16 __attribute__((ext_vector_type(16)));
__device__ __forceinline__ unsigned score_key(float s) { const unsigned u = __builtin_bit_cast(unsigned, s + 0.0f); return u ^ ((unsigned)((int)u >> 31) | 0x80000000u); }
__device__ __forceinline__ float key_score(unsigned k) { return __builtin_bit_cast(float, (k & 0x80000000u) ? (k & 0x7fffffffu) : ~k); }
__device__ __forceinline__ float wave_sum_f32(float v) {
    v += __builtin_bit_cast(float, __builtin_amdgcn_update_dpp(0, __builtin_bit_cast(int, v), 0xb1, 0xf, 0xf, false));
    v += __builtin_bit_cast(float, __builtin_amdgcn_update_dpp(0, __builtin_bit_cast(int, v), 0x4e, 0xf, 0xf, false));
    v += __builtin_bit_cast(float, __builtin_amdgcn_update_dpp(0, __builtin_bit_cast(int, v), 0x141, 0xf, 0xf, false));
    v += __builtin_bit_cast(float, __builtin_amdgcn_update_dpp(0, __builtin_bit_cast(int, v), 0x140, 0xf, 0xf, false));
    return __builtin_bit_cast(float, __builtin_amdgcn_readlane(__builtin_bit_cast(int, v), 0)) + __builtin_bit_cast(float, __builtin_amdgcn_readlane(__builtin_bit_cast(int, v), 16))
         + __builtin_bit_cast(float, __builtin_amdgcn_readlane(__builtin_bit_cast(int, v), 32)) + __builtin_bit_cast(float, __builtin_amdgcn_readlane(__builtin_bit_cast(int, v), 48));
}
__device__ __forceinline__ int wave_sum_i32(int v) {
    v += __builtin_amdgcn_update_dpp(0, v, 0xb1, 0xf, 0xf, false);
    v += __builtin_amdgcn_update_dpp(0, v, 0x4e, 0xf, 0xf, false);
    v += __builtin_amdgcn_update_dpp(0, v, 0x141, 0xf, 0xf, false);
    v += __builtin_amdgcn_update_dpp(0, v, 0x140, 0xf, 0xf, false);
    return __builtin_amdgcn_readlane(v, 0) + __builtin_amdgcn_readlane(v, 16) + __builtin_amdgcn_readlane(v, 32) + __builtin_amdgcn_readlane(v, 48);
}
__device__ __forceinline__ void count_ge8(unsigned& cnt, unsigned cand, unsigned k0, unsigned k1, unsigned k2, unsigned k3, unsigned k4, unsigned k5, unsigned k6, unsigned k7) {
    unsigned long long m0, m1, m2, m3;
    asm volatile(
        "v_cmp_ge_u32_e64 %1, %5, %13\n\tv_cmp_ge_u32_e64 %2, %6, %13\n\tv_cmp_ge_u32_e64 %3, %7, %13\n\tv_cmp_ge_u32_e64 %4, %8, %13\n\t"
        "v_addc_co_u32_e64 %0, vcc, 0, %0, %1\n\tv_cmp_ge_u32_e64 %1, %9, %13\n\t"
        "v_addc_co_u32_e64 %0, vcc, 0, %0, %2\n\tv_cmp_ge_u32_e64 %2, %10, %13\n\t"
        "v_addc_co_u32_e64 %0, vcc, 0, %0, %3\n\tv_cmp_ge_u32_e64 %3, %11, %13\n\t"
        "v_addc_co_u32_e64 %0, vcc, 0, %0, %4\n\tv_cmp_ge_u32_e64 %4, %12, %13\n\t"
        "v_addc_co_u32_e64 %0, vcc, 0, %0, %1\n\tv_addc_co_u32_e64 %0, vcc, 0, %0, %2\n\tv_addc_co_u32_e64 %0, vcc, 0, %0, %3\n\tv_addc_co_u32_e64 %0, vcc, 0, %0, %4"
        : "+v"(cnt), "=&s"(m0), "=&s"(m1), "=&s"(m2), "=&s"(m3)
        : "v"(k0), "v"(k1), "v"(k2), "v"(k3), "v"(k4), "v"(k5), "v"(k6), "v"(k7), "s"(cand) : "vcc");
}
#define IDX_REP8(X, o) X((o) + 0) X((o) + 1) X((o) + 2) X((o) + 3) X((o) + 4) X((o) + 5) X((o) + 6) X((o) + 7)
template <int NREG>
__device__ __forceinline__ void indexer_task_n(int b, int t0, const f16_t* __restrict__ QI, const f16_t* __restrict__ KI, const float* __restrict__ WI, unsigned long long* __restrict__ MASK, int lane) {
    const int r32 = lane & 31, hi = lane >> 5; const size_t rowb = (size_t)b * SEQ;
    const f16_t* qp = QI + (rowb + t0 + (r32 >> 3)) * 256 + 32 * (r32 & 7) + 8 * hi;
    const f16x8 a0 = *(const f16x8*)(qp), a1 = *(const f16x8*)(qp + 16);
    f32x4 wv[4];
#pragma unroll
    for (int q = 0; q < 4; ++q) wv[q] = *(const f32x4*)(WI + (rowb + t0 + q) * 8 + 4 * hi);
    const int nst = (t0 + 3) / 64 + 1;
    const f16_t* kp = KI + (rowb + r32) * 32 + 8 * hi;
    unsigned key[4][NREG];
    f16x8 bq[3][4];
#pragma unroll
    for (int i = 0; i < 4; ++i) bq[0][i] = *(const f16x8*)(kp + (i >> 1) * 1024 + (i & 1) * 16);
    if (1 < nst) {
#pragma unroll
        for (int i = 0; i < 4; ++i) bq[1][i] = *(const f16x8*)(kp + (size_t)2048 + (i >> 1) * 1024 + (i & 1) * 16); }
#pragma unroll
    for (int st = 0; st < NREG; ++st) {
        if (st < nst) {
            if (st + 2 < NREG && st + 2 < nst) {
#pragma unroll
                for (int i = 0; i < 4; ++i) bq[(st + 2) % 3][i] = *(const f16x8*)(kp + (size_t)(st + 2) * 2048 + (i >> 1) * 1024 + (i & 1) * 16);
            }
            const f32x16 z16 = (f32x16){0.f, 0.f, 0.f, 0.f, 0.f, 0.f, 0.f, 0.f, 0.f, 0.f, 0.f, 0.f, 0.f, 0.f, 0.f, 0.f};
            f32x16 c0 = __builtin_amdgcn_mfma_f32_32x32x16_f16(a0, bq[st % 3][0], z16, 0, 0, 0);
            c0 = __builtin_amdgcn_mfma_f32_32x32x16_f16(a1, bq[st % 3][1], c0, 0, 0, 0);
            f32x16 c1 = __builtin_amdgcn_mfma_f32_32x32x16_f16(a0, bq[st % 3][2], z16, 0, 0, 0);
            c1 = __builtin_amdgcn_mfma_f32_32x32x16_f16(a1, bq[st % 3][3], c1, 0, 0, 0);
#pragma unroll
            for (int q = 0; q < 4; ++q) {
                float pa = 0.f, pb = 0.f;
#pragma unroll
                for (int i = 0; i < 4; ++i) { pa += wv[q][i] * __builtin_amdgcn_fmed3f(c0[4 * q + i], 0.f, __builtin_inff()); pb += wv[q][i] * __builtin_amdgcn_fmed3f(c1[4 * q + i], 0.f, __builtin_inff()); }
                const auto rr = __builtin_amdgcn_permlane32_swap(__builtin_bit_cast(unsigned, pa), __builtin_bit_cast(unsigned, pb), false, false);
                const unsigned rr0 = rr[0], rr1 = rr[1];
                const float sc = __builtin_bit_cast(float, rr0) + __builtin_bit_cast(float, rr1);
                key[q][st] = __builtin_bit_cast(unsigned, sc + 0.0f);
            }
        } else {
#pragma unroll
            for (int q = 0; q < 4; ++q) key[q][st] = 0u;
        }
    }
    const int t0u = __builtin_amdgcn_readfirstlane(t0), nstu = (t0u + 3) / 64 + 1;
    bool done[4], exact[4]; unsigned eq[4], gt[4], cgt[4];
#pragma unroll
    for (int q = 0; q < 4; ++q) { exact[q] = false; done[q] = (t0u + q < TOPK); gt[q] = 0u; cgt[q] = 0u;
        { const int nv_ = (lane <= t0u + q) ? ((t0u + q - lane) >> 6) + 1 : 0; eq[q] = nv_ >= 32 ? 0xffffffffu : ((1u << nv_) - 1u); }
        if (!done[q]) {
#define IDX_PSTAGE(J, SA, SB) _Pragma("unroll") for (int k = 0; k < 32; ++k) if ((k & J) == 0) { const unsigned a_ = key[q][k], b_ = key[q][k + J]; key[q][k] = __builtin_amdgcn_perm(b_, a_, SA); key[q][k + J] = __builtin_amdgcn_perm(b_, a_, SB); if ((k & 3) == 3) __builtin_amdgcn_sched_barrier(0); }
#define IDX_TSTAGE(J, MK) _Pragma("unroll") for (int k = 0; k < 32; ++k) if ((k & J) == 0) { const unsigned a_ = key[q][k], b_ = key[q][k + J]; \
                key[q][k] = (a_ & ~(MK << J)) | ((b_ << J) & (MK << J)); key[q][k + J] = (b_ & ~MK) | ((a_ >> J) & MK); if ((k & 3) == 3) __builtin_amdgcn_sched_barrier(0); }
            IDX_PSTAGE(16, 0x05040100u, 0x07060302u) IDX_PSTAGE(8, 0x06020400u, 0x07030501u) IDX_TSTAGE(4, 0x0f0f0f0fu) IDX_TSTAGE(2, 0x33333333u) IDX_TSTAGE(1, 0x55555555u)
#undef IDX_TSTAGE
#undef IDX_PSTAGE
        } }
#pragma unroll
    for (int b = 31; b >= 0; --b) {
        if (done[0] && done[1] && done[2] && done[3]) break;
        unsigned tb[4], c[4] = {0u, 0u, 0u, 0u};
#pragma unroll
        for (int q = 0; q < 4; ++q) { tb[q] = 0u; if (!done[q]) { unsigned sg_ = key[q][31]; asm volatile("" : "+v"(sg_));
            tb[q] = eq[q] & (b == 31 ? ~sg_ : (key[q][b] ^ sg_)); c[q] = (unsigned)__builtin_popcount(tb[q]) + cgt[q]; } }
        const int c01 = (done[0] && done[1]) ? 0 : wave_sum_i32((int)(c[0] | (c[1] << 16))), c23 = (done[2] && done[3]) ? 0 : wave_sum_i32((int)(c[2] | (c[3] << 16)));
        const int cs[4] = {c01 & 0xffff, c01 >> 16, c23 & 0xffff, c23 >> 16};
#pragma unroll
        for (int q = 0; q < 4; ++q) if (!done[q]) {
            if (cs[q] >= TOPK) { eq[q] = tb[q]; if (cs[q] == TOPK) { gt[q] |= tb[q]; done[q] = true; exact[q] = true; } }
            else { gt[q] |= tb[q]; cgt[q] = c[q]; eq[q] ^= tb[q]; } }
    }
#define IDX_PUTW(bal, st) do { const unsigned long long b_ = (bal); asm volatile("s_nop 1\n\tv_writelane_b32 %0, %2, %4\n\tv_writelane_b32 %1, %3, %4" : "+v"(wlo), "+v"(whi) : "s"((unsigned)b_), "s"((unsigned)(b_ >> 32)), "n"(st));     } while (0)
#pragma unroll
    for (int q = 0; q < 4; ++q) {
        const int t = t0 + q; unsigned wlo = 0u, whi = 0u;
        if (t < TOPK) {
#define IDX_X(st) IDX_PUTW(__ballot(64 * (st) + lane <= t), st);
            IDX_REP8(IDX_X, 0)
#undef IDX_X
        } else {
            const bool ex = exact[q]; const unsigned gsel = gt[q], ties = eq[q]; int need = 0;
            if (!ex) need = TOPK - wave_sum_i32((int)cgt[q]);
            const unsigned long long lt = (1ull << lane) - 1ull;
#define IDX_X(st) { bool sel_ = (gsel >> (st)) & 1u; \
                    if (!ex) { const bool tie_ = (ties >> (st)) & 1u; const unsigned long long tb_ = __ballot(tie_); sel_ = sel_ || (tie_ && __popcll(tb_ & lt) < need); need -= __popcll(tb_); if (need < 0) need = 0; } \
                    IDX_PUTW(__ballot(sel_), st); }
            IDX_REP8(IDX_X, 0)
            if (NREG > 8 && nst > 8) { IDX_REP8(IDX_X, 8) }
            if (NREG > 16 && nst > 16) { IDX_REP8(IDX_X, 16) }
            if (NREG > 24 && nst > 24) { IDX_REP8(IDX_X, 24) }
#undef IDX_X
        }
        if (lane < 32) MASK[(rowb + t) * 32 + lane] = (unsigned long long)wlo | ((unsigned long long)whi << 32);
    }
#undef IDX_PUTW
}
#undef IDX_REP8

constexpr int NWAVES = 8;
constexpr int RING_OFF = 0, RING_BYTES = 131072;
constexpr int LDSCTL_OFF = RING_BYTES, MISC_OFF = LDSCTL_OFF + 320;
constexpr int LDS_BYTES = 147456;
constexpr int TAB_OFF = MISC_OFF + 128;
constexpr int WTAB_OFF = TAB_OFF + 2048;
static_assert(WTAB_OFF + 8192 <= LDS_BYTES, "LDS map");
constexpr int N_PHASES = 8;

struct Args { const float* in[13]; float* out; unsigned char* ws; int ph_lo, ph_hi, li, pad; };

__device__ __forceinline__ void p0_transpose_item(const float* W, int K, int N, bf16_t* WT, int Nv, int mode, const float* kscale, LAS float* scr, int item, int lane) {
    const int nblk = Nv / 32, kb = item / nblk, nb = item % nblk, k0 = 64 * kb, n0 = 32 * nb;
    const int v = n0 + (lane & 31); const int a = mode == 0 ? v : (mode == 1 ? win_actual(v) : wup_actual(v));
    float vals[32];
    const float* wp = W + (size_t)(k0 + (lane >> 5)) * N + (a >= 0 ? a : 0);
#pragma unroll
    for (int i = 0; i < 32; ++i) vals[i] = wp[(size_t)(2 * i) * N];
#pragma unroll
    for (int i = 0; i < 32; ++i) { const int kk = 2 * i + (lane >> 5); float val = (a >= 0) ? vals[i] : 0.f;
        if (kscale) val *= kscale[k0 + kk];
        scr[kk * 33 + (lane & 31)] = val; }
    LDS_WAIT(); asm volatile("" ::: "memory");
    const int c = lane & 7;
#pragma unroll
    for (int j = 0; j < 4; ++j) { const int n = (lane >> 3) + 8 * j; const LAS float* s = scr + (8 * c) * 33 + n;
        v4u o; o.x = pk2(s[0 * 33], s[1 * 33]); o.y = pk2(s[2 * 33], s[3 * 33]); o.z = pk2(s[4 * 33], s[5 * 33]); o.w = pk2(s[6 * 33], s[7 * 33]);
        *(GAS v4u*)(WT + (size_t)(n0 + n) * K + k0 + 8 * c) = o; }
    LDS_WAIT(); asm volatile("" ::: "memory");
}

__global__ void __launch_bounds__(NWAVES * 64, 2) mk_fwd(Args args) {
    extern __shared__ __attribute__((aligned(16))) unsigned char lds[];
    LAS unsigned char* L = (LAS unsigned char*)lds;
    volatile LAS unsigned* MISC = (volatile LAS unsigned*)(L + MISC_OFF);
    const int wave = __builtin_amdgcn_readfirstlane((int)threadIdx.x >> 6);
#define MK_IDS const int lane = mk_lane(), tid = wave * 64 + lane; (void)tid
    const int G = gridDim.x; const int bx = blockIdx.x; const int vcu = (G % 8 == 0) ? (bx % 8) * (G / 8) + bx / 8 : bx;
    unsigned char* ws = args.ws;
    gu32* ctl = (gu32*)(ws + WS_CTL);
    const float* x = args.in[0]; const float* norm1_g = args.in[1]; const float* w_in = args.in[2]; const float* q_norm_g = args.in[3]; const float* k_norm_g = args.in[4];
    const float* w_out = args.in[7]; const float* norm2_g = args.in[8]; const float* w_up = args.in[9]; const float* conv_w = args.in[10]; const float* conv_b = args.in[11]; const float* w_down = args.in[12];
    float* out = args.out;
    float* ROPE = (float*)(ws + WS_ROPE); float* ROPE16 = (float*)(ws + WS_ROPE16);
    bf16_t *Win = (bf16_t*)(ws + WS_WIN), *Wout = (bf16_t*)(ws + WS_WOUT), *Wup = (bf16_t*)(ws + WS_WUP), *Wdn = (bf16_t*)(ws + WS_WDN);
    float* SS2 = (float*)(ws + WS_SS2);
    bf16_t *XN = (bf16_t*)(ws + WS_XN), *VP = (bf16_t*)(ws + WS_VP), *Q = (bf16_t*)(ws + WS_Q), *Kb = (bf16_t*)(ws + WS_K), *Vb = (bf16_t*)(ws + WS_V);
    f16_t *QI = (f16_t*)(ws + WS_QI), *KI = (f16_t*)(ws + WS_KI); float* WI = (float*)(ws + WS_WI);
    bf16_t *MIX = (bf16_t*)(ws + WS_MIX), *Gb = (bf16_t*)(ws + WS_G);
    bf16_t *HF = (bf16_t*)(ws + WS_HF), *HL = (bf16_t*)(ws + WS_HL);
    unsigned long long* MASK = (unsigned long long*)(ws + WS_MASK); const float* pool_w = args.in[5]; const float* pool_scale = args.in[6];

    for (int u = (int)threadIdx.x; u < (LDS_BYTES - LDSCTL_OFF) / 4; u += NWAVES * 64) ((LAS unsigned*)(L + LDSCTL_OFF))[u] = 0u;
    __syncthreads();
    XcdBarrier bar = xcd_barrier_post((unsigned*)(ctl + CW_BAR) + args.li * XCD_BAR_WORDS, MISC + 8); bar.w0 = (wave == 0);
    const int lo = args.ph_lo, hi = args.ph_hi;
#define IN(k) (lo <= (k) && (k) < hi)
#define SEAM(k) do { if (IN(k) && IN((k) + 1)) xcd_barrier(bar); } while (0)
    const int gw = vcu * NWAVES + wave, NGW = G * NWAVES;
    constexpr int I_IN = (D_MODEL / 64) * (IN_WV / 32), I_OUT = (D_MODEL / 64) * (D_MODEL / 32), I_UP = (D_MODEL / 64) * (UP_W / 32), I_DN = (DFF / 64) * (D_MODEL / 32);
#define MK_TAIL(nU) const int rounds_ = ((nU) + G - 1) / G; int nidle_ = rounds_ * G - (nU), first_ = G - nidle_; if (nidle_ == 0) { first_ = 0; nidle_ = G; }

    if (IN(0)) for (int rep_ = 0; rep_ < kReps[0]; ++rep_) { if (rep_) xcd_barrier(bar);
        MK_IDS;
        LAS float* scr = (LAS float*)(L + RING_OFF + wave * 16384);
        for (int sr_ = 0; sr_ < kSub[0]; ++sr_)
        for (int it = gw; it < I_IN + I_UP; it += NGW) {
            if (it < I_IN) p0_transpose_item(w_in, D_MODEL, IN_W, Win, IN_WV, 1, nullptr, scr, it, lane);
            else p0_transpose_item(w_up, D_MODEL, UP_W, Wup, UP_W, 2, norm2_g, scr, it - I_IN, lane);
        }
        for (int sr_ = 0; sr_ < kSub[2]; ++sr_)
        for (int i = vcu * NWAVES * 64 + tid; i < SEQ * 48; i += G * NWAVES * 64) {
            int pos, k; float inv; float* dst;
            if (i < SEQ * 32) { pos = i >> 5; k = i & 31; inv = expf(-logf(10000.0f) * (float)k / 32.0f); dst = ROPE + 2 * i; }
            else { const int i2 = i - SEQ * 32; pos = i2 >> 4; k = i2 & 15; inv = expf(-logf(10000.0f) * (float)k / 16.0f); dst = ROPE16 + 2 * i2; }
            float s, c; sincosf((float)pos * inv, &s, &c); dst[0] = c; dst[1] = s;
        }
        for (int sr_ = 0; sr_ < kSub[3]; ++sr_)
        for (int m4 = gw; m4 < M / 4; m4 += NGW) {
            f32x4 v[4][4]; float ssq[4];
#pragma unroll
            for (int r = 0; r < 4; ++r) { const GAS f32x4* xr = (const GAS f32x4*)(x + (size_t)(4 * m4 + r) * D_MODEL) + lane;
#pragma unroll
                for (int j = 0; j < 4; ++j) v[r][j] = xr[64 * j]; }
#pragma unroll
            for (int r = 0; r < 4; ++r) { float s = 0.f;
#pragma unroll
                for (int j = 0; j < 4; ++j) s += (v[r][j].x * v[r][j].x + v[r][j].y * v[r][j].y) + (v[r][j].z * v[r][j].z + v[r][j].w * v[r][j].w);
                ssq[r] = s; }
#pragma unroll
            for (int o = 1; o < 64; o <<= 1) {
#pragma unroll
                for (int r = 0; r < 4; ++r) ssq[r] += __shfl_xor(ssq[r], o); }
#pragma unroll
            for (int r = 0; r < 4; ++r) { const float rstd = 1.0f / sqrtf(ssq[r] * (1.0f / D_MODEL) + EPS);
                GAS unsigned long long* o8 = (GAS unsigned long long*)(XN + (size_t)(4 * m4 + r) * D_MODEL) + lane;
#pragma unroll
                for (int j = 0; j < 4; ++j) { const f32x4 gg = ((const f32x4*)norm1_g)[lane + 64 * j];
                    o8[64 * j] = (unsigned long long)pk2(v[r][j].x * rstd * gg.x, v[r][j].y * rstd * gg.y) | ((unsigned long long)pk2(v[r][j].z * rstd * gg.z, v[r][j].w * rstd * gg.w) << 32); } }
        }
    }
    SEAM(0);
    if (IN(1)) for (int rep_ = 0; rep_ < kReps[1]; ++rep_) { if (rep_) xcd_barrier(bar);
        pg8::Gemm g{XN, Win, M, IN_WV, D_MODEL}; pg8::StaticOrder S; S.init(M, IN_WV, G, bx);
        pg8::EpiProj E{VP, Q, Kb, Vb, QI, KI, WI, ROPE, ROPE16, q_norm_g, k_norm_g};
        pg8::gemm_phase<pg8::EpiProj, pg8::StaticOrder, true, true>(L + RING_OFF, g, S, E, wave);
        MK_TAIL((M / 256) * (IN_WV / 256));
        if (bx >= first_) {
        MK_IDS; LAS float* scr = (LAS float*)(L + RING_OFF + wave * 16384);
        for (int it = (bx - first_) * NWAVES + wave; it < I_OUT - 8 * (D_MODEL / 32); it += nidle_ * NWAVES) p0_transpose_item(w_out, D_MODEL, D_MODEL, Wout, D_MODEL, 0, nullptr, scr, it + 8 * (D_MODEL / 32), lane);
        __syncthreads();
        for (int sr_ = 0; sr_ < kSub[1]; ++sr_)
        for (int item = bx - first_; item < 4 * (D_MODEL / 16); item += nidle_) {
            const int g = item >> 6, n0 = 16 * (item & 63);
            LAS float* pwL = (LAS float*)(L + RING_OFF); LAS float* woL = pwL + 128 * 132;
#pragma unroll
            for (int k = 0; k < 8; ++k) { const int idx = tid + 512 * k, c = idx >> 5, d4 = idx & 31;
                *(LAS f32x4*)(pwL + c * 132 + 4 * d4) = *(const f32x4*)(pool_w + (size_t)(128 * g + c) * 128 + 4 * d4); }
            { const int d = tid >> 2, q = tid & 3; *(LAS f32x4*)(woL + d * 16 + 4 * q) = *(const f32x4*)(w_out + (size_t)(128 * g + d) * D_MODEL + n0 + 4 * q) * pool_scale[128 * g + d]; }
            __syncthreads();
            const int c = tid & 127, nq = wave >> 1;
            f32x4 acc4 = (f32x4){0.f, 0.f, 0.f, 0.f};
#pragma unroll 8
            for (int d4 = 0; d4 < 32; ++d4) { const f32x4 p = *(const LAS f32x4*)(pwL + c * 132 + 4 * d4);
#pragma unroll
                for (int i = 0; i < 4; ++i) acc4 += p[i] * *(const LAS f32x4*)(woL + (4 * d4 + i) * 16 + 4 * nq); }
#pragma unroll
            for (int j = 0; j < 4; ++j) Wout[(size_t)(n0 + 4 * nq + j) * D_MODEL + 128 * g + c] = (bf16_t)f2bf(acc4[j]);
            __syncthreads();
        }
        }
    }
    SEAM(1);
    if (IN(2)) for (int rep_ = 0; rep_ < kReps[2]; ++rep_) { if (rep_) xcd_barrier(bar);
        MK_IDS;
        for (int sr_ = 0; sr_ < kSub[4]; ++sr_)
        for (int wi = gw; wi < M / 4; wi += NGW) {
            const int row = 4 * wi + (lane >> 4), t = row & (SEQ - 1);
            const bf16_t* vp = VP + (size_t)row * POOL_W + 8 * (lane & 15);
            v4u u2[2], u4[4], u8[8], u16[16];
#define POOL_LD(U, W, g) _Pragma("unroll") for (int k = 0; k < W; ++k) U[k] = *(const v4u*)(vp + 128 * (g) - (size_t)((k <= t) ? k : 0) * POOL_W);
            POOL_LD(u2, 2, 0) POOL_LD(u4, 4, 1) POOL_LD(u8, 8, 2) POOL_LD(u16, 16, 3)
#undef POOL_LD
#define POOL_OUT(U, W, g) do { float sum[8], v0[8]; \
                _Pragma("unroll") for (int e = 0; e < 8; ++e) sum[e] = 0.f; \
                _Pragma("unroll") for (int k = 0; k < W; ++k) { const float m_ = (k <= t) ? 1.f : 0.f; const unsigned uu[4] = {U[k].x, U[k].y, U[k].z, U[k].w}; \
                    _Pragma("unroll") for (int e = 0; e < 4; ++e) { const float lo = __builtin_bit_cast(float, uu[e] << 16), hh = __builtin_bit_cast(float, uu[e] & 0xffff0000u); sum[2 * e] += m_ * lo; sum[2 * e + 1] += m_ * hh; \
                        if (k == 0) { v0[2 * e] = lo; v0[2 * e + 1] = hh; } } } \
                const float rc = 1.0f / (float)((t + 1 < W) ? t + 1 : W); \
                v4u o; o.x = pk2(sum[0] * rc - v0[0], sum[1] * rc - v0[1]); o.y = pk2(sum[2] * rc - v0[2], sum[3] * rc - v0[3]); o.z = pk2(sum[4] * rc - v0[4], sum[5] * rc - v0[5]); o.w = pk2(sum[6] * rc - v0[6], sum[7] * rc - v0[7]); \
                *(v4u*)(MIX + (size_t)row * 1024 + 128 * (g) + 8 * (lane & 15)) = o; } while (0)
            POOL_OUT(u2, 2, 0); POOL_OUT(u4, 4, 1); POOL_OUT(u8, 8, 2); POOL_OUT(u16, 16, 3);
#undef POOL_OUT
        }
        for (int sr_ = 0; sr_ < kSub[5]; ++sr_)
        for (int id = gw; id < M / 4; id += NGW) {
            const int w = id & 2047, bb = w >> 8, tq = (id < 2048) ? (w & 255) : 511 - (w & 255);
            indexer_task_n<32>(bb, 4 * tq, QI, KI, WI, MASK, lane);
        }
    }
    SEAM(2);
    if (IN(3)) for (int rep_ = 0; rep_ < kReps[3]; ++rep_) { if (rep_) xcd_barrier(bar);
        const attn_body::AttnTensors AT{(const attn_body::bf16*)Q, (const attn_body::bf16*)Kb, (const attn_body::bf16*)Vb, MASK, (attn_body::bf16*)MIX};
        const attn_body::StaticOrder S((int)G, (int)bx);
        attn_body::attn_phase<attn_body::StaticOrder>((char*)lds + RING_OFF, AT, S, wave);
    }
    SEAM(3);
    if (IN(4)) for (int rep_ = 0; rep_ < kReps[4]; ++rep_) { if (rep_) xcd_barrier(bar);
        pg8::Gemm g{MIX, Wout, M, D_MODEL, D_MODEL}; pg8::StaticOrder S; S.init(M, D_MODEL, G, bx);
        pg8::EpiWout E{x, XN, SS2};
        pg8::gemm_phase<pg8::EpiWout, pg8::StaticOrder, true, true>(L + RING_OFF, g, S, E, wave);
    }
    SEAM(4);
    if (IN(5)) for (int rep_ = 0; rep_ < kReps[5]; ++rep_) { if (rep_) xcd_barrier(bar);
        pg8::Gemm g{XN, Wup, M, UP_W, D_MODEL}; pg8::UpOrder S; S.init(M, UP_W, G, bx); S.SS2 = SS2; S.tab = (LAS float*)(L + TAB_OFF); S.wtab = (LAS float*)(L + WTAB_OFF); S.conv_w = conv_w; S.conv_b = conv_b; S.wv = wave; S.par = 0;
        pg8::EpiUp E{(const LAS float*)(L + TAB_OFF), (const LAS float*)(L + WTAB_OFF), Gb, HF, HL, 0};
        pg8::gemm_phase<pg8::EpiUp, pg8::UpOrder, true, true, true>(L + RING_OFF, g, S, E, wave);
        MK_TAIL((M / 256) * (UP_W / 256));
        if (bx >= first_) { MK_IDS; LAS float* scr = (LAS float*)(L + RING_OFF + wave * 16384);
            for (int it = (bx - first_) * NWAVES + wave; it < I_DN; it += nidle_ * NWAVES) p0_transpose_item(w_down, DFF, D_MODEL, Wdn, D_MODEL, 0, nullptr, scr, it, lane); }
    }
    SEAM(5);
    if (IN(6)) for (int rep_ = 0; rep_ < kReps[6]; ++rep_) { if (rep_) xcd_barrier(bar);
        MK_IDS;
        for (int idx = vcu * NWAVES * 64 + tid; idx < 256 * 2 * (DFF / 4); idx += G * NWAVES * 64) {
            const int n4 = idx % (DFF / 4), gj = idx / (DFF / 4), j = gj & 1, g64 = gj >> 1, n = 4 * n4;
            const int vg = 256 * (n >> 7) + (n & 127);
            f32x4 cc[2];
#pragma unroll
            for (int bj = 0; bj < 2; ++bj) { const int v = vg + 128 * bj;
#define HLD(P, r) ({ const unsigned long long w_ = *(const unsigned long long*)((P) + (size_t)(r) * UP_W + v); (f32x4){__builtin_bit_cast(float, (unsigned)w_ << 16), __builtin_bit_cast(float, (unsigned)w_ & 0xffff0000u), __builtin_bit_cast(float, (unsigned)(w_ >> 32) << 16), __builtin_bit_cast(float, (unsigned)(w_ >> 32) & 0xffff0000u)}; })
                const f32x4 f0 = HLD(HF, g64 * 2 + 0), f1 = HLD(HF, g64 * 2 + 1);
                f32x4 l0 = (f32x4){0.f, 0.f, 0.f, 0.f}, l1 = l0;
                if (g64 & 31) { l0 = HLD(HL, (g64 - 1) * 2 + 0); l1 = HLD(HL, (g64 - 1) * 2 + 1); }
#undef HLD
                const f32x4 um2 = j ? l1 : l0, um1 = j ? f0 : l1, u0 = j ? f1 : f0;
                const float* wp = conv_w + bj * DFF + n;
                cc[bj] = *(const f32x4*)(conv_b + bj * DFF + n) + *(const f32x4*)(wp) * um2 + *(const f32x4*)(wp + UP_W) * um1 + *(const f32x4*)(wp + 2 * UP_W) * u0; }
            float gs[4];
#pragma unroll
            for (int i = 0; i < 4; ++i) { const float gt = cc[0][i]; gs[i] = gt / (1.0f + __expf(-gt)) * cc[1][i]; }
            unsigned long long w = (unsigned long long)pk2(gs[0], gs[1]) | ((unsigned long long)pk2(gs[2], gs[3]) << 32);
            *(unsigned long long*)(Gb + (size_t)(64 * g64 + j) * DFF + n) = w;
        }
    }
    SEAM(6);
    if (IN(7)) {
        pg8::Gemm g{Gb, Wdn, M, D_MODEL, DFF}; pg8::StaticOrder S; S.init(M, D_MODEL, G, bx);
        pg8::EpiDown E{XN, out};
        pg8::gemm_phase<pg8::EpiDown, pg8::StaticOrder, true, true>(L + RING_OFF, g, S, E, wave);
    }
#undef IN
#undef SEAM
}

static int mk_grid() {
    static int grid = 0;
    if (grid == 0) {
        int dev = 0, cus = 0, per_cu = 0;
        if (hipGetDevice(&dev) != hipSuccess || hipDeviceGetAttribute(&cus, hipDeviceAttributeMultiprocessorCount, dev) != hipSuccess) { fprintf(stderr, "kernel_launch: device query failed\n"); grid = -1; return grid; }
        if (hipFuncSetAttribute((const void*)mk_fwd, hipFuncAttributeMaxDynamicSharedMemorySize, LDS_BYTES) != hipSuccess) { fprintf(stderr, "kernel_launch: hipFuncSetAttribute failed\n"); grid = -1; return grid; }
        if (hipOccupancyMaxActiveBlocksPerMultiprocessor(&per_cu, (const void*)mk_fwd, NWAVES * 64, LDS_BYTES) != hipSuccess || per_cu < 1) { fprintf(stderr, "kernel_launch: occupancy query reports %d workgroups per CU\n", per_cu); (void)hipGetLastError(); }
        grid = cus;
    }
    return grid;
}
static void mk_launch(Args a, int lo, int hi, int li, hipStream_t stream) {
    const int grid = mk_grid(); if (grid <= 0) return;
    a.ph_lo = lo; a.ph_hi = hi; a.li = li;
    hipLaunchKernelGGL(mk_fwd, dim3(grid), dim3(NWAVES * 64), LDS_BYTES, stream, a);
}

extern "C" void kernel_launch(void* const* d_in, const int* in_sizes, int n_in, void* d_out, int out_size, void* d_ws, size_t ws_size, hipStream_t stream) {
    const float* pool_w = (const float*)d_in[5]; const float* pool_scale = (const float*)d_in[6];
    unsigned char* ws = (unsigned char*)d_ws;
    bf16_t *VP = (bf16_t*)(ws + WS_VP), *Q = (bf16_t*)(ws + WS_Q), *Kb = (bf16_t*)(ws + WS_K), *Vb = (bf16_t*)(ws + WS_V);
    f16_t *QI = (f16_t*)(ws + WS_QI), *KI = (f16_t*)(ws + WS_KI); float* WI = (float*)(ws + WS_WI);
    unsigned long long* MASK = (unsigned long long*)(ws + WS_MASK); bf16_t* MIX = (bf16_t*)(ws + WS_MIX);
    (void)hipMemsetAsync(ws + WS_CTL, 0, CTL_ZERO_BYTES, stream);
    Args a{};
    for (int i = 0; i < 13; ++i) a.in[i] = (const float*)d_in[i];
    a.out = (float*)d_out; a.ws = ws;
    mk_launch(a, 0, N_PHASES, 0, stream);
}
```

```cpp
#include <hip/hip_runtime.h>
#include <cstdint>
#include <cstdio>

typedef unsigned short bf16_t;
typedef _Float16 f16_t;

constexpr int D_MODEL = 1024, BATCH = 8, SEQ = 2048, M = BATCH * SEQ;
constexpr int POOL_W = 512, NQH = 8, HD = 64, NKV = 2, IH = 8, ID = 32, TOPK = 256;
constexpr int IN_W = 1576, IN_WV = 1792;
constexpr int DFF = 2816, UP_W = 2 * DFF;
constexpr float EPS = 1e-6f;
constexpr float C2 = 0.125f * 1.4426950408889634f;

constexpr size_t MiB = 1u << 20;
constexpr size_t WS_CTL = 0, CTL_ZERO_BYTES = 32768;
constexpr size_t WS_ROPE = 1 * MiB;
constexpr size_t WS_ROPE16 = 1 * MiB + 512 * 1024;
constexpr size_t WS_WIN = 2 * MiB, WS_WOUT = 6 * MiB, WS_WUP = 8 * MiB, WS_WDN = 19 * MiB;
constexpr size_t WS_SS2 = 25 * MiB;
constexpr size_t WS_RSTD2 = 26 * MiB;
constexpr size_t WS_XN = 28 * MiB;
constexpr size_t WS_VP = 60 * MiB, WS_Q = 76 * MiB, WS_K = 92 * MiB, WS_V = 96 * MiB, WS_QI = 100 * MiB, WS_KI = 108 * MiB, WS_WI = 109 * MiB;
constexpr size_t WS_MASK = 110 * MiB, WS_MIX = 114 * MiB;
constexpr size_t WS_G = 146 * MiB;
constexpr size_t WS_HF = 234 * MiB, WS_HL = 240 * MiB;
constexpr int CW_XCCT = 7680;
constexpr int CW_GRP = 0;
constexpr int CW_BAR = 4096;

#define GAS __attribute__((address_space(1)))
#define LAS __attribute__((address_space(3)))
typedef unsigned short bf16;
typedef unsigned v4u __attribute__((ext_vector_type(4)));
typedef float f32x4 __attribute__((ext_vector_type(4)));
typedef short bf16x8 __attribute__((ext_vector_type(8)));
typedef GAS unsigned gu32;
typedef GAS unsigned long long gu64;
#define RLX_AGENT __ATOMIC_RELAXED, __HIP_MEMORY_SCOPE_AGENT
#define LDS_WAIT() asm volatile("s_waitcnt lgkmcnt(0)" ::: "memory")
#define VM_WAIT() asm volatile("s_waitcnt vmcnt(0)" ::: "memory")
__device__ __forceinline__ unsigned long long rt() { return __builtin_amdgcn_s_memrealtime(); }
__device__ __forceinline__ unsigned f2bf(float f) { unsigned u = __builtin_bit_cast(unsigned, f); return (u + 0x7fffu + ((u >> 16) & 1u)) >> 16; }
__device__ __forceinline__ unsigned pk2(float lo, float hi) { return f2bf(lo) | (f2bf(hi) << 16); }

#define XB_TMO      128
#define XB_XCNT(j)  (256  + 64 * (j))
#define XB_XSUB(j)  (1280 + 64 * (j))
#define XB_XGEN(j)  (2304 + 64 * (j))
#define XB_TOP      3328
#define XB_TOPGEN   3392
#define XCD_BAR_WORDS 3456
#define XB_SPIN_CAP (1u << 18)

__device__ __forceinline__ unsigned xb_ld(unsigned* p)              { return __hip_atomic_load(p, __ATOMIC_RELAXED, __HIP_MEMORY_SCOPE_AGENT); }
__device__ __forceinline__ unsigned xb_add(unsigned* p, unsigned v) { return __hip_atomic_fetch_add(p, v, __ATOMIC_RELAXED, __HIP_MEMORY_SCOPE_AGENT); }
__device__ __forceinline__ unsigned xb_xcc_id() { return (unsigned)__builtin_amdgcn_s_getreg((3 << 11) | 20) & 0xFu; }
#define XB_SPIN(cond, bar) do { unsigned _sp = 0; while (cond) { __builtin_amdgcn_s_sleep(1); \
    if ((++_sp & 255u) == 0u) { if (xb_ld(&(bar)[XB_TMO])) break; if (_sp > XB_SPIN_CAP) { atomicAdd(&(bar)[XB_TMO], 1u); break; } } } } while (0)

struct XcdBarrier {
    unsigned* bar; unsigned x;
    volatile LAS unsigned* st;
    bool w0;
};

__device__ __forceinline__ XcdBarrier xcd_barrier_post(unsigned* bar, volatile LAS unsigned* st) {
    XcdBarrier b; b.bar = bar; b.x = xb_xcc_id(); b.st = st;
    if (threadIdx.x == 0) (void)xb_add(&bar[XB_XCNT(b.x)], 1u);
    return b;
}
__device__ __forceinline__ void xcd_barrier_complete(unsigned* bar, unsigned x, unsigned& nloc, unsigned& nx) {
    const unsigned G = gridDim.x * gridDim.y * gridDim.z;
    unsigned sum, cnt, mine, sp = 0u;
    for (;;) {
        sum = 0u; cnt = 0u; mine = 0u;
#pragma unroll
        for (unsigned j = 0; j < 16; ++j) { const unsigned c = xb_ld(&bar[XB_XCNT(j)]); sum += c; cnt += (c > 0u) ? 1u : 0u; mine = (j == x) ? c : mine; }
        if (sum == G) break;
        __builtin_amdgcn_s_sleep(1);
        if ((++sp & 255u) == 0u) { if (xb_ld(&bar[XB_TMO])) break; if (sp > XB_SPIN_CAP) { atomicAdd(&bar[XB_TMO], 1u); break; } }
    }
    nloc = mine > 0u ? mine : 1u; nx = cnt > 0u ? cnt : 1u;
}

__device__ __forceinline__ void xcd_barrier(const XcdBarrier& b) {
    asm volatile("s_waitcnt vmcnt(0)" ::: "memory");
    __syncthreads();
    if (b.w0 && __builtin_amdgcn_mbcnt_hi(~0u, __builtin_amdgcn_mbcnt_lo(~0u, 0u)) == 0u) {
        unsigned* bar = b.bar;
        __builtin_amdgcn_s_waitcnt(0);
        unsigned nloc = b.st[0], nx = b.st[1];
        if (nloc == 0u) { xcd_barrier_complete(bar, b.x, nloc, nx); b.st[0] = nloc; b.st[1] = nx; }
        const unsigned old = xb_add(&bar[XB_XSUB(b.x)], 1u);
        const unsigned gen = old / nloc;
        if (old + 1u == (gen + 1u) * nloc) {
            __builtin_amdgcn_fence(__ATOMIC_RELEASE, "agent");
            asm volatile("s_waitcnt vmcnt(0)" ::: "memory");
            const unsigned og = xb_add(&bar[XB_TOP], 1u);
            const unsigned tg = og / nx;
            if (og + 1u == (tg + 1u) * nx) xb_add(&bar[XB_TOPGEN], 1u);
            else XB_SPIN(xb_ld(&bar[XB_TOPGEN]) == tg, bar);
            __builtin_amdgcn_fence(__ATOMIC_ACQUIRE, "agent");
            xb_add(&bar[XB_XGEN(b.x)], 1u);
            asm volatile("s_waitcnt vmcnt(0)" ::: "memory");
        } else {
            XB_SPIN(xb_ld(&bar[XB_XGEN(b.x)]) == gen, bar);
            __builtin_amdgcn_fence(__ATOMIC_ACQUIRE, "agent");
            asm volatile("s_waitcnt vmcnt(0)" ::: "memory");
        }
    }
    __syncthreads();
}

struct GrpBar { unsigned* cnt; unsigned n; volatile LAS unsigned* st; bool w0; };
__device__ __forceinline__ void grp_barrier(const GrpBar& b) {
    asm volatile("s_waitcnt vmcnt(0)" ::: "memory");
    __syncthreads();
    if (b.w0 && __builtin_amdgcn_mbcnt_hi(~0u, __builtin_amdgcn_mbcnt_lo(~0u, 0u)) == 0u) {
        __builtin_amdgcn_s_waitcnt(0);
        if (b.st[2] != 2u) { __builtin_amdgcn_fence(__ATOMIC_RELEASE, "agent"); asm volatile("s_waitcnt vmcnt(0)" ::: "memory"); }
        const unsigned old = xb_add(b.cnt, 1u), target = (old / b.n + 1u) * b.n;
        unsigned sp = 0u; while (xb_ld(b.cnt) < target) { __builtin_amdgcn_s_sleep(1); if (++sp > (1u << 22)) break; }
        __builtin_amdgcn_fence(__ATOMIC_ACQUIRE, "agent");
        asm volatile("s_waitcnt vmcnt(0)" ::: "memory");
    }
    __syncthreads();
}

__device__ __forceinline__ int mk_lane() { return (int)__builtin_amdgcn_mbcnt_hi(~0u, __builtin_amdgcn_mbcnt_lo(~0u, 0u)); }
__device__ __forceinline__ float bf2f(bf16_t b) { return __builtin_bit_cast(float, (unsigned)b << 16); }
__device__ __forceinline__ float wave_sum(float v) {
#pragma unroll
    for (int o = 1; o < 64; o <<= 1) v += __shfl_xor(v, o);
    return v;
}
__device__ __forceinline__ float wave_max(float v) {
#pragma unroll
    for (int o = 1; o < 64; o <<= 1) v = fmaxf(v, __shfl_xor(v, o));
    return v;
}

__host__ __device__ __forceinline__ int win_actual(int v) {
    const int pn = v >> 8, w = v & 255, bj = w >> 7, wc = (w >> 5) & 3, j = w & 31;
    if (pn < 2) return v;
    if (pn < 5) return 512 + 64 * (4 * (pn - 2) + wc) + 32 * bj + j;
    const int hd = 2 * wc + (j >> 4), d = 16 * bj + (j & 15);
    if (pn == 5) return 1280 + 32 * hd + d;
    if (hd == 0) return 1536 + d;
    if (hd == 1 && d < 8) return 1568 + d;
    return -1;
}
__host__ __device__ __forceinline__ int wup_actual(int v) { const int pn = v >> 8, w = v & 255; return (w >> 7) * DFF + 128 * pn + (w & 127); }

namespace pg8 {
#define PG8_LAS __attribute__((address_space(3)))
typedef unsigned short bf16_t;
typedef short bf16x8 __attribute__((ext_vector_type(8)));
typedef float f32x4 __attribute__((ext_vector_type(4)));
typedef unsigned u32x4 __attribute__((ext_vector_type(4)));
constexpr int BM = 256, BK = 64, HALF = 128, HTB = HALF * BK * 2  , STAGE_BYTES = 8 * HTB, NXCD = 8, WGM = 8;

__host__ __device__ __forceinline__ int lds_byte(int r, int c) { const int st = (r >> 4) * 2 + (c >> 5), rr = r & 15, cc = c & 31, ob = rr * 64 + cc * 2; return st * 1024 + (ob ^ (((ob >> 9) & 1) << 5)); }
__host__ __device__ __forceinline__ void stage_rc(int b, int& R, int& C) { const int st = b / 1024, sb = b % 1024, swz = sb ^ (((sb >> 9) & 1) << 5); R = (st >> 1) * 16 + swz / 64; C = (st & 1) * 32 + (swz % 64) / 2; }
__host__ __device__ __forceinline__ int perm32(int rho) { const int n = rho >> 4, i = rho & 15; return 8 * (i >> 2) + 4 * n + (i & 3); }

struct Unit { int pm, pn; };
struct Gemm { const bf16_t* A; const bf16_t* Bt; int M, N, K; };

struct StaticOrder {
    int nM, nN, nwg, G, c;
    __host__ __device__ void init(int M, int N, int G_, int c_) { nM = M / BM; nN = N / BM; nwg = nM * nN; G = G_; c = c_; }
    __host__ __device__ bool next(int i, Unit& u) const {
        const long L = (long)i * G + c; if (L >= nwg) return false;
        int wgid = (int)L; { const int q = nwg / NXCD, r = nwg % NXCD, xcd = wgid % NXCD, off = wgid / NXCD; wgid = (xcd < r ? xcd * (q + 1) : r * (q + 1) + (xcd - r) * q) + off; }
        const int nig = WGM * nN, gid = wgid / nig, fm = gid * WGM, gsz = (nM - fm) < WGM ? (nM - fm) : WGM;
        u.pm = fm + ((wgid % nig) % gsz); u.pn = (wgid % nig) / gsz; return true;
    }
    __device__ __forceinline__ void a_ready(const Unit&) const {}
    __device__ __forceinline__ void done(const Unit&) const {}
};

__device__ __forceinline__ unsigned cvt_pk_bf16(float lo, float hi) { unsigned r; asm volatile("v_cvt_pk_bf16_f32 %0, %1, %2" : "=v"(r) : "v"(lo), "v"(hi)); return r; }
__device__ __forceinline__ unsigned cvt_pk_f16(float lo, float hi) { return (unsigned)__builtin_bit_cast(unsigned short, (_Float16)lo) | ((unsigned)__builtin_bit_cast(unsigned short, (_Float16)hi) << 16); }
typedef float f32x2 __attribute__((ext_vector_type(2)));
typedef unsigned u32x2 __attribute__((ext_vector_type(2)));
__device__ __forceinline__ u32x4 pack8_bf16(const f32x4 a, const f32x4 b) { u32x4 w; w.x = cvt_pk_bf16(a[0], a[1]); w.y = cvt_pk_bf16(a[2], a[3]); w.z = cvt_pk_bf16(b[0], b[1]); w.w = cvt_pk_bf16(b[2], b[3]); return w; }
__device__ __forceinline__ u32x4 pack8_f16(const f32x4 a, const f32x4 b) { u32x4 w; w.x = cvt_pk_f16(a[0], a[1]); w.y = cvt_pk_f16(a[2], a[3]); w.z = cvt_pk_f16(b[0], b[1]); w.w = cvt_pk_f16(b[2], b[3]); return w; }

struct EpiProj {
    static constexpr bool PERM = true, AFTER_DRAIN = false, HAS_INIT = false;
    bf16_t *VP, *Q, *Kb, *Vb; _Float16 *QI, *KI; float* WI; const float* rope32; const float* rope16; const float *gq, *gk;
    __device__ __forceinline__ void operator()(const f32x4 (&acc)[2][2][4][2], const Unit& u, int wr, int wc, int fr, int fq) const {
        const int pn = u.pn, rowb = u.pm * BM + wr * 64 + fr;
        if (pn < 2) {
#pragma unroll
            for (int ai = 0; ai < 2; ++ai)
#pragma unroll
                for (int m = 0; m < 4; ++m) { bf16_t* rp = VP + (size_t)(rowb + ai * HALF + m * 16) * 512 + pn * 256 + wc * 32 + 8 * fq;
#pragma unroll
                    for (int bj = 0; bj < 2; ++bj) *(u32x4*)(rp + bj * HALF) = pack8_bf16(acc[ai][bj][m][0], acc[ai][bj][m][1]); }
        } else if (pn < 5) {
            if (pn == 4 && wc >= 2) {
#pragma unroll
                for (int ai = 0; ai < 2; ++ai)
#pragma unroll
                    for (int m = 0; m < 4; ++m) { bf16_t* rp = Vb + (size_t)(rowb + ai * HALF + m * 16) * 128 + 64 * (wc - 2) + 8 * fq;
#pragma unroll
                        for (int bj = 0; bj < 2; ++bj) *(u32x4*)(rp + bj * 32) = pack8_bf16(acc[ai][bj][m][0], acc[ai][bj][m][1]); }
            } else {
                const bool isk = (pn == 4); const float* g = isk ? gk : gq; const float osc = isk ? 1.0f : 0.18033688011112042f  ;
                f32x4 gv[2][2];
#pragma unroll
                for (int bj = 0; bj < 2; ++bj)
#pragma unroll
                    for (int n = 0; n < 2; ++n) gv[bj][n] = *(const f32x4*)(g + 32 * bj + 8 * fq + 4 * n);
                bf16_t* dst = isk ? (Kb + 64 * wc) : (Q + 64 * (4 * (pn - 2) + wc)); const int ld = isk ? 128 : 512;
#pragma unroll
                for (int ai = 0; ai < 2; ++ai)
#pragma unroll
                    for (int m = 0; m < 4; ++m) { const int row = rowb + ai * HALF + m * 16, pos = row & 2047;
                        float ss = 0.f;
#pragma unroll
                        for (int bj = 0; bj < 2; ++bj)
#pragma unroll
                            for (int n = 0; n < 2; ++n) { const f32x4 v = acc[ai][bj][m][n]; ss += (v[0] * v[0] + v[1] * v[1]) + (v[2] * v[2] + v[3] * v[3]); }
                        ss += __shfl_xor(ss, 16); ss += __shfl_xor(ss, 32);
                        const float rstd = 1.0f / sqrtf(ss * (1.0f / 64.0f) + 1e-6f);
                        const f32x4* rp = (const f32x4*)(rope32 + (size_t)(pos * 32 + 8 * fq) * 2);
                        f32x4 o1[2], o2[2];
#pragma unroll
                        for (int n = 0; n < 2; ++n) { const f32x4 cs0 = rp[2 * n], cs1 = rp[2 * n + 1];
                            const f32x4 x1 = acc[ai][0][m][n] * rstd * gv[0][n], x2 = acc[ai][1][m][n] * rstd * gv[1][n];
                            const f32x4 c = (f32x4){cs0[0], cs0[2], cs1[0], cs1[2]}, s = (f32x4){cs0[1], cs0[3], cs1[1], cs1[3]};
                            o1[n] = (x1 * c - x2 * s) * osc; o2[n] = (x2 * c + x1 * s) * osc; }
                        bf16_t* op = dst + (size_t)row * ld + 8 * fq;
                        *(u32x4*)(op) = pack8_bf16(o1[0], o1[1]); *(u32x4*)(op + 32) = pack8_bf16(o2[0], o2[1]); }
            }
        } else {
            const int hd = 2 * wc + (fq >> 1);
            if (pn == 6 && wc != 0) return;
            if (pn == 6 && hd == 1) {
                if (fq == 2) {
#pragma unroll
                    for (int ai = 0; ai < 2; ++ai)
#pragma unroll
                        for (int m = 0; m < 4; ++m) { float* wp = WI + (size_t)(rowb + ai * HALF + m * 16) * 8;
                            *(f32x4*)(wp) = acc[ai][0][m][0] * 0.0625f; *(f32x4*)(wp + 4) = acc[ai][0][m][1] * 0.0625f; }
                }
                return;
            }
            _Float16* dst = (pn == 5) ? (QI + 32 * hd) : KI; const int ld = (pn == 5) ? 256 : 32;
#pragma unroll
            for (int ai = 0; ai < 2; ++ai)
#pragma unroll
                for (int m = 0; m < 4; ++m) { const int row = rowb + ai * HALF + m * 16, pos = row & 2047;
                    const f32x4* rp = (const f32x4*)(rope16 + (size_t)(pos * 16 + 8 * (fq & 1)) * 2);
                    f32x4 o1[2], o2[2];
#pragma unroll
                    for (int n = 0; n < 2; ++n) { const f32x4 cs0 = rp[2 * n], cs1 = rp[2 * n + 1];
                        const f32x4 x1 = acc[ai][0][m][n], x2 = acc[ai][1][m][n];
                        const f32x4 c = (f32x4){cs0[0], cs0[2], cs1[0], cs1[2]}, s = (f32x4){cs0[1], cs0[3], cs1[1], cs1[3]};
                        o1[n] = x1 * c - x2 * s; o2[n] = x2 * c + x1 * s; }
                    _Float16* op = dst + (size_t)row * ld + 8 * (fq & 1);
                    *(u32x4*)(op) = pack8_f16(o1[0], o1[1]); *(u32x4*)(op + 16) = pack8_f16(o2[0], o2[1]); }
        }
    }
};

__device__ __forceinline__ f32x4 bf16lo_to_f32(const u32x2 w) { return (f32x4){__builtin_bit_cast(float, w.x << 16), __builtin_bit_cast(float, w.x & 0xffff0000u), __builtin_bit_cast(float, w.y << 16), __builtin_bit_cast(float, w.y & 0xffff0000u)}; }
struct EpiWout {
    static constexpr bool PERM = true, AFTER_DRAIN = false, HAS_INIT = true, NEXT_HOOK = false;
    const float* x; bf16_t* X1B; float* SS2;
    __device__ __forceinline__ void init(f32x4 (&acc)[2][2][4][2], const Unit& u, int wr, int wc, int fr, int fq) const {
        const int rowb = u.pm * BM + wr * 64 + fr, col0 = u.pn * BM + wc * 32 + 8 * fq;
#pragma unroll
        for (int ai = 0; ai < 2; ++ai)
#pragma unroll
            for (int m = 0; m < 4; ++m) { const size_t off = (size_t)(rowb + ai * HALF + m * 16) * 1024 + col0;
#pragma unroll
                for (int bj = 0; bj < 2; ++bj) { acc[ai][bj][m][0] = *(const f32x4*)(x + off + bj * HALF); acc[ai][bj][m][1] = *(const f32x4*)(x + off + bj * HALF + 4); } }
    }
    __device__ __forceinline__ void operator()(const f32x4 (&acc)[2][2][4][2], const Unit& u, int wr, int wc, int fr, int fq) const {
        const int rowb = u.pm * BM + wr * 64 + fr, col0 = u.pn * BM + wc * 32 + 8 * fq;
#pragma unroll
        for (int ai = 0; ai < 2; ++ai)
#pragma unroll
            for (int m = 0; m < 4; ++m) { const int row = rowb + ai * HALF + m * 16; const size_t off = (size_t)row * 1024 + col0; float ss = 0.f;
#pragma unroll
                for (int bj = 0; bj < 2; ++bj) { const f32x4 v0 = acc[ai][bj][m][0], v1 = acc[ai][bj][m][1];
                    ss += (v0[0] * v0[0] + v0[1] * v0[1]) + (v0[2] * v0[2] + v0[3] * v0[3]) + (v1[0] * v1[0] + v1[1] * v1[1]) + (v1[2] * v1[2] + v1[3] * v1[3]);
                    *(u32x4*)(X1B + off + bj * HALF) = pack8_bf16(v0, v1); }
                ss += __shfl_xor(ss, 16); ss += __shfl_xor(ss, 32);
                if (fq == 0) SS2[(size_t)row * 16 + 4 * u.pn + wc] = ss; }
    }
};
struct EpiDown {
    static constexpr bool PERM = true, AFTER_DRAIN = false, HAS_INIT = true, NEXT_HOOK = false;
    const bf16_t* X1B; float* out;
    __device__ __forceinline__ void init(f32x4 (&acc)[2][2][4][2], const Unit& u, int wr, int wc, int fr, int fq) const {
        const int rowb = u.pm * BM + wr * 64 + fr, col0 = u.pn * BM + wc * 32 + 8 * fq;
#pragma unroll
        for (int ai = 0; ai < 2; ++ai) {
            u32x4 hv[4][2];
#pragma unroll
            for (int m = 0; m < 4; ++m) { const size_t off = (size_t)(rowb + ai * HALF + m * 16) * 1024 + col0;
#pragma unroll
                for (int bj = 0; bj < 2; ++bj) hv[m][bj] = *(const u32x4*)(X1B + off + bj * HALF); }
#pragma unroll
            for (int m = 0; m < 4; ++m)
#pragma unroll
                for (int bj = 0; bj < 2; ++bj) { acc[ai][bj][m][0] = bf16lo_to_f32((u32x2){hv[m][bj].x, hv[m][bj].y}); acc[ai][bj][m][1] = bf16lo_to_f32((u32x2){hv[m][bj].z, hv[m][bj].w}); }
        }
    }
    __device__ __forceinline__ void operator()(const f32x4 (&acc)[2][2][4][2], const Unit& u, int wr, int wc, int fr, int fq) const {
        const int rowb = u.pm * BM + wr * 64 + fr, col0 = u.pn * BM + wc * 32 + 8 * fq;
#pragma unroll
        for (int ai = 0; ai < 2; ++ai)
#pragma unroll
            for (int m = 0; m < 4; ++m) { float* p = out + (size_t)(rowb + ai * HALF + m * 16) * 1024 + col0;
#pragma unroll
                for (int bj = 0; bj < 2; ++bj) { *(f32x4*)(p + bj * HALF) = acc[ai][bj][m][0]; *(f32x4*)(p + bj * HALF + 4) = acc[ai][bj][m][1]; } }
    }
};
__device__ __forceinline__ float dpp_shr1(float v) { return __builtin_bit_cast(float, __builtin_amdgcn_update_dpp(0, __builtin_bit_cast(int, v), 0x111, 0xf, 0xf, false)); }
template <class T> __device__ __forceinline__ void stg_u32(void* base, unsigned boff, const T v) { *(T*)((char*)base + boff) = v; }
struct EpiUp {
    static constexpr bool PERM = true, AFTER_DRAIN = false, HAS_INIT = false;
    const PG8_LAS float* tab; const PG8_LAS float* wtab; bf16_t* G; bf16_t* HF; bf16_t* HL; mutable int par;
    __device__ __forceinline__ void operator()(const f32x4 (&acc)[2][2][4][2], const Unit& u, int wr, int wc, int fr_, int fq_) const {
        int fr = fr_, fq = fq_; asm volatile("" : "+v"(fr), "+v"(fq));
        const unsigned cb = 32 * wc + 8 * fq, ncol = 128 * u.pn + cb;
        const PG8_LAS float* tb = tab + par * 256 + wr * 64 + 4 * fr; const PG8_LAS float* wt = wtab + par * 1024 + cb; par ^= 1;
#pragma unroll
        for (int ai = 0; ai < 2; ++ai) {
            const unsigned rg = u.pm * BM + ai * HALF + wr * 64, g64 = rg >> 6;
            const f32x4 rs = *(const PG8_LAS f32x4*)(tb + ai * HALF);
            u32x2 gp[2][4];
            u32x2 hp[2][2][2];
            const bool last_ = (fr == 15);
#pragma unroll
            for (int n = 0; n < 2; ++n) {
                f32x4 cg[4];
#pragma unroll
                for (int bj = 0; bj < 2; ++bj) {
                    const PG8_LAS f32x4* wq = (const PG8_LAS f32x4*)(wt + 128 * bj + 4 * n);
                    const f32x4 w0 = wq[0], w1 = wq[64], w2 = wq[128], bb = wq[192];
                    f32x4 uu[4];
#pragma unroll
                    for (int m = 0; m < 4; ++m) uu[m] = acc[ai][bj][m][n] * rs[m];
#pragma unroll
                    for (int r = 0; r < 2; ++r) { const f32x4 hv = last_ ? uu[2 + r] : uu[r]; hp[bj][r][n] = (u32x2){cvt_pk_bf16(hv[0], hv[1]), cvt_pk_bf16(hv[2], hv[3])}; }
                    f32x4 d2, d3;
#pragma unroll
                    for (int i = 0; i < 4; ++i) { d2[i] = dpp_shr1(uu[2][i]); d3[i] = dpp_shr1(uu[3][i]); }
                    f32x4 c[4];
                    c[0] = bb + w0 * d2 + w1 * d3 + w2 * uu[0];
                    c[1] = bb + w0 * d3 + w1 * uu[0] + w2 * uu[1];
                    c[2] = bb + w0 * uu[0] + w1 * uu[1] + w2 * uu[2];
                    c[3] = bb + w0 * uu[1] + w1 * uu[2] + w2 * uu[3];
#pragma unroll
                    for (int m = 0; m < 4; ++m) {
                        if (bj == 0) cg[m] = c[m];
                        else { f32x4 gsl;
#pragma unroll
                            for (int i = 0; i < 4; ++i) gsl[i] = __builtin_amdgcn_exp2f(-cg[m][i]);
                            gsl = gsl + 1.0f;
#pragma unroll
                            for (int i = 0; i < 4; ++i) gsl[i] = __builtin_amdgcn_rcpf(gsl[i]);
                            gsl = (cg[m] * gsl) * c[m];
                            gp[n][m] = (u32x2){cvt_pk_bf16(gsl[0], gsl[1]), cvt_pk_bf16(gsl[2], gsl[3])}; }
                    }
                }
            }
            if (fr == 0 || last_) { bf16_t* hb = last_ ? HL : HF;
#pragma unroll
                for (int bj = 0; bj < 2; ++bj)
#pragma unroll
                    for (int r = 0; r < 2; ++r) stg_u32<u32x4>(hb, ((g64 * 2u + r) * 5632u + u.pn * 256u + bj * 128u + cb) * 2u, (u32x4){hp[bj][r][0].x, hp[bj][r][0].y, hp[bj][r][1].x, hp[bj][r][1].y}); }
#pragma unroll
            for (int m = 0; m < 4; ++m)
                stg_u32<u32x4>(G, ((rg + 4u * fr + m) * 2816u + ncol) * 2u, (u32x4){gp[0][m].x, gp[0][m].y, gp[1][m].x, gp[1][m].y});
        }
    }
};
struct UpOrder : StaticOrder {
    const float* SS2; PG8_LAS float* tab; PG8_LAS float* wtab; const float* conv_w; const float* conv_b; int wv; mutable int par;
    __device__ __forceinline__ void a_ready(const Unit& u) const {
        const int t = wv * 64 + (int)__builtin_amdgcn_mbcnt_hi(~0u, __builtin_amdgcn_mbcnt_lo(~0u, 0u));
#pragma unroll
        for (int k = 0; k < 2; ++k) { const int idx = t + 512 * k, tap = idx >> 8, v = idx & 255, col = (v >> 7) * 2816 + 128 * u.pn + (v & 127);
            wtab[par * 1024 + idx] = (tap < 3 ? conv_w[tap * 5632 + col] : conv_b[col]) * ((v >> 7) ? 0.6931471805599453f : 1.4426950408889634f); }
        if (t < 256) { const f32x4* sp = (const f32x4*)(SS2 + (size_t)(u.pm * BM + t) * 16); const f32x4 a = sp[0], b = sp[1], c = sp[2], d = sp[3];
            const float s = (((a[0] + a[1]) + (a[2] + a[3])) + ((b[0] + b[1]) + (b[2] + b[3]))) + (((c[0] + c[1]) + (c[2] + c[3])) + ((d[0] + d[1]) + (d[2] + d[3])));
            tab[par * 256 + t] = __builtin_amdgcn_rsqf(s * (1.0f / 1024.0f) + 1e-6f); }
        par ^= 1;
    }
};

template <class Epi, class Sched, bool ALIGN_EPI = false, bool SP2 = false, bool ROWPERM = false>
__device__ __forceinline__ void gemm_phase(PG8_LAS unsigned char* lds, const Gemm g, const Sched& S, const Epi& E, const int wv  ) {
    int tid_ = wv * 64 + (int)__builtin_amdgcn_mbcnt_hi(~0u, __builtin_amdgcn_mbcnt_lo(~0u, 0u)); asm volatile("" : "+v"(tid_));
    const int tid = tid_, wid = __builtin_amdgcn_readfirstlane(tid >> 6), lane = tid & 63, wr = wid >> 2, wc = wid & 3, fr = lane & 15, fq = lane >> 4;
    const int K = g.K, nt = K / BK;
    unsigned voffA[2], voffB[2];
#pragma unroll
    for (int i = 0; i < 2; ++i) { int R, C; stage_rc(tid * 16 + i * 8192, R, C); const int Rb = Epi::PERM ? ((R & ~31) + perm32(R & 31)) : R;
        const int Ra = ROWPERM ? ((R & ~63) + 4 * (R & 15) + ((R >> 4) & 3)) : R;
        voffA[i] = (unsigned)(Ra * K + C) * 2u; voffB[i] = (unsigned)(Rb * K + C) * 2u; }
    const size_t kstep = (size_t)(BK * 2);
    const size_t hstep = (size_t)HALF * K * 2;
    const size_t tstep = 2 * hstep;
    const unsigned ldsw = (unsigned)wid * 1024u;
    const int aoff = lds_byte(wr * 64 + fr, fq * 8), boff = lds_byte(wc * 32 + fr, fq * 8);
#define PG8_SA(b, h) (((b) * 2 + (h)) * HTB)
#define PG8_SB(b, h) ((4 + (b) * 2 + (h)) * HTB)
#define PG8_STAGE(bufoff, gbase, voff) do { _Pragma("unroll") for (int _i = 0; _i < 2; ++_i) \
        __builtin_amdgcn_global_load_lds((const unsigned*)((const char*)(gbase) + (voff)[_i]), (PG8_LAS unsigned*)(lds + (bufoff) + ldsw + _i * 8192), 16, 0, 0); } while (0)
#define PG8_LDA(dst, b, h) do { _Pragma("unroll") for (int m = 0; m < 4; ++m) _Pragma("unroll") for (int k = 0; k < 2; ++k) dst[m][k] = *(const PG8_LAS bf16x8*)(lds + PG8_SA(b, h) + aoff + m * 2048 + k * 1024); } while (0)
#define PG8_LDB(dst, b, h) do { _Pragma("unroll") for (int n = 0; n < 2; ++n) _Pragma("unroll") for (int k = 0; k < 2; ++k) dst[n][k] = *(const PG8_LAS bf16x8*)(lds + PG8_SB(b, h) + boff + n * 2048 + k * 1024); } while (0)
#define PG8_MMA(ai, bj, At, Bt) do { __builtin_amdgcn_s_setprio(1); _Pragma("unroll") for (int m = 0; m < 4; ++m) _Pragma("unroll") for (int n = 0; n < 2; ++n) _Pragma("unroll") for (int k = 0; k < 2; ++k) \
        acc[ai][bj][m][n] = __builtin_amdgcn_mfma_f32_16x16x32_bf16(Bt[n][k], At[m][k], acc[ai][bj][m][n], 0, 0, 0); __builtin_amdgcn_s_setprio(0); } while (0)
#define PG8_WAIT_V(n) asm volatile("s_waitcnt vmcnt(" #n ")" ::: "memory")
#define PG8_WAIT_L(n) asm volatile("s_waitcnt lgkmcnt(" #n ")" ::: "memory")
#define PG8_BAR __builtin_amdgcn_s_barrier()
#define PG8_SCHED __builtin_amdgcn_sched_barrier(0)
    Unit cur, nxt; int ui = 0;
    if (!S.next(0, cur)) return;
    f32x4 acc[2][2][4][2];
    if constexpr (Epi::HAS_INIT) E.init(acc, cur, wr, wc, fr, fq);
    else {
#pragma unroll
    for (int a = 0; a < 2; ++a)
#pragma unroll
        for (int b = 0; b < 2; ++b)
#pragma unroll
            for (int m = 0; m < 4; ++m)
#pragma unroll
                for (int n = 0; n < 2; ++n) acc[a][b][m][n] = (f32x4){0.f, 0.f, 0.f, 0.f};
    }
    bf16x8 At[4][2], B0[2][2], B1[2][2];
    const char* cA = (const char*)g.A + (size_t)cur.pm * tstep; const char* cB = (const char*)g.Bt + (size_t)cur.pn * tstep;
    S.a_ready(cur);
    if constexpr (SP2) {
        PG8_STAGE(PG8_SB(0, 0), cB, voffB); PG8_STAGE(PG8_SB(0, 1), cB + hstep, voffB); PG8_STAGE(PG8_SA(0, 0), cA, voffA); PG8_STAGE(PG8_SA(0, 1), cA + hstep, voffA);
        if (wr == 1) PG8_BAR;
        PG8_WAIT_V(2); PG8_BAR;
        PG8_STAGE(PG8_SB(1, 0), cB + kstep, voffB); PG8_STAGE(PG8_SA(1, 0), cA + kstep, voffA); PG8_STAGE(PG8_SB(1, 1), cB + hstep + kstep, voffB);
        PG8_WAIT_V(6); PG8_BAR;
    } else {
        PG8_STAGE(PG8_SB(0, 0), cB, voffB); PG8_STAGE(PG8_SA(0, 0), cA, voffA); PG8_STAGE(PG8_SB(0, 1), cB + hstep, voffB); PG8_STAGE(PG8_SA(0, 1), cA + hstep, voffA);
        if (wr == 1) PG8_BAR;
        PG8_WAIT_V(4); PG8_BAR;
        PG8_STAGE(PG8_SB(1, 0), cB + kstep, voffB); PG8_STAGE(PG8_SA(1, 0), cA + kstep, voffA); PG8_STAGE(PG8_SB(1, 1), cB + hstep + kstep, voffB);
        PG8_WAIT_V(6); PG8_BAR;
    }
    for (;;) {
        const bool has_next = S.next(ui + 1, nxt);
        const char* nA = has_next ? (const char*)g.A + (size_t)nxt.pm * tstep : cA; const char* nB = has_next ? (const char*)g.Bt + (size_t)nxt.pn * tstep : cB;
        for (int t = 0; t < nt; t += 2) {
            const bool last = (t == nt - 2);
            const char* a1 = cA + (size_t)(t + 1) * kstep;
            const char* a2 = last ? nA : cA + (size_t)(t + 2) * kstep; const char* b2 = last ? nB : cB + (size_t)(t + 2) * kstep;
            const char* a3 = a2 + kstep; const char* b3 = b2 + kstep;
            if (last && has_next) S.a_ready(nxt);
            if constexpr (SP2) {
            PG8_LDB(B0, 0, 0); PG8_LDB(B1, 0, 1); PG8_SCHED; PG8_LDA(At, 0, 0); PG8_STAGE(PG8_SA(1, 1), a1 + hstep, voffA);
            PG8_WAIT_V(8); PG8_WAIT_L(0); PG8_BAR; PG8_MMA(0, 0, At, B0); PG8_MMA(0, 1, At, B1); PG8_BAR; PG8_SCHED;
            PG8_LDA(At, 0, 1); PG8_STAGE(PG8_SB(0, 0), b2, voffB); PG8_STAGE(PG8_SB(0, 1), b2 + hstep, voffB); PG8_STAGE(PG8_SA(0, 0), a2, voffA);
            PG8_WAIT_V(8); PG8_WAIT_L(0); PG8_BAR; PG8_MMA(1, 0, At, B0); PG8_MMA(1, 1, At, B1); PG8_BAR; PG8_SCHED;
            PG8_LDB(B0, 1, 0); PG8_LDB(B1, 1, 1); PG8_SCHED; PG8_LDA(At, 1, 0); PG8_STAGE(PG8_SA(0, 1), a2 + hstep, voffA);
            PG8_WAIT_V(8); PG8_WAIT_L(0); PG8_BAR; PG8_MMA(0, 0, At, B0); PG8_MMA(0, 1, At, B1); PG8_BAR; PG8_SCHED;
            PG8_LDA(At, 1, 1); PG8_STAGE(PG8_SB(1, 0), b3, voffB); PG8_STAGE(PG8_SB(1, 1), b3 + hstep, voffB); PG8_STAGE(PG8_SA(1, 0), a3, voffA);
            PG8_WAIT_V(8); PG8_WAIT_L(0); PG8_BAR; PG8_MMA(1, 0, At, B0); PG8_MMA(1, 1, At, B1); PG8_BAR; PG8_SCHED;
            } else {
            PG8_LDB(B0, 0, 0); PG8_SCHED; PG8_LDA(At, 0, 0); PG8_STAGE(PG8_SA(1, 1), a1 + hstep, voffA);
            PG8_WAIT_L(8); PG8_BAR; PG8_WAIT_L(0); PG8_MMA(0, 0, At, B0); PG8_BAR; PG8_SCHED;
            PG8_LDB(B1, 0, 1); PG8_STAGE(PG8_SB(0, 0), b2, voffB);
            PG8_BAR; PG8_WAIT_L(0); PG8_MMA(0, 1, At, B1); PG8_BAR;
            PG8_LDA(At, 0, 1); PG8_STAGE(PG8_SA(0, 0), a2, voffA);
            PG8_BAR; PG8_WAIT_L(0); PG8_MMA(1, 0, At, B0); PG8_BAR; PG8_SCHED;
            PG8_STAGE(PG8_SB(0, 1), b2 + hstep, voffB);
            PG8_WAIT_V(6); PG8_BAR; PG8_MMA(1, 1, At, B1); PG8_BAR;
            PG8_LDB(B0, 1, 0); PG8_SCHED; PG8_LDA(At, 1, 0); PG8_STAGE(PG8_SA(0, 1), a2 + hstep, voffA);
            PG8_WAIT_L(8); PG8_BAR; PG8_WAIT_L(0); PG8_MMA(0, 0, At, B0); PG8_BAR; PG8_SCHED;
            PG8_LDB(B1, 1, 1); PG8_STAGE(PG8_SB(1, 0), b3, voffB);
            PG8_BAR; PG8_WAIT_L(0); PG8_MMA(0, 1, At, B1); PG8_BAR;
            PG8_LDA(At, 1, 1); PG8_STAGE(PG8_SA(1, 0), a3, voffA);
            PG8_BAR; PG8_WAIT_L(0); PG8_MMA(1, 0, At, B0); PG8_BAR; PG8_SCHED;
            PG8_STAGE(PG8_SB(1, 1), b3 + hstep, voffB);
            PG8_WAIT_V(6); PG8_BAR; PG8_MMA(1, 1, At, B1); PG8_BAR;
            }
        }
        if constexpr (ALIGN_EPI) { if (wr == 0) PG8_BAR; }
        if constexpr (!Epi::AFTER_DRAIN) { E(acc, cur, wr, wc, fr, fq); S.done(cur); }
        if (!has_next) break;
        if constexpr (Epi::HAS_INIT) E.init(acc, nxt, wr, wc, fr, fq);
        else {
#pragma unroll
        for (int a = 0; a < 2; ++a)
#pragma unroll
            for (int b = 0; b < 2; ++b)
#pragma unroll
                for (int m = 0; m < 4; ++m)
#pragma unroll
                    for (int n = 0; n < 2; ++n) acc[a][b][m][n] = (f32x4){0.f, 0.f, 0.f, 0.f};
        }
        cur = nxt; cA = nA; cB = nB; ++ui;
        if constexpr (ALIGN_EPI) { if (wr == 1) PG8_BAR; }
    }
    PG8_WAIT_V(0);
    if constexpr (!ALIGN_EPI) { if (wr == 0) PG8_BAR; }
    PG8_BAR;
    if constexpr (Epi::AFTER_DRAIN) { E.fused(acc, cur, wr, wc, fr, fq, lds, wid, lane); S.done(cur); }
#undef PG8_SA
#undef PG8_SB
#undef PG8_STAGE
#undef PG8_LDA
#undef PG8_LDB
#undef PG8_MMA
#undef PG8_WAIT_V
#undef PG8_WAIT_L
#undef PG8_BAR
#undef PG8_SCHED
}
}

#include <hip/hip_bf16.h>
#include <cmath>
namespace attn_body {
using bf16=__hip_bfloat16;
using bf16x8=__attribute__((ext_vector_type(8)))short;
using s16x4=__attribute__((ext_vector_type(4)))short;
using f32x16=__attribute__((ext_vector_type(16)))float;
using u32x4=__attribute__((ext_vector_type(4)))unsigned;
constexpr int BATCH=8,NHEAD=8,SEQ=2048,D=64,QP=512,KP=128,OP=1024,OOFF=512;
constexpr int NW=8,QBLK=32,QB=QBLK*NW,KVBLK=64,NQB=SEQ/QB;
constexpr int ATTN_UNIT_ROWS=QB;
__device__ __forceinline__ int crow(int r,int hi){return (r&3)+8*(r>>2)+4*hi;}
#define SBAR() __builtin_amdgcn_sched_barrier(0)
__device__ __forceinline__ void cmask(f32x16&p0,f32x16&p1,int jb,int qrel,int hi){
  const float NEG=-INFINITY; int kb=64*jb+4*hi;
  #pragma unroll
  for(int r=0;r<16;++r){int kv=kb+(r&3)+8*(r>>2); if(kv>qrel)p0[r]=NEG; if(kv+32>qrel)p1[r]=NEG;}
}

constexpr int NSLOT=3, SLOTB=8192;
constexpr int LDS_K=0, LDS_V=NSLOT*SLOTB, LDS_WS=2*NSLOT*SLOTB, LDS_OST=LDS_WS+NW*64*4, LDS_BYTES=LDS_OST+NW*4096;
constexpr float C2=0.125f*1.4426950408889634f;
__device__ __forceinline__ void glds16(const void*gsrc,unsigned lds_dst){unsigned keep;
  asm volatile("s_mov_b32 %0, m0\n\ts_mov_b32 m0, %2\n\ts_nop 0\n\tglobal_load_lds_dwordx4 %1, off\n\ts_mov_b32 m0, %0":"=&s"(keep):"v"(gsrc),"s"(lds_dst):"memory");}
__device__ __forceinline__ float max3f(float a,float b,float c){float r;asm("v_max3_f32 %0, %1, %2, %3":"=v"(r):"v"(a),"v"(b),"v"(c));return r;}
__device__ __forceinline__ float max2f(float a,float b){float r;asm("v_max_f32_e32 %0, %1, %2":"=v"(r):"v"(a),"v"(b));return r;}
__device__ __forceinline__ float fadd_s(float a,float b){float r;asm("v_add_f32_e32 %0, %1, %2":"=v"(r):"v"(a),"v"(b));return r;}
__device__ __forceinline__ float fsub_s(float a,float b){float r;asm("v_sub_f32_e32 %0, %1, %2":"=v"(r):"v"(a),"v"(b));return r;}
typedef float f32x2_t __attribute__((ext_vector_type(2))); typedef __bf16 bf16x2_t __attribute__((ext_vector_type(2)));
__device__ __forceinline__ unsigned cvtpk_s(float lo,float hi){f32x2_t v={lo,hi};bf16x2_t b=__builtin_convertvector(v,bf16x2_t);return __builtin_bit_cast(unsigned,b);}
#define WAIT_BAR(N) asm volatile("s_waitcnt vmcnt(" #N ") lgkmcnt(0)\n\ts_barrier":::"memory")

__device__ __forceinline__ void qkt(f32x16&p0,f32x16&p1,const char*Kslot,const bf16x8*qr,const f32x16&negm,int r32,int hi){
  const char*kb=Kslot+hi*1024+r32*16;
  #pragma unroll
  for(int d0=0;d0<4;++d0){
    const bf16x8 b0=*reinterpret_cast<const bf16x8*>(kb+d0*2048);
    const bf16x8 b1=*reinterpret_cast<const bf16x8*>(kb+d0*2048+512);
    if(d0==0){p0=__builtin_amdgcn_mfma_f32_32x32x16_bf16(b0,qr[0],negm,0,0,0);p1=__builtin_amdgcn_mfma_f32_32x32x16_bf16(b1,qr[0],negm,0,0,0);}
    else{p0=__builtin_amdgcn_mfma_f32_32x32x16_bf16(b0,qr[d0],p0,0,0,0);p1=__builtin_amdgcn_mfma_f32_32x32x16_bf16(b1,qr[d0],p1,0,0,0);}}
}
typedef __attribute__((address_space(3))) const char* lds_cptr;
typedef short v4i16_t __attribute__((ext_vector_type(4)));
__device__ __forceinline__ void kload8(bf16x8*kf,lds_cptr kp){
  kf[0]=*(const __attribute__((address_space(3))) bf16x8*)(kp);      kf[1]=*(const __attribute__((address_space(3))) bf16x8*)(kp+512);
  kf[2]=*(const __attribute__((address_space(3))) bf16x8*)(kp+2048); kf[3]=*(const __attribute__((address_space(3))) bf16x8*)(kp+2560);
  kf[4]=*(const __attribute__((address_space(3))) bf16x8*)(kp+4096); kf[5]=*(const __attribute__((address_space(3))) bf16x8*)(kp+4608);
  kf[6]=*(const __attribute__((address_space(3))) bf16x8*)(kp+6144); kf[7]=*(const __attribute__((address_space(3))) bf16x8*)(kp+6656);
}
__device__ __forceinline__ void kload2(bf16x8*kf,lds_cptr kp,int j){ kf[2*j]=*(const __attribute__((address_space(3))) bf16x8*)(kp+j*2048); kf[2*j+1]=*(const __attribute__((address_space(3))) bf16x8*)(kp+j*2048+512); }
__device__ __forceinline__ s16x4 vtr(lds_cptr p){ return __builtin_bit_cast(s16x4,__builtin_amdgcn_ds_read_tr16_b64_v4i16((__attribute__((address_space(3))) v4i16_t*)p)); }
__device__ __forceinline__ float rowmax(const f32x16&p0,const f32x16&p1){
  float a=max3f(p0[0],p0[1],p1[0]),b=max3f(p0[2],p0[3],p1[1]);a=max3f(a,p1[2],p1[3]);
  #pragma unroll
  for(int r=4;r<16;r+=4){a=max3f(a,p0[r],p0[r+1]);b=max3f(b,p0[r+2],p0[r+3]);a=max3f(a,p1[r],p1[r+1]);b=max3f(b,p1[r+2],p1[r+3]);}
  const float m=max2f(a,b);
  auto rr=__builtin_amdgcn_permlane32_swap(__float_as_uint(m),__float_as_uint(m),false,false);
  return max2f(__uint_as_float(rr[0]),__uint_as_float(rr[1]));
}
__device__ __forceinline__ void pv(f32x16*o,int vb,bf16x8 pa0,bf16x8 pa1,bf16x8 pa2,bf16x8 pa3){
  #pragma unroll
  for(int d0=0;d0<2;++d0){s16x4 lo[4],hi[4];
    #pragma unroll
    for(int ks=0;ks<4;++ks){
      asm volatile("ds_read_b64_tr_b16 %0,%1 offset:%c2":"=&v"(lo[ks]):"v"(vb),"i"(d0*4096+ks*1024):"memory");
      asm volatile("ds_read_b64_tr_b16 %0,%1 offset:%c2":"=&v"(hi[ks]):"v"(vb),"i"(d0*4096+ks*1024+512):"memory");}
    asm volatile("s_waitcnt lgkmcnt(0)":::"memory");SBAR();
    #define PK(k) (bf16x8){lo[k][0],lo[k][1],lo[k][2],lo[k][3],hi[k][0],hi[k][1],hi[k][2],hi[k][3]}
    o[d0]=__builtin_amdgcn_mfma_f32_32x32x16_bf16(pa0,PK(0),o[d0],0,0,0);
    o[d0]=__builtin_amdgcn_mfma_f32_32x32x16_bf16(pa1,PK(1),o[d0],0,0,0);
    o[d0]=__builtin_amdgcn_mfma_f32_32x32x16_bf16(pa2,PK(2),o[d0],0,0,0);
    o[d0]=__builtin_amdgcn_mfma_f32_32x32x16_bf16(pa3,PK(3),o[d0],0,0,0);
    #undef PK
  }
}

#ifndef ATTN_STORE16
#define ATTN_STORE16(p,v) (*(u32x4*)(p)=(v))
#endif
template<int THRL> __device__ __forceinline__ void attn_unit(int b,int h,int qb,const bf16*Q,const bf16*__restrict__ K,const bf16*__restrict__ V,const unsigned long long*__restrict__ MASK,bf16*O,char*shm,const int wv){
  int tid_=wv*64+(int)__builtin_amdgcn_mbcnt_hi(~0u,__builtin_amdgcn_mbcnt_lo(~0u,0u)); asm volatile("":"+v"(tid_)); const int tid=tid_,lane=tid&63,r32=lane&31,hi=lane>>5; const int wid=__builtin_amdgcn_readfirstlane(tid>>6);
  const long rowbase=(long)b*SEQ; const int q0=qb*QB;
  const bf16*Qw=Q+(rowbase+q0+wid*QBLK)*QP+h*D;
  const bf16*Kh=K+rowbase*KP+(h>>2)*D,*Vh=V+rowbase*KP+(h>>2)*D;
  const unsigned lds0=(unsigned)(uintptr_t)shm;
  float*wsf=(float*)(shm+LDS_WS)+wid*64;
  const bf16*ksrc=Kh+(long)lane*KP+wid*8;
  const bf16*vsrc=Vh+(long)(16*(wid&3)+(lane>>2))*KP+(wid>>2)*32+(lane&3)*8;
  const unsigned kdst=lds0+LDS_K+wid*1024, vdst=lds0+LDS_V+wid*1024;
  #define DMA_K(t,slot) glds16(ksrc+(long)(t)*KVBLK*KP,(unsigned)__builtin_amdgcn_readfirstlane(kdst+(slot)))
  #define DMA_V(t,slot) glds16(vsrc+(long)(t)*KVBLK*KP,(unsigned)__builtin_amdgcn_readfirstlane(vdst+(slot)))
  const int vb0=(int)(lds0+LDS_V)+((lane>>4)&1)*32+(lane&3)*8+(4*hi+((lane&15)>>2))*64;
  const char*Kbase=shm+LDS_K; bf16x8 kf[8];
  const lds_cptr shm3=(lds_cptr)shm; const lds_cptr kp0=shm3+LDS_K+hi*1024+r32*16; const lds_cptr vp0=shm3+LDS_V+((lane>>4)&1)*32+(lane&3)*8+(4*hi+((lane&15)>>2))*64;
  const int NT=(q0+QB)/KVBLK;
  DMA_K(0,0);DMA_V(0,0);DMA_K(1,SLOTB);
  bf16x8 qr[4];
  #pragma unroll
  for(int d0=0;d0<4;++d0)qr[d0]=*reinterpret_cast<const bf16x8*>(&Qw[(long)r32*QP+d0*16+hi*8]);
  float l_reg=0.f;f32x16 o[2];o[0]=f32x16{};o[1]=f32x16{};const f32x16 negm=f32x16{};
  const int qrel=wid*QBLK+r32;
  const unsigned long long*mrow=MASK+(rowbase+q0+qrel)*(SEQ/64);
  unsigned long long mk=mrow[0];
  #define MKSH(WL,WH,t) unsigned WL=(unsigned)mk>>(4*hi), WH=(unsigned)(mk>>32)>>(4*hi); asm volatile("":"+v"(WL),"+v"(WH)); mk=mrow[(t)+1]
  #define CMASKW(P0,P1,WL,WH) do{ _Pragma("unroll") for(int r=0;r<16;++r){ const int ps_=(r&3)+8*(r>>2); const float a_=P0[r], b_=P1[r]; \
      const unsigned m0_=(unsigned)__builtin_amdgcn_sbfe((int)WL,ps_,1), m1_=(unsigned)__builtin_amdgcn_sbfe((int)WH,ps_,1); \
      const unsigned ua_=(__builtin_bit_cast(unsigned,a_)&m0_)|(0xff800000u&~m0_), ub_=(__builtin_bit_cast(unsigned,b_)&m1_)|(0xff800000u&~m1_); \
      P0[r]=__builtin_bit_cast(float,ua_); P1[r]=__builtin_bit_cast(float,ub_); } }while(0)
  #define START(P0,P1) do{ _Pragma("unroll") for(int r=0;r<16;++r)P0[r]=__builtin_amdgcn_exp2f(P0[r]); }while(0)
  #define RESC() do{}while(0)
  f32x16 pA0,pA1,pB0,pB1;
  int sl_prev=0,sl_cur=0,sl_next=SLOTB;
  #define ROT() do{sl_prev=sl_cur;sl_cur=sl_next;sl_next=(sl_next==(NSLOT-1)*SLOTB)?0:sl_next+SLOTB;}while(0)
  DMA_K(2,2*SLOTB);
  WAIT_BAR(3);
  qkt(pA0,pA1,Kbase,qr,negm,r32,hi);asm volatile("s_nop 15\n\ts_nop 7":"+v"(pA0),"+v"(pA1));{MKSH(wl0_,wh0_,0);CMASKW(pA0,pA1,wl0_,wh0_);}
  START(pA0,pA1);
  _Pragma("unroll") for(int r=0;r<16;++r)pA1[r]=__builtin_amdgcn_exp2f(pA1[r]);
  WAIT_BAR(0);
  DMA_K(3,0);DMA_V(1,SLOTB);
  ROT();
  kload8(kf,kp0+sl_cur);
  WAIT_BAR(2);
  s16x4 vlo[8],vhi[8]; u32x4 pw0,pw1,pw2,pw3;
  #define PKW(P,B) cvtpk_s(P[B],P[B+1])
  #define PAF(k) __builtin_bit_cast(bf16x8,pw##k)
  #define VFR(i) (bf16x8){vlo[i][0],vlo[i][1],vlo[i][2],vlo[i][3],vhi[i][0],vhi[i][1],vhi[i][2],vhi[i][3]}
  #define PIN(x) asm volatile("":"+v"(x))
  #define MX3(a,b,c) __builtin_fmaxf(__builtin_fmaxf((a),(b)),(c))
  #define GAPA(MF,A0,A1,A2,A3,W0,W1,PW) do{ MF; sacc+=A0; sacc+=A1; sacc+=A2; sacc+=A3; PIN(sacc); W0; W1; PIN(PW); SBAR(); }while(0)
  #define EX(v) __builtin_amdgcn_exp2f(v)
  #define GAPB(MF,X,B) do{ MF; X[B]=EX(X[B]); X[B+1]=EX(X[B+1]); X[B+2]=EX(X[B+2]); X[B+3]=EX(X[B+3]); PIN(X); SBAR(); }while(0)
  #define VRD(i) do{ vlo[i]=vtr(vp_+(((i)>>2)*4096+((i)&3)*1024)); vhi[i]=vtr(vp_+(((i)>>2)*4096+((i)&3)*1024+512)); }while(0)
  #define KRD(G,j) do{ if(G){ kload2(kf,kp0+sl_next,j); SBAR(); } }while(0)
  #define STEP(C0,C1,P0,P1,t,GK,GV,GL) do{ SBAR(); \
    const lds_cptr vp_=vp0+sl_prev; \
    VRD(0); SBAR(); float sacc=(P0[0]+P0[1]); \
    GAPA(C0=__builtin_amdgcn_mfma_f32_32x32x16_bf16(kf[0],qr[0],negm,0,0,0), P0[2],P0[3],P0[4],P0[5],     pw0[0]=PKW(P0,0), pw0[1]=PKW(P0,2), pw0); \
    VRD(4); SBAR(); GAPA(C1=__builtin_amdgcn_mfma_f32_32x32x16_bf16(kf[1],qr[0],negm,0,0,0), P0[6],P0[7],P0[8],P0[9],     pw0[2]=PKW(P0,4), pw0[3]=PKW(P0,6), pw0); \
    VRD(1); SBAR(); GAPA(C0=__builtin_amdgcn_mfma_f32_32x32x16_bf16(kf[2],qr[1],C0,0,0,0),   P0[10],P0[11],P0[12],P0[13], pw1[0]=PKW(P0,8), pw1[1]=PKW(P0,10), pw1); \
    VRD(5); SBAR(); GAPA(C1=__builtin_amdgcn_mfma_f32_32x32x16_bf16(kf[3],qr[1],C1,0,0,0),   P0[14],P0[15],P1[0],P1[1],   pw1[2]=PKW(P0,12),pw1[3]=PKW(P0,14), pw1); \
    VRD(2); SBAR(); GAPA(C0=__builtin_amdgcn_mfma_f32_32x32x16_bf16(kf[4],qr[2],C0,0,0,0),   P1[2],P1[3],P1[4],P1[5],     pw2[0]=PKW(P1,0), pw2[1]=PKW(P1,2), pw2); \
    VRD(6); SBAR(); GAPA(C1=__builtin_amdgcn_mfma_f32_32x32x16_bf16(kf[5],qr[2],C1,0,0,0),   P1[6],P1[7],P1[8],P1[9],     pw2[2]=PKW(P1,4), pw2[3]=PKW(P1,6), pw2); \
    VRD(3); SBAR(); GAPA(C0=__builtin_amdgcn_mfma_f32_32x32x16_bf16(kf[6],qr[3],C0,0,0,0),   P1[10],P1[11],P1[12],P1[13], pw3[0]=PKW(P1,8), pw3[1]=PKW(P1,10), pw3); \
    VRD(7); SBAR(); GAPA(C1=__builtin_amdgcn_mfma_f32_32x32x16_bf16(kf[7],qr[3],C1,0,0,0),   P1[14],P1[15],0.f,0.f,       pw3[2]=PKW(P1,12),pw3[3]=PKW(P1,14), pw3); \
    l_reg+=sacc; \
    MKSH(wl_,wh_,t); \
    if(GK){DMA_K((t)+3,sl_cur);} if(GV){DMA_V((t)+1,sl_next);} \
    CMASKW(C0,C1,wl_,wh_); \
    SBAR(); \
    GAPB(o[0]=__builtin_amdgcn_mfma_f32_32x32x16_bf16(PAF(0),VFR(0),o[0],0,0,0), C0,0); \
    GAPB(o[1]=__builtin_amdgcn_mfma_f32_32x32x16_bf16(PAF(0),VFR(4),o[1],0,0,0), C0,4); \
    KRD(GL,0); GAPB(o[0]=__builtin_amdgcn_mfma_f32_32x32x16_bf16(PAF(1),VFR(1),o[0],0,0,0), C0,8); \
    KRD(GL,1); GAPB(o[1]=__builtin_amdgcn_mfma_f32_32x32x16_bf16(PAF(1),VFR(5),o[1],0,0,0), C0,12); \
    KRD(GL,2); GAPB(o[0]=__builtin_amdgcn_mfma_f32_32x32x16_bf16(PAF(2),VFR(2),o[0],0,0,0), C1,0); \
    KRD(GL,3); GAPB(o[1]=__builtin_amdgcn_mfma_f32_32x32x16_bf16(PAF(2),VFR(6),o[1],0,0,0), C1,4); \
    GAPB(o[0]=__builtin_amdgcn_mfma_f32_32x32x16_bf16(PAF(3),VFR(3),o[0],0,0,0), C1,8); \
    GAPB(o[1]=__builtin_amdgcn_mfma_f32_32x32x16_bf16(PAF(3),VFR(7),o[1],0,0,0), C1,12); \
    }while(0)
  int t=1;
  for(;t+5<NT;t+=2){
    STEP(pB0,pB1,pA0,pA1,t,true,true,true);     WAIT_BAR(2); RESC(); ROT();
    STEP(pA0,pA1,pB0,pB1,t+1,true,true,true);   WAIT_BAR(2); RESC(); ROT();
  }
  #define ENDW(tt) do{ if((tt)+3<NT){WAIT_BAR(2);} else if((tt)+2<NT){WAIT_BAR(1);} else {WAIT_BAR(0);} }while(0)
  for(;t+1<NT;t+=2){
    STEP(pB0,pB1,pA0,pA1,t,(t+3<NT),(t+1<NT),(t+1<NT));       ENDW(t);   RESC(); ROT();
    STEP(pA0,pA1,pB0,pB1,t+1,(t+4<NT),(t+2<NT),(t+2<NT));     ENDW(t+1); RESC(); ROT();
  }
  STEP(pB0,pB1,pA0,pA1,NT-1,false,false,false); RESC();
  { float sacc=pB0[0]+pB0[1]; _Pragma("unroll") for(int r=2;r<16;++r)sacc+=pB0[r]; _Pragma("unroll") for(int r=0;r<16;++r)sacc+=pB1[r]; l_reg+=sacc;
    pw0=(u32x4){PKW(pB0,0),PKW(pB0,2),PKW(pB0,4),PKW(pB0,6)};pw1=(u32x4){PKW(pB0,8),PKW(pB0,10),PKW(pB0,12),PKW(pB0,14)};pw2=(u32x4){PKW(pB1,0),PKW(pB1,2),PKW(pB1,4),PKW(pB1,6)};pw3=(u32x4){PKW(pB1,8),PKW(pB1,10),PKW(pB1,12),PKW(pB1,14)};
    SBAR(); pv(o,vb0+sl_cur,PAF(0),PAF(1),PAF(2),PAF(3)); }
  #undef PKW
  #undef PAF
  #undef VFR
  #undef PIN
  #undef MX3
  #undef GAPA
  #undef GAPB
  #undef EX
  #undef VRD
  #undef KRD
  #undef STEP
  #undef ENDW
  {auto rr=__builtin_amdgcn_permlane32_swap(__float_as_uint(l_reg),__float_as_uint(l_reg),false,false);l_reg=__uint_as_float(rr[0])+__uint_as_float(rr[1]);}
  if(hi==0)wsf[32+r32]=l_reg;asm volatile("s_waitcnt lgkmcnt(0)":::"memory");
  float rli[16];
  #pragma unroll
  for(int r=0;r<16;++r)rli[r]=__builtin_amdgcn_rcpf(wsf[32+crow(r,hi)]);
  bf16*Ow=O+(rowbase+q0+wid*QBLK)*OP+OOFF+h*D;
  { bf16*stg=(bf16*)(shm+LDS_OST)+wid*2048;
    #pragma unroll
    for(int r=0;r<16;++r){const int orow=crow(r,hi);
      #pragma unroll
      for(int d0=0;d0<2;++d0)stg[orow*64+d0*32+r32]=__float2bfloat16(o[d0][r]*rli[r]);}
    asm volatile("s_waitcnt lgkmcnt(0)":::"memory");
    #pragma unroll
    for(int i=0;i<4;++i){const int row=i*8+(lane>>3),ch=lane&7; const u32x4 v=*(const u32x4*)(stg+row*64+ch*8); ATTN_STORE16(Ow+(long)row*OP+ch*8,v);} }
  asm volatile("s_waitcnt lgkmcnt(0)\n\ts_barrier":::"memory");
  #undef DMA_K
  #undef DMA_V
  #undef CMASKW
  #undef MKSH
  #undef START
  #undef RESC
  #undef ROT
}
constexpr int ATTN_LDS_BYTES=LDS_BYTES;
struct AttnTensors { const bf16* Q; const bf16* K; const bf16* V; const unsigned long long* MASK; bf16* O; };
struct AttnUnit { int bh; int qb; };
struct StaticOrder {
  int vcu,G;
  __device__ __forceinline__ explicit StaticOrder(int grid,int block):vcu((grid%8==0)?(block%8)*(grid/8)+block/8:block),G(grid){}
  __device__ __forceinline__ bool next(int i,AttnUnit&u)const{ const int it=vcu+(i>>1)*G; if(it>=BATCH*NHEAD*4)return false; const int s=it&3; u.bh=it>>2; u.qb=(i&1)?7-s:s; return true; }
  __device__ __forceinline__ void a_ready(const AttnUnit&)const{}
  __device__ __forceinline__ void done(const AttnUnit&)const{}
};
template<class Sched,int THRL=8> __device__ __forceinline__ void attn_phase(char*lds,const AttnTensors&T,const Sched&S,const int wv){
  AttnUnit u;
  for(int i=0;S.next(i,u);++i){ S.a_ready(u); attn_unit<THRL>(u.bh/NHEAD,u.bh%NHEAD,u.qb,T.Q,T.K,T.V,T.MASK,T.O,lds,wv); S.done(u); }
}
#undef SBAR
#undef WAIT_BAR
}

#ifndef REPS
#define REPS {1, 1, 1, 1, 1, 1, 1, 1}
#endif
constexpr int kReps[8] = REPS;
#ifndef SREPS
#define SREPS {1, 1, 1, 1, 1, 1, 1, 1}
#endif
constexpr int kSub[8] = SREPS;
typedef _Float16 f16x8 __attribute__((ext_vector_type(8)));
typedef float f32x16 __attribute__((ext_vector_type(16)));
__device__ __forceinline__ unsigned score_key(float s) { const unsigned u = __builtin_bit_cast(unsigned, s + 0.0f); return u ^ ((unsigned)((int)u >> 31) | 0x80000000u); }
__device__ __forceinline__ float key_score(unsigned k) { return __builtin_bit_cast(float, (k & 0x80000000u) ? (k & 0x7fffffffu) : ~k); }
__device__ __forceinline__ float wave_sum_f32(float v) {
    v += __builtin_bit_cast(float, __builtin_amdgcn_update_dpp(0, __builtin_bit_cast(int, v), 0xb1, 0xf, 0xf, false));
    v += __builtin_bit_cast(float, __builtin_amdgcn_update_dpp(0, __builtin_bit_cast(int, v), 0x4e, 0xf, 0xf, false));
    v += __builtin_bit_cast(float, __builtin_amdgcn_update_dpp(0, __builtin_bit_cast(int, v), 0x141, 0xf, 0xf, false));
    v += __builtin_bit_cast(float, __builtin_amdgcn_update_dpp(0, __builtin_bit_cast(int, v), 0x140, 0xf, 0xf, false));
    return __builtin_bit_cast(float, __builtin_amdgcn_readlane(__builtin_bit_cast(int, v), 0)) + __builtin_bit_cast(float, __builtin_amdgcn_readlane(__builtin_bit_cast(int, v), 16))
         + __builtin_bit_cast(float, __builtin_amdgcn_readlane(__builtin_bit_cast(int, v), 32)) + __builtin_bit_cast(float, __builtin_amdgcn_readlane(__builtin_bit_cast(int, v), 48));
}
__device__ __forceinline__ int wave_sum_i32(int v) {
    v += __builtin_amdgcn_update_dpp(0, v, 0xb1, 0xf, 0xf, false);
    v += __builtin_amdgcn_update_dpp(0, v, 0x4e, 0xf, 0xf, false);
    v += __builtin_amdgcn_update_dpp(0, v, 0x141, 0xf, 0xf, false);
    v += __builtin_amdgcn_update_dpp(0, v, 0x140, 0xf, 0xf, false);
    return __builtin_amdgcn_readlane(v, 0) + __builtin_amdgcn_readlane(v, 16) + __builtin_amdgcn_readlane(v, 32) + __builtin_amdgcn_readlane(v, 48);
}
__device__ __forceinline__ void count_ge8(unsigned& cnt, unsigned cand, unsigned k0, unsigned k1, unsigned k2, unsigned k3, unsigned k4, unsigned k5, unsigned k6, unsigned k7) {
    unsigned long long m0, m1, m2, m3;
    asm volatile(
        "v_cmp_ge_u32_e64 %1, %5, %13\n\tv_cmp_ge_u32_e64 %2, %6, %13\n\tv_cmp_ge_u32_e64 %3, %7, %13\n\tv_cmp_ge_u32_e64 %4, %8, %13\n\t"
        "v_addc_co_u32_e64 %0, vcc, 0, %0, %1\n\tv_cmp_ge_u32_e64 %1, %9, %13\n\t"
        "v_addc_co_u32_e64 %0, vcc, 0, %0, %2\n\tv_cmp_ge_u32_e64 %2, %10, %13\n\t"
        "v_addc_co_u32_e64 %0, vcc, 0, %0, %3\n\tv_cmp_ge_u32_e64 %3, %11, %13\n\t"
        "v_addc_co_u32_e64 %0, vcc, 0, %0, %4\n\tv_cmp_ge_u32_e64 %4, %12, %13\n\t"
        "v_addc_co_u32_e64 %0, vcc, 0, %0, %1\n\tv_addc_co_u32_e64 %0, vcc, 0, %0, %2\n\tv_addc_co_u32_e64 %0, vcc, 0, %0, %3\n\tv_addc_co_u32_e64 %0, vcc, 0, %0, %4"
        : "+v"(cnt), "=&s"(m0), "=&s"(m1), "=&s"(m2), "=&s"(m3)
        : "v"(k0), "v"(k1), "v"(k2), "v"(k3), "v"(k4), "v"(k5), "v"(k6), "v"(k7), "s"(cand) : "vcc");
}
#define IDX_REP8(X, o) X((o) + 0) X((o) + 1) X((o) + 2) X((o) + 3) X((o) + 4) X((o) + 5) X((o) + 6) X((o) + 7)
template <int NREG>
__device__ __forceinline__ void indexer_task_n(int b, int t0, const f16_t* __restrict__ QI, const f16_t* __restrict__ KI, const float* __restrict__ WI, unsigned long long* __restrict__ MASK, int lane) {
    const int r32 = lane & 31, hi = lane >> 5; const size_t rowb = (size_t)b * SEQ;
    const f16_t* qp = QI + (rowb + t0 + (r32 >> 3)) * 256 + 32 * (r32 & 7) + 8 * hi;
    const f16x8 a0 = *(const f16x8*)(qp), a1 = *(const f16x8*)(qp + 16);
    f32x4 wv[4];
#pragma unroll
    for (int q = 0; q < 4; ++q) wv[q] = *(const f32x4*)(WI + (rowb + t0 + q) * 8 + 4 * hi);
    const int nst = (t0 + 3) / 64 + 1;
    const f16_t* kp = KI + (rowb + r32) * 32 + 8 * hi;
    unsigned key[4][NREG];
    f16x8 bq[3][4];
#pragma unroll
    for (int i = 0; i < 4; ++i) bq[0][i] = *(const f16x8*)(kp + (i >> 1) * 1024 + (i & 1) * 16);
    if (1 < nst) {
#pragma unroll
        for (int i = 0; i < 4; ++i) bq[1][i] = *(const f16x8*)(kp + (size_t)2048 + (i >> 1) * 1024 + (i & 1) * 16); }
#pragma unroll
    for (int st = 0; st < NREG; ++st) {
        if (st < nst) {
            if (st + 2 < NREG && st + 2 < nst) {
#pragma unroll
                for (int i = 0; i < 4; ++i) bq[(st + 2) % 3][i] = *(const f16x8*)(kp + (size_t)(st + 2) * 2048 + (i >> 1) * 1024 + (i & 1) * 16);
            }
            const f32x16 z16 = (f32x16){0.f, 0.f, 0.f, 0.f, 0.f, 0.f, 0.f, 0.f, 0.f, 0.f, 0.f, 0.f, 0.f, 0.f, 0.f, 0.f};
            f32x16 c0 = __builtin_amdgcn_mfma_f32_32x32x16_f16(a0, bq[st % 3][0], z16, 0, 0, 0);
            c0 = __builtin_amdgcn_mfma_f32_32x32x16_f16(a1, bq[st % 3][1], c0, 0, 0, 0);
            f32x16 c1 = __builtin_amdgcn_mfma_f32_32x32x16_f16(a0, bq[st % 3][2], z16, 0, 0, 0);
            c1 = __builtin_amdgcn_mfma_f32_32x32x16_f16(a1, bq[st % 3][3], c1, 0, 0, 0);
#pragma unroll
            for (int q = 0; q < 4; ++q) {
                float pa = 0.f, pb = 0.f;
#pragma unroll
                for (int i = 0; i < 4; ++i) { pa += wv[q][i] * __builtin_amdgcn_fmed3f(c0[4 * q + i], 0.f, __builtin_inff()); pb += wv[q][i] * __builtin_amdgcn_fmed3f(c1[4 * q + i], 0.f, __builtin_inff()); }
                const auto rr = __builtin_amdgcn_permlane32_swap(__builtin_bit_cast(unsigned, pa), __builtin_bit_cast(unsigned, pb), false, false);
                const unsigned rr0 = rr[0], rr1 = rr[1];
                const float sc = __builtin_bit_cast(float, rr0) + __builtin_bit_cast(float, rr1);
                key[q][st] = __builtin_bit_cast(unsigned, sc + 0.0f);
            }
        } else {
#pragma unroll
            for (int q = 0; q < 4; ++q) key[q][st] = 0u;
        }
    }
    const int t0u = __builtin_amdgcn_readfirstlane(t0), nstu = (t0u + 3) / 64 + 1;
    bool done[4], exact[4]; unsigned eq[4], gt[4], cgt[4];
#pragma unroll
    for (int q = 0; q < 4; ++q) { exact[q] = false; done[q] = (t0u + q < TOPK); gt[q] = 0u; cgt[q] = 0u;
        { const int nv_ = (lane <= t0u + q) ? ((t0u + q - lane) >> 6) + 1 : 0; eq[q] = nv_ >= 32 ? 0xffffffffu : ((1u << nv_) - 1u); }
        if (!done[q]) {
#define IDX_PSTAGE(J, SA, SB) _Pragma("unroll") for (int k = 0; k < 32; ++k) if ((k & J) == 0) { const unsigned a_ = key[q][k], b_ = key[q][k + J]; key[q][k] = __builtin_amdgcn_perm(b_, a_, SA); key[q][k + J] = __builtin_amdgcn_perm(b_, a_, SB); if ((k & 3) == 3) __builtin_amdgcn_sched_barrier(0); }
#define IDX_TSTAGE(J, MK) _Pragma("unroll") for (int k = 0; k < 32; ++k) if ((k & J) == 0) { const unsigned a_ = key[q][k], b_ = key[q][k + J]; \
                key[q][k] = (a_ & ~(MK << J)) | ((b_ << J) & (MK << J)); key[q][k + J] = (b_ & ~MK) | ((a_ >> J) & MK); if ((k & 3) == 3) __builtin_amdgcn_sched_barrier(0); }
            IDX_PSTAGE(16, 0x05040100u, 0x07060302u) IDX_PSTAGE(8, 0x06020400u, 0x07030501u) IDX_TSTAGE(4, 0x0f0f0f0fu) IDX_TSTAGE(2, 0x33333333u) IDX_TSTAGE(1, 0x55555555u)
#undef IDX_TSTAGE
#undef IDX_PSTAGE
        } }
#pragma unroll
    for (int b = 31; b >= 0; --b) {
        if (done[0] && done[1] && done[2] && done[3]) break;
        unsigned tb[4], c[4] = {0u, 0u, 0u, 0u};
#pragma unroll
        for (int q = 0; q < 4; ++q) { tb[q] = 0u; if (!done[q]) { unsigned sg_ = key[q][31]; asm volatile("" : "+v"(sg_));
            tb[q] = eq[q] & (b == 31 ? ~sg_ : (key[q][b] ^ sg_)); c[q] = (unsigned)__builtin_popcount(tb[q]) + cgt[q]; } }
        const int c01 = (done[0] && done[1]) ? 0 : wave_sum_i32((int)(c[0] | (c[1] << 16))), c23 = (done[2] && done[3]) ? 0 : wave_sum_i32((int)(c[2] | (c[3] << 16)));
        const int cs[4] = {c01 & 0xffff, c01 >> 16, c23 & 0xffff, c23 >> 16};
#pragma unroll
        for (int q = 0; q < 4; ++q) if (!done[q]) {
            if (cs[q] >= TOPK) { eq[q] = tb[q]; if (cs[q] == TOPK) { gt[q] |= tb[q]; done[q] = true; exact[q] = true; } }
            else { gt[q] |= tb[q]; cgt[q] = c[q]; eq[q] ^= tb[q]; } }
    }
#define IDX_PUTW(bal, st) do { const unsigned long long b_ = (bal); asm volatile("s_nop 1\n\tv_writelane_b32 %0, %2, %4\n\tv_writelane_b32 %1, %3, %4" : "+v"(wlo), "+v"(whi) : "s"((unsigned)b_), "s"((unsigned)(b_ >> 32)), "n"(st));     } while (0)
#pragma unroll
    for (int q = 0; q < 4; ++q) {
        const int t = t0 + q; unsigned wlo = 0u, whi = 0u;
        if (t < TOPK) {
#define IDX_X(st) IDX_PUTW(__ballot(64 * (st) + lane <= t), st);
            IDX_REP8(IDX_X, 0)
#undef IDX_X
        } else {
            const bool ex = exact[q]; const unsigned gsel = gt[q], ties = eq[q]; int need = 0;
            if (!ex) need = TOPK - wave_sum_i32((int)cgt[q]);
            const unsigned long long lt = (1ull << lane) - 1ull;
#define IDX_X(st) { bool sel_ = (gsel >> (st)) & 1u; \
                    if (!ex) { const bool tie_ = (ties >> (st)) & 1u; const unsigned long long tb_ = __ballot(tie_); sel_ = sel_ || (tie_ && __popcll(tb_ & lt) < need); need -= __popcll(tb_); if (need < 0) need = 0; } \
                    IDX_PUTW(__ballot(sel_), st); }
            IDX_REP8(IDX_X, 0)
            if (NREG > 8 && nst > 8) { IDX_REP8(IDX_X, 8) }
            if (NREG > 16 && nst > 16) { IDX_REP8(IDX_X, 16) }
            if (NREG > 24 && nst > 24) { IDX_REP8(IDX_X, 24) }
#undef IDX_X
        }
        if (lane < 32) MASK[(rowb + t) * 32 + lane] = (unsigned long long)wlo | ((unsigned long long)whi << 32);
    }
#undef IDX_PUTW
}
#undef IDX_REP8

constexpr int NWAVES = 8;
constexpr int RING_OFF = 0, RING_BYTES = 131072;
constexpr int LDSCTL_OFF = RING_BYTES, MISC_OFF = LDSCTL_OFF + 320;
constexpr int LDS_BYTES = 147456;
constexpr int TAB_OFF = MISC_OFF + 128;
constexpr int WTAB_OFF = TAB_OFF + 2048;
static_assert(WTAB_OFF + 8192 <= LDS_BYTES, "LDS map");
constexpr int N_PHASES = 8;

struct Args { const float* in[13]; float* out; unsigned char* ws; int ph_lo, ph_hi, li, pad; };

__device__ __forceinline__ void p0_transpose_item(const float* W, int K, int N, bf16_t* WT, int Nv, int mode, const float* kscale, LAS float* scr, int item, int lane) {
    const int nblk = Nv / 32, kb = item / nblk, nb = item % nblk, k0 = 64 * kb, n0 = 32 * nb;
    const int v = n0 + (lane & 31); const int a = mode == 0 ? v : (mode == 1 ? win_actual(v) : wup_actual(v));
    float vals[32];
    const float* wp = W + (size_t)(k0 + (lane >> 5)) * N + (a >= 0 ? a : 0);
#pragma unroll
    for (int i = 0; i < 32; ++i) vals[i] = wp[(size_t)(2 * i) * N];
#pragma unroll
    for (int i = 0; i < 32; ++i) { const int kk = 2 * i + (lane >> 5); float val = (a >= 0) ? vals[i] : 0.f;
        if (kscale) val *= kscale[k0 + kk];
        scr[kk * 33 + (lane & 31)] = val; }
    LDS_WAIT(); asm volatile("" ::: "memory");
    const int c = lane & 7;
#pragma unroll
    for (int j = 0; j < 4; ++j) { const int n = (lane >> 3) + 8 * j; const LAS float* s = scr + (8 * c) * 33 + n;
        v4u o; o.x = pk2(s[0 * 33], s[1 * 33]); o.y = pk2(s[2 * 33], s[3 * 33]); o.z = pk2(s[4 * 33], s[5 * 33]); o.w = pk2(s[6 * 33], s[7 * 33]);
        *(GAS v4u*)(WT + (size_t)(n0 + n) * K + k0 + 8 * c) = o; }
    LDS_WAIT(); asm volatile("" ::: "memory");
}

__global__ void __launch_bounds__(NWAVES * 64, 2) mk_fwd(Args args) {
    extern __shared__ __attribute__((aligned(16))) unsigned char lds[];
    LAS unsigned char* L = (LAS unsigned char*)lds;
    volatile LAS unsigned* MISC = (volatile LAS unsigned*)(L + MISC_OFF);
    const int wave = __builtin_amdgcn_readfirstlane((int)threadIdx.x >> 6);
#define MK_IDS const int lane = mk_lane(), tid = wave * 64 + lane; (void)tid
    const int G = gridDim.x; const int bx = blockIdx.x; const int vcu = (G % 8 == 0) ? (bx % 8) * (G / 8) + bx / 8 : bx;
    unsigned char* ws = args.ws;
    gu32* ctl = (gu32*)(ws + WS_CTL);
    const float* x = args.in[0]; const float* norm1_g = args.in[1]; const float* w_in = args.in[2]; const float* q_norm_g = args.in[3]; const float* k_norm_g = args.in[4];
    const float* w_out = args.in[7]; const float* norm2_g = args.in[8]; const float* w_up = args.in[9]; const float* conv_w = args.in[10]; const float* conv_b = args.in[11]; const float* w_down = args.in[12];
    float* out = args.out;
    float* ROPE = (float*)(ws + WS_ROPE); float* ROPE16 = (float*)(ws + WS_ROPE16);
    bf16_t *Win = (bf16_t*)(ws + WS_WIN), *Wout = (bf16_t*)(ws + WS_WOUT), *Wup = (bf16_t*)(ws + WS_WUP), *Wdn = (bf16_t*)(ws + WS_WDN);
    float* SS2 = (float*)(ws + WS_SS2);
    bf16_t *XN = (bf16_t*)(ws + WS_XN), *VP = (bf16_t*)(ws + WS_VP), *Q = (bf16_t*)(ws + WS_Q), *Kb = (bf16_t*)(ws + WS_K), *Vb = (bf16_t*)(ws + WS_V);
    f16_t *QI = (f16_t*)(ws + WS_QI), *KI = (f16_t*)(ws + WS_KI); float* WI = (float*)(ws + WS_WI);
    bf16_t *MIX = (bf16_t*)(ws + WS_MIX), *Gb = (bf16_t*)(ws + WS_G);
    bf16_t *HF = (bf16_t*)(ws + WS_HF), *HL = (bf16_t*)(ws + WS_HL);
    unsigned long long* MASK = (unsigned long long*)(ws + WS_MASK); const float* pool_w = args.in[5]; const float* pool_scale = args.in[6];

    for (int u = (int)threadIdx.x; u < (LDS_BYTES - LDSCTL_OFF) / 4; u += NWAVES * 64) ((LAS unsigned*)(L + LDSCTL_OFF))[u] = 0u;
    __syncthreads();
    if (threadIdx.x == 0) __hip_atomic_store((unsigned*)ctl + CW_XCCT + bx, 1u + xb_xcc_id(), __ATOMIC_RELAXED, __HIP_MEMORY_SCOPE_AGENT);
    const int ngrp = (G == 256) ? 8 : 1, grp = bx % ngrp, gsz = G / ngrp, member = vcu % gsz;
    GrpBar gbar{(unsigned*)ctl + CW_GRP + 64 * grp, (unsigned)gsz, MISC + 8, wave == 0};
    XcdBarrier bar = xcd_barrier_post((unsigned*)(ctl + CW_BAR) + args.li * XCD_BAR_WORDS, MISC + 8); bar.w0 = (wave == 0);
    const int lo = args.ph_lo, hi = args.ph_hi;
#define IN(k) (lo <= (k) && (k) < hi)
#define SEAM(k) do { if (IN(k) && IN((k) + 1)) { if ((k) == 0) xcd_barrier(bar); else grp_barrier(gbar); } } while (0)
    const int gw = vcu * NWAVES + wave, NGW = G * NWAVES;

    if (IN(0)) for (int rep_ = 0; rep_ < kReps[0]; ++rep_) { if (rep_) xcd_barrier(bar);
        MK_IDS;
        LAS float* scr = (LAS float*)(L + RING_OFF + wave * 16384);
        constexpr int I_IN = (D_MODEL / 64) * (IN_WV / 32), I_OUT = (D_MODEL / 64) * (D_MODEL / 32), I_UP = (D_MODEL / 64) * (UP_W / 32), I_DN = (DFF / 64) * (D_MODEL / 32);
        for (int sr_ = 0; sr_ < kSub[1]; ++sr_)
        for (int item = vcu; item < 4 * (D_MODEL / 16); item += G) {
            const int g = item >> 6, n0 = 16 * (item & 63);
            LAS float* pwL = (LAS float*)(L + RING_OFF); LAS float* woL = pwL + 128 * 132;
#pragma unroll
            for (int k = 0; k < 8; ++k) { const int idx = tid + 512 * k, c = idx >> 5, d4 = idx & 31;
                *(LAS f32x4*)(pwL + c * 132 + 4 * d4) = *(const f32x4*)(pool_w + (size_t)(128 * g + c) * 128 + 4 * d4); }
            { const int d = tid >> 2, q = tid & 3; *(LAS f32x4*)(woL + d * 16 + 4 * q) = *(const f32x4*)(w_out + (size_t)(128 * g + d) * D_MODEL + n0 + 4 * q) * pool_scale[128 * g + d]; }
            __syncthreads();
            const int c = tid & 127, nq = wave >> 1;
            f32x4 acc4 = (f32x4){0.f, 0.f, 0.f, 0.f};
#pragma unroll 8
            for (int d4 = 0; d4 < 32; ++d4) { const f32x4 p = *(const LAS f32x4*)(pwL + c * 132 + 4 * d4);
#pragma unroll
                for (int i = 0; i < 4; ++i) acc4 += p[i] * *(const LAS f32x4*)(woL + (4 * d4 + i) * 16 + 4 * nq); }
#pragma unroll
            for (int j = 0; j < 4; ++j) Wout[(size_t)(n0 + 4 * nq + j) * D_MODEL + 128 * g + c] = (bf16_t)f2bf(acc4[j]);
            __syncthreads();
        }
        for (int sr_ = 0; sr_ < kSub[0]; ++sr_)
        for (int it = gw; it < I_IN + I_OUT + I_UP + I_DN; it += NGW) {
            int r = it;
            if (r < I_IN) { p0_transpose_item(w_in, D_MODEL, IN_W, Win, IN_WV, 1, nullptr, scr, r, lane); continue; } r -= I_IN;
            if (r < I_OUT) { if (r >= 8 * (D_MODEL / 32)) p0_transpose_item(w_out, D_MODEL, D_MODEL, Wout, D_MODEL, 0, nullptr, scr, r, lane); continue; } r -= I_OUT;
            if (r < I_UP) { p0_transpose_item(w_up, D_MODEL, UP_W, Wup, UP_W, 2, norm2_g, scr, r, lane); continue; } r -= I_UP;
            p0_transpose_item(w_down, DFF, D_MODEL, Wdn, D_MODEL, 0, nullptr, scr, r, lane);
        }
        for (int sr_ = 0; sr_ < kSub[2]; ++sr_)
        for (int i = vcu * NWAVES * 64 + tid; i < SEQ * 48; i += G * NWAVES * 64) {
            int pos, k; float inv; float* dst;
            if (i < SEQ * 32) { pos = i >> 5; k = i & 31; inv = expf(-logf(10000.0f) * (float)k / 32.0f); dst = ROPE + 2 * i; }
            else { const int i2 = i - SEQ * 32; pos = i2 >> 4; k = i2 & 15; inv = expf(-logf(10000.0f) * (float)k / 16.0f); dst = ROPE16 + 2 * i2; }
            float s, c; sincosf((float)pos * inv, &s, &c); dst[0] = c; dst[1] = s;
        }
        for (int sr_ = 0; sr_ < kSub[3]; ++sr_)
        for (int m4 = gw; m4 < M / 4; m4 += NGW) {
            f32x4 v[4][4]; float ssq[4];
#pragma unroll
            for (int r = 0; r < 4; ++r) { const GAS f32x4* xr = (const GAS f32x4*)(x + (size_t)(4 * m4 + r) * D_MODEL) + lane;
#pragma unroll
                for (int j = 0; j < 4; ++j) v[r][j] = xr[64 * j]; }
#pragma unroll
            for (int r = 0; r < 4; ++r) { float s = 0.f;
#pragma unroll
                for (int j = 0; j < 4; ++j) s += (v[r][j].x * v[r][j].x + v[r][j].y * v[r][j].y) + (v[r][j].z * v[r][j].z + v[r][j].w * v[r][j].w);
                ssq[r] = s; }
#pragma unroll
            for (int o = 1; o < 64; o <<= 1) {
#pragma unroll
                for (int r = 0; r < 4; ++r) ssq[r] += __shfl_xor(ssq[r], o); }
#pragma unroll
            for (int r = 0; r < 4; ++r) { const float rstd = 1.0f / sqrtf(ssq[r] * (1.0f / D_MODEL) + EPS);
                GAS unsigned long long* o8 = (GAS unsigned long long*)(XN + (size_t)(4 * m4 + r) * D_MODEL) + lane;
#pragma unroll
                for (int j = 0; j < 4; ++j) { const f32x4 gg = ((const f32x4*)norm1_g)[lane + 64 * j];
                    o8[64 * j] = (unsigned long long)pk2(v[r][j].x * rstd * gg.x, v[r][j].y * rstd * gg.y) | ((unsigned long long)pk2(v[r][j].z * rstd * gg.z, v[r][j].w * rstd * gg.w) << 32); } }
        }
    }
    SEAM(0);
    if (wave == 0) {
        const int l = mk_lane(); const unsigned mine = __hip_atomic_load((unsigned*)ctl + CW_XCCT + bx, __ATOMIC_RELAXED, __HIP_MEMORY_SCOPE_AGENT);
        bool ok = (ngrp == 8) && mine != 0u;
        for (int m = l; m < gsz; m += 64) ok = ok && (__hip_atomic_load((unsigned*)ctl + CW_XCCT + grp + ngrp * m, __ATOMIC_RELAXED, __HIP_MEMORY_SCOPE_AGENT) == mine);
        const bool same = __all(ok);
        if (l == 0) MISC[10] = same ? 2u : 1u;
    }
    if (IN(1)) for (int rep_ = 0; rep_ < kReps[1]; ++rep_) { if (rep_) xcd_barrier(bar);
        pg8::Gemm g{XN, Win, M, IN_WV, D_MODEL}; pg8::StaticOrder S; S.init(M, IN_WV, G, bx);
        pg8::EpiProj E{VP, Q, Kb, Vb, QI, KI, WI, ROPE, ROPE16, q_norm_g, k_norm_g};
        pg8::gemm_phase<pg8::EpiProj, pg8::StaticOrder, true, true>(L + RING_OFF, g, S, E, wave);
    }
    SEAM(1);
    if (IN(2)) for (int rep_ = 0; rep_ < kReps[2]; ++rep_) { if (rep_) xcd_barrier(bar);
        MK_IDS;
        for (int sr_ = 0; sr_ < kSub[4]; ++sr_)
        for (int wj = member * NWAVES + wave; wj < M / 4 / ngrp; wj += gsz * NWAVES) { const int wi = grp * (M / 4 / ngrp) + wj;
            const int row = 4 * wi + (lane >> 4), t = row & (SEQ - 1);
            const bf16_t* vp = VP + (size_t)row * POOL_W + 8 * (lane & 15);
            v4u u2[2], u4[4], u8[8], u16[16];
#define POOL_LD(U, W, g) _Pragma("unroll") for (int k = 0; k < W; ++k) U[k] = *(const v4u*)(vp + 128 * (g) - (size_t)((k <= t) ? k : 0) * POOL_W);
            POOL_LD(u2, 2, 0) POOL_LD(u4, 4, 1) POOL_LD(u8, 8, 2) POOL_LD(u16, 16, 3)
#undef POOL_LD
#define POOL_OUT(U, W, g) do { float sum[8], v0[8]; \
                _Pragma("unroll") for (int e = 0; e < 8; ++e) sum[e] = 0.f; \
                _Pragma("unroll") for (int k = 0; k < W; ++k) { const float m_ = (k <= t) ? 1.f : 0.f; const unsigned uu[4] = {U[k].x, U[k].y, U[k].z, U[k].w}; \
                    _Pragma("unroll") for (int e = 0; e < 4; ++e) { const float lo = __builtin_bit_cast(float, uu[e] << 16), hh = __builtin_bit_cast(float, uu[e] & 0xffff0000u); sum[2 * e] += m_ * lo; sum[2 * e + 1] += m_ * hh; \
                        if (k == 0) { v0[2 * e] = lo; v0[2 * e + 1] = hh; } } } \
                const float rc = 1.0f / (float)((t + 1 < W) ? t + 1 : W); \
                v4u o; o.x = pk2(sum[0] * rc - v0[0], sum[1] * rc - v0[1]); o.y = pk2(sum[2] * rc - v0[2], sum[3] * rc - v0[3]); o.z = pk2(sum[4] * rc - v0[4], sum[5] * rc - v0[5]); o.w = pk2(sum[6] * rc - v0[6], sum[7] * rc - v0[7]); \
                *(v4u*)(MIX + (size_t)row * 1024 + 128 * (g) + 8 * (lane & 15)) = o; } while (0)
            POOL_OUT(u2, 2, 0); POOL_OUT(u4, 4, 1); POOL_OUT(u8, 8, 2); POOL_OUT(u16, 16, 3);
#undef POOL_OUT
        }
        for (int sr_ = 0; sr_ < kSub[5]; ++sr_)
        for (int id = gw; id < M / 4; id += NGW) {
            const int w = id & 2047, bb = w >> 8, tq = (id < 2048) ? (w & 255) : 511 - (w & 255);
            indexer_task_n<32>(bb, 4 * tq, QI, KI, WI, MASK, lane);
        }
    }
    SEAM(2);
    if (IN(3)) for (int rep_ = 0; rep_ < kReps[3]; ++rep_) { if (rep_) xcd_barrier(bar);
        const attn_body::AttnTensors AT{(const attn_body::bf16*)Q, (const attn_body::bf16*)Kb, (const attn_body::bf16*)Vb, MASK, (attn_body::bf16*)MIX};
        const attn_body::StaticOrder S((int)G, (int)bx);
        attn_body::attn_phase<attn_body::StaticOrder>((char*)lds + RING_OFF, AT, S, wave);
    }
    SEAM(3);
    if (IN(4)) for (int rep_ = 0; rep_ < kReps[4]; ++rep_) { if (rep_) xcd_barrier(bar);
        pg8::Gemm g{MIX, Wout, M, D_MODEL, D_MODEL}; pg8::StaticOrder S; S.init(M, D_MODEL, G, bx);
        pg8::EpiWout E{x, XN, SS2};
        pg8::gemm_phase<pg8::EpiWout, pg8::StaticOrder, true, true>(L + RING_OFF, g, S, E, wave);
    }
    SEAM(4);
    if (IN(5)) for (int rep_ = 0; rep_ < kReps[5]; ++rep_) { if (rep_) xcd_barrier(bar);
        pg8::Gemm g{XN, Wup, M, UP_W, D_MODEL}; pg8::UpOrder S; S.init(M, UP_W, G, bx); S.SS2 = SS2; S.tab = (LAS float*)(L + TAB_OFF); S.wtab = (LAS float*)(L + WTAB_OFF); S.conv_w = conv_w; S.conv_b = conv_b; S.wv = wave; S.par = 0;
        pg8::EpiUp E{(const LAS float*)(L + TAB_OFF), (const LAS float*)(L + WTAB_OFF), Gb, HF, HL, 0};
        pg8::gemm_phase<pg8::EpiUp, pg8::UpOrder, true, true, true>(L + RING_OFF, g, S, E, wave);
    }
    SEAM(5);
    if (IN(6)) for (int rep_ = 0; rep_ < kReps[6]; ++rep_) { if (rep_) xcd_barrier(bar);
        MK_IDS;
        for (int il = member * NWAVES * 64 + tid; il < (256 / ngrp) * 2 * (DFF / 4); il += gsz * NWAVES * 64) { const int idx = grp * ((256 / ngrp) * 2 * (DFF / 4)) + il;
            const int n4 = idx % (DFF / 4), gj = idx / (DFF / 4), j = gj & 1, g64 = gj >> 1, n = 4 * n4;
            const int vg = 256 * (n >> 7) + (n & 127);
            f32x4 cc[2];
#pragma unroll
            for (int bj = 0; bj < 2; ++bj) { const int v = vg + 128 * bj;
#define HLD(P, r) ({ const unsigned long long w_ = *(const unsigned long long*)((P) + (size_t)(r) * UP_W + v); (f32x4){__builtin_bit_cast(float, (unsigned)w_ << 16), __builtin_bit_cast(float, (unsigned)w_ & 0xffff0000u), __builtin_bit_cast(float, (unsigned)(w_ >> 32) << 16), __builtin_bit_cast(float, (unsigned)(w_ >> 32) & 0xffff0000u)}; })
                const f32x4 f0 = HLD(HF, g64 * 2 + 0), f1 = HLD(HF, g64 * 2 + 1);
                f32x4 l0 = (f32x4){0.f, 0.f, 0.f, 0.f}, l1 = l0;
                if (g64 & 31) { l0 = HLD(HL, (g64 - 1) * 2 + 0); l1 = HLD(HL, (g64 - 1) * 2 + 1); }
#undef HLD
                const f32x4 um2 = j ? l1 : l0, um1 = j ? f0 : l1, u0 = j ? f1 : f0;
                const float* wp = conv_w + bj * DFF + n;
                cc[bj] = *(const f32x4*)(conv_b + bj * DFF + n) + *(const f32x4*)(wp) * um2 + *(const f32x4*)(wp + UP_W) * um1 + *(const f32x4*)(wp + 2 * UP_W) * u0; }
            float gs[4];
#pragma unroll
            for (int i = 0; i < 4; ++i) { const float gt = cc[0][i]; gs[i] = gt / (1.0f + __expf(-gt)) * cc[1][i]; }
            unsigned long long w = (unsigned long long)pk2(gs[0], gs[1]) | ((unsigned long long)pk2(gs[2], gs[3]) << 32);
            *(unsigned long long*)(Gb + (size_t)(64 * g64 + j) * DFF + n) = w;
        }
    }
    SEAM(6);
    if (IN(7)) {
        pg8::Gemm g{Gb, Wdn, M, D_MODEL, DFF}; pg8::StaticOrder S; S.init(M, D_MODEL, G, bx);
        pg8::EpiDown E{XN, out};
        pg8::gemm_phase<pg8::EpiDown, pg8::StaticOrder, true, true>(L + RING_OFF, g, S, E, wave);
    }
#undef IN
#undef SEAM
}

static int mk_grid() {
    static int grid = 0;
    if (grid == 0) {
        int dev = 0, cus = 0, per_cu = 0;
        if (hipGetDevice(&dev) != hipSuccess || hipDeviceGetAttribute(&cus, hipDeviceAttributeMultiprocessorCount, dev) != hipSuccess) { fprintf(stderr, "kernel_launch: device query failed\n"); grid = -1; return grid; }
        if (hipFuncSetAttribute((const void*)mk_fwd, hipFuncAttributeMaxDynamicSharedMemorySize, LDS_BYTES) != hipSuccess) { fprintf(stderr, "kernel_launch: hipFuncSetAttribute failed\n"); grid = -1; return grid; }
        if (hipOccupancyMaxActiveBlocksPerMultiprocessor(&per_cu, (const void*)mk_fwd, NWAVES * 64, LDS_BYTES) != hipSuccess || per_cu < 1) { fprintf(stderr, "kernel_launch: occupancy query reports %d workgroups per CU\n", per_cu); (void)hipGetLastError(); }
        grid = cus;
    }
    return grid;
}
static void mk_launch(Args a, int lo, int hi, int li, hipStream_t stream) {
    const int grid = mk_grid(); if (grid <= 0) return;
    a.ph_lo = lo; a.ph_hi = hi; a.li = li;
    hipLaunchKernelGGL(mk_fwd, dim3(grid), dim3(NWAVES * 64), LDS_BYTES, stream, a);
}

extern "C" void kernel_launch(void* const* d_in, const int* in_sizes, int n_in, void* d_out, int out_size, void* d_ws, size_t ws_size, hipStream_t stream) {
    const float* pool_w = (const float*)d_in[5]; const float* pool_scale = (const float*)d_in[6];
    unsigned char* ws = (unsigned char*)d_ws;
    bf16_t *VP = (bf16_t*)(ws + WS_VP), *Q = (bf16_t*)(ws + WS_Q), *Kb = (bf16_t*)(ws + WS_K), *Vb = (bf16_t*)(ws + WS_V);
    f16_t *QI = (f16_t*)(ws + WS_QI), *KI = (f16_t*)(ws + WS_KI); float* WI = (float*)(ws + WS_WI);
    unsigned long long* MASK = (unsigned long long*)(ws + WS_MASK); bf16_t* MIX = (bf16_t*)(ws + WS_MIX);
    (void)hipMemsetAsync(ws + WS_CTL, 0, CTL_ZERO_BYTES, stream);
    Args a{};
    for (int i = 0; i < 13; ++i) a.in[i] = (const float*)d_in[i];
    a.out = (float*)d_out; a.ws = ws;
    mk_launch(a, 0, N_PHASES, 0, stream);
}
```

```cpp
#include <hip/hip_runtime.h>
#include <cstdint>
#include <cstdio>

typedef unsigned short bf16_t;
typedef _Float16 f16_t;

constexpr int D_MODEL = 1024, BATCH = 8, SEQ = 2048, M = BATCH * SEQ;
constexpr int POOL_W = 512, NQH = 8, HD = 64, NKV = 2, IH = 8, ID = 32, TOPK = 256;
constexpr int IN_W = 1576, IN_WV = 1792;
constexpr int DFF = 2816, UP_W = 2 * DFF;
constexpr float EPS = 1e-6f;
constexpr float C2 = 0.125f * 1.4426950408889634f;

constexpr size_t MiB = 1u << 20;
constexpr size_t WS_CTL = 0, CTL_ZERO_BYTES = 32768;
constexpr size_t WS_ROPE = 1 * MiB;
constexpr size_t WS_ROPE16 = 1 * MiB + 512 * 1024;
constexpr size_t WS_WIN = 2 * MiB, WS_WOUT = 6 * MiB, WS_WUP = 8 * MiB, WS_WDN = 19 * MiB;
constexpr size_t WS_SS2 = 25 * MiB;
constexpr size_t WS_RSTD2 = 26 * MiB;
constexpr size_t WS_XN = 28 * MiB;
constexpr size_t WS_VP = 60 * MiB, WS_Q = 76 * MiB, WS_K = 92 * MiB, WS_V = 96 * MiB, WS_QI = 100 * MiB, WS_KI = 108 * MiB, WS_WI = 109 * MiB;
constexpr size_t WS_MASK = 110 * MiB, WS_MIX = 114 * MiB;
constexpr size_t WS_G = 146 * MiB;
constexpr size_t WS_HF = 234 * MiB, WS_HL = 240 * MiB;
constexpr int CW_XCCT = 7680;
constexpr int CW_GRP = 0;
constexpr int CW_BAR = 4096;

#define GAS __attribute__((address_space(1)))
#define LAS __attribute__((address_space(3)))
typedef unsigned short bf16;
typedef unsigned v4u __attribute__((ext_vector_type(4)));
typedef float f32x4 __attribute__((ext_vector_type(4)));
typedef short bf16x8 __attribute__((ext_vector_type(8)));
typedef GAS unsigned gu32;
typedef GAS unsigned long long gu64;
#define RLX_AGENT __ATOMIC_RELAXED, __HIP_MEMORY_SCOPE_AGENT
#define LDS_WAIT() asm volatile("s_waitcnt lgkmcnt(0)" ::: "memory")
#define VM_WAIT() asm volatile("s_waitcnt vmcnt(0)" ::: "memory")
__device__ __forceinline__ unsigned long long rt() { return __builtin_amdgcn_s_memrealtime(); }
__device__ __forceinline__ unsigned f2bf(float f) { unsigned u = __builtin_bit_cast(unsigned, f); return (u + 0x7fffu + ((u >> 16) & 1u)) >> 16; }
__device__ __forceinline__ unsigned pk2(float lo, float hi) { return f2bf(lo) | (f2bf(hi) << 16); }

#define XB_TMO      128
#define XB_XCNT(j)  (256  + 64 * (j))
#define XB_XSUB(j)  (1280 + 64 * (j))
#define XB_XGEN(j)  (2304 + 64 * (j))
#define XB_TOP      3328
#define XB_TOPGEN   3392
#define XCD_BAR_WORDS 3456
#define XB_SPIN_CAP (1u << 18)

__device__ __forceinline__ unsigned xb_ld(unsigned* p)              { return __hip_atomic_load(p, __ATOMIC_RELAXED, __HIP_MEMORY_SCOPE_AGENT); }
__device__ __forceinline__ unsigned xb_add(unsigned* p, unsigned v) { return __hip_atomic_fetch_add(p, v, __ATOMIC_RELAXED, __HIP_MEMORY_SCOPE_AGENT); }
__device__ __forceinline__ unsigned xb_xcc_id() { return (unsigned)__builtin_amdgcn_s_getreg((3 << 11) | 20) & 0xFu; }
#define XB_SPIN(cond, bar) do { unsigned _sp = 0; while (cond) { __builtin_amdgcn_s_sleep(1); \
    if ((++_sp & 255u) == 0u) { if (xb_ld(&(bar)[XB_TMO])) break; if (_sp > XB_SPIN_CAP) { atomicAdd(&(bar)[XB_TMO], 1u); break; } } } } while (0)

struct XcdBarrier {
    unsigned* bar; unsigned x;
    volatile LAS unsigned* st;
    bool w0;
};

__device__ __forceinline__ XcdBarrier xcd_barrier_post(unsigned* bar, volatile LAS unsigned* st) {
    XcdBarrier b; b.bar = bar; b.x = xb_xcc_id(); b.st = st;
    if (threadIdx.x == 0) (void)xb_add(&bar[XB_XCNT(b.x)], 1u);
    return b;
}
__device__ __forceinline__ void xcd_barrier_complete(unsigned* bar, unsigned x, unsigned& nloc, unsigned& nx) {
    const unsigned G = gridDim.x * gridDim.y * gridDim.z;
    unsigned sum, cnt, mine, sp = 0u;
    for (;;) {
        sum = 0u; cnt = 0u; mine = 0u;
#pragma unroll
        for (unsigned j = 0; j < 16; ++j) { const unsigned c = xb_ld(&bar[XB_XCNT(j)]); sum += c; cnt += (c > 0u) ? 1u : 0u; mine = (j == x) ? c : mine; }
        if (sum == G) break;
        __builtin_amdgcn_s_sleep(1);
        if ((++sp & 255u) == 0u) { if (xb_ld(&bar[XB_TMO])) break; if (sp > XB_SPIN_CAP) { atomicAdd(&bar[XB_TMO], 1u); break; } }
    }
    nloc = mine > 0u ? mine : 1u; nx = cnt > 0u ? cnt : 1u;
}

__device__ __forceinline__ void xcd_barrier(const XcdBarrier& b) {
    asm volatile("s_waitcnt vmcnt(0)" ::: "memory");
    __syncthreads();
    if (b.w0 && __builtin_amdgcn_mbcnt_hi(~0u, __builtin_amdgcn_mbcnt_lo(~0u, 0u)) == 0u) {
        unsigned* bar = b.bar;
        __builtin_amdgcn_s_waitcnt(0);
        unsigned nloc = b.st[0], nx = b.st[1];
        if (nloc == 0u) { xcd_barrier_complete(bar, b.x, nloc, nx); b.st[0] = nloc; b.st[1] = nx; }
        const unsigned old = xb_add(&bar[XB_XSUB(b.x)], 1u);
        const unsigned gen = old / nloc;
        if (old + 1u == (gen + 1u) * nloc) {
            __builtin_amdgcn_fence(__ATOMIC_RELEASE, "agent");
            asm volatile("s_waitcnt vmcnt(0)" ::: "memory");
            const unsigned og = xb_add(&bar[XB_TOP], 1u);
            const unsigned tg = og / nx;
            if (og + 1u == (tg + 1u) * nx) xb_add(&bar[XB_TOPGEN], 1u);
            else XB_SPIN(xb_ld(&bar[XB_TOPGEN]) == tg, bar);
            __builtin_amdgcn_fence(__ATOMIC_ACQUIRE, "agent");
            xb_add(&bar[XB_XGEN(b.x)], 1u);
            asm volatile("s_waitcnt vmcnt(0)" ::: "memory");
        } else {
            XB_SPIN(xb_ld(&bar[XB_XGEN(b.x)]) == gen, bar);
            __builtin_amdgcn_fence(__ATOMIC_ACQUIRE, "agent");
            asm volatile("s_waitcnt vmcnt(0)" ::: "memory");
        }
    }
    __syncthreads();
}

struct GrpBar { unsigned* cnt; unsigned n; volatile LAS unsigned* st; bool w0; };
__device__ __forceinline__ void grp_barrier(const GrpBar& b) {
    asm volatile("s_waitcnt vmcnt(0)" ::: "memory");
    __syncthreads();
    if (b.w0 && __builtin_amdgcn_mbcnt_hi(~0u, __builtin_amdgcn_mbcnt_lo(~0u, 0u)) == 0u) {
        __builtin_amdgcn_s_waitcnt(0);
        if (b.st[2] != 2u) { __builtin_amdgcn_fence(__ATOMIC_RELEASE, "agent"); asm volatile("s_waitcnt vmcnt(0)" ::: "memory"); }
        const unsigned old = xb_add(b.cnt, 1u), target = (old / b.n + 1u) * b.n;
        unsigned sp = 0u; while (xb_ld(b.cnt) < target) { __builtin_amdgcn_s_sleep(1); if (++sp > (1u << 22)) break; }
        __builtin_amdgcn_fence(__ATOMIC_ACQUIRE, "agent");
        asm volatile("s_waitcnt vmcnt(0)" ::: "memory");
    }
    __syncthreads();
}

__device__ __forceinline__ int mk_lane() { return (int)__builtin_amdgcn_mbcnt_hi(~0u, __builtin_amdgcn_mbcnt_lo(~0u, 0u)); }
__device__ __forceinline__ float bf2f(bf16_t b) { return __builtin_bit_cast(float, (unsigned)b << 16); }
__device__ __forceinline__ float wave_sum(float v) {
#pragma unroll
    for (int o = 1; o < 64; o <<= 1) v += __shfl_xor(v, o);
    return v;
}
__device__ __forceinline__ float wave_max(float v) {
#pragma unroll
    for (int o = 1; o < 64; o <<= 1) v = fmaxf(v, __shfl_xor(v, o));
    return v;
}

__host__ __device__ __forceinline__ int win_actual(int v) {
    const int pn = v >> 8, w = v & 255, bj = w >> 7, wc = (w >> 5) & 3, j = w & 31;
    if (pn < 2) return v;
    if (pn < 5) return 512 + 64 * (4 * (pn - 2) + wc) + 32 * bj + j;
    const int hd = 2 * wc + (j >> 4), d = 16 * bj + (j & 15);
    if (pn == 5) return 1280 + 32 * hd + d;
    if (hd == 0) return 1536 + d;
    if (hd == 1 && d < 8) return 1568 + d;
    return -1;
}
__host__ __device__ __forceinline__ int wup_actual(int v) { const int pn = v >> 8, w = v & 255; return (w >> 7) * DFF + 128 * pn + (w & 127); }

namespace pg8 {
#define PG8_LAS __attribute__((address_space(3)))
typedef unsigned short bf16_t;
typedef short bf16x8 __attribute__((ext_vector_type(8)));
typedef float f32x4 __attribute__((ext_vector_type(4)));
typedef unsigned u32x4 __attribute__((ext_vector_type(4)));
constexpr int BM = 256, BK = 64, HALF = 128, HTB = HALF * BK * 2  , STAGE_BYTES = 8 * HTB, NXCD = 8, WGM = 8;

__host__ __device__ __forceinline__ int lds_byte(int r, int c) { const int st = (r >> 4) * 2 + (c >> 5), rr = r & 15, cc = c & 31, ob = rr * 64 + cc * 2; return st * 1024 + (ob ^ (((ob >> 9) & 1) << 5)); }
__host__ __device__ __forceinline__ void stage_rc(int b, int& R, int& C) { const int st = b / 1024, sb = b % 1024, swz = sb ^ (((sb >> 9) & 1) << 5); R = (st >> 1) * 16 + swz / 64; C = (st & 1) * 32 + (swz % 64) / 2; }
__host__ __device__ __forceinline__ int perm32(int rho) { const int n = rho >> 4, i = rho & 15; return 8 * (i >> 2) + 4 * n + (i & 3); }

struct Unit { int pm, pn; };
struct Gemm { const bf16_t* A; const bf16_t* Bt; int M, N, K; };

struct StaticOrder {
    int nM, nN, nwg, G, c;
    __host__ __device__ void init(int M, int N, int G_, int c_) { nM = M / BM; nN = N / BM; nwg = nM * nN; G = G_; c = c_; }
    __host__ __device__ bool next(int i, Unit& u) const {
        const long L = (long)i * G + c; if (L >= nwg) return false;
        int wgid = (int)L; { const int q = nwg / NXCD, r = nwg % NXCD, xcd = wgid % NXCD, off = wgid / NXCD; wgid = (xcd < r ? xcd * (q + 1) : r * (q + 1) + (xcd - r) * q) + off; }
        const int nig = WGM * nN, gid = wgid / nig, fm = gid * WGM, gsz = (nM - fm) < WGM ? (nM - fm) : WGM;
        u.pm = fm + ((wgid % nig) % gsz); u.pn = (wgid % nig) / gsz; return true;
    }
    __device__ __forceinline__ void a_ready(const Unit&) const {}
    __device__ __forceinline__ void done(const Unit&) const {}
};

__device__ __forceinline__ unsigned cvt_pk_bf16(float lo, float hi) { unsigned r; asm volatile("v_cvt_pk_bf16_f32 %0, %1, %2" : "=v"(r) : "v"(lo), "v"(hi)); return r; }
__device__ __forceinline__ unsigned cvt_pk_f16(float lo, float hi) { return (unsigned)__builtin_bit_cast(unsigned short, (_Float16)lo) | ((unsigned)__builtin_bit_cast(unsigned short, (_Float16)hi) << 16); }
typedef float f32x2 __attribute__((ext_vector_type(2)));
typedef unsigned u32x2 __attribute__((ext_vector_type(2)));
__device__ __forceinline__ u32x4 pack8_bf16(const f32x4 a, const f32x4 b) { u32x4 w; w.x = cvt_pk_bf16(a[0], a[1]); w.y = cvt_pk_bf16(a[2], a[3]); w.z = cvt_pk_bf16(b[0], b[1]); w.w = cvt_pk_bf16(b[2], b[3]); return w; }
__device__ __forceinline__ u32x4 pack8_f16(const f32x4 a, const f32x4 b) { u32x4 w; w.x = cvt_pk_f16(a[0], a[1]); w.y = cvt_pk_f16(a[2], a[3]); w.z = cvt_pk_f16(b[0], b[1]); w.w = cvt_pk_f16(b[2], b[3]); return w; }

struct EpiProj {
    static constexpr bool PERM = true, AFTER_DRAIN = false, HAS_INIT = false;
    bf16_t *VP, *Q, *Kb, *Vb; _Float16 *QI, *KI; float* WI; const float* rope32; const float* rope16; const float *gq, *gk;
    __device__ __forceinline__ void operator()(const f32x4 (&acc)[2][2][4][2], const Unit& u, int wr, int wc, int fr, int fq) const {
        const int pn = u.pn, rowb = u.pm * BM + wr * 64 + fr;
        if (pn < 2) {
#pragma unroll
            for (int ai = 0; ai < 2; ++ai)
#pragma unroll
                for (int m = 0; m < 4; ++m) { bf16_t* rp = VP + (size_t)(rowb + ai * HALF + m * 16) * 512 + pn * 256 + wc * 32 + 8 * fq;
#pragma unroll
                    for (int bj = 0; bj < 2; ++bj) *(u32x4*)(rp + bj * HALF) = pack8_bf16(acc[ai][bj][m][0], acc[ai][bj][m][1]); }
        } else if (pn < 5) {
            if (pn == 4 && wc >= 2) {
#pragma unroll
                for (int ai = 0; ai < 2; ++ai)
#pragma unroll
                    for (int m = 0; m < 4; ++m) { bf16_t* rp = Vb + (size_t)(rowb + ai * HALF + m * 16) * 128 + 64 * (wc - 2) + 8 * fq;
#pragma unroll
                        for (int bj = 0; bj < 2; ++bj) *(u32x4*)(rp + bj * 32) = pack8_bf16(acc[ai][bj][m][0], acc[ai][bj][m][1]); }
            } else {
                const bool isk = (pn == 4); const float* g = isk ? gk : gq; const float osc = isk ? 1.0f : 0.18033688011112042f  ;
                f32x4 gv[2][2];
#pragma unroll
                for (int bj = 0; bj < 2; ++bj)
#pragma unroll
                    for (int n = 0; n < 2; ++n) gv[bj][n] = *(const f32x4*)(g + 32 * bj + 8 * fq + 4 * n);
                bf16_t* dst = isk ? (Kb + 64 * wc) : (Q + 64 * (4 * (pn - 2) + wc)); const int ld = isk ? 128 : 512;
#pragma unroll
                for (int ai = 0; ai < 2; ++ai)
#pragma unroll
                    for (int m = 0; m < 4; ++m) { const int row = rowb + ai * HALF + m * 16, pos = row & 2047;
                        float ss = 0.f;
#pragma unroll
                        for (int bj = 0; bj < 2; ++bj)
#pragma unroll
                            for (int n = 0; n < 2; ++n) { const f32x4 v = acc[ai][bj][m][n]; ss += (v[0] * v[0] + v[1] * v[1]) + (v[2] * v[2] + v[3] * v[3]); }
                        ss += __shfl_xor(ss, 16); ss += __shfl_xor(ss, 32);
                        const float rstd = 1.0f / sqrtf(ss * (1.0f / 64.0f) + 1e-6f);
                        const f32x4* rp = (const f32x4*)(rope32 + (size_t)(pos * 32 + 8 * fq) * 2);
                        f32x4 o1[2], o2[2];
#pragma unroll
                        for (int n = 0; n < 2; ++n) { const f32x4 cs0 = rp[2 * n], cs1 = rp[2 * n + 1];
                            const f32x4 x1 = acc[ai][0][m][n] * rstd * gv[0][n], x2 = acc[ai][1][m][n] * rstd * gv[1][n];
                            const f32x4 c = (f32x4){cs0[0], cs0[2], cs1[0], cs1[2]}, s = (f32x4){cs0[1], cs0[3], cs1[1], cs1[3]};
                            o1[n] = (x1 * c - x2 * s) * osc; o2[n] = (x2 * c + x1 * s) * osc; }
                        bf16_t* op = dst + (size_t)row * ld + 8 * fq;
                        *(u32x4*)(op) = pack8_bf16(o1[0], o1[1]); *(u32x4*)(op + 32) = pack8_bf16(o2[0], o2[1]); }
            }
        } else {
            const int hd = 2 * wc + (fq >> 1);
            if (pn == 6 && wc != 0) return;
            if (pn == 6 && hd == 1) {
                if (fq == 2) {
#pragma unroll
                    for (int ai = 0; ai < 2; ++ai)
#pragma unroll
                        for (int m = 0; m < 4; ++m) { float* wp = WI + (size_t)(rowb + ai * HALF + m * 16) * 8;
                            *(f32x4*)(wp) = acc[ai][0][m][0] * 0.0625f; *(f32x4*)(wp + 4) = acc[ai][0][m][1] * 0.0625f; }
                }
                return;
            }
            _Float16* dst = (pn == 5) ? (QI + 32 * hd) : KI; const int ld = (pn == 5) ? 256 : 32;
#pragma unroll
            for (int ai = 0; ai < 2; ++ai)
#pragma unroll
                for (int m = 0; m < 4; ++m) { const int row = rowb + ai * HALF + m * 16, pos = row & 2047;
                    const f32x4* rp = (const f32x4*)(rope16 + (size_t)(pos * 16 + 8 * (fq & 1)) * 2);
                    f32x4 o1[2], o2[2];
#pragma unroll
                    for (int n = 0; n < 2; ++n) { const f32x4 cs0 = rp[2 * n], cs1 = rp[2 * n + 1];
                        const f32x4 x1 = acc[ai][0][m][n], x2 = acc[ai][1][m][n];
                        const f32x4 c = (f32x4){cs0[0], cs0[2], cs1[0], cs1[2]}, s = (f32x4){cs0[1], cs0[3], cs1[1], cs1[3]};
                        o1[n] = x1 * c - x2 * s; o2[n] = x2 * c + x1 * s; }
                    _Float16* op = dst + (size_t)row * ld + 8 * (fq & 1);
                    *(u32x4*)(op) = pack8_f16(o1[0], o1[1]); *(u32x4*)(op + 16) = pack8_f16(o2[0], o2[1]); }
        }
    }
};

__device__ __forceinline__ f32x4 bf16lo_to_f32(const u32x2 w) { return (f32x4){__builtin_bit_cast(float, w.x << 16), __builtin_bit_cast(float, w.x & 0xffff0000u), __builtin_bit_cast(float, w.y << 16), __builtin_bit_cast(float, w.y & 0xffff0000u)}; }
struct EpiWout {
    static constexpr bool PERM = true, AFTER_DRAIN = false, HAS_INIT = true, NEXT_HOOK = false;
    const float* x; bf16_t* X1B; float* SS2;
    __device__ __forceinline__ void init(f32x4 (&acc)[2][2][4][2], const Unit& u, int wr, int wc, int fr, int fq) const {
        const int rowb = u.pm * BM + wr * 64 + fr, col0 = u.pn * BM + wc * 32 + 8 * fq;
#pragma unroll
        for (int ai = 0; ai < 2; ++ai)
#pragma unroll
            for (int m = 0; m < 4; ++m) { const size_t off = (size_t)(rowb + ai * HALF + m * 16) * 1024 + col0;
#pragma unroll
                for (int bj = 0; bj < 2; ++bj) { acc[ai][bj][m][0] = *(const f32x4*)(x + off + bj * HALF); acc[ai][bj][m][1] = *(const f32x4*)(x + off + bj * HALF + 4); } }
    }
    __device__ __forceinline__ void operator()(const f32x4 (&acc)[2][2][4][2], const Unit& u, int wr, int wc, int fr, int fq) const {
        const int rowb = u.pm * BM + wr * 64 + fr, col0 = u.pn * BM + wc * 32 + 8 * fq;
#pragma unroll
        for (int ai = 0; ai < 2; ++ai)
#pragma unroll
            for (int m = 0; m < 4; ++m) { const int row = rowb + ai * HALF + m * 16; const size_t off = (size_t)row * 1024 + col0; float ss = 0.f;
#pragma unroll
                for (int bj = 0; bj < 2; ++bj) { const f32x4 v0 = acc[ai][bj][m][0], v1 = acc[ai][bj][m][1];
                    ss += (v0[0] * v0[0] + v0[1] * v0[1]) + (v0[2] * v0[2] + v0[3] * v0[3]) + (v1[0] * v1[0] + v1[1] * v1[1]) + (v1[2] * v1[2] + v1[3] * v1[3]);
                    *(u32x4*)(X1B + off + bj * HALF) = pack8_bf16(v0, v1); }
                ss += __shfl_xor(ss, 16); ss += __shfl_xor(ss, 32);
                if (fq == 0) SS2[(size_t)row * 16 + 4 * u.pn + wc] = ss; }
    }
};
struct EpiDown {
    static constexpr bool PERM = true, AFTER_DRAIN = false, HAS_INIT = true, NEXT_HOOK = false;
    const bf16_t* X1B; float* out;
    __device__ __forceinline__ void init(f32x4 (&acc)[2][2][4][2], const Unit& u, int wr, int wc, int fr, int fq) const {
        const int rowb = u.pm * BM + wr * 64 + fr, col0 = u.pn * BM + wc * 32 + 8 * fq;
#pragma unroll
        for (int ai = 0; ai < 2; ++ai) {
            u32x4 hv[4][2];
#pragma unroll
            for (int m = 0; m < 4; ++m) { const size_t off = (size_t)(rowb + ai * HALF + m * 16) * 1024 + col0;
#pragma unroll
                for (int bj = 0; bj < 2; ++bj) hv[m][bj] = *(const u32x4*)(X1B + off + bj * HALF); }
#pragma unroll
            for (int m = 0; m < 4; ++m)
#pragma unroll
                for (int bj = 0; bj < 2; ++bj) { acc[ai][bj][m][0] = bf16lo_to_f32((u32x2){hv[m][bj].x, hv[m][bj].y}); acc[ai][bj][m][1] = bf16lo_to_f32((u32x2){hv[m][bj].z, hv[m][bj].w}); }
        }
    }
    __device__ __forceinline__ void operator()(const f32x4 (&acc)[2][2][4][2], const Unit& u, int wr, int wc, int fr, int fq) const {
        const int rowb = u.pm * BM + wr * 64 + fr, col0 = u.pn * BM + wc * 32 + 8 * fq;
#pragma unroll
        for (int ai = 0; ai < 2; ++ai)
#pragma unroll
            for (int m = 0; m < 4; ++m) { float* p = out + (size_t)(rowb + ai * HALF + m * 16) * 1024 + col0;
#pragma unroll
                for (int bj = 0; bj < 2; ++bj) { *(f32x4*)(p + bj * HALF) = acc[ai][bj][m][0]; *(f32x4*)(p + bj * HALF + 4) = acc[ai][bj][m][1]; } }
    }
};
__device__ __forceinline__ float dpp_shr1(float v) { return __builtin_bit_cast(float, __builtin_amdgcn_update_dpp(0, __builtin_bit_cast(int, v), 0x111, 0xf, 0xf, false)); }
template <class T> __device__ __forceinline__ void stg_u32(void* base, unsigned boff, const T v) { *(T*)((char*)base + boff) = v; }
struct EpiUp {
    static constexpr bool PERM = true, AFTER_DRAIN = false, HAS_INIT = false;
    const PG8_LAS float* tab; const PG8_LAS float* wtab; bf16_t* G; bf16_t* HF; bf16_t* HL; mutable int par;
    __device__ __forceinline__ void operator()(const f32x4 (&acc)[2][2][4][2], const Unit& u, int wr, int wc, int fr_, int fq_) const {
        int fr = fr_, fq = fq_; asm volatile("" : "+v"(fr), "+v"(fq));
        const unsigned cb = 32 * wc + 8 * fq, ncol = 128 * u.pn + cb;
        const PG8_LAS float* tb = tab + par * 256 + wr * 64 + 4 * fr; const PG8_LAS float* wt = wtab + par * 1024 + cb; par ^= 1;
#pragma unroll
        for (int ai = 0; ai < 2; ++ai) {
            const unsigned rg = u.pm * BM + ai * HALF + wr * 64, g64 = rg >> 6;
            const f32x4 rs = *(const PG8_LAS f32x4*)(tb + ai * HALF);
            u32x2 gp[2][4];
            u32x2 hp[2][2][2];
            const bool last_ = (fr == 15);
#pragma unroll
            for (int n = 0; n < 2; ++n) {
                f32x4 cg[4];
#pragma unroll
                for (int bj = 0; bj < 2; ++bj) {
                    const PG8_LAS f32x4* wq = (const PG8_LAS f32x4*)(wt + 128 * bj + 4 * n);
                    const f32x4 w0 = wq[0], w1 = wq[64], w2 = wq[128], bb = wq[192];
                    f32x4 uu[4];
#pragma unroll
                    for (int m = 0; m < 4; ++m) uu[m] = acc[ai][bj][m][n] * rs[m];
#pragma unroll
                    for (int r = 0; r < 2; ++r) { const f32x4 hv = last_ ? uu[2 + r] : uu[r]; hp[bj][r][n] = (u32x2){cvt_pk_bf16(hv[0], hv[1]), cvt_pk_bf16(hv[2], hv[3])}; }
                    f32x4 d2, d3;
#pragma unroll
                    for (int i = 0; i < 4; ++i) { d2[i] = dpp_shr1(uu[2][i]); d3[i] = dpp_shr1(uu[3][i]); }
                    f32x4 c[4];
                    c[0] = bb + w0 * d2 + w1 * d3 + w2 * uu[0];
                    c[1] = bb + w0 * d3 + w1 * uu[0] + w2 * uu[1];
                    c[2] = bb + w0 * uu[0] + w1 * uu[1] + w2 * uu[2];
                    c[3] = bb + w0 * uu[1] + w1 * uu[2] + w2 * uu[3];
#pragma unroll
                    for (int m = 0; m < 4; ++m) {
                        if (bj == 0) cg[m] = c[m];
                        else { f32x4 gsl;
#pragma unroll
                            for (int i = 0; i < 4; ++i) gsl[i] = __builtin_amdgcn_exp2f(-cg[m][i]);
                            gsl = gsl + 1.0f;
#pragma unroll
                            for (int i = 0; i < 4; ++i) gsl[i] = __builtin_amdgcn_rcpf(gsl[i]);
                            gsl = (cg[m] * gsl) * c[m];
                            gp[n][m] = (u32x2){cvt_pk_bf16(gsl[0], gsl[1]), cvt_pk_bf16(gsl[2], gsl[3])}; }
                    }
                }
            }
            if (fr == 0 || last_) { bf16_t* hb = last_ ? HL : HF;
#pragma unroll
                for (int bj = 0; bj < 2; ++bj)
#pragma unroll
                    for (int r = 0; r < 2; ++r) stg_u32<u32x4>(hb, ((g64 * 2u + r) * 5632u + u.pn * 256u + bj * 128u + cb) * 2u, (u32x4){hp[bj][r][0].x, hp[bj][r][0].y, hp[bj][r][1].x, hp[bj][r][1].y}); }
#pragma unroll
            for (int m = 0; m < 4; ++m)
                stg_u32<u32x4>(G, ((rg + 4u * fr + m) * 2816u + ncol) * 2u, (u32x4){gp[0][m].x, gp[0][m].y, gp[1][m].x, gp[1][m].y});
        }
    }
};
struct UpOrder : StaticOrder {
    const float* SS2; PG8_LAS float* tab; PG8_LAS float* wtab; const float* conv_w; const float* conv_b; int wv; mutable int par;
    __device__ __forceinline__ void a_ready(const Unit& u) const {
        const int t = wv * 64 + (int)__builtin_amdgcn_mbcnt_hi(~0u, __builtin_amdgcn_mbcnt_lo(~0u, 0u));
#pragma unroll
        for (int k = 0; k < 2; ++k) { const int idx = t + 512 * k, tap = idx >> 8, v = idx & 255, col = (v >> 7) * 2816 + 128 * u.pn + (v & 127);
            wtab[par * 1024 + idx] = (tap < 3 ? conv_w[tap * 5632 + col] : conv_b[col]) * ((v >> 7) ? 0.6931471805599453f : 1.4426950408889634f); }
        if (t < 256) { const f32x4* sp = (const f32x4*)(SS2 + (size_t)(u.pm * BM + t) * 16); const f32x4 a = sp[0], b = sp[1], c = sp[2], d = sp[3];
            const float s = (((a[0] + a[1]) + (a[2] + a[3])) + ((b[0] + b[1]) + (b[2] + b[3]))) + (((c[0] + c[1]) + (c[2] + c[3])) + ((d[0] + d[1]) + (d[2] + d[3])));
            tab[par * 256 + t] = __builtin_amdgcn_rsqf(s * (1.0f / 1024.0f) + 1e-6f); }
        par ^= 1;
    }
};

template <class Epi, class Sched, bool ALIGN_EPI = false, bool SP2 = false, bool ROWPERM = false>
__device__ __forceinline__ void gemm_phase(PG8_LAS unsigned char* lds, const Gemm g, const Sched& S, const Epi& E, const int wv  ) {
    int tid_ = wv * 64 + (int)__builtin_amdgcn_mbcnt_hi(~0u, __builtin_amdgcn_mbcnt_lo(~0u, 0u)); asm volatile("" : "+v"(tid_));
    const int tid = tid_, wid = __builtin_amdgcn_readfirstlane(tid >> 6), lane = tid & 63, wr = wid >> 2, wc = wid & 3, fr = lane & 15, fq = lane >> 4;
    const int K = g.K, nt = K / BK;
    unsigned voffA[2], voffB[2];
#pragma unroll
    for (int i = 0; i < 2; ++i) { int R, C; stage_rc(tid * 16 + i * 8192, R, C); const int Rb = Epi::PERM ? ((R & ~31) + perm32(R & 31)) : R;
        const int Ra = ROWPERM ? ((R & ~63) + 4 * (R & 15) + ((R >> 4) & 3)) : R;
        voffA[i] = (unsigned)(Ra * K + C) * 2u; voffB[i] = (unsigned)(Rb * K + C) * 2u; }
    const size_t kstep = (size_t)(BK * 2);
    const size_t hstep = (size_t)HALF * K * 2;
    const size_t tstep = 2 * hstep;
    const unsigned ldsw = (unsigned)wid * 1024u;
    const int aoff = lds_byte(wr * 64 + fr, fq * 8), boff = lds_byte(wc * 32 + fr, fq * 8);
#define PG8_SA(b, h) (((b) * 2 + (h)) * HTB)
#define PG8_SB(b, h) ((4 + (b) * 2 + (h)) * HTB)
#define PG8_STAGE(bufoff, gbase, voff) do { _Pragma("unroll") for (int _i = 0; _i < 2; ++_i) \
        __builtin_amdgcn_global_load_lds((const unsigned*)((const char*)(gbase) + (voff)[_i]), (PG8_LAS unsigned*)(lds + (bufoff) + ldsw + _i * 8192), 16, 0, 0); } while (0)
#define PG8_LDA(dst, b, h) do { _Pragma("unroll") for (int m = 0; m < 4; ++m) _Pragma("unroll") for (int k = 0; k < 2; ++k) dst[m][k] = *(const PG8_LAS bf16x8*)(lds + PG8_SA(b, h) + aoff + m * 2048 + k * 1024); } while (0)
#define PG8_LDB(dst, b, h) do { _Pragma("unroll") for (int n = 0; n < 2; ++n) _Pragma("unroll") for (int k = 0; k < 2; ++k) dst[n][k] = *(const PG8_LAS bf16x8*)(lds + PG8_SB(b, h) + boff + n * 2048 + k * 1024); } while (0)
#define PG8_MMA(ai, bj, At, Bt) do { __builtin_amdgcn_s_setprio(1); _Pragma("unroll") for (int m = 0; m < 4; ++m) _Pragma("unroll") for (int n = 0; n < 2; ++n) _Pragma("unroll") for (int k = 0; k < 2; ++k) \
        acc[ai][bj][m][n] = __builtin_amdgcn_mfma_f32_16x16x32_bf16(Bt[n][k], At[m][k], acc[ai][bj][m][n], 0, 0, 0); __builtin_amdgcn_s_setprio(0); } while (0)
#define PG8_WAIT_V(n) asm volatile("s_waitcnt vmcnt(" #n ")" ::: "memory")
#define PG8_WAIT_L(n) asm volatile("s_waitcnt lgkmcnt(" #n ")" ::: "memory")
#define PG8_BAR __builtin_amdgcn_s_barrier()
#define PG8_SCHED __builtin_amdgcn_sched_barrier(0)
    Unit cur, nxt; int ui = 0;
    if (!S.next(0, cur)) return;
    f32x4 acc[2][2][4][2];
    if constexpr (Epi::HAS_INIT) E.init(acc, cur, wr, wc, fr, fq);
    else {
#pragma unroll
    for (int a = 0; a < 2; ++a)
#pragma unroll
        for (int b = 0; b < 2; ++b)
#pragma unroll
            for (int m = 0; m < 4; ++m)
#pragma unroll
                for (int n = 0; n < 2; ++n) acc[a][b][m][n] = (f32x4){0.f, 0.f, 0.f, 0.f};
    }
    bf16x8 At[4][2], B0[2][2], B1[2][2];
    const char* cA = (const char*)g.A + (size_t)cur.pm * tstep; const char* cB = (const char*)g.Bt + (size_t)cur.pn * tstep;
    S.a_ready(cur);
    if constexpr (SP2) {
        PG8_STAGE(PG8_SB(0, 0), cB, voffB); PG8_STAGE(PG8_SB(0, 1), cB + hstep, voffB); PG8_STAGE(PG8_SA(0, 0), cA, voffA); PG8_STAGE(PG8_SA(0, 1), cA + hstep, voffA);
        if (wr == 1) PG8_BAR;
        PG8_WAIT_V(2); PG8_BAR;
        PG8_STAGE(PG8_SB(1, 0), cB + kstep, voffB); PG8_STAGE(PG8_SA(1, 0), cA + kstep, voffA); PG8_STAGE(PG8_SB(1, 1), cB + hstep + kstep, voffB);
        PG8_WAIT_V(6); PG8_BAR;
    } else {
        PG8_STAGE(PG8_SB(0, 0), cB, voffB); PG8_STAGE(PG8_SA(0, 0), cA, voffA); PG8_STAGE(PG8_SB(0, 1), cB + hstep, voffB); PG8_STAGE(PG8_SA(0, 1), cA + hstep, voffA);
        if (wr == 1) PG8_BAR;
        PG8_WAIT_V(4); PG8_BAR;
        PG8_STAGE(PG8_SB(1, 0), cB + kstep, voffB); PG8_STAGE(PG8_SA(1, 0), cA + kstep, voffA); PG8_STAGE(PG8_SB(1, 1), cB + hstep + kstep, voffB);
        PG8_WAIT_V(6); PG8_BAR;
    }
    for (;;) {
        const bool has_next = S.next(ui + 1, nxt);
        const char* nA = has_next ? (const char*)g.A + (size_t)nxt.pm * tstep : cA; const char* nB = has_next ? (const char*)g.Bt + (size_t)nxt.pn * tstep : cB;
        for (int t = 0; t < nt; t += 2) {
            const bool last = (t == nt - 2);
            const char* a1 = cA + (size_t)(t + 1) * kstep;
            const char* a2 = last ? nA : cA + (size_t)(t + 2) * kstep; const char* b2 = last ? nB : cB + (size_t)(t + 2) * kstep;
            const char* a3 = a2 + kstep; const char* b3 = b2 + kstep;
            if (last && has_next) S.a_ready(nxt);
            if constexpr (SP2) {
            PG8_LDB(B0, 0, 0); PG8_LDB(B1, 0, 1); PG8_SCHED; PG8_LDA(At, 0, 0); PG8_STAGE(PG8_SA(1, 1), a1 + hstep, voffA);
            PG8_WAIT_V(8); PG8_WAIT_L(0); PG8_BAR; PG8_MMA(0, 0, At, B0); PG8_MMA(0, 1, At, B1); PG8_BAR; PG8_SCHED;
            PG8_LDA(At, 0, 1); PG8_STAGE(PG8_SB(0, 0), b2, voffB); PG8_STAGE(PG8_SB(0, 1), b2 + hstep, voffB); PG8_STAGE(PG8_SA(0, 0), a2, voffA);
            PG8_WAIT_V(8); PG8_WAIT_L(0); PG8_BAR; PG8_MMA(1, 0, At, B0); PG8_MMA(1, 1, At, B1); PG8_BAR; PG8_SCHED;
            PG8_LDB(B0, 1, 0); PG8_LDB(B1, 1, 1); PG8_SCHED; PG8_LDA(At, 1, 0); PG8_STAGE(PG8_SA(0, 1), a2 + hstep, voffA);
            PG8_WAIT_V(8); PG8_WAIT_L(0); PG8_BAR; PG8_MMA(0, 0, At, B0); PG8_MMA(0, 1, At, B1); PG8_BAR; PG8_SCHED;
            PG8_LDA(At, 1, 1); PG8_STAGE(PG8_SB(1, 0), b3, voffB); PG8_STAGE(PG8_SB(1, 1), b3 + hstep, voffB); PG8_STAGE(PG8_SA(1, 0), a3, voffA);
            PG8_WAIT_V(8); PG8_WAIT_L(0); PG8_BAR; PG8_MMA(1, 0, At, B0); PG8_MMA(1, 1, At, B1); PG8_BAR; PG8_SCHED;
            } else {
            PG8_LDB(B0, 0, 0); PG8_SCHED; PG8_LDA(At, 0, 0); PG8_STAGE(PG8_SA(1, 1), a1 + hstep, voffA);
            PG8_WAIT_L(8); PG8_BAR; PG8_WAIT_L(0); PG8_MMA(0, 0, At, B0); PG8_BAR; PG8_SCHED;
            PG8_LDB(B1, 0, 1); PG8_STAGE(PG8_SB(0, 0), b2, voffB);
            PG8_BAR; PG8_WAIT_L(0); PG8_MMA(0, 1, At, B1); PG8_BAR;
            PG8_LDA(At, 0, 1); PG8_STAGE(PG8_SA(0, 0), a2, voffA);
            PG8_BAR; PG8_WAIT_L(0); PG8_MMA(1, 0, At, B0); PG8_BAR; PG8_SCHED;
            PG8_STAGE(PG8_SB(0, 1), b2 + hstep, voffB);
            PG8_WAIT_V(6); PG8_BAR; PG8_MMA(1, 1, At, B1); PG8_BAR;
            PG8_LDB(B0, 1, 0); PG8_SCHED; PG8_LDA(At, 1, 0); PG8_STAGE(PG8_SA(0, 1), a2 + hstep, voffA);
            PG8_WAIT_L(8); PG8_BAR; PG8_WAIT_L(0); PG8_MMA(0, 0, At, B0); PG8_BAR; PG8_SCHED;
            PG8_LDB(B1, 1, 1); PG8_STAGE(PG8_SB(1, 0), b3, voffB);
            PG8_BAR; PG8_WAIT_L(0); PG8_MMA(0, 1, At, B1); PG8_BAR;
            PG8_LDA(At, 1, 1); PG8_STAGE(PG8_SA(1, 0), a3, voffA);
            PG8_BAR; PG8_WAIT_L(0); PG8_MMA(1, 0, At, B0); PG8_BAR; PG8_SCHED;
            PG8_STAGE(PG8_SB(1, 1), b3 + hstep, voffB);
            PG8_WAIT_V(6); PG8_BAR; PG8_MMA(1, 1, At, B1); PG8_BAR;
            }
        }
        if constexpr (ALIGN_EPI) { if (wr == 0) PG8_BAR; }
        if constexpr (!Epi::AFTER_DRAIN) { E(acc, cur, wr, wc, fr, fq); S.done(cur); }
        if (!has_next) break;
        if constexpr (Epi::HAS_INIT) E.init(acc, nxt, wr, wc, fr, fq);
        else {
#pragma unroll
        for (int a = 0; a < 2; ++a)
#pragma unroll
            for (int b = 0; b < 2; ++b)
#pragma unroll
                for (int m = 0; m < 4; ++m)
#pragma unroll
                    for (int n = 0; n < 2; ++n) acc[a][b][m][n] = (f32x4){0.f, 0.f, 0.f, 0.f};
        }
        cur = nxt; cA = nA; cB = nB; ++ui;
        if constexpr (ALIGN_EPI) { if (wr == 1) PG8_BAR; }
    }
    PG8_WAIT_V(0);
    if constexpr (!ALIGN_EPI) { if (wr == 0) PG8_BAR; }
    PG8_BAR;
    if constexpr (Epi::AFTER_DRAIN) { E.fused(acc, cur, wr, wc, fr, fq, lds, wid, lane); S.done(cur); }
#undef PG8_SA
#undef PG8_SB
#undef PG8_STAGE
#undef PG8_LDA
#undef PG8_LDB
#undef PG8_MMA
#undef PG8_WAIT_V
#undef PG8_WAIT_L
#undef PG8_BAR
#undef PG8_SCHED
}
}

#include <hip/hip_bf16.h>
#include <cmath>
namespace attn_body {
using bf16=__hip_bfloat16;
using bf16x8=__attribute__((ext_vector_type(8)))short;
using s16x4=__attribute__((ext_vector_type(4)))short;
using f32x16=__attribute__((ext_vector_type(16)))float;
using u32x4=__attribute__((ext_vector_type(4)))unsigned;
constexpr int BATCH=8,NHEAD=8,SEQ=2048,D=64,QP=512,KP=128,OP=1024,OOFF=512;
constexpr int NW=8,QBLK=32,QB=QBLK*NW,KVBLK=64,NQB=SEQ/QB;
constexpr int ATTN_UNIT_ROWS=QB;
__device__ __forceinline__ int crow(int r,int hi){return (r&3)+8*(r>>2)+4*hi;}
#define SBAR() __builtin_amdgcn_sched_barrier(0)
__device__ __forceinline__ void cmask(f32x16&p0,f32x16&p1,int jb,int qrel,int hi){
  const float NEG=-INFINITY; int kb=64*jb+4*hi;
  #pragma unroll
  for(int r=0;r<16;++r){int kv=kb+(r&3)+8*(r>>2); if(kv>qrel)p0[r]=NEG; if(kv+32>qrel)p1[r]=NEG;}
}

constexpr int NSLOT=3, SLOTB=8192;
constexpr int LDS_K=0, LDS_V=NSLOT*SLOTB, LDS_WS=2*NSLOT*SLOTB, LDS_OST=LDS_WS+NW*64*4, LDS_BYTES=LDS_OST+NW*4096;
constexpr float C2=0.125f*1.4426950408889634f;
__device__ __forceinline__ void glds16(const void*gsrc,unsigned lds_dst){unsigned keep;
  asm volatile("s_mov_b32 %0, m0\n\ts_mov_b32 m0, %2\n\ts_nop 0\n\tglobal_load_lds_dwordx4 %1, off\n\ts_mov_b32 m0, %0":"=&s"(keep):"v"(gsrc),"s"(lds_dst):"memory");}
__device__ __forceinline__ float max3f(float a,float b,float c){float r;asm("v_max3_f32 %0, %1, %2, %3":"=v"(r):"v"(a),"v"(b),"v"(c));return r;}
__device__ __forceinline__ float max2f(float a,float b){float r;asm("v_max_f32_e32 %0, %1, %2":"=v"(r):"v"(a),"v"(b));return r;}
__device__ __forceinline__ float fadd_s(float a,float b){float r;asm("v_add_f32_e32 %0, %1, %2":"=v"(r):"v"(a),"v"(b));return r;}
__device__ __forceinline__ float fsub_s(float a,float b){float r;asm("v_sub_f32_e32 %0, %1, %2":"=v"(r):"v"(a),"v"(b));return r;}
typedef float f32x2_t __attribute__((ext_vector_type(2))); typedef __bf16 bf16x2_t __attribute__((ext_vector_type(2)));
__device__ __forceinline__ unsigned cvtpk_s(float lo,float hi){f32x2_t v={lo,hi};bf16x2_t b=__builtin_convertvector(v,bf16x2_t);return __builtin_bit_cast(unsigned,b);}
#define WAIT_BAR(N) asm volatile("s_waitcnt vmcnt(" #N ") lgkmcnt(0)\n\ts_barrier":::"memory")

__device__ __forceinline__ void qkt(f32x16&p0,f32x16&p1,const char*Kslot,const bf16x8*qr,const f32x16&negm,int r32,int hi){
  const char*kb=Kslot+hi*1024+r32*16;
  #pragma unroll
  for(int d0=0;d0<4;++d0){
    const bf16x8 b0=*reinterpret_cast<const bf16x8*>(kb+d0*2048);
    const bf16x8 b1=*reinterpret_cast<const bf16x8*>(kb+d0*2048+512);
    if(d0==0){p0=__builtin_amdgcn_mfma_f32_32x32x16_bf16(b0,qr[0],negm,0,0,0);p1=__builtin_amdgcn_mfma_f32_32x32x16_bf16(b1,qr[0],negm,0,0,0);}
    else{p0=__builtin_amdgcn_mfma_f32_32x32x16_bf16(b0,qr[d0],p0,0,0,0);p1=__builtin_amdgcn_mfma_f32_32x32x16_bf16(b1,qr[d0],p1,0,0,0);}}
}
typedef __attribute__((address_space(3))) const char* lds_cptr;
typedef short v4i16_t __attribute__((ext_vector_type(4)));
__device__ __forceinline__ void kload8(bf16x8*kf,lds_cptr kp){
  kf[0]=*(const __attribute__((address_space(3))) bf16x8*)(kp);      kf[1]=*(const __attribute__((address_space(3))) bf16x8*)(kp+512);
  kf[2]=*(const __attribute__((address_space(3))) bf16x8*)(kp+2048); kf[3]=*(const __attribute__((address_space(3))) bf16x8*)(kp+2560);
  kf[4]=*(const __attribute__((address_space(3))) bf16x8*)(kp+4096); kf[5]=*(const __attribute__((address_space(3))) bf16x8*)(kp+4608);
  kf[6]=*(const __attribute__((address_space(3))) bf16x8*)(kp+6144); kf[7]=*(const __attribute__((address_space(3))) bf16x8*)(kp+6656);
}
__device__ __forceinline__ void kload2(bf16x8*kf,lds_cptr kp,int j){ kf[2*j]=*(const __attribute__((address_space(3))) bf16x8*)(kp+j*2048); kf[2*j+1]=*(const __attribute__((address_space(3))) bf16x8*)(kp+j*2048+512); }
__device__ __forceinline__ s16x4 vtr(lds_cptr p){ return __builtin_bit_cast(s16x4,__builtin_amdgcn_ds_read_tr16_b64_v4i16((__attribute__((address_space(3))) v4i16_t*)p)); }
__device__ __forceinline__ float rowmax(const f32x16&p0,const f32x16&p1){
  float a=max3f(p0[0],p0[1],p1[0]),b=max3f(p0[2],p0[3],p1[1]);a=max3f(a,p1[2],p1[3]);
  #pragma unroll
  for(int r=4;r<16;r+=4){a=max3f(a,p0[r],p0[r+1]);b=max3f(b,p0[r+2],p0[r+3]);a=max3f(a,p1[r],p1[r+1]);b=max3f(b,p1[r+2],p1[r+3]);}
  const float m=max2f(a,b);
  auto rr=__builtin_amdgcn_permlane32_swap(__float_as_uint(m),__float_as_uint(m),false,false);
  return max2f(__uint_as_float(rr[0]),__uint_as_float(rr[1]));
}
__device__ __forceinline__ void pv(f32x16*o,int vb,bf16x8 pa0,bf16x8 pa1,bf16x8 pa2,bf16x8 pa3){
  #pragma unroll
  for(int d0=0;d0<2;++d0){s16x4 lo[4],hi[4];
    #pragma unroll
    for(int ks=0;ks<4;++ks){
      asm volatile("ds_read_b64_tr_b16 %0,%1 offset:%c2":"=&v"(lo[ks]):"v"(vb),"i"(d0*4096+ks*1024):"memory");
      asm volatile("ds_read_b64_tr_b16 %0,%1 offset:%c2":"=&v"(hi[ks]):"v"(vb),"i"(d0*4096+ks*1024+512):"memory");}
    asm volatile("s_waitcnt lgkmcnt(0)":::"memory");SBAR();
    #define PK(k) (bf16x8){lo[k][0],lo[k][1],lo[k][2],lo[k][3],hi[k][0],hi[k][1],hi[k][2],hi[k][3]}
    o[d0]=__builtin_amdgcn_mfma_f32_32x32x16_bf16(pa0,PK(0),o[d0],0,0,0);
    o[d0]=__builtin_amdgcn_mfma_f32_32x32x16_bf16(pa1,PK(1),o[d0],0,0,0);
    o[d0]=__builtin_amdgcn_mfma_f32_32x32x16_bf16(pa2,PK(2),o[d0],0,0,0);
    o[d0]=__builtin_amdgcn_mfma_f32_32x32x16_bf16(pa3,PK(3),o[d0],0,0,0);
    #undef PK
  }
}

#ifndef ATTN_STORE16
#define ATTN_STORE16(p,v) (*(u32x4*)(p)=(v))
#endif
template<int THRL> __device__ __forceinline__ void attn_unit(int b,int h,int qb,const bf16*Q,const bf16*__restrict__ K,const bf16*__restrict__ V,const unsigned long long*__restrict__ MASK,bf16*O,char*shm,const int wv){
  int tid_=wv*64+(int)__builtin_amdgcn_mbcnt_hi(~0u,__builtin_amdgcn_mbcnt_lo(~0u,0u)); asm volatile("":"+v"(tid_)); const int tid=tid_,lane=tid&63,r32=lane&31,hi=lane>>5; const int wid=__builtin_amdgcn_readfirstlane(tid>>6);
  const long rowbase=(long)b*SEQ; const int q0=qb*QB;
  const bf16*Qw=Q+(rowbase+q0+wid*QBLK)*QP+h*D;
  const bf16*Kh=K+rowbase*KP+(h>>2)*D,*Vh=V+rowbase*KP+(h>>2)*D;
  const unsigned lds0=(unsigned)(uintptr_t)shm;
  float*wsf=(float*)(shm+LDS_WS)+wid*64;
  const bf16*ksrc=Kh+(long)lane*KP+wid*8;
  const bf16*vsrc=Vh+(long)(16*(wid&3)+(lane>>2))*KP+(wid>>2)*32+(lane&3)*8;
  const unsigned kdst=lds0+LDS_K+wid*1024, vdst=lds0+LDS_V+wid*1024;
  #define DMA_K(t,slot) glds16(ksrc+(long)(t)*KVBLK*KP,(unsigned)__builtin_amdgcn_readfirstlane(kdst+(slot)))
  #define DMA_V(t,slot) glds16(vsrc+(long)(t)*KVBLK*KP,(unsigned)__builtin_amdgcn_readfirstlane(vdst+(slot)))
  const int vb0=(int)(lds0+LDS_V)+((lane>>4)&1)*32+(lane&3)*8+(4*hi+((lane&15)>>2))*64;
  const char*Kbase=shm+LDS_K; bf16x8 kf[8];
  const lds_cptr shm3=(lds_cptr)shm; const lds_cptr kp0=shm3+LDS_K+hi*1024+r32*16; const lds_cptr vp0=shm3+LDS_V+((lane>>4)&1)*32+(lane&3)*8+(4*hi+((lane&15)>>2))*64;
  const int NT=(q0+QB)/KVBLK;
  DMA_K(0,0);DMA_V(0,0);DMA_K(1,SLOTB);
  bf16x8 qr[4];
  #pragma unroll
  for(int d0=0;d0<4;++d0)qr[d0]=*reinterpret_cast<const bf16x8*>(&Qw[(long)r32*QP+d0*16+hi*8]);
  float l_reg=0.f;f32x16 o[2];o[0]=f32x16{};o[1]=f32x16{};const f32x16 negm=f32x16{};
  const int qrel=wid*QBLK+r32;
  const unsigned long long*mrow=MASK+(rowbase+q0+qrel)*(SEQ/64);
  unsigned long long mk=mrow[0];
  #define MKSH(WL,WH,t) unsigned WL=(unsigned)mk>>(4*hi), WH=(unsigned)(mk>>32)>>(4*hi); asm volatile("":"+v"(WL),"+v"(WH)); mk=mrow[(t)+1]
  #define CMASKW(P0,P1,WL,WH) do{ _Pragma("unroll") for(int r=0;r<16;++r){ const int ps_=(r&3)+8*(r>>2); const float a_=P0[r], b_=P1[r]; \
      const unsigned m0_=(unsigned)__builtin_amdgcn_sbfe((int)WL,ps_,1), m1_=(unsigned)__builtin_amdgcn_sbfe((int)WH,ps_,1); \
      const unsigned ua_=(__builtin_bit_cast(unsigned,a_)&m0_)|(0xff800000u&~m0_), ub_=(__builtin_bit_cast(unsigned,b_)&m1_)|(0xff800000u&~m1_); \
      P0[r]=__builtin_bit_cast(float,ua_); P1[r]=__builtin_bit_cast(float,ub_); } }while(0)
  #define START(P0,P1) do{ _Pragma("unroll") for(int r=0;r<16;++r)P0[r]=__builtin_amdgcn_exp2f(P0[r]); }while(0)
  #define RESC() do{}while(0)
  f32x16 pA0,pA1,pB0,pB1;
  int sl_prev=0,sl_cur=0,sl_next=SLOTB;
  #define ROT() do{sl_prev=sl_cur;sl_cur=sl_next;sl_next=(sl_next==(NSLOT-1)*SLOTB)?0:sl_next+SLOTB;}while(0)
  DMA_K(2,2*SLOTB);
  WAIT_BAR(3);
  qkt(pA0,pA1,Kbase,qr,negm,r32,hi);asm volatile("s_nop 15\n\ts_nop 7":"+v"(pA0),"+v"(pA1));{MKSH(wl0_,wh0_,0);CMASKW(pA0,pA1,wl0_,wh0_);}
  START(pA0,pA1);
  _Pragma("unroll") for(int r=0;r<16;++r)pA1[r]=__builtin_amdgcn_exp2f(pA1[r]);
  WAIT_BAR(0);
  DMA_K(3,0);DMA_V(1,SLOTB);
  ROT();
  kload8(kf,kp0+sl_cur);
  WAIT_BAR(2);
  s16x4 vlo[8],vhi[8]; u32x4 pw0,pw1,pw2,pw3;
  #define PKW(P,B) cvtpk_s(P[B],P[B+1])
  #define PAF(k) __builtin_bit_cast(bf16x8,pw##k)
  #define VFR(i) (bf16x8){vlo[i][0],vlo[i][1],vlo[i][2],vlo[i][3],vhi[i][0],vhi[i][1],vhi[i][2],vhi[i][3]}
  #define PIN(x) asm volatile("":"+v"(x))
  #define MX3(a,b,c) __builtin_fmaxf(__builtin_fmaxf((a),(b)),(c))
  #define GAPA(MF,A0,A1,A2,A3,W0,W1,PW) do{ MF; sacc+=A0; sacc+=A1; sacc+=A2; sacc+=A3; PIN(sacc); W0; W1; PIN(PW); SBAR(); }while(0)
  #define EX(v) __builtin_amdgcn_exp2f(v)
  #define GAPB(MF,X,B) do{ MF; X[B]=EX(X[B]); X[B+1]=EX(X[B+1]); X[B+2]=EX(X[B+2]); X[B+3]=EX(X[B+3]); PIN(X); SBAR(); }while(0)
  #define VRD(i) do{ vlo[i]=vtr(vp_+(((i)>>2)*4096+((i)&3)*1024)); vhi[i]=vtr(vp_+(((i)>>2)*4096+((i)&3)*1024+512)); }while(0)
  #define KRD(G,j) do{ if(G){ kload2(kf,kp0+sl_next,j); SBAR(); } }while(0)
  #define STEP(C0,C1,P0,P1,t,GK,GV,GL) do{ SBAR(); \
    const lds_cptr vp_=vp0+sl_prev; \
    VRD(0); SBAR(); float sacc=(P0[0]+P0[1]); \
    GAPA(C0=__builtin_amdgcn_mfma_f32_32x32x16_bf16(kf[0],qr[0],negm,0,0,0), P0[2],P0[3],P0[4],P0[5],     pw0[0]=PKW(P0,0), pw0[1]=PKW(P0,2), pw0); \
    VRD(4); SBAR(); GAPA(C1=__builtin_amdgcn_mfma_f32_32x32x16_bf16(kf[1],qr[0],negm,0,0,0), P0[6],P0[7],P0[8],P0[9],     pw0[2]=PKW(P0,4), pw0[3]=PKW(P0,6), pw0); \
    VRD(1); SBAR(); GAPA(C0=__builtin_amdgcn_mfma_f32_32x32x16_bf16(kf[2],qr[1],C0,0,0,0),   P0[10],P0[11],P0[12],P0[13], pw1[0]=PKW(P0,8), pw1[1]=PKW(P0,10), pw1); \
    VRD(5); SBAR(); GAPA(C1=__builtin_amdgcn_mfma_f32_32x32x16_bf16(kf[3],qr[1],C1,0,0,0),   P0[14],P0[15],P1[0],P1[1],   pw1[2]=PKW(P0,12),pw1[3]=PKW(P0,14), pw1); \
    VRD(2); SBAR(); GAPA(C0=__builtin_amdgcn_mfma_f32_32x32x16_bf16(kf[4],qr[2],C0,0,0,0),   P1[2],P1[3],P1[4],P1[5],     pw2[0]=PKW(P1,0), pw2[1]=PKW(P1,2), pw2); \
    VRD(6); SBAR(); GAPA(C1=__builtin_amdgcn_mfma_f32_32x32x16_bf16(kf[5],qr[2],C1,0,0,0),   P1[6],P1[7],P1[8],P1[9],     pw2[2]=PKW(P1,4), pw2[3]=PKW(P1,6), pw2); \
    VRD(3); SBAR(); GAPA(C0=__builtin_amdgcn_mfma_f32_32x32x16_bf16(kf[6],qr[3],C0,0,0,0),   P1[10],P1[11],P1[12],P1[13], pw3[0]=PKW(P1,8), pw3[1]=PKW(P1,10), pw3); \
    VRD(7); SBAR(); GAPA(C1=__builtin_amdgcn_mfma_f32_32x32x16_bf16(kf[7],qr[3],C1,0,0,0),   P1[14],P1[15],0.f,0.f,       pw3[2]=PKW(P1,12),pw3[3]=PKW(P1,14), pw3); \
    l_reg+=sacc; \
    MKSH(wl_,wh_,t); \
    if(GK){DMA_K((t)+3,sl_cur);} if(GV){DMA_V((t)+1,sl_next);} \
    CMASKW(C0,C1,wl_,wh_); \
    SBAR(); \
    GAPB(o[0]=__builtin_amdgcn_mfma_f32_32x32x16_bf16(PAF(0),VFR(0),o[0],0,0,0), C0,0); \
    GAPB(o[1]=__builtin_amdgcn_mfma_f32_32x32x16_bf16(PAF(0),VFR(4),o[1],0,0,0), C0,4); \
    KRD(GL,0); GAPB(o[0]=__builtin_amdgcn_mfma_f32_32x32x16_bf16(PAF(1),VFR(1),o[0],0,0,0), C0,8); \
    KRD(GL,1); GAPB(o[1]=__builtin_amdgcn_mfma_f32_32x32x16_bf16(PAF(1),VFR(5),o[1],0,0,0), C0,12); \
    KRD(GL,2); GAPB(o[0]=__builtin_amdgcn_mfma_f32_32x32x16_bf16(PAF(2),VFR(2),o[0],0,0,0), C1,0); \
    KRD(GL,3); GAPB(o[1]=__builtin_amdgcn_mfma_f32_32x32x16_bf16(PAF(2),VFR(6),o[1],0,0,0), C1,4); \
    GAPB(o[0]=__builtin_amdgcn_mfma_f32_32x32x16_bf16(PAF(3),VFR(3),o[0],0,0,0), C1,8); \
    GAPB(o[1]=__builtin_amdgcn_mfma_f32_32x32x16_bf16(PAF(3),VFR(7),o[1],0,0,0), C1,12); \
    }while(0)
  int t=1;
  for(;t+5<NT;t+=2){
    STEP(pB0,pB1,pA0,pA1,t,true,true,true);     WAIT_BAR(2); RESC(); ROT();
    STEP(pA0,pA1,pB0,pB1,t+1,true,true,true);   WAIT_BAR(2); RESC(); ROT();
  }
  #define ENDW(tt) do{ if((tt)+3<NT){WAIT_BAR(2);} else if((tt)+2<NT){WAIT_BAR(1);} else {WAIT_BAR(0);} }while(0)
  for(;t+1<NT;t+=2){
    STEP(pB0,pB1,pA0,pA1,t,(t+3<NT),(t+1<NT),(t+1<NT));       ENDW(t);   RESC(); ROT();
    STEP(pA0,pA1,pB0,pB1,t+1,(t+4<NT),(t+2<NT),(t+2<NT));     ENDW(t+1); RESC(); ROT();
  }
  STEP(pB0,pB1,pA0,pA1,NT-1,false,false,false); RESC();
  { float sacc=pB0[0]+pB0[1]; _Pragma("unroll") for(int r=2;r<16;++r)sacc+=pB0[r]; _Pragma("unroll") for(int r=0;r<16;++r)sacc+=pB1[r]; l_reg+=sacc;
    pw0=(u32x4){PKW(pB0,0),PKW(pB0,2),PKW(pB0,4),PKW(pB0,6)};pw1=(u32x4){PKW(pB0,8),PKW(pB0,10),PKW(pB0,12),PKW(pB0,14)};pw2=(u32x4){PKW(pB1,0),PKW(pB1,2),PKW(pB1,4),PKW(pB1,6)};pw3=(u32x4){PKW(pB1,8),PKW(pB1,10),PKW(pB1,12),PKW(pB1,14)};
    SBAR(); pv(o,vb0+sl_cur,PAF(0),PAF(1),PAF(2),PAF(3)); }
  #undef PKW
  #undef PAF
  #undef VFR
  #undef PIN
  #undef MX3
  #undef GAPA
  #undef GAPB
  #undef EX
  #undef VRD
  #undef KRD
  #undef STEP
  #undef ENDW
  {auto rr=__builtin_amdgcn_permlane32_swap(__float_as_uint(l_reg),__float_as_uint(l_reg),false,false);l_reg=__uint_as_float(rr[0])+__uint_as_float(rr[1]);}
  if(hi==0)wsf[32+r32]=l_reg;asm volatile("s_waitcnt lgkmcnt(0)":::"memory");
  float rli[16];
  #pragma unroll
  for(int r=0;r<16;++r)rli[r]=__builtin_amdgcn_rcpf(wsf[32+crow(r,hi)]);
  bf16*Ow=O+(rowbase+q0+wid*QBLK)*OP+OOFF+h*D;
  { bf16*stg=(bf16*)(shm+LDS_OST)+wid*2048;
    #pragma unroll
    for(int r=0;r<16;++r){const int orow=crow(r,hi);
      #pragma unroll
      for(int d0=0;d0<2;++d0)stg[orow*64+d0*32+r32]=__float2bfloat16(o[d0][r]*rli[r]);}
    asm volatile("s_waitcnt lgkmcnt(0)":::"memory");
    #pragma unroll
    for(int i=0;i<4;++i){const int row=i*8+(lane>>3),ch=lane&7; const u32x4 v=*(const u32x4*)(stg+row*64+ch*8); ATTN_STORE16(Ow+(long)row*OP+ch*8,v);} }
  asm volatile("s_waitcnt lgkmcnt(0)\n\ts_barrier":::"memory");
  #undef DMA_K
  #undef DMA_V
  #undef CMASKW
  #undef MKSH
  #undef START
  #undef RESC
  #undef ROT
}
constexpr int ATTN_LDS_BYTES=LDS_BYTES;
struct AttnTensors { const bf16* Q; const bf16* K; const bf16* V; const unsigned long long* MASK; bf16* O; };
struct AttnUnit { int bh; int qb; };
struct StaticOrder {
  int vcu,G;
  __device__ __forceinline__ explicit StaticOrder(int grid,int block):vcu((grid%8==0)?(block%8)*(grid/8)+block/8:block),G(grid){}
  __device__ __forceinline__ bool next(int i,AttnUnit&u)const{ const int it=vcu+(i>>1)*G; if(it>=BATCH*NHEAD*4)return false; const int s=it&3; u.bh=it>>2; u.qb=(i&1)?7-s:s; return true; }
  __device__ __forceinline__ void a_ready(const AttnUnit&)const{}
  __device__ __forceinline__ void done(const AttnUnit&)const{}
};
template<class Sched,int THRL=8> __device__ __forceinline__ void attn_phase(char*lds,const AttnTensors&T,const Sched&S,const int wv){
  AttnUnit u;
  for(int i=0;S.next(i,u);++i){ S.a_ready(u); attn_unit<THRL>(u.bh/NHEAD,u.bh%NHEAD,u.qb,T.Q,T.K,T.V,T.MASK,T.O,lds,wv); S.done(u); }
}
#undef SBAR
#undef WAIT_BAR
}

#ifndef REPS
#define REPS {1, 1, 1, 1, 1, 1, 1, 1}
#endif
constexpr int kReps[8] = REPS;
#ifndef SREPS
#define SREPS {1, 1, 1, 1, 1, 1, 1, 1}
#endif
constexpr int kSub[8] = SREPS;
typedef _Float16 f16x8 __attribute__((ext_vector_type(8)));
typedef float f32x16 __attribute__((ext_vector_type(16)));
__device__ __forceinline__ unsigned score_key(float s) { const unsigned u = __builtin_bit_cast(unsigned, s + 0.0f); return u ^ ((unsigned)((int)u >> 31) | 0x80000000u); }
__device__ __forceinline__ float key_score(unsigned k) { return __builtin_bit_cast(float, (k & 0x80000000u) ? (k & 0x7fffffffu) : ~k); }
__device__ __forceinline__ float wave_sum_f32(float v) {
    v += __builtin_bit_cast(float, __builtin_amdgcn_update_dpp(0, __builtin_bit_cast(int, v), 0xb1, 0xf, 0xf, false));
    v += __builtin_bit_cast(float, __builtin_amdgcn_update_dpp(0, __builtin_bit_cast(int, v), 0x4e, 0xf, 0xf, false));
    v += __builtin_bit_cast(float, __builtin_amdgcn_update_dpp(0, __builtin_bit_cast(int, v), 0x141, 0xf, 0xf, false));
    v += __builtin_bit_cast(float, __builtin_amdgcn_update_dpp(0, __builtin_bit_cast(int, v), 0x140, 0xf, 0xf, false));
    return __builtin_bit_cast(float, __builtin_amdgcn_readlane(__builtin_bit_cast(int, v), 0)) + __builtin_bit_cast(float, __builtin_amdgcn_readlane(__builtin_bit_cast(int, v), 16))
         + __builtin_bit_cast(float, __builtin_amdgcn_readlane(__builtin_bit_cast(int, v), 32)) + __builtin_bit_cast(float, __builtin_amdgcn_readlane(__builtin_bit_cast(int, v), 48));
}
__device__ __forceinline__ int wave_sum_i32(int v) {
    v += __builtin_amdgcn_update_dpp(0, v, 0xb1, 0xf, 0xf, false);
    v += __builtin_amdgcn_update_dpp(0, v, 0x4e, 0xf, 0xf, false);
    v += __builtin_amdgcn_update_dpp(0, v, 0x141, 0xf, 0xf, false);
    v += __builtin_amdgcn_update_dpp(0, v, 0x140, 0xf, 0xf, false);
    return __builtin_amdgcn_readlane(v, 0) + __builtin_amdgcn_readlane(v, 16) + __builtin_amdgcn_readlane(v, 32) + __builtin_amdgcn_readlane(v, 48);
}
__device__ __forceinline__ void count_ge8(unsigned& cnt, unsigned cand, unsigned k0, unsigned k1, unsigned k2, unsigned k3, unsigned k4, unsigned k5, unsigned k6, unsigned k7) {
    unsigned long long m0, m1, m2, m3;
    asm volatile(
        "v_cmp_ge_u32_e64 %1, %5, %13\n\tv_cmp_ge_u32_e64 %2, %6, %13\n\tv_cmp_ge_u32_e64 %3, %7, %13\n\tv_cmp_ge_u32_e64 %4, %8, %13\n\t"
        "v_addc_co_u32_e64 %0, vcc, 0, %0, %1\n\tv_cmp_ge_u32_e64 %1, %9, %13\n\t"
        "v_addc_co_u32_e64 %0, vcc, 0, %0, %2\n\tv_cmp_ge_u32_e64 %2, %10, %13\n\t"
        "v_addc_co_u32_e64 %0, vcc, 0, %0, %3\n\tv_cmp_ge_u32_e64 %3, %11, %13\n\t"
        "v_addc_co_u32_e64 %0, vcc, 0, %0, %4\n\tv_cmp_ge_u32_e64 %4, %12, %13\n\t"
        "v_addc_co_u32_e64 %0, vcc, 0, %0, %1\n\tv_addc_co_u32_e64 %0, vcc, 0, %0, %2\n\tv_addc_co_u32_e64 %0, vcc, 0, %0, %3\n\tv_addc_co_u32_e64 %0, vcc, 0, %0, %4"
        : "+v"(cnt), "=&s"(m0), "=&s"(m1), "=&s"(m2), "=&s"(m3)
        : "v"(k0), "v"(k1), "v"(k2), "v"(k3), "v"(k4), "v"(k5), "v"(k6), "v"(k7), "s"(cand) : "vcc");
}
#define IDX_REP8(X, o) X((o) + 0) X((o) + 1) X((o) + 2) X((o) + 3) X((o) + 4) X((o) + 5) X((o) + 6) X((o) + 7)
template <int NREG>
__device__ __forceinline__ void indexer_task_n(int b, int t0, const f16_t* __restrict__ QI, const f16_t* __restrict__ KI, const float* __restrict__ WI, unsigned long long* __restrict__ MASK, int lane) {
    const int r32 = lane & 31, hi = lane >> 5; const size_t rowb = (size_t)b * SEQ;
    const f16_t* qp = QI + (rowb + t0 + (r32 >> 3)) * 256 + 32 * (r32 & 7) + 8 * hi;
    const f16x8 a0 = *(const f16x8*)(qp), a1 = *(const f16x8*)(qp + 16);
    f32x4 wv[4];
#pragma unroll
    for (int q = 0; q < 4; ++q) wv[q] = *(const f32x4*)(WI + (rowb + t0 + q) * 8 + 4 * hi);
    const int nst = (t0 + 3) / 64 + 1;
    const f16_t* kp = KI + (rowb + r32) * 32 + 8 * hi;
    unsigned key[4][NREG];
    f16x8 bq[3][4];
#pragma unroll
    for (int i = 0; i < 4; ++i) bq[0][i] = *(const f16x8*)(kp + (i >> 1) * 1024 + (i & 1) * 16);
    if (1 < nst) {
#pragma unroll
        for (int i = 0; i < 4; ++i) bq[1][i] = *(const f16x8*)(kp + (size_t)2048 + (i >> 1) * 1024 + (i & 1) * 16); }
#pragma unroll
    for (int st = 0; st < NREG; ++st) {
        if (st < nst) {
            if (st + 2 < NREG && st + 2 < nst) {
#pragma unroll
                for (int i = 0; i < 4; ++i) bq[(st + 2) % 3][i] = *(const f16x8*)(kp + (size_t)(st + 2) * 2048 + (i >> 1) * 1024 + (i & 1) * 16);
            }
            const f32x16 z16 = (f32x16){0.f, 0.f, 0.f, 0.f, 0.f, 0.f, 0.f, 0.f, 0.f, 0.f, 0.f, 0.f, 0.f, 0.f, 0.f, 0.f};
            f32x16 c0 = __builtin_amdgcn_mfma_f32_32x32x16_f16(a0, bq[st % 3][0], z16, 0, 0, 0);
            c0 = __builtin_amdgcn_mfma_f32_32x32x16_f16(a1, bq[st % 3][1], c0, 0, 0, 0);
            f32x16 c1 = __builtin_amdgcn_mfma_f32_32x32x16_f16(a0, bq[st % 3][2], z16, 0, 0, 0);
            c1 = __builtin_amdgcn_mfma_f32_32x32x16_f16(a1, bq[st % 3][3], c1, 0, 0, 0);
#pragma unroll
            for (int q = 0; q < 4; ++q) {
                float r0[4], r1[4];
#pragma unroll
                for (int i = 0; i < 4; ++i) { const float x0 = c0[4 * q + i], x1 = c1[4 * q + i]; const int i0 = __builtin_bit_cast(int, x0), i1 = __builtin_bit_cast(int, x1);
                    r0[i] = __builtin_bit_cast(float, i0 > 0 ? i0 : 0); r1[i] = __builtin_bit_cast(float, i1 > 0 ? i1 : 0); }
                const pg8::f32x2 w01 = (pg8::f32x2){wv[q][0], wv[q][1]}, w23 = (pg8::f32x2){wv[q][2], wv[q][3]};
                pg8::f32x2 sa = (pg8::f32x2){r0[0], r0[1]} * w01, sb = (pg8::f32x2){r1[0], r1[1]} * w01;
                sa = __builtin_elementwise_fma((pg8::f32x2){r0[2], r0[3]}, w23, sa); sb = __builtin_elementwise_fma((pg8::f32x2){r1[2], r1[3]}, w23, sb);
                const float pa = sa[0] + sa[1], pb = sb[0] + sb[1];
                const auto rr = __builtin_amdgcn_permlane32_swap(__builtin_bit_cast(unsigned, pa), __builtin_bit_cast(unsigned, pb), false, false);
                const unsigned rr0 = rr[0], rr1 = rr[1];
                const float sc = __builtin_bit_cast(float, rr0) + __builtin_bit_cast(float, rr1);
                key[q][st] = __builtin_bit_cast(unsigned, sc + 0.0f);
            }
        } else {
#pragma unroll
            for (int q = 0; q < 4; ++q) key[q][st] = 0u;
        }
    }
    const int t0u = __builtin_amdgcn_readfirstlane(t0), nstu = (t0u + 3) / 64 + 1;
    bool small_[4]; unsigned eq[4], gt[4]; int CG[4];
#pragma unroll
    for (int q = 0; q < 4; ++q) { small_[q] = (t0u + q < TOPK); gt[q] = 0u; CG[q] = small_[q] ? TOPK : 0;
        { const int nv_ = (lane <= t0u + q) ? ((t0u + q - lane) >> 6) + 1 : 0; eq[q] = small_[q] ? 0u : (nv_ >= 32 ? 0xffffffffu : ((1u << nv_) - 1u)); }
        if (!small_[q]) {
#define IDX_PSTAGE(J, SA, SB) _Pragma("unroll") for (int k = 0; k < 32; ++k) if ((k & J) == 0) { const unsigned a_ = key[q][k], b_ = key[q][k + J]; key[q][k] = __builtin_amdgcn_perm(b_, a_, SA); key[q][k + J] = __builtin_amdgcn_perm(b_, a_, SB); if ((k & 3) == 3) __builtin_amdgcn_sched_barrier(0); }
#define IDX_TSTAGE(J, MK) _Pragma("unroll") for (int k = 0; k < 32; ++k) if ((k & J) == 0) { const unsigned a_ = key[q][k], b_ = key[q][k + J]; \
                key[q][k] = (a_ & ~(MK << J)) | ((b_ << J) & (MK << J)); key[q][k + J] = (b_ & ~MK) | ((a_ >> J) & MK); if ((k & 3) == 3) __builtin_amdgcn_sched_barrier(0); }
            IDX_PSTAGE(16, 0x05040100u, 0x07060302u) IDX_PSTAGE(8, 0x06020400u, 0x07030501u) IDX_TSTAGE(4, 0x0f0f0f0fu) IDX_TSTAGE(2, 0x33333333u) IDX_TSTAGE(1, 0x55555555u)
#undef IDX_TSTAGE
#undef IDX_PSTAGE
        } }
#pragma unroll
    for (int b = 31; b >= 0; --b) {
        if (CG[0] == TOPK && CG[1] == TOPK && CG[2] == TOPK && CG[3] == TOPK) break;
        unsigned tb[4], c[4];
#pragma unroll
        for (int q = 0; q < 4; ++q) { unsigned sg_ = key[q][31]; asm volatile("" : "+v"(sg_));
            tb[q] = eq[q] & (b == 31 ? ~sg_ : (key[q][b] ^ sg_)); c[q] = (unsigned)__builtin_popcount(tb[q]); }
        const int s01 = wave_sum_i32((int)(c[0] | (c[1] << 16))), s23 = wave_sum_i32((int)(c[2] | (c[3] << 16)));
        const int tot[4] = {CG[0] + (s01 & 0xffff), CG[1] + (s01 >> 16), CG[2] + (s23 & 0xffff), CG[3] + (s23 >> 16)};
#pragma unroll
        for (int q = 0; q < 4; ++q) { const bool ge = tot[q] >= TOPK, ex = tot[q] == TOPK;
            const unsigned m1 = (!ge || ex) ? 0xffffffffu : 0u, ncm = ge ? 0u : 0xffffffffu;
            gt[q] |= tb[q] & m1; eq[q] = tb[q] ^ (eq[q] & ncm); CG[q] = (ge && !ex) ? CG[q] : tot[q]; }
    }
#define IDX_PUTW(bal, st) do { const unsigned long long b_ = (bal); asm volatile("s_nop 1\n\tv_writelane_b32 %0, %2, %4\n\tv_writelane_b32 %1, %3, %4" : "+v"(wlo), "+v"(whi) : "s"((unsigned)b_), "s"((unsigned)(b_ >> 32)), "n"(st));     } while (0)
#pragma unroll
    for (int q = 0; q < 4; ++q) {
        const int t = t0 + q; unsigned wlo = 0u, whi = 0u;
        if (t < TOPK) {
#define IDX_X(st) IDX_PUTW(__ballot(64 * (st) + lane <= t), st);
            IDX_REP8(IDX_X, 0)
#undef IDX_X
        } else {
            const bool ex = (CG[q] == TOPK); const unsigned gsel = gt[q], ties = eq[q]; int need = TOPK - CG[q];
            const unsigned long long lt = (1ull << lane) - 1ull;
#define IDX_X(st) { bool sel_ = (gsel >> (st)) & 1u; \
                    if (!ex) { const bool tie_ = (ties >> (st)) & 1u; const unsigned long long tb_ = __ballot(tie_); sel_ = sel_ || (tie_ && __popcll(tb_ & lt) < need); need -= __popcll(tb_); if (need < 0) need = 0; } \
                    IDX_PUTW(__ballot(sel_), st); }
            if (ex) {
                unsigned g = gsel;
#define IDX_XE(st) { unsigned long long bal_; asm volatile("v_add_co_u32_e64 %0, %1, %0, %0" : "+v"(g), "=s"(bal_)); IDX_PUTW(bal_, st); }
#define IDX_XE8(o) IDX_XE((o) + 7) IDX_XE((o) + 6) IDX_XE((o) + 5) IDX_XE((o) + 4) IDX_XE((o) + 3) IDX_XE((o) + 2) IDX_XE((o) + 1) IDX_XE((o) + 0)
                if (NREG > 24 && nst > 24) { IDX_XE8(24) } else g <<= 8;
                if (NREG > 16 && nst > 16) { IDX_XE8(16) } else g <<= 8;
                if (NREG > 8 && nst > 8) { IDX_XE8(8) } else g <<= 8;
                IDX_XE8(0)
#undef IDX_XE8
#undef IDX_XE
            } else {
            IDX_REP8(IDX_X, 0)
            if (NREG > 8 && nst > 8) { IDX_REP8(IDX_X, 8) }
            if (NREG > 16 && nst > 16) { IDX_REP8(IDX_X, 16) }
            if (NREG > 24 && nst > 24) { IDX_REP8(IDX_X, 24) }
            }
#undef IDX_X
        }
        if (lane < 32) MASK[(rowb + t) * 32 + lane] = (unsigned long long)wlo | ((unsigned long long)whi << 32);
    }
#undef IDX_PUTW
}
#undef IDX_REP8

constexpr int NWAVES = 8;
constexpr int RING_OFF = 0, RING_BYTES = 131072;
constexpr int LDSCTL_OFF = RING_BYTES, MISC_OFF = LDSCTL_OFF + 320;
constexpr int LDS_BYTES = 147456;
constexpr int TAB_OFF = MISC_OFF + 128;
constexpr int WTAB_OFF = TAB_OFF + 2048;
static_assert(WTAB_OFF + 8192 <= LDS_BYTES, "LDS map");
constexpr int N_PHASES = 8;

struct Args { const float* in[13]; float* out; unsigned char* ws; int ph_lo, ph_hi, li, pad; };

__device__ __forceinline__ void p0_transpose_item(const float* W, int K, int N, bf16_t* WT, int Nv, int mode, const float* kscale, LAS float* scr, int item, int lane) {
    const int nblk = Nv / 32, kb = item / nblk, nb = item % nblk, k0 = 64 * kb, n0 = 32 * nb;
    const int v = n0 + (lane & 31); const int a = mode == 0 ? v : (mode == 1 ? win_actual(v) : wup_actual(v));
    float vals[32];
    const float* wp = W + (size_t)(k0 + (lane >> 5)) * N + (a >= 0 ? a : 0);
#pragma unroll
    for (int i = 0; i < 32; ++i) vals[i] = wp[(size_t)(2 * i) * N];
#pragma unroll
    for (int i = 0; i < 32; ++i) { const int kk = 2 * i + (lane >> 5); float val = (a >= 0) ? vals[i] : 0.f;
        if (kscale) val *= kscale[k0 + kk];
        scr[kk * 33 + (lane & 31)] = val; }
    LDS_WAIT(); asm volatile("" ::: "memory");
    const int c = lane & 7;
#pragma unroll
    for (int j = 0; j < 4; ++j) { const int n = (lane >> 3) + 8 * j; const LAS float* s = scr + (8 * c) * 33 + n;
        v4u o; o.x = pk2(s[0 * 33], s[1 * 33]); o.y = pk2(s[2 * 33], s[3 * 33]); o.z = pk2(s[4 * 33], s[5 * 33]); o.w = pk2(s[6 * 33], s[7 * 33]);
        *(GAS v4u*)(WT + (size_t)(n0 + n) * K + k0 + 8 * c) = o; }
    LDS_WAIT(); asm volatile("" ::: "memory");
}

__global__ void __launch_bounds__(NWAVES * 64, 2) mk_fwd(Args args) {
    extern __shared__ __attribute__((aligned(16))) unsigned char lds[];
    LAS unsigned char* L = (LAS unsigned char*)lds;
    volatile LAS unsigned* MISC = (volatile LAS unsigned*)(L + MISC_OFF);
    const int wave = __builtin_amdgcn_readfirstlane((int)threadIdx.x >> 6);
#define MK_IDS const int lane = mk_lane(), tid = wave * 64 + lane; (void)tid
    const int G = gridDim.x; const int bx = blockIdx.x; const int vcu = (G % 8 == 0) ? (bx % 8) * (G / 8) + bx / 8 : bx;
    unsigned char* ws = args.ws;
    gu32* ctl = (gu32*)(ws + WS_CTL);
    const float* x = args.in[0]; const float* norm1_g = args.in[1]; const float* w_in = args.in[2]; const float* q_norm_g = args.in[3]; const float* k_norm_g = args.in[4];
    const float* w_out = args.in[7]; const float* norm2_g = args.in[8]; const float* w_up = args.in[9]; const float* conv_w = args.in[10]; const float* conv_b = args.in[11]; const float* w_down = args.in[12];
    float* out = args.out;
    float* ROPE = (float*)(ws + WS_ROPE); float* ROPE16 = (float*)(ws + WS_ROPE16);
    bf16_t *Win = (bf16_t*)(ws + WS_WIN), *Wout = (bf16_t*)(ws + WS_WOUT), *Wup = (bf16_t*)(ws + WS_WUP), *Wdn = (bf16_t*)(ws + WS_WDN);
    float* SS2 = (float*)(ws + WS_SS2);
    bf16_t *XN = (bf16_t*)(ws + WS_XN), *VP = (bf16_t*)(ws + WS_VP), *Q = (bf16_t*)(ws + WS_Q), *Kb = (bf16_t*)(ws + WS_K), *Vb = (bf16_t*)(ws + WS_V);
    f16_t *QI = (f16_t*)(ws + WS_QI), *KI = (f16_t*)(ws + WS_KI); float* WI = (float*)(ws + WS_WI);
    bf16_t *MIX = (bf16_t*)(ws + WS_MIX), *Gb = (bf16_t*)(ws + WS_G);
    bf16_t *HF = (bf16_t*)(ws + WS_HF), *HL = (bf16_t*)(ws + WS_HL);
    unsigned long long* MASK = (unsigned long long*)(ws + WS_MASK); const float* pool_w = args.in[5]; const float* pool_scale = args.in[6];

    for (int u = (int)threadIdx.x; u < (LDS_BYTES - LDSCTL_OFF) / 4; u += NWAVES * 64) ((LAS unsigned*)(L + LDSCTL_OFF))[u] = 0u;
    __syncthreads();
    if (threadIdx.x == 0) __hip_atomic_store((unsigned*)ctl + CW_XCCT + bx, 1u + xb_xcc_id(), __ATOMIC_RELAXED, __HIP_MEMORY_SCOPE_AGENT);
    const int ngrp = (G == 256) ? 8 : 1, grp = bx % ngrp, gsz = G / ngrp, member = vcu % gsz;
    GrpBar gbar{(unsigned*)ctl + CW_GRP + 64 * grp, (unsigned)gsz, MISC + 8, wave == 0};
    XcdBarrier bar = xcd_barrier_post((unsigned*)(ctl + CW_BAR) + args.li * XCD_BAR_WORDS, MISC + 8); bar.w0 = (wave == 0);
    const int lo = args.ph_lo, hi = args.ph_hi;
#define IN(k) (lo <= (k) && (k) < hi)
#define SEAM(k) do { if (IN(k) && IN((k) + 1)) { if ((k) == 0) xcd_barrier(bar); else grp_barrier(gbar); } } while (0)
    const int gw = vcu * NWAVES + wave, NGW = G * NWAVES;

    if (IN(0)) for (int rep_ = 0; rep_ < kReps[0]; ++rep_) { if (rep_) xcd_barrier(bar);
        MK_IDS;
        LAS float* scr = (LAS float*)(L + RING_OFF + wave * 16384);
        constexpr int I_IN = (D_MODEL / 64) * (IN_WV / 32), I_OUT = (D_MODEL / 64) * (D_MODEL / 32), I_UP = (D_MODEL / 64) * (UP_W / 32), I_DN = (DFF / 64) * (D_MODEL / 32);
        for (int sr_ = 0; sr_ < kSub[1]; ++sr_)
        for (int item = vcu; item < 4 * (D_MODEL / 16); item += G) {
            const int g = item >> 6, n0 = 16 * (item & 63);
            LAS float* pwL = (LAS float*)(L + RING_OFF); LAS float* woL = pwL + 128 * 132;
#pragma unroll
            for (int k = 0; k < 8; ++k) { const int idx = tid + 512 * k, c = idx >> 5, d4 = idx & 31;
                *(LAS f32x4*)(pwL + c * 132 + 4 * d4) = *(const f32x4*)(pool_w + (size_t)(128 * g + c) * 128 + 4 * d4); }
            { const int d = tid >> 2, q = tid & 3; *(LAS f32x4*)(woL + d * 16 + 4 * q) = *(const f32x4*)(w_out + (size_t)(128 * g + d) * D_MODEL + n0 + 4 * q) * pool_scale[128 * g + d]; }
            __syncthreads();
            const int c = tid & 127, nq = wave >> 1;
            f32x4 acc4 = (f32x4){0.f, 0.f, 0.f, 0.f};
#pragma unroll 8
            for (int d4 = 0; d4 < 32; ++d4) { const f32x4 p = *(const LAS f32x4*)(pwL + c * 132 + 4 * d4);
#pragma unroll
                for (int i = 0; i < 4; ++i) acc4 += p[i] * *(const LAS f32x4*)(woL + (4 * d4 + i) * 16 + 4 * nq); }
#pragma unroll
            for (int j = 0; j < 4; ++j) Wout[(size_t)(n0 + 4 * nq + j) * D_MODEL + 128 * g + c] = (bf16_t)f2bf(acc4[j]);
            __syncthreads();
        }
        for (int sr_ = 0; sr_ < kSub[0]; ++sr_)
        for (int it = gw; it < I_IN + I_OUT + I_UP + I_DN; it += NGW) {
            int r = it;
            if (r < I_IN) { p0_transpose_item(w_in, D_MODEL, IN_W, Win, IN_WV, 1, nullptr, scr, r, lane); continue; } r -= I_IN;
            if (r < I_OUT) { if (r >= 8 * (D_MODEL / 32)) p0_transpose_item(w_out, D_MODEL, D_MODEL, Wout, D_MODEL, 0, nullptr, scr, r, lane); continue; } r -= I_OUT;
            if (r < I_UP) { p0_transpose_item(w_up, D_MODEL, UP_W, Wup, UP_W, 2, norm2_g, scr, r, lane); continue; } r -= I_UP;
            p0_transpose_item(w_down, DFF, D_MODEL, Wdn, D_MODEL, 0, nullptr, scr, r, lane);
        }
        for (int sr_ = 0; sr_ < kSub[2]; ++sr_)
        for (int i = vcu * NWAVES * 64 + tid; i < SEQ * 48; i += G * NWAVES * 64) {
            int pos, k; float inv; float* dst;
            if (i < SEQ * 32) { pos = i >> 5; k = i & 31; inv = expf(-logf(10000.0f) * (float)k / 32.0f); dst = ROPE + 2 * i; }
            else { const int i2 = i - SEQ * 32; pos = i2 >> 4; k = i2 & 15; inv = expf(-logf(10000.0f) * (float)k / 16.0f); dst = ROPE16 + 2 * i2; }
            float s, c; sincosf((float)pos * inv, &s, &c); dst[0] = c; dst[1] = s;
        }
        for (int sr_ = 0; sr_ < kSub[3]; ++sr_)
        for (int m4 = gw; m4 < M / 4; m4 += NGW) {
            f32x4 v[4][4]; float ssq[4];
#pragma unroll
            for (int r = 0; r < 4; ++r) { const GAS f32x4* xr = (const GAS f32x4*)(x + (size_t)(4 * m4 + r) * D_MODEL) + lane;
#pragma unroll
                for (int j = 0; j < 4; ++j) v[r][j] = xr[64 * j]; }
#pragma unroll
            for (int r = 0; r < 4; ++r) { float s = 0.f;
#pragma unroll
                for (int j = 0; j < 4; ++j) s += (v[r][j].x * v[r][j].x + v[r][j].y * v[r][j].y) + (v[r][j].z * v[r][j].z + v[r][j].w * v[r][j].w);
                ssq[r] = s; }
#pragma unroll
            for (int o = 1; o < 64; o <<= 1) {
#pragma unroll
                for (int r = 0; r < 4; ++r) ssq[r] += __shfl_xor(ssq[r], o); }
#pragma unroll
            for (int r = 0; r < 4; ++r) { const float rstd = 1.0f / sqrtf(ssq[r] * (1.0f / D_MODEL) + EPS);
                GAS unsigned long long* o8 = (GAS unsigned long long*)(XN + (size_t)(4 * m4 + r) * D_MODEL) + lane;
#pragma unroll
                for (int j = 0; j < 4; ++j) { const f32x4 gg = ((const f32x4*)norm1_g)[lane + 64 * j];
                    o8[64 * j] = (unsigned long long)pk2(v[r][j].x * rstd * gg.x, v[r][j].y * rstd * gg.y) | ((unsigned long long)pk2(v[r][j].z * rstd * gg.z, v[r][j].w * rstd * gg.w) << 32); } }
        }
    }
    SEAM(0);
    if (wave == 0) {
        const int l = mk_lane(); const unsigned mine = __hip_atomic_load((unsigned*)ctl + CW_XCCT + bx, __ATOMIC_RELAXED, __HIP_MEMORY_SCOPE_AGENT);
        bool ok = (ngrp == 8) && mine != 0u;
        for (int m = l; m < gsz; m += 64) ok = ok && (__hip_atomic_load((unsigned*)ctl + CW_XCCT + grp + ngrp * m, __ATOMIC_RELAXED, __HIP_MEMORY_SCOPE_AGENT) == mine);
        const bool same = __all(ok);
        if (l == 0) MISC[10] = same ? 2u : 1u;
    }
    if (IN(1)) for (int rep_ = 0; rep_ < kReps[1]; ++rep_) { if (rep_) xcd_barrier(bar);
        pg8::Gemm g{XN, Win, M, IN_WV, D_MODEL}; pg8::StaticOrder S; S.init(M, IN_WV, G, bx);
        pg8::EpiProj E{VP, Q, Kb, Vb, QI, KI, WI, ROPE, ROPE16, q_norm_g, k_norm_g};
        pg8::gemm_phase<pg8::EpiProj, pg8::StaticOrder, true, true>(L + RING_OFF, g, S, E, wave);
    }
    SEAM(1);
    if (IN(2)) for (int rep_ = 0; rep_ < kReps[2]; ++rep_) { if (rep_) xcd_barrier(bar);
        MK_IDS;
        for (int sr_ = 0; sr_ < kSub[4]; ++sr_)
        for (int wj = member * NWAVES + wave; wj < M / 4 / ngrp; wj += gsz * NWAVES) { const int wi = grp * (M / 4 / ngrp) + wj;
            const int row = 4 * wi + (lane >> 4), t = row & (SEQ - 1);
            const bf16_t* vp = VP + (size_t)row * POOL_W + 8 * (lane & 15);
            v4u u2[2], u4[4], u8[8], u16[16];
#define POOL_LD(U, W, g) _Pragma("unroll") for (int k = 0; k < W; ++k) U[k] = *(const v4u*)(vp + 128 * (g) - (size_t)((k <= t) ? k : 0) * POOL_W);
            POOL_LD(u2, 2, 0) POOL_LD(u4, 4, 1) POOL_LD(u8, 8, 2) POOL_LD(u16, 16, 3)
#undef POOL_LD
#define POOL_OUT(U, W, g) do { float sum[8], v0[8]; \
                _Pragma("unroll") for (int e = 0; e < 8; ++e) sum[e] = 0.f; \
                _Pragma("unroll") for (int k = 0; k < W; ++k) { const float m_ = (k <= t) ? 1.f : 0.f; const unsigned uu[4] = {U[k].x, U[k].y, U[k].z, U[k].w}; \
                    _Pragma("unroll") for (int e = 0; e < 4; ++e) { const float lo = __builtin_bit_cast(float, uu[e] << 16), hh = __builtin_bit_cast(float, uu[e] & 0xffff0000u); sum[2 * e] += m_ * lo; sum[2 * e + 1] += m_ * hh; \
                        if (k == 0) { v0[2 * e] = lo; v0[2 * e + 1] = hh; } } } \
                const float rc = 1.0f / (float)((t + 1 < W) ? t + 1 : W); \
                v4u o; o.x = pk2(sum[0] * rc - v0[0], sum[1] * rc - v0[1]); o.y = pk2(sum[2] * rc - v0[2], sum[3] * rc - v0[3]); o.z = pk2(sum[4] * rc - v0[4], sum[5] * rc - v0[5]); o.w = pk2(sum[6] * rc - v0[6], sum[7] * rc - v0[7]); \
                *(v4u*)(MIX + (size_t)row * 1024 + 128 * (g) + 8 * (lane & 15)) = o; } while (0)
            POOL_OUT(u2, 2, 0); POOL_OUT(u4, 4, 1); POOL_OUT(u8, 8, 2); POOL_OUT(u16, 16, 3);
#undef POOL_OUT
        }
        for (int sr_ = 0; sr_ < kSub[5]; ++sr_)
        for (int id = gw; id < M / 4; id += NGW) {
            const int w = id & 2047, bb = w >> 8, tq = (id < 2048) ? (w & 255) : 511 - (w & 255);
            indexer_task_n<32>(bb, 4 * tq, QI, KI, WI, MASK, lane);
        }
    }
    SEAM(2);
    if (IN(3)) for (int rep_ = 0; rep_ < kReps[3]; ++rep_) { if (rep_) xcd_barrier(bar);
        const attn_body::AttnTensors AT{(const attn_body::bf16*)Q, (const attn_body::bf16*)Kb, (const attn_body::bf16*)Vb, MASK, (attn_body::bf16*)MIX};
        const attn_body::StaticOrder S((int)G, (int)bx);
        attn_body::attn_phase<attn_body::StaticOrder>((char*)lds + RING_OFF, AT, S, wave);
    }
    SEAM(3);
    if (IN(4)) for (int rep_ = 0; rep_ < kReps[4]; ++rep_) { if (rep_) xcd_barrier(bar);
        pg8::Gemm g{MIX, Wout, M, D_MODEL, D_MODEL}; pg8::StaticOrder S; S.init(M, D_MODEL, G, bx);
        pg8::EpiWout E{x, XN, SS2};
        pg8::gemm_phase<pg8::EpiWout, pg8::StaticOrder, true, true>(L + RING_OFF, g, S, E, wave);
    }
    SEAM(4);
    if (IN(5)) for (int rep_ = 0; rep_ < kReps[5]; ++rep_) { if (rep_) xcd_barrier(bar);
        pg8::Gemm g{XN, Wup, M, UP_W, D_MODEL}; pg8::UpOrder S; S.init(M, UP_W, G, bx); S.SS2 = SS2; S.tab = (LAS float*)(L + TAB_OFF); S.wtab = (LAS float*)(L + WTAB_OFF); S.conv_w = conv_w; S.conv_b = conv_b; S.wv = wave; S.par = 0;
        pg8::EpiUp E{(const LAS float*)(L + TAB_OFF), (const LAS float*)(L + WTAB_OFF), Gb, HF, HL, 0};
        pg8::gemm_phase<pg8::EpiUp, pg8::UpOrder, true, true, true>(L + RING_OFF, g, S, E, wave);
    }
    SEAM(5);
    if (IN(6)) for (int rep_ = 0; rep_ < kReps[6]; ++rep_) { if (rep_) xcd_barrier(bar);
        MK_IDS;
        for (int il = member * NWAVES * 64 + tid; il < (256 / ngrp) * 2 * (DFF / 4); il += gsz * NWAVES * 64) { const int idx = grp * ((256 / ngrp) * 2 * (DFF / 4)) + il;
            const int n4 = idx % (DFF / 4), gj = idx / (DFF / 4), j = gj & 1, g64 = gj >> 1, n = 4 * n4;
            const int vg = 256 * (n >> 7) + (n & 127);
            f32x4 cc[2];
#pragma unroll
            for (int bj = 0; bj < 2; ++bj) { const int v = vg + 128 * bj;
#define HLD(P, r) ({ const unsigned long long w_ = *(const unsigned long long*)((P) + (size_t)(r) * UP_W + v); (f32x4){__builtin_bit_cast(float, (unsigned)w_ << 16), __builtin_bit_cast(float, (unsigned)w_ & 0xffff0000u), __builtin_bit_cast(float, (unsigned)(w_ >> 32) << 16), __builtin_bit_cast(float, (unsigned)(w_ >> 32) & 0xffff0000u)}; })
                const f32x4 f0 = HLD(HF, g64 * 2 + 0), f1 = HLD(HF, g64 * 2 + 1);
                f32x4 l0 = (f32x4){0.f, 0.f, 0.f, 0.f}, l1 = l0;
                if (g64 & 31) { l0 = HLD(HL, (g64 - 1) * 2 + 0); l1 = HLD(HL, (g64 - 1) * 2 + 1); }
#undef HLD
                const f32x4 um2 = j ? l1 : l0, um1 = j ? f0 : l1, u0 = j ? f1 : f0;
                const float* wp = conv_w + bj * DFF + n;
                cc[bj] = *(const f32x4*)(conv_b + bj * DFF + n) + *(const f32x4*)(wp) * um2 + *(const f32x4*)(wp + UP_W) * um1 + *(const f32x4*)(wp + 2 * UP_W) * u0; }
            float gs[4];
#pragma unroll
            for (int i = 0; i < 4; ++i) { const float gt = cc[0][i]; gs[i] = gt / (1.0f + __expf(-gt)) * cc[1][i]; }
            unsigned long long w = (unsigned long long)pk2(gs[0], gs[1]) | ((unsigned long long)pk2(gs[2], gs[3]) << 32);
            *(unsigned long long*)(Gb + (size_t)(64 * g64 + j) * DFF + n) = w;
        }
    }
    SEAM(6);
    if (IN(7)) {
        pg8::Gemm g{Gb, Wdn, M, D_MODEL, DFF}; pg8::StaticOrder S; S.init(M, D_MODEL, G, bx);
        pg8::EpiDown E{XN, out};
        pg8::gemm_phase<pg8::EpiDown, pg8::StaticOrder, true, true>(L + RING_OFF, g, S, E, wave);
    }
#undef IN
#undef SEAM
}

static int mk_grid() {
    static int grid = 0;
    if (grid == 0) {
        int dev = 0, cus = 0, per_cu = 0;
        if (hipGetDevice(&dev) != hipSuccess || hipDeviceGetAttribute(&cus, hipDeviceAttributeMultiprocessorCount, dev) != hipSuccess) { fprintf(stderr, "kernel_launch: device query failed\n"); grid = -1; return grid; }
        if (hipFuncSetAttribute((const void*)mk_fwd, hipFuncAttributeMaxDynamicSharedMemorySize, LDS_BYTES) != hipSuccess) { fprintf(stderr, "kernel_launch: hipFuncSetAttribute failed\n"); grid = -1; return grid; }
        if (hipOccupancyMaxActiveBlocksPerMultiprocessor(&per_cu, (const void*)mk_fwd, NWAVES * 64, LDS_BYTES) != hipSuccess || per_cu < 1) { fprintf(stderr, "kernel_launch: occupancy query reports %d workgroups per CU\n", per_cu); (void)hipGetLastError(); }
        grid = cus;
    }
    return grid;
}
static void mk_launch(Args a, int lo, int hi, int li, hipStream_t stream) {
    const int grid = mk_grid(); if (grid <= 0) return;
    a.ph_lo = lo; a.ph_hi = hi; a.li = li;
    hipLaunchKernelGGL(mk_fwd, dim3(grid), dim3(NWAVES * 64), LDS_BYTES, stream, a);
}

extern "C" void kernel_launch(void* const* d_in, const int* in_sizes, int n_in, void* d_out, int out_size, void* d_ws, size_t ws_size, hipStream_t stream) {
    const float* pool_w = (const float*)d_in[5]; const float* pool_scale = (const float*)d_in[6];
    unsigned char* ws = (unsigned char*)d_ws;
    bf16_t *VP = (bf16_t*)(ws + WS_VP), *Q = (bf16_t*)(ws + WS_Q), *Kb = (bf16_t*)(ws + WS_K), *Vb = (bf16_t*)(ws + WS_V);
    f16_t *QI = (f16_t*)(ws + WS_QI), *KI = (f16_t*)(ws + WS_KI); float* WI = (float*)(ws + WS_WI);
    unsigned long long* MASK = (unsigned long long*)(ws + WS_MASK); bf16_t* MIX = (bf16_t*)(ws + WS_MIX);
    (void)hipMemsetAsync(ws + WS_CTL, 0, CTL_ZERO_BYTES, stream);
    Args a{};
    for (int i = 0; i < 13; ++i) a.in[i] = (const float*)d_in[i];
    a.out = (float*)d_out; a.ws = ws;
    mk_launch(a, 0, N_PHASES, 0, stream);
}
```

```cpp
#include <hip/hip_runtime.h>
#include <cstdint>
#include <cstdio>

typedef unsigned short bf16_t;
typedef _Float16 f16_t;

constexpr int D_MODEL = 1024, BATCH = 8, SEQ = 2048, M = BATCH * SEQ;
constexpr int POOL_W = 512, NQH = 8, HD = 64, NKV = 2, IH = 8, ID = 32, TOPK = 256;
constexpr int IN_W = 1576, IN_WV = 1792;
constexpr int DFF = 2816, UP_W = 2 * DFF;
constexpr float EPS = 1e-6f;
constexpr float C2 = 0.125f * 1.4426950408889634f;

constexpr size_t MiB = 1u << 20;
constexpr size_t WS_CTL = 0, CTL_ZERO_BYTES = 32768;
constexpr size_t WS_ROPE = 1 * MiB;
constexpr size_t WS_ROPE16 = 1 * MiB + 512 * 1024;
constexpr size_t WS_WIN = 2 * MiB, WS_WOUT = 6 * MiB, WS_WUP = 8 * MiB, WS_WDN = 19 * MiB;
constexpr size_t WS_SS2 = 25 * MiB;
constexpr size_t WS_RSTD2 = 26 * MiB;
constexpr size_t WS_XN = 28 * MiB;
constexpr size_t WS_VP = 60 * MiB, WS_Q = 76 * MiB, WS_K = 92 * MiB, WS_V = 96 * MiB, WS_QI = 100 * MiB, WS_KI = 108 * MiB, WS_WI = 109 * MiB;
constexpr size_t WS_MASK = 110 * MiB, WS_MIX = 114 * MiB;
constexpr size_t WS_G = 146 * MiB;
constexpr size_t WS_HF = 234 * MiB, WS_HL = 240 * MiB;
constexpr int CW_XCCT = 7680;
constexpr int CW_GRP = 0;
constexpr int CW_BAR = 4096;

#define GAS __attribute__((address_space(1)))
#define LAS __attribute__((address_space(3)))
typedef unsigned short bf16;
typedef unsigned v4u __attribute__((ext_vector_type(4)));
typedef float f32x4 __attribute__((ext_vector_type(4)));
typedef short bf16x8 __attribute__((ext_vector_type(8)));
typedef GAS unsigned gu32;
typedef GAS unsigned long long gu64;
#define RLX_AGENT __ATOMIC_RELAXED, __HIP_MEMORY_SCOPE_AGENT
#define LDS_WAIT() asm volatile("s_waitcnt lgkmcnt(0)" ::: "memory")
#define VM_WAIT() asm volatile("s_waitcnt vmcnt(0)" ::: "memory")
__device__ __forceinline__ unsigned long long rt() { return __builtin_amdgcn_s_memrealtime(); }
__device__ __forceinline__ unsigned f2bf(float f) { unsigned u = __builtin_bit_cast(unsigned, f); return (u + 0x7fffu + ((u >> 16) & 1u)) >> 16; }
typedef float mk_f32x2 __attribute__((ext_vector_type(2))); typedef __bf16 mk_bf16x2 __attribute__((ext_vector_type(2)));
__device__ __forceinline__ unsigned pk2(float lo, float hi) { const mk_f32x2 v = {lo, hi}; return __builtin_bit_cast(unsigned, __builtin_convertvector(v, mk_bf16x2)); }

#define XB_TMO      128
#define XB_XCNT(j)  (256  + 64 * (j))
#define XB_XSUB(j)  (1280 + 64 * (j))
#define XB_XGEN(j)  (2304 + 64 * (j))
#define XB_TOP      3328
#define XB_TOPGEN   3392
#define XCD_BAR_WORDS 3456
#define XB_SPIN_CAP (1u << 18)

__device__ __forceinline__ unsigned xb_ld(unsigned* p)              { return __hip_atomic_load(p, __ATOMIC_RELAXED, __HIP_MEMORY_SCOPE_AGENT); }
__device__ __forceinline__ unsigned xb_add(unsigned* p, unsigned v) { return __hip_atomic_fetch_add(p, v, __ATOMIC_RELAXED, __HIP_MEMORY_SCOPE_AGENT); }
__device__ __forceinline__ unsigned xb_xcc_id() { return (unsigned)__builtin_amdgcn_s_getreg((3 << 11) | 20) & 0xFu; }
#define XB_SPIN(cond, bar) do { unsigned _sp = 0; while (cond) { __builtin_amdgcn_s_sleep(1); \
    if ((++_sp & 255u) == 0u) { if (xb_ld(&(bar)[XB_TMO])) break; if (_sp > XB_SPIN_CAP) { atomicAdd(&(bar)[XB_TMO], 1u); break; } } } } while (0)

struct XcdBarrier {
    unsigned* bar; unsigned x;
    volatile LAS unsigned* st;
    bool w0;
};

__device__ __forceinline__ XcdBarrier xcd_barrier_post(unsigned* bar, volatile LAS unsigned* st) {
    XcdBarrier b; b.bar = bar; b.x = xb_xcc_id(); b.st = st;
    if (threadIdx.x == 0) (void)xb_add(&bar[XB_XCNT(b.x)], 1u);
    return b;
}
__device__ __forceinline__ void xcd_barrier_complete(unsigned* bar, unsigned x, unsigned& nloc, unsigned& nx) {
    const unsigned G = gridDim.x * gridDim.y * gridDim.z;
    unsigned sum, cnt, mine, sp = 0u;
    for (;;) {
        sum = 0u; cnt = 0u; mine = 0u;
#pragma unroll
        for (unsigned j = 0; j < 16; ++j) { const unsigned c = xb_ld(&bar[XB_XCNT(j)]); sum += c; cnt += (c > 0u) ? 1u : 0u; mine = (j == x) ? c : mine; }
        if (sum == G) break;
        __builtin_amdgcn_s_sleep(1);
        if ((++sp & 255u) == 0u) { if (xb_ld(&bar[XB_TMO])) break; if (sp > XB_SPIN_CAP) { atomicAdd(&bar[XB_TMO], 1u); break; } }
    }
    nloc = mine > 0u ? mine : 1u; nx = cnt > 0u ? cnt : 1u;
}

__device__ __forceinline__ void xcd_barrier(const XcdBarrier& b) {
    asm volatile("s_waitcnt vmcnt(0)" ::: "memory");
    __syncthreads();
    if (b.w0 && __builtin_amdgcn_mbcnt_hi(~0u, __builtin_amdgcn_mbcnt_lo(~0u, 0u)) == 0u) {
        unsigned* bar = b.bar;
        __builtin_amdgcn_s_waitcnt(0);
        unsigned nloc = b.st[0], nx = b.st[1];
        if (nloc == 0u) { xcd_barrier_complete(bar, b.x, nloc, nx); b.st[0] = nloc; b.st[1] = nx; }
        const unsigned old = xb_add(&bar[XB_XSUB(b.x)], 1u);
        const unsigned gen = old / nloc;
        if (old + 1u == (gen + 1u) * nloc) {
            __builtin_amdgcn_fence(__ATOMIC_RELEASE, "agent");
            asm volatile("s_waitcnt vmcnt(0)" ::: "memory");
            const unsigned og = xb_add(&bar[XB_TOP], 1u);
            const unsigned tg = og / nx;
            if (og + 1u == (tg + 1u) * nx) xb_add(&bar[XB_TOPGEN], 1u);
            else XB_SPIN(xb_ld(&bar[XB_TOPGEN]) == tg, bar);
            __builtin_amdgcn_fence(__ATOMIC_ACQUIRE, "agent");
            xb_add(&bar[XB_XGEN(b.x)], 1u);
            asm volatile("s_waitcnt vmcnt(0)" ::: "memory");
        } else {
            XB_SPIN(xb_ld(&bar[XB_XGEN(b.x)]) == gen, bar);
            __builtin_amdgcn_fence(__ATOMIC_ACQUIRE, "agent");
            asm volatile("s_waitcnt vmcnt(0)" ::: "memory");
        }
    }
    __syncthreads();
}

struct GrpBar { unsigned* cnt; unsigned n; volatile LAS unsigned* st; bool w0; };
__device__ __forceinline__ void grp_barrier_arrive(const GrpBar& b) {
    asm volatile("s_waitcnt vmcnt(0)" ::: "memory");
    __syncthreads();
    if (b.w0 && __builtin_amdgcn_mbcnt_hi(~0u, __builtin_amdgcn_mbcnt_lo(~0u, 0u)) == 0u) {
        __builtin_amdgcn_s_waitcnt(0);
        if (b.st[2] != 2u) { __builtin_amdgcn_fence(__ATOMIC_RELEASE, "agent"); asm volatile("s_waitcnt vmcnt(0)" ::: "memory"); }
        const unsigned old = xb_add(b.cnt, 1u); b.st[3] = (old / b.n + 1u) * b.n;
    }
}
__device__ __forceinline__ void grp_barrier_wait(const GrpBar& b) {
    if (b.w0 && __builtin_amdgcn_mbcnt_hi(~0u, __builtin_amdgcn_mbcnt_lo(~0u, 0u)) == 0u) {
        const unsigned target = b.st[3];
        unsigned sp = 0u; while ((int)(xb_ld(b.cnt) - target) < 0) { __builtin_amdgcn_s_sleep(1); if (++sp > (1u << 22)) break; }
        __builtin_amdgcn_fence(__ATOMIC_ACQUIRE, "agent");
        asm volatile("s_waitcnt vmcnt(0)" ::: "memory");
    }
    __syncthreads();
}
__device__ __forceinline__ void grp_barrier_wait_asm(const GrpBar& b) {
    if (b.w0) {
        const unsigned target = b.st[3]; unsigned t0, t1;
        asm volatile("v_mov_b32 %1, 0\n"
                     "1:\n\t"
                     "global_load_dword %0, %2, off sc1\n\t"
                     "s_waitcnt vmcnt(0)\n\t"
                     "v_sub_u32 %0, %0, %3\n\t"
                     "v_add_u32 %1, 1, %1\n\t"
                     "v_cmp_gt_i32 vcc, 0, %0\n\t"
                     "s_cbranch_vccz 2f\n\t"
                     "v_cmp_gt_u32 vcc, 0x400000, %1\n\t"
                     "s_cbranch_vccz 2f\n\t"
                     "s_sleep 1\n\t"
                     "s_branch 1b\n"
                     "2:\n\t"
                     "buffer_inv sc1\n\t"
                     "s_waitcnt vmcnt(0)"
                     : "=&v"(t0), "=&v"(t1) : "v"(b.cnt), "v"(target) : "vcc", "memory");
    }
    __syncthreads();
}
__device__ __forceinline__ void grp_barrier(const GrpBar& b) {
    asm volatile("s_waitcnt vmcnt(0)" ::: "memory");
    __syncthreads();
    if (b.w0 && __builtin_amdgcn_mbcnt_hi(~0u, __builtin_amdgcn_mbcnt_lo(~0u, 0u)) == 0u) {
        __builtin_amdgcn_s_waitcnt(0);
        if (b.st[2] != 2u) { __builtin_amdgcn_fence(__ATOMIC_RELEASE, "agent"); asm volatile("s_waitcnt vmcnt(0)" ::: "memory"); }
        const unsigned old = xb_add(b.cnt, 1u), target = (old / b.n + 1u) * b.n;
        unsigned sp = 0u; while (xb_ld(b.cnt) < target) { __builtin_amdgcn_s_sleep(1); if (++sp > (1u << 22)) break; }
        __builtin_amdgcn_fence(__ATOMIC_ACQUIRE, "agent");
        asm volatile("s_waitcnt vmcnt(0)" ::: "memory");
    }
    __syncthreads();
}

__device__ __forceinline__ void xcd_barrier_arrive(const XcdBarrier& b) {
    asm volatile("s_waitcnt vmcnt(0)" ::: "memory");
    __syncthreads();
    if (b.w0 && __builtin_amdgcn_mbcnt_hi(~0u, __builtin_amdgcn_mbcnt_lo(~0u, 0u)) == 0u) {
        unsigned* bar = b.bar;
        __builtin_amdgcn_s_waitcnt(0);
        unsigned nloc = b.st[0], nx = b.st[1];
        if (nloc == 0u) { xcd_barrier_complete(bar, b.x, nloc, nx); b.st[0] = nloc; b.st[1] = nx; }
        const unsigned old = xb_add(&bar[XB_XSUB(b.x)], 1u);
        if (old + 1u == nloc) {
            __builtin_amdgcn_fence(__ATOMIC_RELEASE, "agent");
            asm volatile("s_waitcnt vmcnt(0)" ::: "memory");
            const unsigned og = xb_add(&bar[XB_TOP], 1u);
            if (og + 1u == nx) xb_add(&bar[XB_TOPGEN], 1u);
        }
    }
}
__device__ __forceinline__ void xcd_barrier_wait(const XcdBarrier& b) {
    if (b.w0 && __builtin_amdgcn_mbcnt_hi(~0u, __builtin_amdgcn_mbcnt_lo(~0u, 0u)) == 0u) {
        unsigned* bar = b.bar;
        XB_SPIN(xb_ld(&bar[XB_TOPGEN]) == 0u, bar);
        __builtin_amdgcn_fence(__ATOMIC_ACQUIRE, "agent");
        asm volatile("s_waitcnt vmcnt(0)" ::: "memory");
    }
    __syncthreads();
}

__device__ __forceinline__ int mk_lane() { return (int)__builtin_amdgcn_mbcnt_hi(~0u, __builtin_amdgcn_mbcnt_lo(~0u, 0u)); }
__device__ __forceinline__ float bf2f(bf16_t b) { return __builtin_bit_cast(float, (unsigned)b << 16); }
__device__ __forceinline__ float wave_sum(float v) {
#pragma unroll
    for (int o = 1; o < 64; o <<= 1) v += __shfl_xor(v, o);
    return v;
}
__device__ __forceinline__ float wave_max(float v) {
#pragma unroll
    for (int o = 1; o < 64; o <<= 1) v = fmaxf(v, __shfl_xor(v, o));
    return v;
}

__host__ __device__ __forceinline__ int win_actual(int v) {
    const int pn = v >> 8, w = v & 255, bj = w >> 7, wc = (w >> 5) & 3, j = w & 31;
    if (pn < 2) return v;
    if (pn < 5) return 512 + 64 * (4 * (pn - 2) + wc) + 32 * bj + j;
    const int hd = 2 * wc + (j >> 4), d = 16 * bj + (j & 15);
    if (pn == 5) return 1280 + 32 * hd + d;
    if (hd == 0) return 1536 + d;
    if (hd == 1 && d < 8) return 1568 + d;
    return -1;
}
__host__ __device__ __forceinline__ int wup_actual(int v) { const int pn = v >> 8, w = v & 255; return (w >> 7) * DFF + 128 * pn + (w & 127); }

namespace pg8 {
#define PG8_LAS __attribute__((address_space(3)))
typedef unsigned short bf16_t;
typedef short bf16x8 __attribute__((ext_vector_type(8)));
typedef float f32x4 __attribute__((ext_vector_type(4)));
typedef unsigned u32x4 __attribute__((ext_vector_type(4)));
constexpr int BM = 256, BK = 64, HALF = 128, HTB = HALF * BK * 2  , STAGE_BYTES = 8 * HTB, NXCD = 8, WGM = 8;

__host__ __device__ __forceinline__ int lds_byte(int r, int c) { const int st = (r >> 4) * 2 + (c >> 5), rr = r & 15, cc = c & 31, ob = rr * 64 + cc * 2; return st * 1024 + (ob ^ (((ob >> 9) & 1) << 5)); }
__host__ __device__ __forceinline__ void stage_rc(int b, int& R, int& C) { const int st = b / 1024, sb = b % 1024, swz = sb ^ (((sb >> 9) & 1) << 5); R = (st >> 1) * 16 + swz / 64; C = (st & 1) * 32 + (swz % 64) / 2; }
__host__ __device__ __forceinline__ int perm32(int rho) { const int n = rho >> 4, i = rho & 15; return 8 * (i >> 2) + 4 * n + (i & 3); }

__host__ __device__ __forceinline__ int g_tile_off(int r, int c) { return (c >> 5) * 16384 + ((r & ~63) + 16 * (r & 3) + ((r & 63) >> 2)) * 64 + (c & 31) * 2; }
constexpr unsigned G_TSTEP = 256u * 2816u * 2u;
struct Unit { int pm, pn; };
struct Gemm { const bf16_t* A; const bf16_t* Bt; int M, N, K; };

struct StaticOrder {
    int nM, nN, nwg, G, c;
    __host__ __device__ void init(int M, int N, int G_, int c_) { nM = M / BM; nN = N / BM; nwg = nM * nN; G = G_; c = c_; }
    __host__ __device__ bool next(int i, Unit& u) const {
        const long L = (long)i * G + c; if (L >= nwg) return false;
        int wgid = (int)L; { const int q = nwg / NXCD, r = nwg % NXCD, xcd = wgid % NXCD, off = wgid / NXCD; wgid = (xcd < r ? xcd * (q + 1) : r * (q + 1) + (xcd - r) * q) + off; }
        const int nig = WGM * nN, gid = wgid / nig, fm = gid * WGM, gsz = (nM - fm) < WGM ? (nM - fm) : WGM;
        u.pm = fm + ((wgid % nig) % gsz); u.pn = (wgid % nig) / gsz; return true;
    }
    __device__ __forceinline__ void a_ready(const Unit&) const {}
    __device__ __forceinline__ void done(const Unit&) const {}
};

__device__ __forceinline__ unsigned cvt_pk_bf16(float lo, float hi) { unsigned r; asm volatile("v_cvt_pk_bf16_f32 %0, %1, %2" : "=v"(r) : "v"(lo), "v"(hi)); return r; }
__device__ __forceinline__ unsigned cvt_pk_f16(float lo, float hi) { return (unsigned)__builtin_bit_cast(unsigned short, (_Float16)lo) | ((unsigned)__builtin_bit_cast(unsigned short, (_Float16)hi) << 16); }
typedef float f32x2 __attribute__((ext_vector_type(2)));
typedef unsigned u32x2 __attribute__((ext_vector_type(2)));
__device__ __forceinline__ u32x4 pack8_bf16(const f32x4 a, const f32x4 b) { u32x4 w; w.x = cvt_pk_bf16(a[0], a[1]); w.y = cvt_pk_bf16(a[2], a[3]); w.z = cvt_pk_bf16(b[0], b[1]); w.w = cvt_pk_bf16(b[2], b[3]); return w; }
__device__ __forceinline__ u32x4 pack8_f16(const f32x4 a, const f32x4 b) { u32x4 w; w.x = cvt_pk_f16(a[0], a[1]); w.y = cvt_pk_f16(a[2], a[3]); w.z = cvt_pk_f16(b[0], b[1]); w.w = cvt_pk_f16(b[2], b[3]); return w; }

__device__ __forceinline__ float fq_sum(float v) {
    { const auto r = __builtin_amdgcn_permlane16_swap(__builtin_bit_cast(unsigned, v), __builtin_bit_cast(unsigned, v), false, false); const unsigned a = r[0], b = r[1]; v = __builtin_bit_cast(float, a) + __builtin_bit_cast(float, b); }
    { const auto r = __builtin_amdgcn_permlane32_swap(__builtin_bit_cast(unsigned, v), __builtin_bit_cast(unsigned, v), false, false); const unsigned a = r[0], b = r[1]; v = __builtin_bit_cast(float, a) + __builtin_bit_cast(float, b); }
    return v;
}
struct EpiProj {
    static constexpr bool PERM = true, AFTER_DRAIN = false, HAS_INIT = false;
    bf16_t *VP, *Q, *Kb, *Vb; _Float16 *QI, *KI; float* WI; const float* rope32; const float* rope16; const float *gq, *gk;
    __device__ __forceinline__ void operator()(const f32x4 (&acc)[2][2][4][2], const Unit& u, int wr, int wc, int fr, int fq) const {
        const int pn = u.pn, rowb = u.pm * BM + wr * 64 + fr;
        if (pn < 2) {
#pragma unroll
            for (int ai = 0; ai < 2; ++ai)
#pragma unroll
                for (int m = 0; m < 4; ++m) { bf16_t* rp = VP + (size_t)(rowb + ai * HALF + m * 16) * 512 + pn * 256 + wc * 32 + 8 * fq;
#pragma unroll
                    for (int bj = 0; bj < 2; ++bj) *(u32x4*)(rp + bj * HALF) = pack8_bf16(acc[ai][bj][m][0], acc[ai][bj][m][1]); }
        } else if (pn < 5) {
            if (pn == 4 && wc >= 2) {
#pragma unroll
                for (int ai = 0; ai < 2; ++ai)
#pragma unroll
                    for (int m = 0; m < 4; ++m) { bf16_t* rp = Vb + (size_t)(rowb + ai * HALF + m * 16) * 128 + 64 * (wc - 2) + 8 * fq;
#pragma unroll
                        for (int bj = 0; bj < 2; ++bj) *(u32x4*)(rp + bj * 32) = pack8_bf16(acc[ai][bj][m][0], acc[ai][bj][m][1]); }
            } else {
                const bool isk = (pn == 4); const float* g = isk ? gk : gq; const float osc = isk ? 1.0f : 0.18033688011112042f  ;
                f32x4 gv[2][2];
#pragma unroll
                for (int bj = 0; bj < 2; ++bj)
#pragma unroll
                    for (int n = 0; n < 2; ++n) gv[bj][n] = *(const f32x4*)(g + 32 * bj + 8 * fq + 4 * n);
                bf16_t* dst = isk ? (Kb + 64 * wc) : (Q + 64 * (4 * (pn - 2) + wc)); const int ld = isk ? 128 : 512;
#pragma unroll
                for (int ai = 0; ai < 2; ++ai) {
#pragma unroll
                  for (int mp = 0; mp < 4; mp += 2) {
                    f32x4 cs[2][4];
#pragma unroll
                    for (int m = 0; m < 2; ++m) { const int pos = (rowb + ai * HALF + (mp + m) * 16) & 2047; const f32x4* rp = (const f32x4*)(rope32 + (size_t)(pos * 32 + 8 * fq) * 2);
#pragma unroll
                        for (int j = 0; j < 4; ++j) cs[m][j] = rp[j]; }
                    float rstd[2];
#pragma unroll
                    for (int m = 0; m < 2; ++m) { float ss = 0.f;
#pragma unroll
                        for (int bj = 0; bj < 2; ++bj)
#pragma unroll
                            for (int n = 0; n < 2; ++n) { const f32x4 v = acc[ai][bj][mp + m][n]; ss += (v[0] * v[0] + v[1] * v[1]) + (v[2] * v[2] + v[3] * v[3]); }
                        ss = fq_sum(ss);
                        rstd[m] = __builtin_amdgcn_rsqf(ss * (1.0f / 64.0f) + 1e-6f); }
#pragma unroll
                    for (int m = 0; m < 2; ++m) { const int row = rowb + ai * HALF + (mp + m) * 16;
                        f32x4 o1[2], o2[2];
#pragma unroll
                        for (int n = 0; n < 2; ++n) { const f32x4 cs0 = cs[m][2 * n], cs1 = cs[m][2 * n + 1];
                            const f32x4 x1 = acc[ai][0][mp + m][n] * rstd[m] * gv[0][n], x2 = acc[ai][1][mp + m][n] * rstd[m] * gv[1][n];
                            const f32x4 c = (f32x4){cs0[0], cs0[2], cs1[0], cs1[2]}, s = (f32x4){cs0[1], cs0[3], cs1[1], cs1[3]};
                            o1[n] = (x1 * c - x2 * s) * osc; o2[n] = (x2 * c + x1 * s) * osc; }
                        bf16_t* op = dst + (size_t)row * ld + 8 * fq;
                        *(u32x4*)(op) = pack8_bf16(o1[0], o1[1]); *(u32x4*)(op + 32) = pack8_bf16(o2[0], o2[1]); }
                  }
                }
            }
        } else {
            const int hd = 2 * wc + (fq >> 1);
            if (pn == 6 && wc != 0) return;
            if (pn == 6 && hd == 1) {
                if (fq == 2) {
#pragma unroll
                    for (int ai = 0; ai < 2; ++ai)
#pragma unroll
                        for (int m = 0; m < 4; ++m) { float* wp = WI + (size_t)(rowb + ai * HALF + m * 16) * 8;
                            *(f32x4*)(wp) = acc[ai][0][m][0] * 0.0625f; *(f32x4*)(wp + 4) = acc[ai][0][m][1] * 0.0625f; }
                }
                return;
            }
            _Float16* dst = (pn == 5) ? (QI + 32 * hd) : KI; const int ld = (pn == 5) ? 256 : 32;
#pragma unroll
            for (int ai = 0; ai < 2; ++ai)
#pragma unroll
                for (int m = 0; m < 4; ++m) { const int row = rowb + ai * HALF + m * 16, pos = row & 2047;
                    const f32x4* rp = (const f32x4*)(rope16 + (size_t)(pos * 16 + 8 * (fq & 1)) * 2);
                    f32x4 o1[2], o2[2];
#pragma unroll
                    for (int n = 0; n < 2; ++n) { const f32x4 cs0 = rp[2 * n], cs1 = rp[2 * n + 1];
                        const f32x4 x1 = acc[ai][0][m][n], x2 = acc[ai][1][m][n];
                        const f32x4 c = (f32x4){cs0[0], cs0[2], cs1[0], cs1[2]}, s = (f32x4){cs0[1], cs0[3], cs1[1], cs1[3]};
                        o1[n] = x1 * c - x2 * s; o2[n] = x2 * c + x1 * s; }
                    _Float16* op = dst + (size_t)row * ld + 8 * (fq & 1);
                    *(u32x4*)(op) = pack8_f16(o1[0], o1[1]); *(u32x4*)(op + 16) = pack8_f16(o2[0], o2[1]); }
        }
    }
};

__device__ __forceinline__ f32x4 bf16lo_to_f32(const u32x2 w) { return (f32x4){__builtin_bit_cast(float, w.x << 16), __builtin_bit_cast(float, w.x & 0xffff0000u), __builtin_bit_cast(float, w.y << 16), __builtin_bit_cast(float, w.y & 0xffff0000u)}; }
struct EpiWout {
    static constexpr bool PERM = true, AFTER_DRAIN = false, HAS_INIT = true, NEXT_HOOK = false;
    const float* x; bf16_t* X1B; float* SS2;
    __device__ __forceinline__ void init(f32x4 (&acc)[2][2][4][2], const Unit& u, int wr, int wc, int fr, int fq) const {
        const int rowb = u.pm * BM + wr * 64 + fr, col0 = u.pn * BM + wc * 32 + 8 * fq;
#pragma unroll
        for (int ai = 0; ai < 2; ++ai)
#pragma unroll
            for (int m = 0; m < 4; ++m) { const size_t off = (size_t)(rowb + ai * HALF + m * 16) * 1024 + col0;
#pragma unroll
                for (int bj = 0; bj < 2; ++bj) { acc[ai][bj][m][0] = *(const f32x4*)(x + off + bj * HALF); acc[ai][bj][m][1] = *(const f32x4*)(x + off + bj * HALF + 4); } }
    }
    __device__ __forceinline__ void operator()(const f32x4 (&acc)[2][2][4][2], const Unit& u, int wr, int wc, int fr, int fq) const {
        const int rowb = u.pm * BM + wr * 64 + fr, col0 = u.pn * BM + wc * 32 + 8 * fq;
#pragma unroll
        for (int ai = 0; ai < 2; ++ai)
#pragma unroll
            for (int m = 0; m < 4; ++m) { const int row = rowb + ai * HALF + m * 16; const size_t off = (size_t)row * 1024 + col0; float ss = 0.f;
#pragma unroll
                for (int bj = 0; bj < 2; ++bj) { const f32x4 v0 = acc[ai][bj][m][0], v1 = acc[ai][bj][m][1];
                    ss += (v0[0] * v0[0] + v0[1] * v0[1]) + (v0[2] * v0[2] + v0[3] * v0[3]) + (v1[0] * v1[0] + v1[1] * v1[1]) + (v1[2] * v1[2] + v1[3] * v1[3]);
                    *(u32x4*)(X1B + off + bj * HALF) = pack8_bf16(v0, v1); }
                ss = fq_sum(ss);
                if (fq == 0) SS2[(size_t)row * 16 + 4 * u.pn + wc] = ss; }
    }
};
struct EpiDown {
    static constexpr bool PERM = true, AFTER_DRAIN = false, HAS_INIT = true, NEXT_HOOK = false;
    const bf16_t* X1B; float* out;
    __device__ __forceinline__ void init(f32x4 (&acc)[2][2][4][2], const Unit& u, int wr, int wc, int fr, int fq) const {
        const int rowb = u.pm * BM + wr * 64 + fr, col0 = u.pn * BM + wc * 32 + 8 * fq;
#pragma unroll
        for (int ai = 0; ai < 2; ++ai) {
            u32x4 hv[4][2];
#pragma unroll
            for (int m = 0; m < 4; ++m) { const size_t off = (size_t)(rowb + ai * HALF + m * 16) * 1024 + col0;
#pragma unroll
                for (int bj = 0; bj < 2; ++bj) hv[m][bj] = *(const u32x4*)(X1B + off + bj * HALF); }
#pragma unroll
            for (int m = 0; m < 4; ++m)
#pragma unroll
                for (int bj = 0; bj < 2; ++bj) { acc[ai][bj][m][0] = bf16lo_to_f32((u32x2){hv[m][bj].x, hv[m][bj].y}); acc[ai][bj][m][1] = bf16lo_to_f32((u32x2){hv[m][bj].z, hv[m][bj].w}); }
        }
    }
    __device__ __forceinline__ void operator()(const f32x4 (&acc)[2][2][4][2], const Unit& u, int wr, int wc, int fr, int fq) const {
        const int rowb = u.pm * BM + wr * 64 + fr, col0 = u.pn * BM + wc * 32 + 4 * fq;
#pragma unroll
        for (int ai = 0; ai < 2; ++ai)
#pragma unroll
            for (int m = 0; m < 4; ++m) { float* p = out + (size_t)(rowb + ai * HALF + m * 16) * 1024 + col0;
#pragma unroll
                for (int bj = 0; bj < 2; ++bj) { f32x4 a = acc[ai][bj][m][0], b = acc[ai][bj][m][1];
#pragma unroll
                    for (int e = 0; e < 4; ++e) { const auto r1 = __builtin_amdgcn_permlane16_swap(__float_as_uint(a[e]), __float_as_uint(b[e]), false, false);
                        const auto r2 = __builtin_amdgcn_permlane32_swap(r1[0], r1[1], false, false); a[e] = __uint_as_float(r2[0]); b[e] = __uint_as_float(r2[1]); }
                    *(f32x4*)(p + bj * HALF) = a; *(f32x4*)(p + bj * HALF + 16) = b; } }
    }
};
__device__ __forceinline__ float dpp_shr1(float v) {     return __builtin_bit_cast(float, __builtin_amdgcn_update_dpp(0, __builtin_bit_cast(int, v), 0x111, 0xf, 0xf, true)); }
template <class T> __device__ __forceinline__ void stg_u32(void* base, unsigned boff, const T v) { *(T*)((char*)base + boff) = v; }
struct EpiUp {
    static constexpr bool PERM = true, AFTER_DRAIN = false, HAS_INIT = false;
    const PG8_LAS float* tab; const PG8_LAS float* wtab; bf16_t* G; bf16_t* HF; bf16_t* HL; mutable int par;
    __device__ __forceinline__ void operator()(const f32x4 (&acc)[2][2][4][2], const Unit& u, int wr, int wc, int fr_, int fq_) const {
        int fr = fr_, fq = fq_; asm volatile("" : "+v"(fr), "+v"(fq));
        const unsigned cb = 32 * wc + 8 * fq, ncol = 128 * u.pn + cb;
        const PG8_LAS float* tb = tab + par * 256 + wr * 64 + 4 * fr; const PG8_LAS float* wt = wtab + par * 1024 + cb; par ^= 1;
#pragma unroll
        for (int ai = 0; ai < 2; ++ai) {
            const unsigned rg = u.pm * BM + ai * HALF + wr * 64, g64 = rg >> 6;
            const f32x4 rs = *(const PG8_LAS f32x4*)(tb + ai * HALF);
            u32x2 gp[2][4];
            u32x2 hp[2][2][2];
            const bool last_ = (fr == 15);
#pragma unroll
            for (int n = 0; n < 2; ++n) {
                f32x4 cg[4];
#pragma unroll
                for (int bj = 0; bj < 2; ++bj) {
                    const PG8_LAS f32x4* wq = (const PG8_LAS f32x4*)(wt + 128 * bj + 4 * n);
                    const f32x4 w0 = wq[0], w1 = wq[64], w2 = wq[128], bb = wq[192];
                    f32x4 uu[4];
#pragma unroll
                    for (int m = 0; m < 4; ++m) uu[m] = acc[ai][bj][m][n] * rs[m];
#pragma unroll
                    for (int r = 0; r < 2; ++r) { const f32x4 hv = last_ ? uu[2 + r] : uu[r]; hp[bj][r][n] = (u32x2){cvt_pk_bf16(hv[0], hv[1]), cvt_pk_bf16(hv[2], hv[3])}; }
                    f32x4 d2, d3;
#pragma unroll
                    for (int i = 0; i < 4; ++i) { d2[i] = dpp_shr1(uu[2][i]); d3[i] = dpp_shr1(uu[3][i]); }
                    f32x4 c[4];
                    c[0] = bb + w0 * d2 + w1 * d3 + w2 * uu[0];
                    c[1] = bb + w0 * d3 + w1 * uu[0] + w2 * uu[1];
                    c[2] = bb + w0 * uu[0] + w1 * uu[1] + w2 * uu[2];
                    c[3] = bb + w0 * uu[1] + w1 * uu[2] + w2 * uu[3];
#pragma unroll
                    for (int m = 0; m < 4; ++m) {
                        if (bj == 0) cg[m] = c[m];
                        else { f32x4 gsl;
#pragma unroll
                            for (int i = 0; i < 4; ++i) gsl[i] = __builtin_amdgcn_exp2f(-cg[m][i]);
                            gsl = gsl + 1.0f;
#pragma unroll
                            for (int i = 0; i < 4; ++i) gsl[i] = __builtin_amdgcn_rcpf(gsl[i]);
                            gsl = (cg[m] * gsl) * c[m];
                            gp[n][m] = (u32x2){cvt_pk_bf16(gsl[0], gsl[1]), cvt_pk_bf16(gsl[2], gsl[3])}; }
                    }
                }
            }
            if (fr == 0 || last_) { bf16_t* hb = last_ ? HL : HF;
#pragma unroll
                for (int bj = 0; bj < 2; ++bj)
#pragma unroll
                    for (int r = 0; r < 2; ++r) stg_u32<u32x4>(hb, ((g64 * 2u + r) * 5632u + u.pn * 256u + bj * 128u + cb) * 2u, (u32x4){hp[bj][r][0].x, hp[bj][r][0].y, hp[bj][r][1].x, hp[bj][r][1].y}); }
#pragma unroll
            for (int m = 0; m < 4; ++m)
                stg_u32<u32x4>(G, u.pm * G_TSTEP + (2u * u.pn + (wc >> 1)) * 32768u + (wc & 1) * 16384u + ((rg & 255u) + 16u * m + fr) * 64u + 16u * fq, (u32x4){gp[0][m].x, gp[0][m].y, gp[1][m].x, gp[1][m].y});
        }
    }
};
struct UpOrder : StaticOrder {
    const float* SS2; PG8_LAS float* tab; PG8_LAS float* wtab; const float* conv_w; const float* conv_b; int wv; mutable int par;
    __device__ __forceinline__ void a_ready(const Unit& u) const {
        const int t = wv * 64 + (int)__builtin_amdgcn_mbcnt_hi(~0u, __builtin_amdgcn_mbcnt_lo(~0u, 0u));
#pragma unroll
        for (int k = 0; k < 2; ++k) { const int idx = t + 512 * k, tap = idx >> 8, v = idx & 255, col = (v >> 7) * 2816 + 128 * u.pn + (v & 127);
            wtab[par * 1024 + idx] = (tap < 3 ? conv_w[tap * 5632 + col] : conv_b[col]) * ((v >> 7) ? 0.6931471805599453f : 1.4426950408889634f); }
        if (t < 256) { const f32x4* sp = (const f32x4*)(SS2 + (size_t)(u.pm * BM + t) * 16); const f32x4 a = sp[0], b = sp[1], c = sp[2], d = sp[3];
            const float s = (((a[0] + a[1]) + (a[2] + a[3])) + ((b[0] + b[1]) + (b[2] + b[3]))) + (((c[0] + c[1]) + (c[2] + c[3])) + ((d[0] + d[1]) + (d[2] + d[3])));
            tab[par * 256 + t] = __builtin_amdgcn_rsqf(s * (1.0f / 1024.0f) + 1e-6f); }
        par ^= 1;
    }
};

template <class Epi, class Sched, bool ALIGN_EPI = false, bool SP2 = false, bool ROWPERM = false, bool ATILE = false>
__device__ __forceinline__ void gemm_phase(PG8_LAS unsigned char* lds, const Gemm g, const Sched& S, const Epi& E, const int wv  , const bool use_pre = false, const GrpBar pre = GrpBar{nullptr, 0u, nullptr, false}  ) {
    int tid_ = wv * 64 + (int)__builtin_amdgcn_mbcnt_hi(~0u, __builtin_amdgcn_mbcnt_lo(~0u, 0u)); asm volatile("" : "+v"(tid_));
    const int tid = tid_, wid = __builtin_amdgcn_readfirstlane(tid >> 6), lane = tid & 63, wr = wid >> 2, wc = wid & 3, fr = lane & 15, fq = lane >> 4;
    const int K = g.K, nt = K / BK;
    unsigned voffA[2], voffB[2];
#pragma unroll
    for (int i = 0; i < 2; ++i) { int R, C; stage_rc(tid * 16 + i * 8192, R, C); const int Rb = Epi::PERM ? ((R & ~31) + perm32(R & 31)) : R;
        const int Ra = ROWPERM ? ((R & ~63) + 4 * (R & 15) + ((R >> 4) & 3)) : R;
        voffA[i] = ATILE ? (unsigned)g_tile_off(Ra, C) : (unsigned)(Ra * K + C) * 2u; voffB[i] = (unsigned)(Rb * K + C) * 2u; }
    const size_t kstep = (size_t)(BK * 2);
    const size_t hstep = (size_t)HALF * K * 2;
    const size_t tstep = 2 * hstep;
    const size_t kstepA = ATILE ? (size_t)32768 : kstep, hstepA = ATILE ? (size_t)8192 : hstep;
    const unsigned ldsw = (unsigned)wid * 1024u;
    const int aoff = lds_byte(wr * 64 + fr, fq * 8), boff = lds_byte(wc * 32 + fr, fq * 8);
#define PG8_SA(b, h) (((b) * 2 + (h)) * HTB)
#define PG8_SB(b, h) ((4 + (b) * 2 + (h)) * HTB)
#define PG8_STAGE(bufoff, gbase, voff) do { _Pragma("unroll") for (int _i = 0; _i < 2; ++_i) \
        __builtin_amdgcn_global_load_lds((const unsigned*)((const char*)(gbase) + (voff)[_i]), (PG8_LAS unsigned*)(lds + (bufoff) + ldsw + _i * 8192), 16, 0, 0); } while (0)
#define PG8_LDA(dst, b, h) do { _Pragma("unroll") for (int m = 0; m < 4; ++m) _Pragma("unroll") for (int k = 0; k < 2; ++k) dst[m][k] = *(const PG8_LAS bf16x8*)(lds + PG8_SA(b, h) + aoff + m * 2048 + k * 1024); } while (0)
#define PG8_LDB(dst, b, h) do { _Pragma("unroll") for (int n = 0; n < 2; ++n) _Pragma("unroll") for (int k = 0; k < 2; ++k) dst[n][k] = *(const PG8_LAS bf16x8*)(lds + PG8_SB(b, h) + boff + n * 2048 + k * 1024); } while (0)
#define PG8_MMA(ai, bj, At, Bt) do { __builtin_amdgcn_s_setprio(1); _Pragma("unroll") for (int m = 0; m < 4; ++m) _Pragma("unroll") for (int n = 0; n < 2; ++n) _Pragma("unroll") for (int k = 0; k < 2; ++k) \
        acc[ai][bj][m][n] = __builtin_amdgcn_mfma_f32_16x16x32_bf16(Bt[n][k], At[m][k], acc[ai][bj][m][n], 0, 0, 0); __builtin_amdgcn_s_setprio(0); } while (0)
#define PG8_WAIT_V(n) asm volatile("s_waitcnt vmcnt(" #n ")" ::: "memory")
#define PG8_WAIT_L(n) asm volatile("s_waitcnt lgkmcnt(" #n ")" ::: "memory")
#define PG8_BAR __builtin_amdgcn_s_barrier()
#define PG8_SCHED __builtin_amdgcn_sched_barrier(0)
    Unit cur, nxt; int ui = 0;
    if (!S.next(0, cur)) { if (use_pre) grp_barrier_wait(pre); return; }
    f32x4 acc[2][2][4][2];
    if constexpr (Epi::HAS_INIT) E.init(acc, cur, wr, wc, fr, fq);
    else {
#pragma unroll
    for (int a = 0; a < 2; ++a)
#pragma unroll
        for (int b = 0; b < 2; ++b)
#pragma unroll
            for (int m = 0; m < 4; ++m)
#pragma unroll
                for (int n = 0; n < 2; ++n) acc[a][b][m][n] = (f32x4){0.f, 0.f, 0.f, 0.f};
    }
    bf16x8 At[4][2], B0[2][2], B1[2][2];
    const char* cA = (const char*)g.A + (size_t)cur.pm * tstep; const char* cB = (const char*)g.Bt + (size_t)cur.pn * tstep;
    if constexpr (!SP2) S.a_ready(cur);
    if constexpr (SP2) {
        PG8_STAGE(PG8_SB(0, 0), cB, voffB); PG8_STAGE(PG8_SB(0, 1), cB + hstep, voffB);
        if (use_pre) grp_barrier_wait(pre);
        PG8_STAGE(PG8_SA(0, 0), cA, voffA); PG8_STAGE(PG8_SA(0, 1), cA + hstepA, voffA);
        S.a_ready(cur);
        if (wr == 1) PG8_BAR;
        PG8_WAIT_V(2); PG8_BAR;
        PG8_STAGE(PG8_SB(1, 0), cB + kstep, voffB); PG8_STAGE(PG8_SA(1, 0), cA + kstepA, voffA); PG8_STAGE(PG8_SB(1, 1), cB + hstep + kstep, voffB);
        PG8_WAIT_V(6); PG8_BAR;
    } else {
        if (use_pre) grp_barrier_wait(pre);
        PG8_STAGE(PG8_SB(0, 0), cB, voffB); PG8_STAGE(PG8_SA(0, 0), cA, voffA); PG8_STAGE(PG8_SB(0, 1), cB + hstep, voffB); PG8_STAGE(PG8_SA(0, 1), cA + hstepA, voffA);
        if (wr == 1) PG8_BAR;
        PG8_WAIT_V(4); PG8_BAR;
        PG8_STAGE(PG8_SB(1, 0), cB + kstep, voffB); PG8_STAGE(PG8_SA(1, 0), cA + kstepA, voffA); PG8_STAGE(PG8_SB(1, 1), cB + hstep + kstep, voffB);
        PG8_WAIT_V(6); PG8_BAR;
    }
    for (;;) {
        const bool has_next = S.next(ui + 1, nxt);
        const char* nA = has_next ? (const char*)g.A + (size_t)nxt.pm * tstep : cA; const char* nB = has_next ? (const char*)g.Bt + (size_t)nxt.pn * tstep : cB;
        for (int t = 0; t < nt; t += 2) {
            const bool last = (t == nt - 2);
            const char* a1 = cA + (size_t)(t + 1) * kstepA;
            const char* a2 = last ? nA : cA + (size_t)(t + 2) * kstepA; const char* b2 = last ? nB : cB + (size_t)(t + 2) * kstep;
            const char* a3 = a2 + kstepA; const char* b3 = b2 + kstep;
            if (last && has_next) S.a_ready(nxt);
            if constexpr (SP2) {
            PG8_LDB(B0, 0, 0); PG8_LDB(B1, 0, 1); PG8_SCHED; PG8_LDA(At, 0, 0); PG8_STAGE(PG8_SA(1, 1), a1 + hstepA, voffA);
            PG8_WAIT_V(8); PG8_WAIT_L(0); PG8_BAR; PG8_MMA(0, 0, At, B0); PG8_MMA(0, 1, At, B1); PG8_BAR; PG8_SCHED;
            PG8_LDA(At, 0, 1); PG8_STAGE(PG8_SB(0, 0), b2, voffB); PG8_STAGE(PG8_SB(0, 1), b2 + hstep, voffB); PG8_STAGE(PG8_SA(0, 0), a2, voffA);
            PG8_WAIT_V(8); PG8_WAIT_L(0); PG8_BAR; PG8_MMA(1, 0, At, B0); PG8_MMA(1, 1, At, B1); PG8_BAR; PG8_SCHED;
            PG8_LDB(B0, 1, 0); PG8_LDB(B1, 1, 1); PG8_SCHED; PG8_LDA(At, 1, 0); PG8_STAGE(PG8_SA(0, 1), a2 + hstepA, voffA);
            PG8_WAIT_V(8); PG8_WAIT_L(0); PG8_BAR; PG8_MMA(0, 0, At, B0); PG8_MMA(0, 1, At, B1); PG8_BAR; PG8_SCHED;
            PG8_LDA(At, 1, 1); PG8_STAGE(PG8_SB(1, 0), b3, voffB); PG8_STAGE(PG8_SB(1, 1), b3 + hstep, voffB); PG8_STAGE(PG8_SA(1, 0), a3, voffA);
            PG8_WAIT_V(8); PG8_WAIT_L(0); PG8_BAR; PG8_MMA(1, 0, At, B0); PG8_MMA(1, 1, At, B1); PG8_BAR; PG8_SCHED;
            } else {
            PG8_LDB(B0, 0, 0); PG8_SCHED; PG8_LDA(At, 0, 0); PG8_STAGE(PG8_SA(1, 1), a1 + hstepA, voffA);
            PG8_WAIT_L(8); PG8_BAR; PG8_WAIT_L(0); PG8_MMA(0, 0, At, B0); PG8_BAR; PG8_SCHED;
            PG8_LDB(B1, 0, 1); PG8_STAGE(PG8_SB(0, 0), b2, voffB);
            PG8_BAR; PG8_WAIT_L(0); PG8_MMA(0, 1, At, B1); PG8_BAR;
            PG8_LDA(At, 0, 1); PG8_STAGE(PG8_SA(0, 0), a2, voffA);
            PG8_BAR; PG8_WAIT_L(0); PG8_MMA(1, 0, At, B0); PG8_BAR; PG8_SCHED;
            PG8_STAGE(PG8_SB(0, 1), b2 + hstep, voffB);
            PG8_WAIT_V(6); PG8_BAR; PG8_MMA(1, 1, At, B1); PG8_BAR;
            PG8_LDB(B0, 1, 0); PG8_SCHED; PG8_LDA(At, 1, 0); PG8_STAGE(PG8_SA(0, 1), a2 + hstepA, voffA);
            PG8_WAIT_L(8); PG8_BAR; PG8_WAIT_L(0); PG8_MMA(0, 0, At, B0); PG8_BAR; PG8_SCHED;
            PG8_LDB(B1, 1, 1); PG8_STAGE(PG8_SB(1, 0), b3, voffB);
            PG8_BAR; PG8_WAIT_L(0); PG8_MMA(0, 1, At, B1); PG8_BAR;
            PG8_LDA(At, 1, 1); PG8_STAGE(PG8_SA(1, 0), a3, voffA);
            PG8_BAR; PG8_WAIT_L(0); PG8_MMA(1, 0, At, B0); PG8_BAR; PG8_SCHED;
            PG8_STAGE(PG8_SB(1, 1), b3 + hstep, voffB);
            PG8_WAIT_V(6); PG8_BAR; PG8_MMA(1, 1, At, B1); PG8_BAR;
            }
        }
        if constexpr (ALIGN_EPI) { if (wr == 0) PG8_BAR; }
        if constexpr (!Epi::AFTER_DRAIN) { E(acc, cur, wr, wc, fr, fq); S.done(cur); }
        if (!has_next) break;
        if constexpr (Epi::HAS_INIT) E.init(acc, nxt, wr, wc, fr, fq);
        else {
#pragma unroll
        for (int a = 0; a < 2; ++a)
#pragma unroll
            for (int b = 0; b < 2; ++b)
#pragma unroll
                for (int m = 0; m < 4; ++m)
#pragma unroll
                    for (int n = 0; n < 2; ++n) acc[a][b][m][n] = (f32x4){0.f, 0.f, 0.f, 0.f};
        }
        cur = nxt; cA = nA; cB = nB; ++ui;
        if constexpr (ALIGN_EPI) { if (wr == 1) PG8_BAR; }
    }
    PG8_WAIT_V(0);
    if constexpr (!ALIGN_EPI) { if (wr == 0) PG8_BAR; }
    PG8_BAR;
    if constexpr (Epi::AFTER_DRAIN) { E.fused(acc, cur, wr, wc, fr, fq, lds, wid, lane); S.done(cur); }
#undef PG8_SA
#undef PG8_SB
#undef PG8_STAGE
#undef PG8_LDA
#undef PG8_LDB
#undef PG8_MMA
#undef PG8_WAIT_V
#undef PG8_WAIT_L
#undef PG8_BAR
#undef PG8_SCHED
}
}

#include <hip/hip_bf16.h>
#include <cmath>
namespace attn_body {
using bf16=__hip_bfloat16;
using bf16x8=__attribute__((ext_vector_type(8)))short;
using s16x4=__attribute__((ext_vector_type(4)))short;
using f32x16=__attribute__((ext_vector_type(16)))float;
using u32x4=__attribute__((ext_vector_type(4)))unsigned;
constexpr int BATCH=8,NHEAD=8,SEQ=2048,D=64,QP=512,KP=128,OP=1024,OOFF=512;
constexpr int NW=8,QBLK=32,QB=QBLK*NW,KVBLK=64,NQB=SEQ/QB;
constexpr int ATTN_UNIT_ROWS=QB;
__device__ __forceinline__ int crow(int r,int hi){return (r&3)+8*(r>>2)+4*hi;}
#define SBAR() __builtin_amdgcn_sched_barrier(0)
__device__ __forceinline__ void cmask(f32x16&p0,f32x16&p1,int jb,int qrel,int hi){
  const float NEG=-INFINITY; int kb=64*jb+4*hi;
  #pragma unroll
  for(int r=0;r<16;++r){int kv=kb+(r&3)+8*(r>>2); if(kv>qrel)p0[r]=NEG; if(kv+32>qrel)p1[r]=NEG;}
}

constexpr int NSLOT=3, SLOTB=8192;
constexpr int LDS_K=0, LDS_V=NSLOT*SLOTB, LDS_WS=2*NSLOT*SLOTB, LDS_OST=LDS_WS+NW*64*4, LDS_BYTES=LDS_OST+NW*4096;
constexpr float C2=0.125f*1.4426950408889634f;
__device__ __forceinline__ void glds16(const void*gsrc,unsigned lds_dst){unsigned keep;
  asm volatile("s_mov_b32 %0, m0\n\ts_mov_b32 m0, %2\n\ts_nop 0\n\tglobal_load_lds_dwordx4 %1, off\n\ts_mov_b32 m0, %0":"=&s"(keep):"v"(gsrc),"s"(lds_dst):"memory");}
__device__ __forceinline__ float max3f(float a,float b,float c){float r;asm("v_max3_f32 %0, %1, %2, %3":"=v"(r):"v"(a),"v"(b),"v"(c));return r;}
__device__ __forceinline__ float max2f(float a,float b){float r;asm("v_max_f32_e32 %0, %1, %2":"=v"(r):"v"(a),"v"(b));return r;}
__device__ __forceinline__ float fadd_s(float a,float b){float r;asm("v_add_f32_e32 %0, %1, %2":"=v"(r):"v"(a),"v"(b));return r;}
__device__ __forceinline__ float fsub_s(float a,float b){float r;asm("v_sub_f32_e32 %0, %1, %2":"=v"(r):"v"(a),"v"(b));return r;}
typedef float f32x2_t __attribute__((ext_vector_type(2))); typedef __bf16 bf16x2_t __attribute__((ext_vector_type(2)));
__device__ __forceinline__ unsigned cvtpk_s(float lo,float hi){f32x2_t v={lo,hi};bf16x2_t b=__builtin_convertvector(v,bf16x2_t);return __builtin_bit_cast(unsigned,b);}
#define WAIT_BAR(N) asm volatile("s_waitcnt vmcnt(" #N ") lgkmcnt(0)\n\ts_barrier":::"memory")

__device__ __forceinline__ void qkt(f32x16&p0,f32x16&p1,const char*Kslot,const bf16x8*qr,const f32x16&negm,int r32,int hi){
  const char*kb=Kslot+hi*1024+r32*16;
  #pragma unroll
  for(int d0=0;d0<4;++d0){
    const bf16x8 b0=*reinterpret_cast<const bf16x8*>(kb+d0*2048);
    const bf16x8 b1=*reinterpret_cast<const bf16x8*>(kb+d0*2048+512);
    if(d0==0){p0=__builtin_amdgcn_mfma_f32_32x32x16_bf16(b0,qr[0],negm,0,0,0);p1=__builtin_amdgcn_mfma_f32_32x32x16_bf16(b1,qr[0],negm,0,0,0);}
    else{p0=__builtin_amdgcn_mfma_f32_32x32x16_bf16(b0,qr[d0],p0,0,0,0);p1=__builtin_amdgcn_mfma_f32_32x32x16_bf16(b1,qr[d0],p1,0,0,0);}}
}
typedef __attribute__((address_space(3))) const char* lds_cptr;
typedef short v4i16_t __attribute__((ext_vector_type(4)));
__device__ __forceinline__ void kload8(bf16x8*kf,lds_cptr kp){
  kf[0]=*(const __attribute__((address_space(3))) bf16x8*)(kp);      kf[1]=*(const __attribute__((address_space(3))) bf16x8*)(kp+512);
  kf[2]=*(const __attribute__((address_space(3))) bf16x8*)(kp+2048); kf[3]=*(const __attribute__((address_space(3))) bf16x8*)(kp+2560);
  kf[4]=*(const __attribute__((address_space(3))) bf16x8*)(kp+4096); kf[5]=*(const __attribute__((address_space(3))) bf16x8*)(kp+4608);
  kf[6]=*(const __attribute__((address_space(3))) bf16x8*)(kp+6144); kf[7]=*(const __attribute__((address_space(3))) bf16x8*)(kp+6656);
}
__device__ __forceinline__ void kload2(bf16x8*kf,lds_cptr kp,int j){ kf[2*j]=*(const __attribute__((address_space(3))) bf16x8*)(kp+j*2048); kf[2*j+1]=*(const __attribute__((address_space(3))) bf16x8*)(kp+j*2048+512); }
__device__ __forceinline__ s16x4 vtr(lds_cptr p){ return __builtin_bit_cast(s16x4,__builtin_amdgcn_ds_read_tr16_b64_v4i16((__attribute__((address_space(3))) v4i16_t*)p)); }
__device__ __forceinline__ float rowmax(const f32x16&p0,const f32x16&p1){
  float a=max3f(p0[0],p0[1],p1[0]),b=max3f(p0[2],p0[3],p1[1]);a=max3f(a,p1[2],p1[3]);
  #pragma unroll
  for(int r=4;r<16;r+=4){a=max3f(a,p0[r],p0[r+1]);b=max3f(b,p0[r+2],p0[r+3]);a=max3f(a,p1[r],p1[r+1]);b=max3f(b,p1[r+2],p1[r+3]);}
  const float m=max2f(a,b);
  auto rr=__builtin_amdgcn_permlane32_swap(__float_as_uint(m),__float_as_uint(m),false,false);
  return max2f(__uint_as_float(rr[0]),__uint_as_float(rr[1]));
}
__device__ __forceinline__ void pv(f32x16*o,int vb,bf16x8 pa0,bf16x8 pa1,bf16x8 pa2,bf16x8 pa3){
  #pragma unroll
  for(int d0=0;d0<2;++d0){s16x4 lo[4],hi[4];
    #pragma unroll
    for(int ks=0;ks<4;++ks){
      asm volatile("ds_read_b64_tr_b16 %0,%1 offset:%c2":"=&v"(lo[ks]):"v"(vb),"i"(d0*4096+ks*1024):"memory");
      asm volatile("ds_read_b64_tr_b16 %0,%1 offset:%c2":"=&v"(hi[ks]):"v"(vb),"i"(d0*4096+ks*1024+512):"memory");}
    asm volatile("s_waitcnt lgkmcnt(0)":::"memory");SBAR();
    #define PK(k) (bf16x8){lo[k][0],lo[k][1],lo[k][2],lo[k][3],hi[k][0],hi[k][1],hi[k][2],hi[k][3]}
    o[d0]=__builtin_amdgcn_mfma_f32_32x32x16_bf16(pa0,PK(0),o[d0],0,0,0);
    o[d0]=__builtin_amdgcn_mfma_f32_32x32x16_bf16(pa1,PK(1),o[d0],0,0,0);
    o[d0]=__builtin_amdgcn_mfma_f32_32x32x16_bf16(pa2,PK(2),o[d0],0,0,0);
    o[d0]=__builtin_amdgcn_mfma_f32_32x32x16_bf16(pa3,PK(3),o[d0],0,0,0);
    #undef PK
  }
}

#ifndef ATTN_STORE16
#define ATTN_STORE16(p,v) (*(u32x4*)(p)=(v))
#endif
template<int THRL> __device__ __forceinline__ void attn_unit(int b,int h,int qb,const bf16*Q,const bf16*__restrict__ K,const bf16*__restrict__ V,const unsigned long long*__restrict__ MASK,bf16*O,char*shm,const int wv){
  int tid_=wv*64+(int)__builtin_amdgcn_mbcnt_hi(~0u,__builtin_amdgcn_mbcnt_lo(~0u,0u)); asm volatile("":"+v"(tid_)); const int tid=tid_,lane=tid&63,r32=lane&31,hi=lane>>5; const int wid=__builtin_amdgcn_readfirstlane(tid>>6);
  const long rowbase=(long)b*SEQ; const int q0=qb*QB;
  const bf16*Qw=Q+(rowbase+q0+wid*QBLK)*QP+h*D;
  const bf16*Kh=K+rowbase*KP+(h>>2)*D,*Vh=V+rowbase*KP+(h>>2)*D;
  const unsigned lds0=(unsigned)(uintptr_t)shm;
  float*wsf=(float*)(shm+LDS_WS)+wid*64;
  const bf16*ksrc=Kh+(long)lane*KP+wid*8;
  const bf16*vsrc=Vh+(long)(16*(wid&3)+(lane>>2))*KP+(wid>>2)*32+(lane&3)*8;
  const unsigned kdst=lds0+LDS_K+wid*1024, vdst=lds0+LDS_V+wid*1024;
  #define DMA_K(t,slot) glds16(ksrc+(long)(t)*KVBLK*KP,(unsigned)__builtin_amdgcn_readfirstlane(kdst+(slot)))
  #define DMA_V(t,slot) glds16(vsrc+(long)(t)*KVBLK*KP,(unsigned)__builtin_amdgcn_readfirstlane(vdst+(slot)))
  const int vb0=(int)(lds0+LDS_V)+((lane>>4)&1)*32+(lane&3)*8+(4*hi+((lane&15)>>2))*64;
  const char*Kbase=shm+LDS_K; bf16x8 kf[8];
  const lds_cptr shm3=(lds_cptr)shm; const lds_cptr kp0=shm3+LDS_K+hi*1024+r32*16; const lds_cptr vp0=shm3+LDS_V+((lane>>4)&1)*32+(lane&3)*8+(4*hi+((lane&15)>>2))*64;
  const int NT=(q0+QB)/KVBLK;
  DMA_K(0,0);DMA_V(0,0);DMA_K(1,SLOTB);
  bf16x8 qr[4];
  #pragma unroll
  for(int d0=0;d0<4;++d0)qr[d0]=*reinterpret_cast<const bf16x8*>(&Qw[(long)r32*QP+d0*16+hi*8]);
  float l_reg=0.f;f32x16 o[2];o[0]=f32x16{};o[1]=f32x16{};const f32x16 negm=f32x16{};
  const int qrel=wid*QBLK+r32;
  const unsigned long long*mrow=MASK+(rowbase+q0+qrel)*(SEQ/64);
  unsigned long long mk=mrow[0];
  #define MKSH(WL,WH,t) unsigned WL=(unsigned)mk>>(4*hi), WH=(unsigned)(mk>>32)>>(4*hi); asm volatile("":"+v"(WL),"+v"(WH)); mk=mrow[(t)+1]
  #define CMASKW(P0,P1,WL,WH) do{ _Pragma("unroll") for(int r=0;r<16;++r){ const int ps_=(r&3)+8*(r>>2); const float a_=P0[r], b_=P1[r]; \
      const unsigned m0_=(unsigned)__builtin_amdgcn_sbfe((int)WL,ps_,1), m1_=(unsigned)__builtin_amdgcn_sbfe((int)WH,ps_,1); \
      const unsigned ua_=(__builtin_bit_cast(unsigned,a_)&m0_)|(0xff800000u&~m0_), ub_=(__builtin_bit_cast(unsigned,b_)&m1_)|(0xff800000u&~m1_); \
      P0[r]=__builtin_bit_cast(float,ua_); P1[r]=__builtin_bit_cast(float,ub_); } }while(0)
  #define START(P0,P1) do{ _Pragma("unroll") for(int r=0;r<16;++r)P0[r]=__builtin_amdgcn_exp2f(P0[r]); }while(0)
  #define RESC() do{}while(0)
  f32x16 pA0,pA1,pB0,pB1;
  int sl_prev=0,sl_cur=0,sl_next=SLOTB;
  #define ROT() do{sl_prev=sl_cur;sl_cur=sl_next;sl_next=(sl_next==(NSLOT-1)*SLOTB)?0:sl_next+SLOTB;}while(0)
  DMA_K(2,2*SLOTB);
  WAIT_BAR(3);
  qkt(pA0,pA1,Kbase,qr,negm,r32,hi);asm volatile("s_nop 15\n\ts_nop 7":"+v"(pA0),"+v"(pA1));{MKSH(wl0_,wh0_,0);CMASKW(pA0,pA1,wl0_,wh0_);}
  START(pA0,pA1);
  _Pragma("unroll") for(int r=0;r<16;++r)pA1[r]=__builtin_amdgcn_exp2f(pA1[r]);
  WAIT_BAR(0);
  DMA_K(3,0);DMA_V(1,SLOTB);
  ROT();
  kload8(kf,kp0+sl_cur);
  WAIT_BAR(2);
  s16x4 vlo[8],vhi[8]; u32x4 pw0,pw1,pw2,pw3;
  #define PKW(P,B) cvtpk_s(P[B],P[B+1])
  #define PAF(k) __builtin_bit_cast(bf16x8,pw##k)
  #define VFR(i) (bf16x8){vlo[i][0],vlo[i][1],vlo[i][2],vlo[i][3],vhi[i][0],vhi[i][1],vhi[i][2],vhi[i][3]}
  #define PIN(x) asm volatile("":"+v"(x))
  #define MX3(a,b,c) __builtin_fmaxf(__builtin_fmaxf((a),(b)),(c))
  #define GAPA(MF,A0,A1,A2,A3,W0,W1,PW) do{ MF; sacc+=A0; sacc+=A1; sacc+=A2; sacc+=A3; PIN(sacc); W0; W1; PIN(PW); SBAR(); }while(0)
  #define EX(v) __builtin_amdgcn_exp2f(v)
  #define GAPB(MF,X,B) do{ MF; X[B]=EX(X[B]); X[B+1]=EX(X[B+1]); X[B+2]=EX(X[B+2]); X[B+3]=EX(X[B+3]); PIN(X); SBAR(); }while(0)
  #define VRD(i) do{ vlo[i]=vtr(vp_+(((i)>>2)*4096+((i)&3)*1024)); vhi[i]=vtr(vp_+(((i)>>2)*4096+((i)&3)*1024+512)); }while(0)
  #define KRD(G,j) do{ if(G){ kload2(kf,kp0+sl_next,j); SBAR(); } }while(0)
  #define STEP(C0,C1,P0,P1,t,GK,GV,GL) do{ SBAR(); \
    const lds_cptr vp_=vp0+sl_prev; \
    VRD(0); SBAR(); float sacc=(P0[0]+P0[1]); \
    GAPA(C0=__builtin_amdgcn_mfma_f32_32x32x16_bf16(kf[0],qr[0],negm,0,0,0), P0[2],P0[3],P0[4],P0[5],     pw0[0]=PKW(P0,0), pw0[1]=PKW(P0,2), pw0); \
    VRD(4); SBAR(); GAPA(C1=__builtin_amdgcn_mfma_f32_32x32x16_bf16(kf[1],qr[0],negm,0,0,0), P0[6],P0[7],P0[8],P0[9],     pw0[2]=PKW(P0,4), pw0[3]=PKW(P0,6), pw0); \
    VRD(1); SBAR(); GAPA(C0=__builtin_amdgcn_mfma_f32_32x32x16_bf16(kf[2],qr[1],C0,0,0,0),   P0[10],P0[11],P0[12],P0[13], pw1[0]=PKW(P0,8), pw1[1]=PKW(P0,10), pw1); \
    VRD(5); SBAR(); GAPA(C1=__builtin_amdgcn_mfma_f32_32x32x16_bf16(kf[3],qr[1],C1,0,0,0),   P0[14],P0[15],P1[0],P1[1],   pw1[2]=PKW(P0,12),pw1[3]=PKW(P0,14), pw1); \
    VRD(2); SBAR(); GAPA(C0=__builtin_amdgcn_mfma_f32_32x32x16_bf16(kf[4],qr[2],C0,0,0,0),   P1[2],P1[3],P1[4],P1[5],     pw2[0]=PKW(P1,0), pw2[1]=PKW(P1,2), pw2); \
    VRD(6); SBAR(); GAPA(C1=__builtin_amdgcn_mfma_f32_32x32x16_bf16(kf[5],qr[2],C1,0,0,0),   P1[6],P1[7],P1[8],P1[9],     pw2[2]=PKW(P1,4), pw2[3]=PKW(P1,6), pw2); \
    VRD(3); SBAR(); GAPA(C0=__builtin_amdgcn_mfma_f32_32x32x16_bf16(kf[6],qr[3],C0,0,0,0),   P1[10],P1[11],P1[12],P1[13], pw3[0]=PKW(P1,8), pw3[1]=PKW(P1,10), pw3); \
    VRD(7); SBAR(); GAPA(C1=__builtin_amdgcn_mfma_f32_32x32x16_bf16(kf[7],qr[3],C1,0,0,0),   P1[14],P1[15],0.f,0.f,       pw3[2]=PKW(P1,12),pw3[3]=PKW(P1,14), pw3); \
    l_reg+=sacc; \
    MKSH(wl_,wh_,t); \
    if(GK){DMA_K((t)+3,sl_cur);} if(GV){DMA_V((t)+1,sl_next);} \
    CMASKW(C0,C1,wl_,wh_); \
    SBAR(); \
    GAPB(o[0]=__builtin_amdgcn_mfma_f32_32x32x16_bf16(PAF(0),VFR(0),o[0],0,0,0), C0,0); \
    GAPB(o[1]=__builtin_amdgcn_mfma_f32_32x32x16_bf16(PAF(0),VFR(4),o[1],0,0,0), C0,4); \
    KRD(GL,0); GAPB(o[0]=__builtin_amdgcn_mfma_f32_32x32x16_bf16(PAF(1),VFR(1),o[0],0,0,0), C0,8); \
    KRD(GL,1); GAPB(o[1]=__builtin_amdgcn_mfma_f32_32x32x16_bf16(PAF(1),VFR(5),o[1],0,0,0), C0,12); \
    KRD(GL,2); GAPB(o[0]=__builtin_amdgcn_mfma_f32_32x32x16_bf16(PAF(2),VFR(2),o[0],0,0,0), C1,0); \
    KRD(GL,3); GAPB(o[1]=__builtin_amdgcn_mfma_f32_32x32x16_bf16(PAF(2),VFR(6),o[1],0,0,0), C1,4); \
    GAPB(o[0]=__builtin_amdgcn_mfma_f32_32x32x16_bf16(PAF(3),VFR(3),o[0],0,0,0), C1,8); \
    GAPB(o[1]=__builtin_amdgcn_mfma_f32_32x32x16_bf16(PAF(3),VFR(7),o[1],0,0,0), C1,12); \
    }while(0)
  int t=1;
  for(;t+5<NT;t+=2){
    STEP(pB0,pB1,pA0,pA1,t,true,true,true);     WAIT_BAR(2); RESC(); ROT();
    STEP(pA0,pA1,pB0,pB1,t+1,true,true,true);   WAIT_BAR(2); RESC(); ROT();
  }
  #define ENDW(tt) do{ if((tt)+3<NT){WAIT_BAR(2);} else if((tt)+2<NT){WAIT_BAR(1);} else {WAIT_BAR(0);} }while(0)
  for(;t+1<NT;t+=2){
    STEP(pB0,pB1,pA0,pA1,t,(t+3<NT),(t+1<NT),(t+1<NT));       ENDW(t);   RESC(); ROT();
    STEP(pA0,pA1,pB0,pB1,t+1,(t+4<NT),(t+2<NT),(t+2<NT));     ENDW(t+1); RESC(); ROT();
  }
  STEP(pB0,pB1,pA0,pA1,NT-1,false,false,false); RESC();
  { float sacc=pB0[0]+pB0[1]; _Pragma("unroll") for(int r=2;r<16;++r)sacc+=pB0[r]; _Pragma("unroll") for(int r=0;r<16;++r)sacc+=pB1[r]; l_reg+=sacc;
    pw0=(u32x4){PKW(pB0,0),PKW(pB0,2),PKW(pB0,4),PKW(pB0,6)};pw1=(u32x4){PKW(pB0,8),PKW(pB0,10),PKW(pB0,12),PKW(pB0,14)};pw2=(u32x4){PKW(pB1,0),PKW(pB1,2),PKW(pB1,4),PKW(pB1,6)};pw3=(u32x4){PKW(pB1,8),PKW(pB1,10),PKW(pB1,12),PKW(pB1,14)};
    SBAR(); pv(o,vb0+sl_cur,PAF(0),PAF(1),PAF(2),PAF(3)); }
  #undef PKW
  #undef PAF
  #undef VFR
  #undef PIN
  #undef MX3
  #undef GAPA
  #undef GAPB
  #undef EX
  #undef VRD
  #undef KRD
  #undef STEP
  #undef ENDW
  {auto rr=__builtin_amdgcn_permlane32_swap(__float_as_uint(l_reg),__float_as_uint(l_reg),false,false);l_reg=__uint_as_float(rr[0])+__uint_as_float(rr[1]);}
  if(hi==0)wsf[32+r32]=l_reg;asm volatile("s_waitcnt lgkmcnt(0)":::"memory");
  float rli[16];
  #pragma unroll
  for(int r=0;r<16;++r)rli[r]=__builtin_amdgcn_rcpf(wsf[32+crow(r,hi)]);
  bf16*Ow=O+(rowbase+q0+wid*QBLK)*OP+OOFF+h*D;
  { bf16*stg=(bf16*)(shm+LDS_OST)+wid*2048;
    #pragma unroll
    for(int r=0;r<16;++r){const int orow=crow(r,hi);
      #pragma unroll
      for(int d0=0;d0<2;++d0)stg[orow*64+d0*32+r32]=__float2bfloat16(o[d0][r]*rli[r]);}
    asm volatile("s_waitcnt lgkmcnt(0)":::"memory");
    #pragma unroll
    for(int i=0;i<4;++i){const int row=i*8+(lane>>3),ch=lane&7; const u32x4 v=*(const u32x4*)(stg+row*64+ch*8); ATTN_STORE16(Ow+(long)row*OP+ch*8,v);} }
  asm volatile("s_waitcnt lgkmcnt(0)\n\ts_barrier":::"memory");
  #undef DMA_K
  #undef DMA_V
  #undef CMASKW
  #undef MKSH
  #undef START
  #undef RESC
  #undef ROT
}
constexpr int ATTN_LDS_BYTES=LDS_BYTES;
struct AttnTensors { const bf16* Q; const bf16* K; const bf16* V; const unsigned long long* MASK; bf16* O; };
struct AttnUnit { int bh; int qb; };
struct StaticOrder {
  int vcu,G;
  __device__ __forceinline__ explicit StaticOrder(int grid,int block):vcu((grid%8==0)?(block%8)*(grid/8)+block/8:block),G(grid){}
  __device__ __forceinline__ bool next(int i,AttnUnit&u)const{ const int it=vcu+(i>>1)*G; if(it>=BATCH*NHEAD*4)return false; const int s=it&3; u.bh=it>>2; u.qb=(i&1)?7-s:s; return true; }
  __device__ __forceinline__ void a_ready(const AttnUnit&)const{}
  __device__ __forceinline__ void done(const AttnUnit&)const{}
};
template<class Sched,int THRL=8> __device__ __forceinline__ void attn_phase(char*lds,const AttnTensors&T,const Sched&S,const int wv){
  AttnUnit u;
  for(int i=0;S.next(i,u);++i){ S.a_ready(u); attn_unit<THRL>(u.bh/NHEAD,u.bh%NHEAD,u.qb,T.Q,T.K,T.V,T.MASK,T.O,lds,wv); S.done(u); }
}
#undef SBAR
#undef WAIT_BAR
}

#ifndef REPS
#define REPS {1, 1, 1, 1, 1, 1, 1, 1}
#endif
constexpr int kReps[8] = REPS;
#ifndef SREPS
#define SREPS {1, 1, 1, 1, 1, 1, 1, 1}
#endif
constexpr int kSub[8] = SREPS;
typedef _Float16 f16x8 __attribute__((ext_vector_type(8)));
typedef float f32x16 __attribute__((ext_vector_type(16)));
__device__ __forceinline__ unsigned score_key(float s) { const unsigned u = __builtin_bit_cast(unsigned, s + 0.0f); return u ^ ((unsigned)((int)u >> 31) | 0x80000000u); }
__device__ __forceinline__ float key_score(unsigned k) { return __builtin_bit_cast(float, (k & 0x80000000u) ? (k & 0x7fffffffu) : ~k); }
__device__ __forceinline__ float wave_sum_f32(float v) {
    v += __builtin_bit_cast(float, __builtin_amdgcn_update_dpp(0, __builtin_bit_cast(int, v), 0xb1, 0xf, 0xf, false));
    v += __builtin_bit_cast(float, __builtin_amdgcn_update_dpp(0, __builtin_bit_cast(int, v), 0x4e, 0xf, 0xf, false));
    v += __builtin_bit_cast(float, __builtin_amdgcn_update_dpp(0, __builtin_bit_cast(int, v), 0x141, 0xf, 0xf, false));
    v += __builtin_bit_cast(float, __builtin_amdgcn_update_dpp(0, __builtin_bit_cast(int, v), 0x140, 0xf, 0xf, false));
    return __builtin_bit_cast(float, __builtin_amdgcn_readlane(__builtin_bit_cast(int, v), 0)) + __builtin_bit_cast(float, __builtin_amdgcn_readlane(__builtin_bit_cast(int, v), 16))
         + __builtin_bit_cast(float, __builtin_amdgcn_readlane(__builtin_bit_cast(int, v), 32)) + __builtin_bit_cast(float, __builtin_amdgcn_readlane(__builtin_bit_cast(int, v), 48));
}
__device__ __forceinline__ int wave_sum_i32(int v) {
    v += __builtin_amdgcn_update_dpp(0, v, 0xb1, 0xf, 0xf, false);
    v += __builtin_amdgcn_update_dpp(0, v, 0x4e, 0xf, 0xf, false);
    v += __builtin_amdgcn_update_dpp(0, v, 0x141, 0xf, 0xf, false);
    v += __builtin_amdgcn_update_dpp(0, v, 0x140, 0xf, 0xf, false);
    return __builtin_amdgcn_readlane(v, 0) + __builtin_amdgcn_readlane(v, 16) + __builtin_amdgcn_readlane(v, 32) + __builtin_amdgcn_readlane(v, 48);
}
__device__ __forceinline__ void count_ge8(unsigned& cnt, unsigned cand, unsigned k0, unsigned k1, unsigned k2, unsigned k3, unsigned k4, unsigned k5, unsigned k6, unsigned k7) {
    unsigned long long m0, m1, m2, m3;
    asm volatile(
        "v_cmp_ge_u32_e64 %1, %5, %13\n\tv_cmp_ge_u32_e64 %2, %6, %13\n\tv_cmp_ge_u32_e64 %3, %7, %13\n\tv_cmp_ge_u32_e64 %4, %8, %13\n\t"
        "v_addc_co_u32_e64 %0, vcc, 0, %0, %1\n\tv_cmp_ge_u32_e64 %1, %9, %13\n\t"
        "v_addc_co_u32_e64 %0, vcc, 0, %0, %2\n\tv_cmp_ge_u32_e64 %2, %10, %13\n\t"
        "v_addc_co_u32_e64 %0, vcc, 0, %0, %3\n\tv_cmp_ge_u32_e64 %3, %11, %13\n\t"
        "v_addc_co_u32_e64 %0, vcc, 0, %0, %4\n\tv_cmp_ge_u32_e64 %4, %12, %13\n\t"
        "v_addc_co_u32_e64 %0, vcc, 0, %0, %1\n\tv_addc_co_u32_e64 %0, vcc, 0, %0, %2\n\tv_addc_co_u32_e64 %0, vcc, 0, %0, %3\n\tv_addc_co_u32_e64 %0, vcc, 0, %0, %4"
        : "+v"(cnt), "=&s"(m0), "=&s"(m1), "=&s"(m2), "=&s"(m3)
        : "v"(k0), "v"(k1), "v"(k2), "v"(k3), "v"(k4), "v"(k5), "v"(k6), "v"(k7), "s"(cand) : "vcc");
}
#define IDX_REP8(X, o) X((o) + 0) X((o) + 1) X((o) + 2) X((o) + 3) X((o) + 4) X((o) + 5) X((o) + 6) X((o) + 7)
template <int NREG>
__device__ __forceinline__ void indexer_task_n(int b, int t0, const f16_t* __restrict__ QI, const f16_t* __restrict__ KI, const float* __restrict__ WI, unsigned long long* __restrict__ MASK, int lane) {
    const int r32 = lane & 31, hi = lane >> 5; const size_t rowb = (size_t)b * SEQ;
    const f16_t* qp = QI + (rowb + t0 + (r32 >> 3)) * 256 + 32 * (r32 & 7) + 8 * hi;
    const f16x8 a0 = *(const f16x8*)(qp), a1 = *(const f16x8*)(qp + 16);
    f32x4 wv[4];
#pragma unroll
    for (int q = 0; q < 4; ++q) wv[q] = *(const f32x4*)(WI + (rowb + t0 + q) * 8 + 4 * hi);
    const int nst = (t0 + 3) / 64 + 1;
    const f16_t* kp = KI + (rowb + r32) * 32 + 8 * hi;
    unsigned key[4][NREG];
    f16x8 bq[3][4];
#pragma unroll
    for (int i = 0; i < 4; ++i) bq[0][i] = *(const f16x8*)(kp + (i >> 1) * 1024 + (i & 1) * 16);
    if (1 < nst) {
#pragma unroll
        for (int i = 0; i < 4; ++i) bq[1][i] = *(const f16x8*)(kp + (size_t)2048 + (i >> 1) * 1024 + (i & 1) * 16); }
#pragma unroll
    for (int st = 0; st < NREG; ++st) {
        if (st < nst) {
            if (st + 2 < NREG && st + 2 < nst) {
#pragma unroll
                for (int i = 0; i < 4; ++i) bq[(st + 2) % 3][i] = *(const f16x8*)(kp + (size_t)(st + 2) * 2048 + (i >> 1) * 1024 + (i & 1) * 16);
            }
            const f32x16 z16 = (f32x16){0.f, 0.f, 0.f, 0.f, 0.f, 0.f, 0.f, 0.f, 0.f, 0.f, 0.f, 0.f, 0.f, 0.f, 0.f, 0.f};
            f32x16 c0 = __builtin_amdgcn_mfma_f32_32x32x16_f16(a0, bq[st % 3][0], z16, 0, 0, 0);
            c0 = __builtin_amdgcn_mfma_f32_32x32x16_f16(a1, bq[st % 3][1], c0, 0, 0, 0);
            f32x16 c1 = __builtin_amdgcn_mfma_f32_32x32x16_f16(a0, bq[st % 3][2], z16, 0, 0, 0);
            c1 = __builtin_amdgcn_mfma_f32_32x32x16_f16(a1, bq[st % 3][3], c1, 0, 0, 0);
#pragma unroll
            for (int q = 0; q < 4; ++q) {
                float r0[4], r1[4];
#pragma unroll
                for (int i = 0; i < 4; ++i) { const float x0 = c0[4 * q + i], x1 = c1[4 * q + i]; const int i0 = __builtin_bit_cast(int, x0), i1 = __builtin_bit_cast(int, x1);
                    r0[i] = __builtin_bit_cast(float, i0 > 0 ? i0 : 0); r1[i] = __builtin_bit_cast(float, i1 > 0 ? i1 : 0); }
                const pg8::f32x2 w01 = (pg8::f32x2){wv[q][0], wv[q][1]}, w23 = (pg8::f32x2){wv[q][2], wv[q][3]};
                pg8::f32x2 sa = (pg8::f32x2){r0[0], r0[1]} * w01, sb = (pg8::f32x2){r1[0], r1[1]} * w01;
                sa = __builtin_elementwise_fma((pg8::f32x2){r0[2], r0[3]}, w23, sa); sb = __builtin_elementwise_fma((pg8::f32x2){r1[2], r1[3]}, w23, sb);
                const float pa = sa[0] + sa[1], pb = sb[0] + sb[1];
                const auto rr = __builtin_amdgcn_permlane32_swap(__builtin_bit_cast(unsigned, pa), __builtin_bit_cast(unsigned, pb), false, false);
                const unsigned rr0 = rr[0], rr1 = rr[1];
                const float sc = __builtin_bit_cast(float, rr0) + __builtin_bit_cast(float, rr1);
                key[q][st] = __builtin_bit_cast(unsigned, sc + 0.0f);
            }
        } else {
#pragma unroll
            for (int q = 0; q < 4; ++q) key[q][st] = 0u;
        }
    }
    const int t0u = __builtin_amdgcn_readfirstlane(t0), nstu = (t0u + 3) / 64 + 1;
    bool small_[4]; unsigned eq[4], gt[4]; int CG[4];
#pragma unroll
    for (int q = 0; q < 4; ++q) { small_[q] = (t0u + q < TOPK); gt[q] = 0u; CG[q] = small_[q] ? TOPK : 0;
        { const int nv_ = (lane <= t0u + q) ? ((t0u + q - lane) >> 6) + 1 : 0; eq[q] = small_[q] ? 0u : (nv_ >= 32 ? 0xffffffffu : ((1u << nv_) - 1u)); }
        if (!small_[q]) {
#define IDX_PSTAGE(J, SA, SB) _Pragma("unroll") for (int k = 0; k < 32; ++k) if ((k & J) == 0) { const unsigned a_ = key[q][k], b_ = key[q][k + J]; key[q][k] = __builtin_amdgcn_perm(b_, a_, SA); key[q][k + J] = __builtin_amdgcn_perm(b_, a_, SB); if ((k & 3) == 3) __builtin_amdgcn_sched_barrier(0); }
#define IDX_TSTAGE(J, MK) _Pragma("unroll") for (int k = 0; k < 32; ++k) if ((k & J) == 0) { const unsigned a_ = key[q][k], b_ = key[q][k + J]; \
                key[q][k] = (a_ & ~(MK << J)) | ((b_ << J) & (MK << J)); key[q][k + J] = (b_ & ~MK) | ((a_ >> J) & MK); if ((k & 3) == 3) __builtin_amdgcn_sched_barrier(0); }
            IDX_PSTAGE(16, 0x05040100u, 0x07060302u) IDX_PSTAGE(8, 0x06020400u, 0x07030501u) IDX_TSTAGE(4, 0x0f0f0f0fu) IDX_TSTAGE(2, 0x33333333u) IDX_TSTAGE(1, 0x55555555u)
#undef IDX_TSTAGE
#undef IDX_PSTAGE
        } }
#pragma unroll
    for (int b = 31; b >= 0; --b) {
        if (CG[0] == TOPK && CG[1] == TOPK && CG[2] == TOPK && CG[3] == TOPK) break;
        unsigned tb[4], c[4];
#pragma unroll
        for (int q = 0; q < 4; ++q) { unsigned sg_ = key[q][31]; asm volatile("" : "+v"(sg_));
            tb[q] = eq[q] & (b == 31 ? ~sg_ : (key[q][b] ^ sg_)); c[q] = (unsigned)__builtin_popcount(tb[q]); }
        const int s01 = wave_sum_i32((int)(c[0] | (c[1] << 16))), s23 = wave_sum_i32((int)(c[2] | (c[3] << 16)));
        const int tot[4] = {CG[0] + (s01 & 0xffff), CG[1] + (s01 >> 16), CG[2] + (s23 & 0xffff), CG[3] + (s23 >> 16)};
#pragma unroll
        for (int q = 0; q < 4; ++q) { const bool ge = tot[q] >= TOPK, ex = tot[q] == TOPK;
            const unsigned m1 = (!ge || ex) ? 0xffffffffu : 0u, ncm = ge ? 0u : 0xffffffffu;
            gt[q] |= tb[q] & m1; eq[q] = tb[q] ^ (eq[q] & ncm); CG[q] = (ge && !ex) ? CG[q] : tot[q]; }
    }
#define IDX_PUTW(bal, st) do { const unsigned long long b_ = (bal); asm volatile("s_nop 1\n\tv_writelane_b32 %0, %2, %4\n\tv_writelane_b32 %1, %3, %4" : "+v"(wlo), "+v"(whi) : "s"((unsigned)b_), "s"((unsigned)(b_ >> 32)), "n"(st));     } while (0)
#pragma unroll
    for (int q = 0; q < 4; ++q) {
        const int t = t0 + q; unsigned wlo = 0u, whi = 0u;
        if (t < TOPK) {
#define IDX_X(st) IDX_PUTW(__ballot(64 * (st) + lane <= t), st);
            IDX_REP8(IDX_X, 0)
#undef IDX_X
        } else {
            const bool ex = (CG[q] == TOPK); const unsigned gsel = gt[q], ties = eq[q]; int need = TOPK - CG[q];
            const unsigned long long lt = (1ull << lane) - 1ull;
#define IDX_X(st) { bool sel_ = (gsel >> (st)) & 1u; \
                    if (!ex) { const bool tie_ = (ties >> (st)) & 1u; const unsigned long long tb_ = __ballot(tie_); sel_ = sel_ || (tie_ && __popcll(tb_ & lt) < need); need -= __popcll(tb_); if (need < 0) need = 0; } \
                    IDX_PUTW(__ballot(sel_), st); }
            if (ex) {
                unsigned g = gsel;
#define IDX_XE(st) { unsigned long long bal_; asm volatile("v_add_co_u32_e64 %0, %1, %0, %0" : "+v"(g), "=s"(bal_)); IDX_PUTW(bal_, st); }
#define IDX_XE8(o) IDX_XE((o) + 7) IDX_XE((o) + 6) IDX_XE((o) + 5) IDX_XE((o) + 4) IDX_XE((o) + 3) IDX_XE((o) + 2) IDX_XE((o) + 1) IDX_XE((o) + 0)
                if (NREG > 24 && nst > 24) { IDX_XE8(24) } else g <<= 8;
                if (NREG > 16 && nst > 16) { IDX_XE8(16) } else g <<= 8;
                if (NREG > 8 && nst > 8) { IDX_XE8(8) } else g <<= 8;
                IDX_XE8(0)
#undef IDX_XE8
#undef IDX_XE
            } else {
            IDX_REP8(IDX_X, 0)
            if (NREG > 8 && nst > 8) { IDX_REP8(IDX_X, 8) }
            if (NREG > 16 && nst > 16) { IDX_REP8(IDX_X, 16) }
            if (NREG > 24 && nst > 24) { IDX_REP8(IDX_X, 24) }
            }
#undef IDX_X
        }
        if (lane < 32) MASK[(rowb + t) * 32 + lane] = (unsigned long long)wlo | ((unsigned long long)whi << 32);
    }
#undef IDX_PUTW
}
#undef IDX_REP8

constexpr int NWAVES = 8;
constexpr int RING_OFF = 0, RING_BYTES = 131072;
constexpr int LDSCTL_OFF = RING_BYTES, MISC_OFF = LDSCTL_OFF + 320;
constexpr int LDS_BYTES = 147456;
constexpr int TAB_OFF = MISC_OFF + 128;
constexpr int WTAB_OFF = TAB_OFF + 2048;
static_assert(WTAB_OFF + 8192 <= LDS_BYTES, "LDS map");
constexpr int N_PHASES = 8;

struct Args { const float* in[13]; float* out; unsigned char* ws; int ph_lo, ph_hi, li, pad; };

__device__ __forceinline__ void p0_transpose_item(const float* W, int K, int N, bf16_t* WT, int Nv, int mode, const float* kscale, LAS float* scr, int item, int lane) {
    const int nblk = Nv / 32, kb = item / nblk, nb = item % nblk, k0 = 64 * kb, n0 = 32 * nb;
    const int v = n0 + (lane & 31); const int a = mode == 0 ? v : (mode == 1 ? win_actual(v) : wup_actual(v));
    float vals[32];
    const float* wp = W + (size_t)(k0 + (lane >> 5)) * N + (a >= 0 ? a : 0);
#pragma unroll
    for (int i = 0; i < 32; ++i) vals[i] = wp[(size_t)(2 * i) * N];
#pragma unroll
    for (int i = 0; i < 32; ++i) { const int kk = 2 * i + (lane >> 5); float val = (a >= 0) ? vals[i] : 0.f;
        if (kscale) val *= kscale[k0 + kk];
        scr[kk * 33 + (lane & 31)] = val; }
    LDS_WAIT(); asm volatile("" ::: "memory");
    const int c = lane & 7;
#pragma unroll
    for (int j = 0; j < 4; ++j) { const int n = (lane >> 3) + 8 * j; const LAS float* s = scr + (8 * c) * 33 + n;
        v4u o; o.x = pk2(s[0 * 33], s[1 * 33]); o.y = pk2(s[2 * 33], s[3 * 33]); o.z = pk2(s[4 * 33], s[5 * 33]); o.w = pk2(s[6 * 33], s[7 * 33]);
        *(GAS v4u*)(WT + (size_t)(n0 + n) * K + k0 + 8 * c) = o; }
    LDS_WAIT(); asm volatile("" ::: "memory");
}

__global__ void __launch_bounds__(NWAVES * 64, 2) mk_fwd(Args args) {
    extern __shared__ __attribute__((aligned(16))) unsigned char lds[];
    LAS unsigned char* L = (LAS unsigned char*)lds;
    volatile LAS unsigned* MISC = (volatile LAS unsigned*)(L + MISC_OFF);
    const int wave = __builtin_amdgcn_readfirstlane((int)threadIdx.x >> 6);
#define MK_IDS const int lane = mk_lane(), tid = wave * 64 + lane; (void)tid
    const int G = gridDim.x; const int bx = blockIdx.x; const int vcu = (G % 8 == 0) ? (bx % 8) * (G / 8) + bx / 8 : bx;
    unsigned char* ws = args.ws;
    gu32* ctl = (gu32*)(ws + WS_CTL);
    const float* x = args.in[0]; const float* norm1_g = args.in[1]; const float* w_in = args.in[2]; const float* q_norm_g = args.in[3]; const float* k_norm_g = args.in[4];
    const float* w_out = args.in[7]; const float* norm2_g = args.in[8]; const float* w_up = args.in[9]; const float* conv_w = args.in[10]; const float* conv_b = args.in[11]; const float* w_down = args.in[12];
    float* out = args.out;
    float* ROPE = (float*)(ws + WS_ROPE); float* ROPE16 = (float*)(ws + WS_ROPE16);
    bf16_t *Win = (bf16_t*)(ws + WS_WIN), *Wout = (bf16_t*)(ws + WS_WOUT), *Wup = (bf16_t*)(ws + WS_WUP), *Wdn = (bf16_t*)(ws + WS_WDN);
    float* SS2 = (float*)(ws + WS_SS2);
    bf16_t *XN = (bf16_t*)(ws + WS_XN), *VP = (bf16_t*)(ws + WS_VP), *Q = (bf16_t*)(ws + WS_Q), *Kb = (bf16_t*)(ws + WS_K), *Vb = (bf16_t*)(ws + WS_V);
    f16_t *QI = (f16_t*)(ws + WS_QI), *KI = (f16_t*)(ws + WS_KI); float* WI = (float*)(ws + WS_WI);
    bf16_t *MIX = (bf16_t*)(ws + WS_MIX), *Gb = (bf16_t*)(ws + WS_G);
    bf16_t *HF = (bf16_t*)(ws + WS_HF), *HL = (bf16_t*)(ws + WS_HL);
    unsigned long long* MASK = (unsigned long long*)(ws + WS_MASK); const float* pool_w = args.in[5]; const float* pool_scale = args.in[6];

    for (int u = (int)threadIdx.x; u < (LDS_BYTES - LDSCTL_OFF) / 4; u += NWAVES * 64) ((LAS unsigned*)(L + LDSCTL_OFF))[u] = 0u;
    __syncthreads();
    if (threadIdx.x == 0) __hip_atomic_store((unsigned*)ctl + CW_XCCT + bx, 1u + xb_xcc_id(), __ATOMIC_RELAXED, __HIP_MEMORY_SCOPE_AGENT);
    const int ngrp = (G == 256) ? 8 : 1, grp = bx % ngrp, gsz = G / ngrp, member = vcu % gsz;
    GrpBar gbar{(unsigned*)ctl + CW_GRP + 64 * grp, (unsigned)gsz, MISC + 8, wave == 0};
    XcdBarrier bar = xcd_barrier_post((unsigned*)(ctl + CW_BAR) + args.li * XCD_BAR_WORDS, MISC + 8); bar.w0 = (wave == 0);
    const int lo = args.ph_lo, hi = args.ph_hi;
#define IN(k) (lo <= (k) && (k) < hi)
#define SEAM(k) do { if (IN(k) && IN((k) + 1)) { if ((k) == 0) xcd_barrier(bar); else grp_barrier(gbar); } } while (0)
    const int gw = vcu * NWAVES + wave, NGW = G * NWAVES;

    if (IN(0)) for (int rep_ = 0; rep_ < kReps[0]; ++rep_) { if (rep_) xcd_barrier(bar);
        MK_IDS;
        LAS float* scr = (LAS float*)(L + RING_OFF + wave * 16384);
        constexpr int I_IN = (D_MODEL / 64) * (IN_WV / 32), I_OUT = (D_MODEL / 64) * (D_MODEL / 32), I_UP = (D_MODEL / 64) * (UP_W / 32), I_DN = (DFF / 64) * (D_MODEL / 32);
        for (int sr_ = 0; sr_ < kSub[1]; ++sr_)
        for (int item = vcu; item < 4 * (D_MODEL / 16); item += G) {
            const int g = item >> 6, n0 = 16 * (item & 63);
            LAS float* pwL = (LAS float*)(L + RING_OFF); LAS float* woL = pwL + 128 * 132;
#pragma unroll
            for (int k = 0; k < 8; ++k) { const int idx = tid + 512 * k, c = idx >> 5, d4 = idx & 31;
                *(LAS f32x4*)(pwL + c * 132 + 4 * d4) = *(const f32x4*)(pool_w + (size_t)(128 * g + c) * 128 + 4 * d4); }
            { const int d = tid >> 2, q = tid & 3; *(LAS f32x4*)(woL + d * 16 + 4 * q) = *(const f32x4*)(w_out + (size_t)(128 * g + d) * D_MODEL + n0 + 4 * q) * pool_scale[128 * g + d]; }
            __syncthreads();
            const int c = tid & 127, nq = wave >> 1;
            f32x4 acc4 = (f32x4){0.f, 0.f, 0.f, 0.f};
#pragma unroll 8
            for (int d4 = 0; d4 < 32; ++d4) { const f32x4 p = *(const LAS f32x4*)(pwL + c * 132 + 4 * d4);
#pragma unroll
                for (int i = 0; i < 4; ++i) acc4 += p[i] * *(const LAS f32x4*)(woL + (4 * d4 + i) * 16 + 4 * nq); }
#pragma unroll
            for (int j = 0; j < 4; ++j) Wout[(size_t)(n0 + 4 * nq + j) * D_MODEL + 128 * g + c] = (bf16_t)f2bf(acc4[j]);
            __syncthreads();
        }
        for (int sr_ = 0; sr_ < kSub[0]; ++sr_)
        for (int it = gw; it < I_IN + I_OUT + I_UP + I_DN; it += NGW) {
            int r = it;
            if (r < I_IN) { p0_transpose_item(w_in, D_MODEL, IN_W, Win, IN_WV, 1, nullptr, scr, r, lane); continue; } r -= I_IN;
            if (r < I_OUT) { if (r >= 8 * (D_MODEL / 32)) p0_transpose_item(w_out, D_MODEL, D_MODEL, Wout, D_MODEL, 0, nullptr, scr, r, lane); continue; } r -= I_OUT;
            if (r < I_UP) { p0_transpose_item(w_up, D_MODEL, UP_W, Wup, UP_W, 2, norm2_g, scr, r, lane); continue; } r -= I_UP;
            p0_transpose_item(w_down, DFF, D_MODEL, Wdn, D_MODEL, 0, nullptr, scr, r, lane);
        }
        for (int sr_ = 0; sr_ < kSub[2]; ++sr_)
        for (int i = vcu * NWAVES * 64 + tid; i < SEQ * 48; i += G * NWAVES * 64) {
            int pos, k; float inv; float* dst;
            if (i < SEQ * 32) { pos = i >> 5; k = i & 31; inv = expf(-logf(10000.0f) * (float)k / 32.0f); dst = ROPE + 2 * i; }
            else { const int i2 = i - SEQ * 32; pos = i2 >> 4; k = i2 & 15; inv = expf(-logf(10000.0f) * (float)k / 16.0f); dst = ROPE16 + 2 * i2; }
            float s, c; sincosf((float)pos * inv, &s, &c); dst[0] = c; dst[1] = s;
        }
        if (IN(1)) xcd_barrier_arrive(bar);
        for (int sr_ = 0; sr_ < kSub[3]; ++sr_)
        for (int mj = member * NWAVES + wave; mj < M / 4 / ngrp; mj += gsz * NWAVES) { const int m4 = grp * (M / 4 / ngrp) + mj;
            f32x4 v[4][4]; float ssq[4];
#pragma unroll
            for (int r = 0; r < 4; ++r) { const GAS f32x4* xr = (const GAS f32x4*)(x + (size_t)(4 * m4 + r) * D_MODEL) + 2 * lane;
#pragma unroll
                for (int j = 0; j < 2; ++j) { v[r][2 * j] = xr[128 * j]; v[r][2 * j + 1] = xr[128 * j + 1]; } }
#pragma unroll
            for (int r = 0; r < 4; ++r) { float s = 0.f;
#pragma unroll
                for (int j = 0; j < 4; ++j) s += (v[r][j].x * v[r][j].x + v[r][j].y * v[r][j].y) + (v[r][j].z * v[r][j].z + v[r][j].w * v[r][j].w);
                ssq[r] = wave_sum_f32(s); }
#pragma unroll
            for (int r = 0; r < 4; ++r) { const float rstd = 1.0f / sqrtf(ssq[r] * (1.0f / D_MODEL) + EPS);
                GAS v4u* o16 = (GAS v4u*)(XN + (size_t)(4 * m4 + r) * D_MODEL) + lane;
#pragma unroll
                for (int j = 0; j < 2; ++j) { const f32x4 g0 = ((const f32x4*)norm1_g)[2 * lane + 128 * j], g1 = ((const f32x4*)norm1_g)[2 * lane + 128 * j + 1]; const f32x4 a = v[r][2 * j], c = v[r][2 * j + 1];
                    v4u o; o.x = pk2(a.x * rstd * g0.x, a.y * rstd * g0.y); o.y = pk2(a.z * rstd * g0.z, a.w * rstd * g0.w); o.z = pk2(c.x * rstd * g1.x, c.y * rstd * g1.y); o.w = pk2(c.z * rstd * g1.z, c.w * rstd * g1.w);
                    o16[64 * j] = o; } }
        }
    }
    if (IN(0) && IN(1)) xcd_barrier_wait(bar);
    if (wave == 0) {
        const int l = mk_lane(); const unsigned mine = __hip_atomic_load((unsigned*)ctl + CW_XCCT + bx, __ATOMIC_RELAXED, __HIP_MEMORY_SCOPE_AGENT);
        bool ok = (ngrp == 8) && mine != 0u;
        for (int m = l; m < gsz; m += 64) ok = ok && (__hip_atomic_load((unsigned*)ctl + CW_XCCT + grp + ngrp * m, __ATOMIC_RELAXED, __HIP_MEMORY_SCOPE_AGENT) == mine);
        const bool same = __all(ok);
        if (l == 0) MISC[10] = same ? 2u : 1u;
    }
    if (IN(0) && IN(1)) grp_barrier_arrive(gbar);
    if (IN(1)) for (int rep_ = 0; rep_ < kReps[1]; ++rep_) { if (rep_) xcd_barrier(bar);
        pg8::Gemm g{XN, Win, M, IN_WV, D_MODEL}; pg8::StaticOrder S; S.init(M, IN_WV, G, bx);
        pg8::EpiProj E{VP, Q, Kb, Vb, QI, KI, WI, ROPE, ROPE16, q_norm_g, k_norm_g};
        pg8::gemm_phase<pg8::EpiProj, pg8::StaticOrder, true, true>(L + RING_OFF, g, S, E, wave, IN(0) && IN(1) && rep_ == 0, gbar);
    }
    SEAM(1);
    if (IN(2)) for (int rep_ = 0; rep_ < kReps[2]; ++rep_) { if (rep_) xcd_barrier(bar);
        MK_IDS;
        for (int sr_ = 0; sr_ < kSub[5]; ++sr_)
        for (int id = gw; id < M / 4; id += NGW) {
            const int w = id & 2047, bb = w >> 8, tq = (id < 2048) ? (w & 255) : 511 - (w & 255);
            indexer_task_n<32>(bb, 4 * tq, QI, KI, WI, MASK, lane);
        }
    }
    if (IN(2) && IN(3)) { grp_barrier_arrive(gbar);
        { MK_IDS;
        for (int sr_ = 0; sr_ < kSub[4]; ++sr_)
        for (int wj = member * NWAVES + wave; wj < M / 4 / ngrp; wj += gsz * NWAVES) { const int wi = grp * (M / 4 / ngrp) + wj;
            const int row = 4 * wi + (lane >> 4), t = row & (SEQ - 1);
            const bf16_t* vp = VP + (size_t)row * POOL_W + 8 * (lane & 15);
            v4u u2[2], u4[4], u8[8], u16[16];
#define POOL_LD(U, W, g) _Pragma("unroll") for (int k = 0; k < W; ++k) U[k] = *(const v4u*)(vp + 128 * (g) - (size_t)((k <= t) ? k : 0) * POOL_W);
            POOL_LD(u2, 2, 0) POOL_LD(u4, 4, 1) POOL_LD(u8, 8, 2) POOL_LD(u16, 16, 3)
#undef POOL_LD
#define POOL_OUT(U, W, g) do { float sum[8], v0[8]; \
                _Pragma("unroll") for (int e = 0; e < 8; ++e) sum[e] = 0.f; \
                _Pragma("unroll") for (int k = 0; k < W; ++k) { const float m_ = (k <= t) ? 1.f : 0.f; const unsigned uu[4] = {U[k].x, U[k].y, U[k].z, U[k].w}; \
                    _Pragma("unroll") for (int e = 0; e < 4; ++e) { const float lo = __builtin_bit_cast(float, uu[e] << 16), hh = __builtin_bit_cast(float, uu[e] & 0xffff0000u); sum[2 * e] += m_ * lo; sum[2 * e + 1] += m_ * hh; \
                        if (k == 0) { v0[2 * e] = lo; v0[2 * e + 1] = hh; } } } \
                const float rc = 1.0f / (float)((t + 1 < W) ? t + 1 : W); \
                v4u o; o.x = pk2(sum[0] * rc - v0[0], sum[1] * rc - v0[1]); o.y = pk2(sum[2] * rc - v0[2], sum[3] * rc - v0[3]); o.z = pk2(sum[4] * rc - v0[4], sum[5] * rc - v0[5]); o.w = pk2(sum[6] * rc - v0[6], sum[7] * rc - v0[7]); \
                *(v4u*)(MIX + (size_t)row * 1024 + 128 * (g) + 8 * (lane & 15)) = o; } while (0)
            POOL_OUT(u2, 2, 0); POOL_OUT(u4, 4, 1); POOL_OUT(u8, 8, 2); POOL_OUT(u16, 16, 3);
#undef POOL_OUT
        }
        }
        grp_barrier_wait(gbar); }
    if (IN(3)) for (int rep_ = 0; rep_ < kReps[3]; ++rep_) { if (rep_) xcd_barrier(bar);
        const attn_body::AttnTensors AT{(const attn_body::bf16*)Q, (const attn_body::bf16*)Kb, (const attn_body::bf16*)Vb, MASK, (attn_body::bf16*)MIX};
        const attn_body::StaticOrder S((int)G, (int)bx);
        attn_body::attn_phase<attn_body::StaticOrder>((char*)lds + RING_OFF, AT, S, wave);
    }
    if (IN(3) && IN(4)) grp_barrier_arrive(gbar);
    if (IN(4)) for (int rep_ = 0; rep_ < kReps[4]; ++rep_) { if (rep_) xcd_barrier(bar);
        pg8::Gemm g{MIX, Wout, M, D_MODEL, D_MODEL}; pg8::StaticOrder S; S.init(M, D_MODEL, G, bx);
        pg8::EpiWout E{x, XN, SS2};
        pg8::gemm_phase<pg8::EpiWout, pg8::StaticOrder, true, true>(L + RING_OFF, g, S, E, wave, IN(3) && IN(4) && rep_ == 0, gbar);
    }
    if (IN(4) && IN(5)) grp_barrier_arrive(gbar);
    if (IN(5)) for (int rep_ = 0; rep_ < kReps[5]; ++rep_) { if (rep_) xcd_barrier(bar);
        pg8::Gemm g{XN, Wup, M, UP_W, D_MODEL}; pg8::UpOrder S; S.init(M, UP_W, G, bx); S.SS2 = SS2; S.tab = (LAS float*)(L + TAB_OFF); S.wtab = (LAS float*)(L + WTAB_OFF); S.conv_w = conv_w; S.conv_b = conv_b; S.wv = wave; S.par = 0;
        pg8::EpiUp E{(const LAS float*)(L + TAB_OFF), (const LAS float*)(L + WTAB_OFF), Gb, HF, HL, 0};
        pg8::gemm_phase<pg8::EpiUp, pg8::UpOrder, true, true, true>(L + RING_OFF, g, S, E, wave, IN(4) && IN(5) && rep_ == 0, gbar);
    }
    SEAM(5);
    if (IN(6)) for (int rep_ = 0; rep_ < kReps[6]; ++rep_) { if (rep_) xcd_barrier(bar);
        MK_IDS;
        for (int il = member * NWAVES * 64 + tid; il < (256 / ngrp) * 2 * (DFF / 4); il += gsz * NWAVES * 64) { const int idx = grp * ((256 / ngrp) * 2 * (DFF / 4)) + il;
            const int n4 = idx % (DFF / 4), gj = idx / (DFF / 4), j = gj & 1, g64 = gj >> 1, n = 4 * n4;
            const int vg = 256 * (n >> 7) + (n & 127);
            f32x4 cc[2];
#pragma unroll
            for (int bj = 0; bj < 2; ++bj) { const int v = vg + 128 * bj;
#define HLD(P, r) ({ const unsigned long long w_ = *(const unsigned long long*)((P) + (size_t)(r) * UP_W + v); (f32x4){__builtin_bit_cast(float, (unsigned)w_ << 16), __builtin_bit_cast(float, (unsigned)w_ & 0xffff0000u), __builtin_bit_cast(float, (unsigned)(w_ >> 32) << 16), __builtin_bit_cast(float, (unsigned)(w_ >> 32) & 0xffff0000u)}; })
                const f32x4 f0 = HLD(HF, g64 * 2 + 0), f1 = HLD(HF, g64 * 2 + 1);
                f32x4 l0 = (f32x4){0.f, 0.f, 0.f, 0.f}, l1 = l0;
                if (g64 & 31) { l0 = HLD(HL, (g64 - 1) * 2 + 0); l1 = HLD(HL, (g64 - 1) * 2 + 1); }
#undef HLD
                const f32x4 um2 = j ? l1 : l0, um1 = j ? f0 : l1, u0 = j ? f1 : f0;
                const float* wp = conv_w + bj * DFF + n;
                cc[bj] = *(const f32x4*)(conv_b + bj * DFF + n) + *(const f32x4*)(wp) * um2 + *(const f32x4*)(wp + UP_W) * um1 + *(const f32x4*)(wp + 2 * UP_W) * u0; }
            float gs[4];
#pragma unroll
            for (int i = 0; i < 4; ++i) { const float gt = cc[0][i]; gs[i] = gt / (1.0f + __expf(-gt)) * cc[1][i]; }
            unsigned long long w = (unsigned long long)pk2(gs[0], gs[1]) | ((unsigned long long)pk2(gs[2], gs[3]) << 32);
            { const int r_ = 64 * g64 + j; *(unsigned long long*)((char*)Gb + (size_t)(r_ >> 8) * pg8::G_TSTEP + (size_t)(n >> 6) * 32768 + pg8::g_tile_off(r_ & 255, n & 63)) = w; }
        }
    }
    if (IN(6) && IN(7)) grp_barrier_arrive(gbar);
    if (IN(7)) {
        pg8::Gemm g{Gb, Wdn, M, D_MODEL, DFF}; pg8::StaticOrder S; S.init(M, D_MODEL, G, bx);
        pg8::EpiDown E{XN, out};
        pg8::gemm_phase<pg8::EpiDown, pg8::StaticOrder, true, true, false, true>(L + RING_OFF, g, S, E, wave, IN(6) && IN(7), gbar);
    }
#undef IN
#undef SEAM
}

static int mk_grid() {
    static int grid = 0;
    if (grid == 0) {
        int dev = 0, cus = 0, per_cu = 0;
        if (hipGetDevice(&dev) != hipSuccess || hipDeviceGetAttribute(&cus, hipDeviceAttributeMultiprocessorCount, dev) != hipSuccess) { fprintf(stderr, "kernel_launch: device query failed\n"); grid = -1; return grid; }
        if (hipFuncSetAttribute((const void*)mk_fwd, hipFuncAttributeMaxDynamicSharedMemorySize, LDS_BYTES) != hipSuccess) { fprintf(stderr, "kernel_launch: hipFuncSetAttribute failed\n"); grid = -1; return grid; }
        if (hipOccupancyMaxActiveBlocksPerMultiprocessor(&per_cu, (const void*)mk_fwd, NWAVES * 64, LDS_BYTES) != hipSuccess || per_cu < 1) { fprintf(stderr, "kernel_launch: occupancy query reports %d workgroups per CU\n", per_cu); (void)hipGetLastError(); }
        grid = cus;
    }
    return grid;
}
static void mk_launch(Args a, int lo, int hi, int li, hipStream_t stream) {
    const int grid = mk_grid(); if (grid <= 0) return;
    a.ph_lo = lo; a.ph_hi = hi; a.li = li;
    hipLaunchKernelGGL(mk_fwd, dim3(grid), dim3(NWAVES * 64), LDS_BYTES, stream, a);
}

extern "C" void kernel_launch(void* const* d_in, const int* in_sizes, int n_in, void* d_out, int out_size, void* d_ws, size_t ws_size, hipStream_t stream) {
    const float* pool_w = (const float*)d_in[5]; const float* pool_scale = (const float*)d_in[6];
    unsigned char* ws = (unsigned char*)d_ws;
    bf16_t *VP = (bf16_t*)(ws + WS_VP), *Q = (bf16_t*)(ws + WS_Q), *Kb = (bf16_t*)(ws + WS_K), *Vb = (bf16_t*)(ws + WS_V);
    f16_t *QI = (f16_t*)(ws + WS_QI), *KI = (f16_t*)(ws + WS_KI); float* WI = (float*)(ws + WS_WI);
    unsigned long long* MASK = (unsigned long long*)(ws + WS_MASK); bf16_t* MIX = (bf16_t*)(ws + WS_MIX);
    (void)hipMemsetAsync(ws + WS_CTL, 0, CTL_ZERO_BYTES, stream);
    Args a{};
    for (int i = 0; i < 13; ++i) a.in[i] = (const float*)d_in[i];
    a.out = (float*)d_out; a.ws = ws;
    mk_launch(a, 0, N_PHASES, 0, stream);
}
```
